# Optimizing an MI355X kernel written in HIP

```python
import jax, jax.numpy as jnp
from jax import lax
import numpy as np

D_MODEL = 1024
BATCH = 16
SEQ = 4096
DEPTH = 2

GRID_W = 64
HEAD_DIM = 64
ROPE_THETA = 10000.0
EPS = 1e-6
Q_BLOCK = 128
NEG = -1e30

MLA_HEADS = 8
MLA_Q_RANK = 256
MLA_KV_RANK = 128
MLA_NOPE = 64
MLA_ROPE = 32
MLA_V = 64
GQA_HEADS = 8
GQA_KV_HEADS = 2
EVEN_SPLITS = tuple(int(v) for v in np.cumsum([MLA_Q_RANK, MLA_KV_RANK, MLA_ROPE,
                                                GQA_HEADS * HEAD_DIM, GQA_KV_HEADS * HEAD_DIM]))
EVEN_IN = EVEN_SPLITS[-1] + GQA_KV_HEADS * HEAD_DIM
EVEN_MIX = MLA_HEADS * MLA_V + GQA_HEADS * HEAD_DIM
DIL_HEADS = D_MODEL // HEAD_DIM
DIL_PATTERNS = ((128, 1), (512, 4), (2048, 16))
DIL_BLOCK = 64
D_FF = 2816
N_EXPERTS = 8
TOP_K = 2
D_FF_EXPERT = 3584
MOE_BLOCK = 256
N_EVEN = (DEPTH + 1) // 2
N_ODD = DEPTH // 2

kernel_name = "hybrid_mla_axialgqa_dilated_moe_encoder"


def rmsnorm(x, g):
    x32 = x.astype(jnp.float32)
    y = x32 * lax.rsqrt(jnp.mean(x32 * x32, axis=-1, keepdims=True) + EPS)
    return (y * g.astype(jnp.float32)).astype(x.dtype)


def modulate(x, g, shift, scale):
    return rmsnorm(x, g) * (1.0 + scale[:, None, :]) + shift[:, None, :]


def rope(x, pos):
    dh = x.shape[-1]
    inv = ROPE_THETA ** (-jnp.arange(0, dh, 2, dtype=jnp.float32) / dh)
    ang = pos.astype(jnp.float32)[:, None] * inv[None, :]
    cos = jnp.cos(ang)[None, :, None, :]
    sin = jnp.sin(ang)[None, :, None, :]
    x1, x2 = jnp.split(x.astype(jnp.float32), 2, axis=-1)
    return jnp.concatenate([x1 * cos - x2 * sin, x1 * sin + x2 * cos], axis=-1).astype(x.dtype)


def axial_rope(x, row_idx, col_idx):
    half = x.shape[-1] // 2
    return jnp.concatenate([rope(x[..., :half], row_idx), rope(x[..., half:], col_idx)], axis=-1)


def blocked_attention(q, k, v):
    B, S, H, dq = q.shape
    Hk = k.shape[2]
    R = H // Hk
    dv = v.shape[-1]
    nblk = S // Q_BLOCK
    qb = q.reshape(B, nblk, Q_BLOCK, Hk, R, dq).transpose(1, 0, 2, 3, 4, 5)
    scale = dq ** -0.5

    def one_block(qblk):
        s = jnp.einsum('bqgrd,bkgd->bgrqk', qblk, k, preferred_element_type=jnp.float32) * scale
        p = jax.nn.softmax(s, axis=-1).astype(v.dtype)
        return jnp.einsum('bgrqk,bkgd->bqgrd', p, v)

    out = lax.map(one_block, qb)
    return out.transpose(1, 0, 2, 3, 4, 5).reshape(B, S, H, dv)


def mixer_even(h, w_in, q_norm, w_uq, kv_norm, w_ukv, mla_q_gain, mla_k_gain,
               gqa_q_gain, gqa_k_gain, w_out):
    B, S, _ = h.shape
    pos = jnp.arange(S, dtype=jnp.int32)
    rows = S // GRID_W
    row_idx = jnp.repeat(jnp.arange(rows, dtype=jnp.int32), GRID_W)
    col_idx = jnp.tile(jnp.arange(GRID_W, dtype=jnp.int32), rows)
    c_q, c_kv, k_pe, q_b, k_b, v_b = jnp.split(h @ w_in, EVEN_SPLITS, axis=-1)

    q_a = (rmsnorm(c_q, q_norm) @ w_uq).reshape(B, S, MLA_HEADS, MLA_NOPE + MLA_ROPE)
    kv = (rmsnorm(c_kv, kv_norm) @ w_ukv).reshape(B, S, MLA_HEADS, MLA_NOPE + MLA_V)
    k_nope, v_a = jnp.split(kv, [MLA_NOPE], axis=-1)
    k_a = jnp.concatenate(
        [k_nope, jnp.broadcast_to(k_pe[:, :, None, :], (B, S, MLA_HEADS, MLA_ROPE))], axis=-1)
    q_a = rmsnorm(q_a, mla_q_gain)
    k_a = rmsnorm(k_a, mla_k_gain)
    q_a = jnp.concatenate([q_a[..., :MLA_NOPE], rope(q_a[..., MLA_NOPE:], pos)], axis=-1)
    k_a = jnp.concatenate([k_a[..., :MLA_NOPE], rope(k_a[..., MLA_NOPE:], pos)], axis=-1)
    o_a = blocked_attention(q_a, k_a, v_a).reshape(B, S, MLA_HEADS * MLA_V)

    q_b = rmsnorm(q_b.reshape(B, S, GQA_HEADS, HEAD_DIM), gqa_q_gain)
    k_b = rmsnorm(k_b.reshape(B, S, GQA_KV_HEADS, HEAD_DIM), gqa_k_gain)
    v_b = v_b.reshape(B, S, GQA_KV_HEADS, HEAD_DIM)
    q_b = axial_rope(q_b, row_idx, col_idx)
    k_b = axial_rope(k_b, row_idx, col_idx)
    o_b = blocked_attention(q_b, k_b, v_b).reshape(B, S, GQA_HEADS * HEAD_DIM)

    return jnp.concatenate([o_a, o_b], axis=-1) @ w_out


def dilated_branch(q, k, v, dilation, half):
    B, S, H, dh = q.shape
    L = S // dilation
    nb = -(-L // DIL_BLOCK)
    Lp = nb * DIL_BLOCK
    qs = jnp.pad(q.reshape(B, L, dilation, H, dh), ((0, 0), (0, Lp - L), (0, 0), (0, 0), (0, 0)))
    pad_kv = ((0, 0), (DIL_BLOCK, Lp - L + DIL_BLOCK), (0, 0), (0, 0), (0, 0))
    ks = jnp.pad(k.reshape(B, L, dilation, H, dh), pad_kv)
    vs = jnp.pad(v.reshape(B, L, dilation, H, dh), pad_kv)
    a = jnp.arange(DIL_BLOCK)[:, None]
    b = jnp.arange(3 * DIL_BLOCK)[None, :]
    in_band = jnp.abs(b - DIL_BLOCK - a) <= half
    scale = dh ** -0.5

    def one_block(i):
        qb = lax.dynamic_slice_in_dim(qs, i * DIL_BLOCK, DIL_BLOCK, axis=1)
        kb = lax.dynamic_slice_in_dim(ks, i * DIL_BLOCK, 3 * DIL_BLOCK, axis=1)
        vb = lax.dynamic_slice_in_dim(vs, i * DIL_BLOCK, 3 * DIL_BLOCK, axis=1)
        kj = (i - 1) * DIL_BLOCK + b
        valid = in_band & (kj >= 0) & (kj < L)
        s = jnp.einsum('bqrhd,bkrhd->brhqk', qb, kb, preferred_element_type=jnp.float32) * scale
        s = jnp.where(valid, s, NEG)
        m = jnp.max(s, axis=-1, keepdims=True)
        p = jnp.exp(s - m)
        den = jnp.sum(p, axis=-1, keepdims=True)
        o = jnp.einsum('brhqk,bkrhd->bqrhd', (p / den).astype(v.dtype), vb)
        lse = (m + jnp.log(den))[..., 0]
        return o, lse.transpose(0, 3, 1, 2)

    o, lse = lax.map(one_block, jnp.arange(nb))
    o = o.transpose(1, 0, 2, 3, 4, 5).reshape(B, Lp, dilation, H, dh)[:, :L].reshape(B, S, H, dh)
    lse = lse.transpose(1, 0, 2, 3, 4).reshape(B, Lp, dilation, H)[:, :L].reshape(B, S, H)
    return o, lse


def mixer_odd(h, w_qkv, q_gain, k_gain, w_out):
    B, S, D = h.shape
    pos = jnp.arange(S, dtype=jnp.int32)
    q, k, v = jnp.split(h @ w_qkv, 3, axis=-1)
    q = rope(rmsnorm(q.reshape(B, S, DIL_HEADS, HEAD_DIM), q_gain), pos)
    k = rope(rmsnorm(k.reshape(B, S, DIL_HEADS, HEAD_DIM), k_gain), pos)
    v = v.reshape(B, S, DIL_HEADS, HEAD_DIM)
    outs, lses = [], []
    for window, dilation in DIL_PATTERNS:
        o, l = dilated_branch(q, k, v, dilation, window // (2 * dilation))
        outs.append(o)
        lses.append(l)
    w = jax.nn.softmax(jnp.stack(lses, axis=0), axis=0)
    o = sum(w[g][..., None] * outs[g].astype(jnp.float32) for g in range(len(DIL_PATTERNS)))
    return o.astype(h.dtype).reshape(B, S, D) @ w_out


def swiglu(h, wg, wu, wd):
    return (jax.nn.silu(h @ wg) * (h @ wu)) @ wd


def moe_swiglu(h, router, wg, wu, wd):
    B, S, D = h.shape
    T = B * S
    xt = h.reshape(T, D)
    logits = jnp.einsum('td,de->te', xt, router, preferred_element_type=jnp.float32)
    top_val, top_idx = lax.top_k(logits, TOP_K)
    gates = jax.nn.softmax(top_val, axis=-1)
    A = T * TOP_K
    e_flat = top_idx.reshape(A).astype(jnp.int32)
    g_flat = gates.reshape(A)
    tok_flat = jnp.repeat(jnp.arange(T, dtype=jnp.int32), TOP_K)
    order = jnp.argsort(e_flat)
    e_s, tok_s, g_s = e_flat[order], tok_flat[order], g_flat[order]
    counts = jnp.bincount(e_flat, length=N_EXPERTS)
    starts = jnp.cumsum(counts) - counts
    pcounts = (counts + MOE_BLOCK - 1) // MOE_BLOCK * MOE_BLOCK
    pends = jnp.cumsum(pcounts)
    pstarts = pends - pcounts
    dest = pstarts[e_s] + jnp.arange(A, dtype=jnp.int32) - starts[e_s]
    n_blk = -(-A // MOE_BLOCK) + N_EXPERTS
    P = n_blk * MOE_BLOCK
    tok_pad = jnp.zeros((P,), jnp.int32).at[dest].set(tok_s)
    g_pad = jnp.zeros((P,), jnp.float32).at[dest].set(g_s)
    blk_e = jnp.minimum(jnp.searchsorted(pends, jnp.arange(n_blk, dtype=jnp.int32) * MOE_BLOCK,
                                         side='right'), N_EXPERTS - 1)

    def one_block(args):
        tok, g, e = args
        xb = xt[tok]
        yb = (jax.nn.silu(xb @ wg[e]) * (xb @ wu[e])) @ wd[e]
        return (yb.astype(jnp.float32) * g[:, None]).astype(h.dtype)

    yb = lax.map(one_block, (tok_pad.reshape(n_blk, MOE_BLOCK), g_pad.reshape(n_blk, MOE_BLOCK), blk_e))
    y = jnp.zeros_like(xt).at[tok_pad].add(yb.reshape(P, D))
    return y.reshape(B, S, D)


def setup_inputs(seed: int = 0) -> dict:
    key = jax.random.key(seed)
    ks = iter(jax.random.split(key, 64))
    D = D_MODEL

    def w(shape, fan_in, s=1.0):
        return s * fan_in ** -0.5 * jax.random.normal(next(ks), shape, jnp.float32)

    def gain(shape):
        return 1.0 + 0.1 * jax.random.normal(next(ks), shape, jnp.float32)

    def bias(shape):
        return 0.02 * jax.random.normal(next(ks), shape, jnp.float32)

    return {
        "x": jax.random.normal(next(ks), (BATCH, SEQ, D), jnp.float32),
        "c": jax.random.normal(next(ks), (BATCH, D), jnp.float32),
        "ada_even_w": w((N_EVEN, D, 6 * D), D, 0.5),
        "ada_even_b": bias((N_EVEN, 6 * D)),
        "norm_even_mix": gain((N_EVEN, D)),
        "norm_even_ffn": gain((N_EVEN, D)),
        "even_w_in": w((N_EVEN, D, EVEN_IN), D),
        "mla_q_norm": gain((N_EVEN, MLA_Q_RANK)),
        "mla_w_uq": w((N_EVEN, MLA_Q_RANK, MLA_HEADS * (MLA_NOPE + MLA_ROPE)), MLA_Q_RANK),
        "mla_kv_norm": gain((N_EVEN, MLA_KV_RANK)),
        "mla_w_ukv": w((N_EVEN, MLA_KV_RANK, MLA_HEADS * (MLA_NOPE + MLA_V)), MLA_KV_RANK),
        "mla_q_gain": gain((N_EVEN, MLA_NOPE + MLA_ROPE)),
        "mla_k_gain": gain((N_EVEN, MLA_NOPE + MLA_ROPE)),
        "gqa_q_gain": gain((N_EVEN, HEAD_DIM)),
        "gqa_k_gain": gain((N_EVEN, HEAD_DIM)),
        "even_w_out": w((N_EVEN, EVEN_MIX, D), EVEN_MIX),
        "ffn_w_gate": w((N_EVEN, D, D_FF), D),
        "ffn_w_up": w((N_EVEN, D, D_FF), D),
        "ffn_w_down": w((N_EVEN, D_FF, D), D_FF),
        "ada_odd_w": w((N_ODD, D, 6 * D), D, 0.5),
        "ada_odd_b": bias((N_ODD, 6 * D)),
        "norm_odd_mix": gain((N_ODD, D)),
        "norm_odd_ffn": gain((N_ODD, D)),
        "dil_w_qkv": w((N_ODD, D, 3 * DIL_HEADS * HEAD_DIM), D),
        "dil_q_gain": gain((N_ODD, HEAD_DIM)),
        "dil_k_gain": gain((N_ODD, HEAD_DIM)),
        "dil_w_out": w((N_ODD, DIL_HEADS * HEAD_DIM, D), DIL_HEADS * HEAD_DIM),
        "moe_router": w((N_ODD, D, N_EXPERTS), D),
        "moe_w_gate": w((N_ODD, N_EXPERTS, D, D_FF_EXPERT), D),
        "moe_w_up": w((N_ODD, N_EXPERTS, D, D_FF_EXPERT), D),
        "moe_w_down": w((N_ODD, N_EXPERTS, D_FF_EXPERT, D), D_FF_EXPERT),
    }


def reference(x, c, ada_even_w, ada_even_b, norm_even_mix, norm_even_ffn, even_w_in,
              mla_q_norm, mla_w_uq, mla_kv_norm, mla_w_ukv, mla_q_gain, mla_k_gain,
              gqa_q_gain, gqa_k_gain, even_w_out, ffn_w_gate, ffn_w_up, ffn_w_down,
              ada_odd_w, ada_odd_b, norm_odd_mix, norm_odd_ffn, dil_w_qkv, dil_q_gain,
              dil_k_gain, dil_w_out, moe_router, moe_w_gate, moe_w_up, moe_w_down):
    B, S, D = x.shape
    sc = jax.nn.silu(c)
    for layer in range(DEPTH):
        i = layer // 2
        if layer % 2 == 0:
            mod = (sc @ ada_even_w[i] + ada_even_b[i]).reshape(B, 6, D)
            h = modulate(x, norm_even_mix[i], mod[:, 0], mod[:, 1])
            x = x + mod[:, 2][:, None, :] * mixer_even(
                h, even_w_in[i], mla_q_norm[i], mla_w_uq[i], mla_kv_norm[i], mla_w_ukv[i],
                mla_q_gain[i], mla_k_gain[i], gqa_q_gain[i], gqa_k_gain[i], even_w_out[i])
            h = modulate(x, norm_even_ffn[i], mod[:, 3], mod[:, 4])
            x = x + mod[:, 5][:, None, :] * swiglu(h, ffn_w_gate[i], ffn_w_up[i], ffn_w_down[i])
        else:
            mod = (sc @ ada_odd_w[i] + ada_odd_b[i]).reshape(B, 6, D)
            h = modulate(x, norm_odd_mix[i], mod[:, 0], mod[:, 1])
            x = x + mod[:, 2][:, None, :] * mixer_odd(
                h, dil_w_qkv[i], dil_q_gain[i], dil_k_gain[i], dil_w_out[i])
            h = modulate(x, norm_odd_ffn[i], mod[:, 3], mod[:, 4])
            x = x + mod[:, 5][:, None, :] * moe_swiglu(
                h, moe_router[i], moe_w_gate[i], moe_w_up[i], moe_w_down[i])
    return x
```

```cpp
#define MK_PER_PHASE 1
#include <hip/hip_runtime.h>
#include <cstdio>
#include <cstdint>
namespace pg8 {
#define PG8_LAS __attribute__((address_space(3)))
typedef unsigned short bf16_t;
typedef short bf16x8 __attribute__((ext_vector_type(8)));
typedef float f32x4 __attribute__((ext_vector_type(4)));
typedef unsigned u32x4 __attribute__((ext_vector_type(4)));
constexpr int BM = 256, BK = 64, HALF = 128, HTB = HALF * BK * 2  , STAGE_BYTES = 8 * HTB, NXCD = 8, WGM = 8;

__host__ __device__ __forceinline__ int lds_byte(int r, int c) { const int st = (r >> 4) * 2 + (c >> 5), rr = r & 15, cc = c & 31, ob = rr * 64 + cc * 2; return st * 1024 + (ob ^ (((ob >> 9) & 1) << 5)); }
__host__ __device__ __forceinline__ void stage_rc(int b, int& R, int& C) { const int st = b / 1024, sb = b % 1024, swz = sb ^ (((sb >> 9) & 1) << 5); R = (st >> 1) * 16 + swz / 64; C = (st & 1) * 32 + (swz % 64) / 2; }
__host__ __device__ __forceinline__ int perm32(int rho) { const int n = rho >> 4, i = rho & 15; return 8 * (i >> 2) + 4 * n + (i & 3); }

struct Unit { int pm, pn; };
struct Gemm { const bf16_t* A; const bf16_t* Bt; int M, N, K; };

struct StaticOrder {
    int nM, nN, nwg, G, c;
    __host__ __device__ void init(int M, int N, int G_, int c_) { nM = M / BM; nN = N / BM; nwg = nM * nN; G = G_; c = c_; }
    __host__ __device__ bool next(int i, Unit& u) const {
        const long L = (long)i * G + c; if (L >= nwg) return false;
        int wgid = (int)L; { const int q = nwg / NXCD, r = nwg % NXCD, xcd = wgid % NXCD, off = wgid / NXCD; wgid = (xcd < r ? xcd * (q + 1) : r * (q + 1) + (xcd - r) * q) + off; }
        const int nig = WGM * nN, gid = wgid / nig, fm = gid * WGM, gsz = (nM - fm) < WGM ? (nM - fm) : WGM;
        u.pm = fm + ((wgid % nig) % gsz); u.pn = (wgid % nig) / gsz; return true;
    }
    __device__ __forceinline__ void a_ready(const Unit&) const {}
    __device__ __forceinline__ void done(const Unit&) const {}
};

__device__ __forceinline__ unsigned cvt_pk_bf16(float lo, float hi) { unsigned r; asm volatile("v_cvt_pk_bf16_f32 %0, %1, %2" : "=v"(r) : "v"(lo), "v"(hi)); return r; }
typedef float f32x2 __attribute__((ext_vector_type(2)));
__device__ __forceinline__ f32x2 gelu_pk(f32x2 v) {
    const f32x2 av = __builtin_elementwise_abs(v), d = av * 0.2316418882f + 1.0f;
    f32x2 t; t.x = __builtin_amdgcn_rcpf(d.x); t.y = __builtin_amdgcn_rcpf(d.y);
    f32x2 q = t * 0.5307027145f + (-0.7265760135f); q = q * t + 0.7107068705f; q = q * t + (-0.142248368f); q = q * t + 0.127414796f; q = q * t;
    const f32x2 s = (v * v) * (-0.72134752044f);
    f32x2 e; e.x = __builtin_amdgcn_exp2f(s.x); e.y = __builtin_amdgcn_exp2f(s.y);
    const f32x2 m = v * (q * e), r = v - m;
    f32x2 o; o.x = v.x < 0.f ? m.x : r.x; o.y = v.y < 0.f ? m.y : r.y; return o;
}

template <int ACT  > struct EpiBf16 {
    static constexpr bool PERM = true, AFTER_DRAIN = false; static_assert(ACT == 0 || ACT == 1, "EpiBf16: ACT is 0 (none) or 1 (gelu_pk)");
    bf16_t* O; int ldc; const float* bias; int split_cols; size_t split_stride; float scale0;
    __device__ __forceinline__ void operator()(const f32x4 (&acc)[2][2][4][2], const Unit& u, int wr, int wc, int fr, int fq) const {
        const int row0 = u.pm * BM + wr * 64 + fr; int colt = u.pn * BM; bf16_t* base = O;
        float sc = 1.f; if (split_cols) { const int t = colt / split_cols; base += (size_t)t * split_stride; colt -= t * split_cols; if (t == 0) sc = scale0; }
        const int col0 = colt + wc * 32 + 8 * fq, bcol0 = u.pn * BM + wc * 32 + 8 * fq;
        f32x4 bv[2][2];
#pragma unroll
        for (int bj = 0; bj < 2; ++bj)
#pragma unroll
            for (int n = 0; n < 2; ++n) bv[bj][n] = bias ? *(const f32x4*)(bias + bcol0 + bj * HALF + 4 * n) : (f32x4){0.f, 0.f, 0.f, 0.f};
#pragma unroll
        for (int ai = 0; ai < 2; ++ai)
#pragma unroll
            for (int m = 0; m < 4; ++m) { bf16_t* rowp = base + (size_t)(row0 + ai * HALF + m * 16) * ldc + col0;
#pragma unroll
                for (int bj = 0; bj < 2; ++bj) { f32x4 v0 = acc[ai][bj][m][0] + bv[bj][0], v1 = acc[ai][bj][m][1] + bv[bj][1];
                    if (ACT == 1) { f32x2 a = gelu_pk((f32x2){v0[0], v0[1]}), b = gelu_pk((f32x2){v0[2], v0[3]}), c = gelu_pk((f32x2){v1[0], v1[1]}), d = gelu_pk((f32x2){v1[2], v1[3]});
                        v0 = (f32x4){a.x, a.y, b.x, b.y}; v1 = (f32x4){c.x, c.y, d.x, d.y}; }
                    v0 = v0 * sc; v1 = v1 * sc; u32x4 w; w.x = cvt_pk_bf16(v0[0], v0[1]); w.y = cvt_pk_bf16(v0[2], v0[3]); w.z = cvt_pk_bf16(v1[0], v1[1]); w.w = cvt_pk_bf16(v1[2], v1[3]);
                    *(u32x4*)(rowp + bj * HALF) = w; } }
    }
};
template <class Epi, class Sched, bool ALIGN_EPI = false, bool SP2 = false>
__device__ __forceinline__ void gemm_phase(PG8_LAS unsigned char* lds, const Gemm g, const Sched& S, const Epi& E) {
    const int tid = threadIdx.x, wid = __builtin_amdgcn_readfirstlane(tid >> 6), lane = tid & 63, wr = wid >> 2, wc = wid & 3, fr = lane & 15, fq = lane >> 4;
    const int K = g.K, nt = K / BK;
    unsigned voffA[2], voffB[2];
#pragma unroll
    for (int i = 0; i < 2; ++i) { int R, C; stage_rc(tid * 16 + i * 8192, R, C); const int Rb = Epi::PERM ? ((R & ~31) + perm32(R & 31)) : R;
        voffA[i] = (unsigned)(R * K + C) * 2u; voffB[i] = (unsigned)(Rb * K + C) * 2u; }
    const size_t kstep = (size_t)(BK * 2);
    const size_t hstep = (size_t)HALF * K * 2;
    const size_t tstep = 2 * hstep;
    const unsigned ldsw = (unsigned)wid * 1024u;
    const int aoff = lds_byte(wr * 64 + fr, fq * 8), boff = lds_byte(wc * 32 + fr, fq * 8);
#define PG8_SA(b, h) (((b) * 2 + (h)) * HTB)
#define PG8_SB(b, h) ((4 + (b) * 2 + (h)) * HTB)
#define PG8_STAGE(bufoff, gbase, voff) do { _Pragma("unroll") for (int _i = 0; _i < 2; ++_i) \
        __builtin_amdgcn_global_load_lds((const unsigned*)((const char*)(gbase) + (voff)[_i]), (PG8_LAS unsigned*)(lds + (bufoff) + ldsw + _i * 8192), 16, 0, 0); } while (0)
#define PG8_LDA(dst, b, h) do { _Pragma("unroll") for (int m = 0; m < 4; ++m) _Pragma("unroll") for (int k = 0; k < 2; ++k) dst[m][k] = *(const PG8_LAS bf16x8*)(lds + PG8_SA(b, h) + aoff + m * 2048 + k * 1024); } while (0)
#define PG8_LDB(dst, b, h) do { _Pragma("unroll") for (int n = 0; n < 2; ++n) _Pragma("unroll") for (int k = 0; k < 2; ++k) dst[n][k] = *(const PG8_LAS bf16x8*)(lds + PG8_SB(b, h) + boff + n * 2048 + k * 1024); } while (0)
#define PG8_MMA(ai, bj, At, Bt) do { __builtin_amdgcn_s_setprio(1); _Pragma("unroll") for (int m = 0; m < 4; ++m) _Pragma("unroll") for (int n = 0; n < 2; ++n) _Pragma("unroll") for (int k = 0; k < 2; ++k) \
        acc[ai][bj][m][n] = __builtin_amdgcn_mfma_f32_16x16x32_bf16(Bt[n][k], At[m][k], acc[ai][bj][m][n], 0, 0, 0); __builtin_amdgcn_s_setprio(0); } while (0)
#define PG8_WAIT_V(n) asm volatile("s_waitcnt vmcnt(" #n ")" ::: "memory")
#define PG8_WAIT_L(n) asm volatile("s_waitcnt lgkmcnt(" #n ")" ::: "memory")
#define PG8_BAR __builtin_amdgcn_s_barrier()
#define PG8_SCHED __builtin_amdgcn_sched_barrier(0)
    Unit cur, nxt; int ui = 0;
    if (!S.next(0, cur)) return;
    f32x4 acc[2][2][4][2];
#pragma unroll
    for (int a = 0; a < 2; ++a)
#pragma unroll
        for (int b = 0; b < 2; ++b)
#pragma unroll
            for (int m = 0; m < 4; ++m)
#pragma unroll
                for (int n = 0; n < 2; ++n) acc[a][b][m][n] = (f32x4){0.f, 0.f, 0.f, 0.f};
    bf16x8 At[4][2], B0[2][2], B1[2][2];
    const char* cA = (const char*)g.A + (size_t)cur.pm * tstep; const char* cB = (const char*)g.Bt + (size_t)cur.pn * tstep;
    S.a_ready(cur);
    if constexpr (SP2) {
        PG8_STAGE(PG8_SB(0, 0), cB, voffB); PG8_STAGE(PG8_SB(0, 1), cB + hstep, voffB); PG8_STAGE(PG8_SA(0, 0), cA, voffA); PG8_STAGE(PG8_SA(0, 1), cA + hstep, voffA);
        if (wr == 1) PG8_BAR;
        PG8_WAIT_V(2); PG8_BAR;
        PG8_STAGE(PG8_SB(1, 0), cB + kstep, voffB); PG8_STAGE(PG8_SA(1, 0), cA + kstep, voffA); PG8_STAGE(PG8_SB(1, 1), cB + hstep + kstep, voffB);
        PG8_WAIT_V(6); PG8_BAR;
    } else {
        PG8_STAGE(PG8_SB(0, 0), cB, voffB); PG8_STAGE(PG8_SA(0, 0), cA, voffA); PG8_STAGE(PG8_SB(0, 1), cB + hstep, voffB); PG8_STAGE(PG8_SA(0, 1), cA + hstep, voffA);
        if (wr == 1) PG8_BAR;
        PG8_WAIT_V(4); PG8_BAR;
        PG8_STAGE(PG8_SB(1, 0), cB + kstep, voffB); PG8_STAGE(PG8_SA(1, 0), cA + kstep, voffA); PG8_STAGE(PG8_SB(1, 1), cB + hstep + kstep, voffB);
        PG8_WAIT_V(6); PG8_BAR;
    }
    for (;;) {
        const bool has_next = S.next(ui + 1, nxt);
        const char* nA = has_next ? (const char*)g.A + (size_t)nxt.pm * tstep : cA; const char* nB = has_next ? (const char*)g.Bt + (size_t)nxt.pn * tstep : cB;
        for (int t = 0; t < nt; t += 2) {
            const bool last = (t == nt - 2);
            const char* a1 = cA + (size_t)(t + 1) * kstep;
            const char* a2 = last ? nA : cA + (size_t)(t + 2) * kstep; const char* b2 = last ? nB : cB + (size_t)(t + 2) * kstep;
            const char* a3 = a2 + kstep; const char* b3 = b2 + kstep;
            if (last && has_next) S.a_ready(nxt);
            if constexpr (SP2) {
            PG8_LDB(B0, 0, 0); PG8_LDB(B1, 0, 1); PG8_SCHED; PG8_LDA(At, 0, 0); PG8_STAGE(PG8_SA(1, 1), a1 + hstep, voffA);
            PG8_WAIT_V(8); PG8_WAIT_L(0); PG8_BAR; PG8_MMA(0, 0, At, B0); PG8_MMA(0, 1, At, B1); PG8_BAR; PG8_SCHED;
            PG8_LDA(At, 0, 1); PG8_STAGE(PG8_SB(0, 0), b2, voffB); PG8_STAGE(PG8_SB(0, 1), b2 + hstep, voffB); PG8_STAGE(PG8_SA(0, 0), a2, voffA);
            PG8_WAIT_V(8); PG8_WAIT_L(0); PG8_BAR; PG8_MMA(1, 0, At, B0); PG8_MMA(1, 1, At, B1); PG8_BAR; PG8_SCHED;
            PG8_LDB(B0, 1, 0); PG8_LDB(B1, 1, 1); PG8_SCHED; PG8_LDA(At, 1, 0); PG8_STAGE(PG8_SA(0, 1), a2 + hstep, voffA);
            PG8_WAIT_V(8); PG8_WAIT_L(0); PG8_BAR; PG8_MMA(0, 0, At, B0); PG8_MMA(0, 1, At, B1); PG8_BAR; PG8_SCHED;
            PG8_LDA(At, 1, 1); PG8_STAGE(PG8_SB(1, 0), b3, voffB); PG8_STAGE(PG8_SB(1, 1), b3 + hstep, voffB); PG8_STAGE(PG8_SA(1, 0), a3, voffA);
            PG8_WAIT_V(8); PG8_WAIT_L(0); PG8_BAR; PG8_MMA(1, 0, At, B0); PG8_MMA(1, 1, At, B1); PG8_BAR; PG8_SCHED;
            } else {
            PG8_LDB(B0, 0, 0); PG8_SCHED; PG8_LDA(At, 0, 0); PG8_STAGE(PG8_SA(1, 1), a1 + hstep, voffA);
            PG8_WAIT_L(8); PG8_BAR; PG8_WAIT_L(0); PG8_MMA(0, 0, At, B0); PG8_BAR; PG8_SCHED;
            PG8_LDB(B1, 0, 1); PG8_STAGE(PG8_SB(0, 0), b2, voffB);
            PG8_BAR; PG8_WAIT_L(0); PG8_MMA(0, 1, At, B1); PG8_BAR;
            PG8_LDA(At, 0, 1); PG8_STAGE(PG8_SA(0, 0), a2, voffA);
            PG8_BAR; PG8_WAIT_L(0); PG8_MMA(1, 0, At, B0); PG8_BAR; PG8_SCHED;
            PG8_STAGE(PG8_SB(0, 1), b2 + hstep, voffB);
            PG8_WAIT_V(6); PG8_BAR; PG8_MMA(1, 1, At, B1); PG8_BAR;
            PG8_LDB(B0, 1, 0); PG8_SCHED; PG8_LDA(At, 1, 0); PG8_STAGE(PG8_SA(0, 1), a2 + hstep, voffA);
            PG8_WAIT_L(8); PG8_BAR; PG8_WAIT_L(0); PG8_MMA(0, 0, At, B0); PG8_BAR; PG8_SCHED;
            PG8_LDB(B1, 1, 1); PG8_STAGE(PG8_SB(1, 0), b3, voffB);
            PG8_BAR; PG8_WAIT_L(0); PG8_MMA(0, 1, At, B1); PG8_BAR;
            PG8_LDA(At, 1, 1); PG8_STAGE(PG8_SA(1, 0), a3, voffA);
            PG8_BAR; PG8_WAIT_L(0); PG8_MMA(1, 0, At, B0); PG8_BAR; PG8_SCHED;
            PG8_STAGE(PG8_SB(1, 1), b3 + hstep, voffB);
            PG8_WAIT_V(6); PG8_BAR; PG8_MMA(1, 1, At, B1); PG8_BAR;
            }
        }
        if constexpr (ALIGN_EPI) { if (wr == 0) PG8_BAR; }
        if constexpr (!Epi::AFTER_DRAIN) { E(acc, cur, wr, wc, fr, fq); S.done(cur); }
        if (!has_next) break;
#pragma unroll
        for (int a = 0; a < 2; ++a)
#pragma unroll
            for (int b = 0; b < 2; ++b)
#pragma unroll
                for (int m = 0; m < 4; ++m)
#pragma unroll
                    for (int n = 0; n < 2; ++n) acc[a][b][m][n] = (f32x4){0.f, 0.f, 0.f, 0.f};
        cur = nxt; cA = nA; cB = nB; ++ui;
        if constexpr (ALIGN_EPI) { if (wr == 1) PG8_BAR; }
    }
    PG8_WAIT_V(0);
    if constexpr (!ALIGN_EPI) { if (wr == 0) PG8_BAR; }
    PG8_BAR;
    if constexpr (Epi::AFTER_DRAIN) { E.fused(acc, cur, wr, wc, fr, fq, lds, wid, lane); S.done(cur); }
#undef PG8_SA
#undef PG8_SB
#undef PG8_STAGE
#undef PG8_LDA
#undef PG8_LDB
#undef PG8_MMA
#undef PG8_WAIT_V
#undef PG8_WAIT_L
#undef PG8_BAR
#undef PG8_SCHED
}
}
#define GAS __attribute__((address_space(1)))
#define LAS __attribute__((address_space(3)))
typedef unsigned short bf16;
typedef unsigned v4u __attribute__((ext_vector_type(4)));
typedef float f32x4 __attribute__((ext_vector_type(4)));
typedef short bf16x8 __attribute__((ext_vector_type(8)));
typedef GAS unsigned gu32;
typedef GAS unsigned long long gu64;
#define RLX_AGENT __ATOMIC_RELAXED, __HIP_MEMORY_SCOPE_AGENT
#define LDS_WAIT() asm volatile("s_waitcnt lgkmcnt(0)" ::: "memory")
#define VM_WAIT() asm volatile("s_waitcnt vmcnt(0)" ::: "memory")
__device__ __forceinline__ unsigned long long rt() { return __builtin_amdgcn_s_memrealtime(); }
__device__ __forceinline__ unsigned f2bf(float f) { unsigned u = __builtin_bit_cast(unsigned, f); return (u + 0x7fffu + ((u >> 16) & 1u)) >> 16; }
__device__ __forceinline__ unsigned pk2(float lo, float hi) { return f2bf(lo) | (f2bf(hi) << 16); }

#define XB_TMO      128
#define XB_XCNT(j)  (256  + 64 * (j))
#define XB_XSUB(j)  (1280 + 64 * (j))
#define XB_XGEN(j)  (2304 + 64 * (j))
#define XB_TOP      3328
#define XB_TOPGEN   3392
#define XCD_BAR_WORDS 3456
#define XB_SPIN_CAP (1u << 18)

__device__ __forceinline__ unsigned xb_ld(unsigned* p)              { return __hip_atomic_load(p, __ATOMIC_RELAXED, __HIP_MEMORY_SCOPE_AGENT); }
__device__ __forceinline__ unsigned xb_add(unsigned* p, unsigned v) { return __hip_atomic_fetch_add(p, v, __ATOMIC_RELAXED, __HIP_MEMORY_SCOPE_AGENT); }
__device__ __forceinline__ unsigned xb_xcc_id() { return (unsigned)__builtin_amdgcn_s_getreg((3 << 11) | 20) & 0xFu; }
#define XB_SPIN(cond, bar) do { unsigned _sp = 0; while (cond) { __builtin_amdgcn_s_sleep(1); \
    if ((++_sp & 255u) == 0u) { if (xb_ld(&(bar)[XB_TMO])) break; if (_sp > XB_SPIN_CAP) { atomicAdd(&(bar)[XB_TMO], 1u); break; } } } } while (0)

struct XcdBarrier {
    unsigned* bar; unsigned x;
    volatile LAS unsigned* st;
};

__device__ __forceinline__ XcdBarrier xcd_barrier_post(unsigned* bar, volatile LAS unsigned* st) {
    XcdBarrier b; b.bar = bar; b.x = xb_xcc_id(); b.st = st;
    if (threadIdx.x == 0) (void)xb_add(&bar[XB_XCNT(b.x)], 1u);
    return b;
}
__device__ __forceinline__ void xcd_barrier_complete(unsigned* bar, unsigned x, unsigned& nloc, unsigned& nx) {
    const unsigned G = gridDim.x * gridDim.y * gridDim.z;
    unsigned sum, cnt, mine, sp = 0u;
    for (;;) {
        sum = 0u; cnt = 0u; mine = 0u;
#pragma unroll
        for (unsigned j = 0; j < 16; ++j) { const unsigned c = xb_ld(&bar[XB_XCNT(j)]); sum += c; cnt += (c > 0u) ? 1u : 0u; mine = (j == x) ? c : mine; }
        if (sum == G) break;
        __builtin_amdgcn_s_sleep(1);
        if ((++sp & 255u) == 0u) { if (xb_ld(&bar[XB_TMO])) break; if (sp > XB_SPIN_CAP) { atomicAdd(&bar[XB_TMO], 1u); break; } }
    }
    nloc = mine > 0u ? mine : 1u; nx = cnt > 0u ? cnt : 1u;
}

__device__ __forceinline__ void xcd_barrier(const XcdBarrier& b) {
    asm volatile("s_waitcnt vmcnt(0)" ::: "memory");
    __syncthreads();
    if (threadIdx.x == 0) {
        unsigned* bar = b.bar;
        __builtin_amdgcn_s_waitcnt(0);
        unsigned nloc = b.st[0], nx = b.st[1];
        if (nloc == 0u) { xcd_barrier_complete(bar, b.x, nloc, nx); b.st[0] = nloc; b.st[1] = nx; }
        const unsigned old = xb_add(&bar[XB_XSUB(b.x)], 1u);
        const unsigned gen = old / nloc;
        if (old + 1u == (gen + 1u) * nloc) {
            __builtin_amdgcn_fence(__ATOMIC_RELEASE, "agent");
            asm volatile("s_waitcnt vmcnt(0)" ::: "memory");
            const unsigned og = xb_add(&bar[XB_TOP], 1u);
            const unsigned tg = og / nx;
            if (og + 1u == (tg + 1u) * nx) xb_add(&bar[XB_TOPGEN], 1u);
            else XB_SPIN(xb_ld(&bar[XB_TOPGEN]) == tg, bar);
            __builtin_amdgcn_fence(__ATOMIC_ACQUIRE, "agent");
            xb_add(&bar[XB_XGEN(b.x)], 1u);
            asm volatile("s_waitcnt vmcnt(0)" ::: "memory");
        } else {
            XB_SPIN(xb_ld(&bar[XB_XGEN(b.x)]) == gen, bar);
            __builtin_amdgcn_fence(__ATOMIC_ACQUIRE, "agent");
            asm volatile("s_waitcnt vmcnt(0)" ::: "memory");
        }
    }
    __syncthreads();
}
constexpr int T = 65536, SEQ = 4096, DM = 1024;
constexpr int NWAVES = 8;
constexpr float EPS = 1e-6f;
constexpr float LOG2E = 1.4426950408889634f;
constexpr float QSCALE_A = 0.10206207261596575f * LOG2E;
constexpr float QSCALE_B = 0.125f * LOG2E;
constexpr float LOG2_THETA = 13.287712379549449f;
constexpr float INV_2PI = 0.15915494309189535f;

constexpr size_t MiB = 1u << 20;
constexpr size_t WS_CTL = 0, CTL_ZERO_BYTES = 4 * MiB;
constexpr size_t WS_MOD = 2 * MiB;
constexpr size_t WS_TOPK = 4 * MiB;
constexpr size_t WS_GATES = 4 * MiB + 512 * 1024;
constexpr size_t WS_SLOTS = 5 * MiB;
constexpr size_t WS_GSLOT = 5 * MiB + 512 * 1024;
constexpr size_t WS_BLKCNT = 6 * MiB + 128 * 1024;
constexpr size_t WS_PENDS = 6 * MiB + 256 * 1024;
constexpr size_t WS_W = 8 * MiB;
constexpr size_t W_IN = WS_W;
constexpr size_t W_UQ = W_IN + (size_t)1280 * 1024 * 2;
constexpr size_t W_UKV = W_UQ + (size_t)768 * 256 * 2;
constexpr size_t W_OUT = W_UKV + (size_t)1024 * 128 * 2;
constexpr size_t W_GU = W_OUT + (size_t)1024 * 1024 * 2;
constexpr size_t W_D = W_GU + (size_t)5632 * 1024 * 2;
constexpr size_t W_QKV = W_D + (size_t)1024 * 2816 * 2;
constexpr size_t W_DO = W_QKV + (size_t)3072 * 1024 * 2;
constexpr size_t W_MGU = W_DO + (size_t)1024 * 1024 * 2;
constexpr size_t W_MD = W_MGU + (size_t)8 * 7168 * 1024 * 2;
constexpr size_t W_END = W_MD + (size_t)8 * 1024 * 3584 * 2;
static_assert(W_END <= 208 * MiB, "weights region");
constexpr size_t A_H = 208 * MiB;
constexpr size_t A_P = 336 * MiB;
constexpr size_t A_CQ = 496 * MiB;
constexpr size_t A_CKV = 528 * MiB;
constexpr size_t A_QB = 544 * MiB;
constexpr size_t A_KB = 608 * MiB;
constexpr size_t A_QA = 624 * MiB;
constexpr size_t A_KV = 720 * MiB;
constexpr size_t A_KA = 848 * MiB;
constexpr size_t A_ATT0 = A_H;
constexpr size_t A_ACT = 336 * MiB;
constexpr size_t A_QKV = 336 * MiB;
constexpr size_t A_ATT1 = 720 * MiB;
constexpr size_t A_O2 = 848 * MiB;
constexpr size_t A_LSE1 = 976 * MiB;
constexpr size_t A_LSE2 = 980 * MiB;
constexpr size_t A_HP = 208 * MiB;
constexpr size_t A_Y = 468 * MiB;
constexpr size_t A_ACTM = 728 * MiB;
constexpr size_t WS_NEED = 984 * MiB;

constexpr int CW_BAR = 4096;
constexpr int RING_BYTES = 131072;
constexpr int MISC_OFF = RING_BYTES + 320;
constexpr int LDS_BYTES = 147456;

constexpr int NPH = 28;

struct Args {
    const float* in[31];
    float* out;
    unsigned char* ws;
    int ph_lo, ph_hi;
};
enum { I_X = 0, I_C, I_ADA_E_W, I_ADA_E_B, I_NORM_E_MIX, I_NORM_E_FFN, I_W_IN, I_Q_NORM, I_W_UQ, I_KV_NORM, I_W_UKV, I_MLA_QG, I_MLA_KG, I_GQA_QG, I_GQA_KG,
       I_E_W_OUT, I_FFN_G, I_FFN_U, I_FFN_D, I_ADA_O_W, I_ADA_O_B, I_NORM_O_MIX, I_NORM_O_FFN, I_DIL_QKV, I_DIL_QG, I_DIL_KG, I_DIL_OUT, I_ROUTER, I_MOE_G, I_MOE_U, I_MOE_D };

__device__ __forceinline__ float bf2f(unsigned b) { return __builtin_bit_cast(float, b << 16); }
__device__ __forceinline__ float bflo(unsigned w) { return __builtin_bit_cast(float, w << 16); }
__device__ __forceinline__ float bfhi(unsigned w) { return __builtin_bit_cast(float, w & 0xffff0000u); }
__device__ __forceinline__ float wave_sum(float v) {
#pragma unroll
    for (int o = 1; o < 64; o <<= 1) v += __shfl_xor(v, o);
    return v;
}
__device__ __forceinline__ unsigned cvtpk(float lo, float hi) { unsigned r; asm volatile("v_cvt_pk_bf16_f32 %0, %1, %2" : "=v"(r) : "v"(lo), "v"(hi)); return r; }

__device__ __forceinline__ void transpose_item(const float* W, int N, int k0, int n0, bf16* dst, int Kd, LAS float* scr, int lane) {
#pragma unroll 8
    for (int i = 0; i < 32; ++i) { const int kk = 2 * i + (lane >> 5); scr[kk * 33 + (lane & 31)] = W[(size_t)(k0 + kk) * N + n0 + (lane & 31)]; }
    LDS_WAIT(); asm volatile("" ::: "memory");
    const int c = lane & 7;
#pragma unroll
    for (int j = 0; j < 4; ++j) { const int n = (lane >> 3) + 8 * j; const LAS float* s = scr + (8 * c) * 33 + n;
        v4u o; o.x = pk2(s[0 * 33], s[1 * 33]); o.y = pk2(s[2 * 33], s[3 * 33]); o.z = pk2(s[4 * 33], s[5 * 33]); o.w = pk2(s[6 * 33], s[7 * 33]);
        *(GAS v4u*)(dst + (size_t)n * Kd + k0 + 8 * c) = o; }
    LDS_WAIT(); asm volatile("" ::: "memory");
}
__device__ __forceinline__ void tr_plain(const float* W, int K, int N, bf16* WT, int r, LAS float* scr, int lane) {
    const int nblk = N / 32, kb = r / nblk, nb = r % nblk;
    transpose_item(W, N, 64 * kb, 32 * nb, WT + (size_t)(32 * nb) * K, K, scr, lane);
}
__device__ __forceinline__ void tr_gu(const float* W, int K, int N, bf16* WT, int upoff, int r, LAS float* scr, int lane) {
    const int nblk = N / 32, kb = r / nblk, nb = r % nblk, n0 = 32 * nb;
    const int drow = (n0 >> 7) * 256 + (n0 & 127) + upoff;
    transpose_item(W, N, 64 * kb, n0, WT + (size_t)drow * K, K, scr, lane);
}

__device__ __forceinline__ void p0_prologue(const Args& a, LAS unsigned char* lds, int gw, int NGW, int wave, int lane) {
    unsigned char* ws = a.ws;
    LAS float* scr = (LAS float*)(lds + wave * 16384);
    constexpr int I0 = 16 * 37, I1 = 4 * 24, I2 = 2 * 32, I3 = 16 * 32, I4 = 16 * 88, I6 = 44 * 32, I7 = 16 * 96, I8 = 16 * 32, IM = 16 * 112, IMD = 56 * 32;
    constexpr int NITEMS = I0 + I1 + I2 + I3 + 2 * I4 + I6 + I7 + I8 + 16 * IM + 8 * IMD;
    for (int it = gw; it < NITEMS; it += NGW) {
        int r = it;
        if (r < I0) { tr_plain(a.in[I_W_IN], 1024, 1184, (bf16*)(ws + W_IN), r, scr, lane); continue; } r -= I0;
        if (r < I1) { tr_plain(a.in[I_W_UQ], 256, 768, (bf16*)(ws + W_UQ), r, scr, lane); continue; } r -= I1;
        if (r < I2) { tr_plain(a.in[I_W_UKV], 128, 1024, (bf16*)(ws + W_UKV), r, scr, lane); continue; } r -= I2;
        if (r < I3) { tr_plain(a.in[I_E_W_OUT], 1024, 1024, (bf16*)(ws + W_OUT), r, scr, lane); continue; } r -= I3;
        if (r < I4) { tr_gu(a.in[I_FFN_G], 1024, 2816, (bf16*)(ws + W_GU), 0, r, scr, lane); continue; } r -= I4;
        if (r < I4) { tr_gu(a.in[I_FFN_U], 1024, 2816, (bf16*)(ws + W_GU), 128, r, scr, lane); continue; } r -= I4;
        if (r < I6) { tr_plain(a.in[I_FFN_D], 2816, 1024, (bf16*)(ws + W_D), r, scr, lane); continue; } r -= I6;
        if (r < I7) { tr_plain(a.in[I_DIL_QKV], 1024, 3072, (bf16*)(ws + W_QKV), r, scr, lane); continue; } r -= I7;
        if (r < I8) { tr_plain(a.in[I_DIL_OUT], 1024, 1024, (bf16*)(ws + W_DO), r, scr, lane); continue; } r -= I8;
        if (r < 8 * IM) { const int e = r / IM; tr_gu(a.in[I_MOE_G] + (size_t)e * 1024 * 3584, 1024, 3584, (bf16*)(ws + W_MGU) + (size_t)e * 7168 * 1024, 0, r % IM, scr, lane); continue; } r -= 8 * IM;
        if (r < 8 * IM) { const int e = r / IM; tr_gu(a.in[I_MOE_U] + (size_t)e * 1024 * 3584, 1024, 3584, (bf16*)(ws + W_MGU) + (size_t)e * 7168 * 1024, 128, r % IM, scr, lane); continue; } r -= 8 * IM;
        { const int e = r / IMD; tr_plain(a.in[I_MOE_D] + (size_t)e * 3584 * 1024, 3584, 1024, (bf16*)(ws + W_MD) + (size_t)e * 1024 * 3584, r % IMD, scr, lane); }
    }
    { GAS v4u* z = (GAS v4u*)(ws + W_IN + (size_t)1184 * 1024 * 2);
      for (int i = gw * 64 + lane; i < 12288; i += NGW * 64) z[i] = (v4u){0u, 0u, 0u, 0u}; }
    for (int u = gw; u < 2 * 96 * 16; u += NGW) {
        const int layer = u / 1536, rem = u % 1536, cg = rem >> 4, kc = rem & 15;
        const float* W = a.in[layer ? I_ADA_O_W : I_ADA_E_W]; const float* bia = a.in[layer ? I_ADA_O_B : I_ADA_E_B];
        unsigned long long* mod = (unsigned long long*)(ws + WS_MOD) + layer * 16 * 6144;
        const int n = cg * 64 + lane, k0 = kc * 64;
        float s[16], acc[16];
#pragma unroll
        for (int b = 0; b < 16; ++b) { const float cv = a.in[I_C][b * 1024 + k0 + lane]; s[b] = cv / (1.f + __expf(-cv)); acc[b] = 0.f; }
#pragma unroll 4
        for (int kk = 0; kk < 64; ++kk) { const float w = W[(size_t)(k0 + kk) * 6144 + n];
#pragma unroll
            for (int b = 0; b < 16; ++b) acc[b] += __builtin_bit_cast(float, __builtin_amdgcn_readlane(__builtin_bit_cast(int, s[b]), kk)) * w; }
        const float bv = (kc == 0) ? bia[n] : 0.f;
#pragma unroll
        for (int b = 0; b < 16; ++b) atomicAdd(mod + b * 6144 + n, (unsigned long long)(long long)((acc[b] + bv) * 1099511627776.0f));
    }
}

struct ModPar { f32x4 a[4], s[4]; };
typedef long long modw_t;
__device__ __forceinline__ float modv(const modw_t* p) { return (float)(*p) * 9.094947017729282e-13f; }
__device__ __forceinline__ f32x4 modv4(const modw_t* p) { return (f32x4){modv(p), modv(p + 1), modv(p + 2), modv(p + 3)}; }
__device__ __forceinline__ void load_modpar(ModPar& mp, const float* g, const modw_t* mod_b, int jshift, int jscale, int lane) {
#pragma unroll
    for (int j = 0; j < 4; ++j) { const int col = 4 * lane + 256 * j;
        const f32x4 gv = *(const f32x4*)(g + col), sc = modv4(mod_b + jscale * 1024 + col), sh = modv4(mod_b + jshift * 1024 + col);
        mp.a[j] = gv * (sc + 1.0f); mp.s[j] = sh; }
}
__device__ __forceinline__ void mod_row_f32(const float* xrow, const ModPar& mp, f32x4 (&h)[4], int lane) {
    const f32x4* xr = (const f32x4*)xrow + lane; float ss = 0.f;
#pragma unroll
    for (int j = 0; j < 4; ++j) { h[j] = xr[64 * j]; ss += (h[j].x * h[j].x + h[j].y * h[j].y) + (h[j].z * h[j].z + h[j].w * h[j].w); }
    const float rs = 1.0f / sqrtf(wave_sum(ss) * (1.f / 1024.f) + EPS);
#pragma unroll
    for (int j = 0; j < 4; ++j) h[j] = h[j] * rs * mp.a[j] + mp.s[j];
}
__device__ __forceinline__ void store_row_bf16(bf16* orow, const f32x4 (&h)[4], int lane) {
    unsigned long long* o8 = (unsigned long long*)orow + lane;
#pragma unroll
    for (int j = 0; j < 4; ++j) o8[64 * j] = (unsigned long long)pk2(h[j].x, h[j].y) | ((unsigned long long)pk2(h[j].z, h[j].w) << 32);
}
__device__ __forceinline__ void modulate_phase(const float* xin, const float* g, const modw_t* mod_layer, int jshift, int jscale, bf16* H, int gw, int NGW, int lane) {
    for (int bi = gw; bi < T / 32; bi += NGW) {
        const int b = bi >> 7; ModPar mp; load_modpar(mp, g, mod_layer + b * 6144, jshift, jscale, lane);
#pragma unroll 2
        for (int r = 0; r < 32; ++r) { const size_t row = (size_t)bi * 32 + r; f32x4 h[4]; mod_row_f32(xin + row * 1024, mp, h, lane); store_row_bf16(H + row * 1024, h, lane); }
    }
}

__device__ __forceinline__ void cs_rev(float pos, float revf, float& c, float& s) { const float fr = __builtin_amdgcn_fractf(pos * revf); c = __builtin_amdgcn_cosf(fr); s = __builtin_amdgcn_sinf(fr); }
__device__ __forceinline__ void unpack8(const v4u& r, float (&v)[8]) { v[0] = bflo(r.x); v[1] = bfhi(r.x); v[2] = bflo(r.y); v[3] = bfhi(r.y); v[4] = bflo(r.z); v[5] = bfhi(r.z); v[6] = bflo(r.w); v[7] = bfhi(r.w); }
__device__ __forceinline__ v4u pack8(const float (&v)[8]) { v4u o; o.x = pk2(v[0], v[1]); o.y = pk2(v[2], v[3]); o.z = pk2(v[4], v[5]); o.w = pk2(v[6], v[7]); return o; }

__device__ __forceinline__ void r2_phase(const Args& a, int gw, int NGW, int lane) {
    unsigned char* ws = a.ws;
    const bf16* P = (const bf16*)(ws + A_P); bf16* CQ = (bf16*)(ws + A_CQ); bf16* CKV = (bf16*)(ws + A_CKV); bf16* QB = (bf16*)(ws + A_QB); bf16* KB = (bf16*)(ws + A_KB);
    const int sub = lane & 7;
    float qn[4], kvn[2], gq[8], gk[8], revf[8];
#pragma unroll
    for (int i = 0; i < 4; ++i) qn[i] = a.in[I_Q_NORM][4 * lane + i];
    kvn[0] = a.in[I_KV_NORM][2 * lane]; kvn[1] = a.in[I_KV_NORM][2 * lane + 1];
#pragma unroll
    for (int j = 0; j < 8; ++j) { gq[j] = a.in[I_GQA_QG][8 * sub + j]; gk[j] = a.in[I_GQA_KG][8 * sub + j];
        const int i = 8 * (sub & 1) + j; revf[j] = exp2f(-(float)i * (LOG2_THETA / 16.f)) * INV_2PI; }
    for (int row = gw; row < T; row += NGW) {
        const bf16* pr = P + (size_t)row * 1280; const int t = row & 4095; const float pos = (float)((sub & 4) ? (t & 63) : (t >> 6));
        { const uint2 raw = *(const uint2*)(pr + 4 * lane); float v0 = bflo(raw.x), v1 = bfhi(raw.x), v2 = bflo(raw.y), v3 = bfhi(raw.y);
          const float rs = 1.0f / sqrtf(wave_sum((v0 * v0 + v1 * v1) + (v2 * v2 + v3 * v3)) * (1.f / 256.f) + EPS);
          uint2 o; o.x = pk2(v0 * rs * qn[0], v1 * rs * qn[1]); o.y = pk2(v2 * rs * qn[2], v3 * rs * qn[3]); *(uint2*)(CQ + (size_t)row * 256 + 4 * lane) = o; }
        { const unsigned raw = *(const unsigned*)(pr + 256 + 2 * lane); float v0 = bflo(raw), v1 = bfhi(raw);
          const float rs = 1.0f / sqrtf(wave_sum(v0 * v0 + v1 * v1) * (1.f / 128.f) + EPS);
          *(unsigned*)(CKV + (size_t)row * 128 + 2 * lane) = pk2(v0 * rs * kvn[0], v1 * rs * kvn[1]); }
#pragma unroll
        for (int which = 0; which < 2; ++which) {
            const int l2 = which ? (lane & 15) : lane;
            const v4u raw = *(const v4u*)(pr + (which ? 928 : 416) + 8 * l2); float v[8]; unpack8(raw, v);
            float ss = 0.f;
#pragma unroll
            for (int j = 0; j < 8; ++j) ss += v[j] * v[j];
            ss += __shfl_xor(ss, 1); ss += __shfl_xor(ss, 2); ss += __shfl_xor(ss, 4);
            const float rs = 1.0f / sqrtf(ss * (1.f / 64.f) + EPS); float o[8];
#pragma unroll
            for (int j = 0; j < 8; ++j) { const float x = v[j] * rs * (which ? gk[j] : gq[j]); const float w = __shfl_xor(x, 2); float c, s; cs_rev(pos, revf[j], c, s);
                o[j] = (sub & 2) ? (x * c + w * s) : (x * c - w * s); if (!which) o[j] *= QSCALE_B; }
            if (!which) *(v4u*)(QB + (size_t)row * 512 + 8 * lane) = pack8(o);
            else if (lane < 16) *(v4u*)(KB + (size_t)row * 128 + 8 * lane) = pack8(o);
        }
    }
}

__device__ __forceinline__ void r3_phase(const Args& a, int gw, int NGW, int lane) {
    unsigned char* ws = a.ws;
    const bf16* P = (const bf16*)(ws + A_P); bf16* QA = (bf16*)(ws + A_QA); const bf16* KV = (const bf16*)(ws + A_KV); bf16* KA = (bf16*)(ws + A_KA);
    const int head = lane >> 3, sub = lane & 7;
    float gqn[8], gqr[4], gkn[8], gkr[4], revf[4];
#pragma unroll
    for (int j = 0; j < 8; ++j) { gqn[j] = a.in[I_MLA_QG][8 * sub + j]; gkn[j] = a.in[I_MLA_KG][8 * sub + j]; }
#pragma unroll
    for (int j = 0; j < 4; ++j) { gqr[j] = a.in[I_MLA_QG][64 + 4 * sub + j]; gkr[j] = a.in[I_MLA_KG][64 + 4 * sub + j];
        const int i = 4 * (sub & 3) + j; revf[j] = exp2f(-(float)i * (LOG2_THETA / 16.f)) * INV_2PI; }
    for (int row = gw; row < T; row += NGW) {
        const float pos = (float)(row & 4095);
#pragma unroll
        for (int which = 0; which < 2; ++which) {
            const bf16* np = which ? (KV + (size_t)row * 1024 + head * 128 + 8 * sub) : (QA + (size_t)row * 768 + head * 96 + 8 * sub);
            const bf16* rp = which ? (P + (size_t)row * 1280 + 384 + 4 * sub) : (QA + (size_t)row * 768 + head * 96 + 64 + 4 * sub);
            const v4u rn = *(const v4u*)np; const uint2 rr = *(const uint2*)rp;
            float v[8], r4[4]; unpack8(rn, v); r4[0] = bflo(rr.x); r4[1] = bfhi(rr.x); r4[2] = bflo(rr.y); r4[3] = bfhi(rr.y);
            float ss = 0.f;
#pragma unroll
            for (int j = 0; j < 8; ++j) ss += v[j] * v[j];
#pragma unroll
            for (int j = 0; j < 4; ++j) ss += r4[j] * r4[j];
            ss += __shfl_xor(ss, 1); ss += __shfl_xor(ss, 2); ss += __shfl_xor(ss, 4);
            const float rs = 1.0f / sqrtf(ss * (1.f / 96.f) + EPS); const float qs = which ? 1.0f : QSCALE_A;
            float o[8], orp[4];
#pragma unroll
            for (int j = 0; j < 8; ++j) o[j] = v[j] * rs * (which ? gkn[j] : gqn[j]) * qs;
#pragma unroll
            for (int j = 0; j < 4; ++j) { const float x = r4[j] * rs * (which ? gkr[j] : gqr[j]); const float w = __shfl_xor(x, 4); float c, s; cs_rev(pos, revf[j], c, s);
                orp[j] = ((sub & 4) ? (x * c + w * s) : (x * c - w * s)) * qs; }
            bf16* on = (which ? KA : QA) + (size_t)row * 768 + head * 96;
            *(v4u*)(on + 8 * sub) = pack8(o);
            uint2 o2; o2.x = pk2(orp[0], orp[1]); o2.y = pk2(orp[2], orp[3]); *(uint2*)(on + 64 + 4 * sub) = o2;
        }
    }
}

__device__ __forceinline__ void r6_phase(const Args& a, int gw, int NGW, int lane) {
    bf16* QKV = (bf16*)(a.ws + A_QKV);
    const int sub = lane & 3;
    float gq[16], gk[16], revf[16];
#pragma unroll
    for (int j = 0; j < 16; ++j) { gq[j] = a.in[I_DIL_QG][16 * sub + j]; gk[j] = a.in[I_DIL_KG][16 * sub + j];
        const int i = 16 * (sub & 1) + j; revf[j] = exp2f(-(float)i * (LOG2_THETA / 32.f)) * INV_2PI; }
    for (int row = gw; row < T; row += NGW) {
        const float pos = (float)(row & 4095);
#pragma unroll
        for (int which = 0; which < 2; ++which) {
            bf16* p = QKV + (size_t)row * 3072 + which * 1024 + 16 * lane;
            const v4u r0 = *(const v4u*)p, r1 = *(const v4u*)(p + 8); float v0[8], v1[8]; unpack8(r0, v0); unpack8(r1, v1);
            float ss = 0.f;
#pragma unroll
            for (int j = 0; j < 8; ++j) ss += v0[j] * v0[j] + v1[j] * v1[j];
            ss += __shfl_xor(ss, 1); ss += __shfl_xor(ss, 2);
            const float rs = 1.0f / sqrtf(ss * (1.f / 64.f) + EPS); float o0[8], o1[8];
#pragma unroll
            for (int j = 0; j < 16; ++j) { const float xin = (j < 8) ? v0[j & 7] : v1[j & 7]; const float x = xin * rs * (which ? gk[j] : gq[j]); const float w = __shfl_xor(x, 2); float c, s; cs_rev(pos, revf[j], c, s);
                float o = (sub & 2) ? (x * c + w * s) : (x * c - w * s); if (!which) o *= QSCALE_B; if (j < 8) o0[j & 7] = o; else o1[j & 7] = o; }
            *(v4u*)p = pack8(o0); *(v4u*)(p + 8) = pack8(o1);
        }
    }
}
namespace att {
using f32x16 = __attribute__((ext_vector_type(16))) float;
using s16x4 = __attribute__((ext_vector_type(4))) short;
#define SBAR() __builtin_amdgcn_sched_barrier(0)
__device__ __forceinline__ int crow(int r, int hi) { return (r & 3) + 8 * (r >> 2) + 4 * hi; }
template <int DQ> struct Lay {
    static constexpr int KROW = DQ * 2 + 16;
    static constexpr int KBUF = 64 * KROW;
    static constexpr int VBUF = 8192;
    static constexpr int K_OFF = 0, V_OFF = 2 * KBUF, WS_OFF = V_OFF + 2 * VBUF, BYTES = WS_OFF + 8 * 512;
};
__device__ __forceinline__ int v_st(int k, int c) { const int kk = (k & ~0xC) | ((k & 4) << 1) | ((k & 8) >> 1); return ((kk >> 3) * 2 + (c >> 5)) * 512 + ((kk & 7) * 32 + (c & 31)) * 2; }
__device__ __forceinline__ int v_rd_base(int lane) { return ((lane & 3) << 3) | (((lane >> 2) & 3) << 6) | (((lane >> 4) & 1) << 5) | (((lane >> 5) & 1) << 8); }
template <int OFF> __device__ __forceinline__ s16x4 tr_read(int vb) { s16x4 r; asm volatile("ds_read_b64_tr_b16 %0, %1 offset:%2" : "=&v"(r) : "v"(vb), "i"(OFF) : "memory"); return r; }
template <int D0> __device__ __forceinline__ void pv_one(f32x16& od, int vb, bf16x8 pa0, bf16x8 pa1, bf16x8 pa2, bf16x8 pa3) {
    const s16x4 l0 = tr_read<D0 * 512 + 0 * 2048>(vb), h0 = tr_read<D0 * 512 + 0 * 2048 + 1024>(vb), l1 = tr_read<D0 * 512 + 1 * 2048>(vb), h1 = tr_read<D0 * 512 + 1 * 2048 + 1024>(vb);
    const s16x4 l2 = tr_read<D0 * 512 + 2 * 2048>(vb), h2 = tr_read<D0 * 512 + 2 * 2048 + 1024>(vb), l3 = tr_read<D0 * 512 + 3 * 2048>(vb), h3 = tr_read<D0 * 512 + 3 * 2048 + 1024>(vb);
    asm volatile("s_waitcnt lgkmcnt(0)" ::: "memory"); SBAR();
#define PKV(L, H) (bf16x8){L[0], L[1], L[2], L[3], H[0], H[1], H[2], H[3]}
    od = __builtin_amdgcn_mfma_f32_32x32x16_bf16(pa0, PKV(l0, h0), od, 0, 0, 0);
    od = __builtin_amdgcn_mfma_f32_32x32x16_bf16(pa1, PKV(l1, h1), od, 0, 0, 0);
    od = __builtin_amdgcn_mfma_f32_32x32x16_bf16(pa2, PKV(l2, h2), od, 0, 0, 0);
    od = __builtin_amdgcn_mfma_f32_32x32x16_bf16(pa3, PKV(l3, h3), od, 0, 0, 0);
#undef PKV
}
struct Merge { const bf16* O1; const bf16* O2; const float* L1; const float* L2; };

template <int DQ, int MODE>
__device__ __forceinline__ void attn_unit(const bf16* __restrict__ Qp, long ldq, const bf16* __restrict__ Kp, long ldk, const bf16* __restrict__ Vp, long ldv, int t0, int t1, int q0,
                                          bf16* Op, long ldo, float* Lp, long ldl, const Merge mg, LAS char* lds) {
    using LY = Lay<DQ>;
    const int tid = threadIdx.x, lane = tid & 63, r32 = lane & 31, hi = lane >> 5; const int wid = __builtin_amdgcn_readfirstlane(tid >> 6);
    LAS float* wsf = (LAS float*)(lds + LY::WS_OFF) + wid * 128;
    bf16x8 qr[DQ / 16];
    { const bf16* Qw = Qp + (long)(wid * 32 + r32) * ldq + hi * 8;
#pragma unroll
      for (int d0 = 0; d0 < DQ / 16; ++d0) qr[d0] = *reinterpret_cast<const bf16x8*>(Qw + d0 * 16); }
    constexpr int CPR = DQ / 8;
    const int kc0 = tid, krow0 = kc0 / CPR, kch0 = kc0 % CPR;
    const int kc1 = tid + 512, krow1 = kc1 / CPR, kch1 = kc1 % CPR;
    const bool k2 = (DQ == 96) && (wid < 4);
    const int vkey = 2 * (tid >> 4) + ((tid >> 2) & 1), vcol = 32 * ((tid >> 3) & 1) + 8 * (tid & 3);
    const int kst0 = krow0 * LY::KROW + kch0 * 16, kst1 = krow1 * LY::KROW + kch1 * 16, vst = v_st(vkey, vcol);
    const bf16* kg0 = Kp + (long)krow0 * ldk + kch0 * 8; const bf16* kg1 = Kp + (long)krow1 * ldk + kch1 * 8; const bf16* vg = Vp + (long)vkey * ldv + vcol;
    bf16x8 sk0, sk1 = {}, sv;
#define A_LOAD(t) do { const long ko = (long)(t) * 64 * ldk; sk0 = *reinterpret_cast<const bf16x8*>(kg0 + ko); if (k2) sk1 = *reinterpret_cast<const bf16x8*>(kg1 + ko); sv = *reinterpret_cast<const bf16x8*>(vg + (long)(t) * 64 * ldv); } while (0)
#define A_WRITE(b) do { *(LAS bf16x8*)(lds + LY::K_OFF + (b) * LY::KBUF + kst0) = sk0; if (k2) *(LAS bf16x8*)(lds + LY::K_OFF + (b) * LY::KBUF + kst1) = sk1; \
        *(LAS bf16x8*)(lds + LY::V_OFF + (b) * LY::VBUF + vst) = sv; } while (0)
    const int vb0 = (int)(unsigned)(size_t)(lds + LY::V_OFF) + v_rd_base(lane);
    float m_reg = -1e30f, l_reg = 0.f; f32x16 o[2]; o[0] = f32x16{}; o[1] = f32x16{};
    int tlo = t0, thi = t1 - 1;
    if (MODE != 0) { const int lo = q0 + 32 * wid; tlo = (lo - 64) >> 6; thi = (lo + 95) >> 6; }
    const int qi = q0 + 32 * wid + r32;
    A_LOAD(t0); asm volatile("s_waitcnt vmcnt(0)" ::: "memory"); A_WRITE(0); __syncthreads();
    for (int t = t0; t < t1; ++t) {
        const int buf = (t - t0) & 1; const bool more = (t + 1 < t1);
        if (more) A_LOAD(t + 1);
        if (MODE == 0 || (t >= tlo && t <= thi)) {
            f32x16 p0 = f32x16{}, p1 = f32x16{};
            { const LAS char* kb = lds + LY::K_OFF + buf * LY::KBUF + r32 * LY::KROW + hi * 16;
#pragma unroll
              for (int d0 = 0; d0 < DQ / 16; ++d0) {
                  const bf16x8 b0 = *(const LAS bf16x8*)(kb + d0 * 32);
                  const bf16x8 b1 = *(const LAS bf16x8*)(kb + 32 * LY::KROW + d0 * 32);
                  p0 = __builtin_amdgcn_mfma_f32_32x32x16_bf16(b0, qr[d0], p0, 0, 0, 0);
                  p1 = __builtin_amdgcn_mfma_f32_32x32x16_bf16(b1, qr[d0], p1, 0, 0, 0); } }
            if (MODE != 0) { const int kb0 = 64 * t + 4 * hi - qi;
#pragma unroll
                for (int r = 0; r < 16; ++r) { const int d = kb0 + (r & 3) + 8 * (r >> 2); if (d > 64 || d < -64) p0[r] = -INFINITY; if (d + 32 > 64 || d + 32 < -64) p1[r] = -INFINITY; } }
            float pmax = p0[0];
#pragma unroll
            for (int r = 1; r < 16; ++r) pmax = fmaxf(pmax, p0[r]);
#pragma unroll
            for (int r = 0; r < 16; ++r) pmax = fmaxf(pmax, p1[r]);
            { auto rr = __builtin_amdgcn_permlane32_swap(__float_as_uint(pmax), __float_as_uint(pmax), false, false); pmax = fmaxf(__uint_as_float(rr[0]), __uint_as_float(rr[1])); }
            if (__any(pmax > m_reg)) {
                const float mn = fmaxf(m_reg, pmax); const float alpha = __builtin_amdgcn_exp2f(m_reg - mn); m_reg = mn; l_reg *= alpha;
                if (hi == 0) wsf[r32] = alpha; asm volatile("s_waitcnt lgkmcnt(0)" ::: "memory");
#pragma unroll
                for (int r = 0; r < 16; ++r) { const float al = wsf[crow(r, hi)]; o[0][r] *= al; o[1][r] *= al; }
            }
#pragma unroll
            for (int r = 0; r < 16; ++r) { p0[r] = __builtin_amdgcn_exp2f(p0[r] - m_reg); p1[r] = __builtin_amdgcn_exp2f(p1[r] - m_reg); }
            float ps = 0.f;
#pragma unroll
            for (int r = 0; r < 16; ++r) ps += p0[r] + p1[r];
            { auto rr = __builtin_amdgcn_permlane32_swap(__float_as_uint(ps), __float_as_uint(ps), false, false); ps = __uint_as_float(rr[0]) + __uint_as_float(rr[1]); }
            l_reg += ps;
            bf16x8 pa0, pa1, pa2, pa3;
#define PK4(P, BASE, OUT) do { unsigned a0 = cvtpk(P[BASE + 0], P[BASE + 1]), a1 = cvtpk(P[BASE + 2], P[BASE + 3]); unsigned b0 = cvtpk(P[BASE + 4], P[BASE + 5]), b1 = cvtpk(P[BASE + 6], P[BASE + 7]); \
    auto r0 = __builtin_amdgcn_permlane32_swap(a0, b0, false, false); auto r1 = __builtin_amdgcn_permlane32_swap(a1, b1, false, false); \
    v4u w = {r0[0], r1[0], r0[1], r1[1]}; OUT = *reinterpret_cast<bf16x8*>(&w); } while (0)
            PK4(p0, 0, pa0); PK4(p0, 8, pa1); PK4(p1, 0, pa2); PK4(p1, 8, pa3);
#undef PK4
            const int vb = vb0 + buf * LY::VBUF;
            pv_one<0>(o[0], vb, pa0, pa1, pa2, pa3); pv_one<1>(o[1], vb, pa0, pa1, pa2, pa3);
        }
        if (more) { asm volatile("s_waitcnt vmcnt(0)" ::: "memory"); A_WRITE(buf ^ 1); }
        __syncthreads();
    }
#undef A_LOAD
#undef A_WRITE
    float lse = 0.f;
    if (MODE != 0) lse = m_reg + __builtin_amdgcn_logf(l_reg);
    if (hi == 0) { wsf[r32] = __builtin_amdgcn_rcpf(l_reg); if (MODE == 2) wsf[32 + r32] = lse; }
    if (MODE == 1 && hi == 0) Lp[(long)(wid * 32 + r32) * ldl] = lse;
    asm volatile("s_waitcnt lgkmcnt(0)" ::: "memory");
    bf16* Ow = Op + (long)(wid * 32) * ldo;
#pragma unroll
    for (int r = 0; r < 16; ++r) { const int orow = crow(r, hi); const float rl = wsf[orow];
        float v0 = o[0][r] * rl, v1 = o[1][r] * rl;
        if (MODE == 2) {
            const long rr = (long)(wid * 32 + orow);
            const float L3 = wsf[32 + orow], L1 = mg.L1[rr * ldl], L2 = mg.L2[rr * ldl];
            const float M = fmaxf(L3, fmaxf(L1, L2)); const float w1 = __builtin_amdgcn_exp2f(L1 - M), w2 = __builtin_amdgcn_exp2f(L2 - M), w3 = __builtin_amdgcn_exp2f(L3 - M);
            const float inv = __builtin_amdgcn_rcpf(w1 + w2 + w3);
            const bf16* o1 = mg.O1 + rr * ldo; const bf16* o2 = mg.O2 + rr * ldo;
            v0 = (w1 * bf2f(o1[r32]) + w2 * bf2f(o2[r32]) + w3 * v0) * inv;
            v1 = (w1 * bf2f(o1[32 + r32]) + w2 * bf2f(o2[32 + r32]) + w3 * v1) * inv;
        }
        Ow[(long)orow * ldo + r32] = (bf16)f2bf(v0); Ow[(long)orow * ldo + 32 + r32] = (bf16)f2bf(v1); }
    asm volatile("s_waitcnt lgkmcnt(0)" ::: "memory");
}
}
namespace pg8 {
struct EpiResGate {
    static constexpr bool PERM = false, AFTER_DRAIN = false;
    const float* base; float* out; const long long* gate;
    __device__ __forceinline__ void operator()(const f32x4 (&acc)[2][2][4][2], const Unit& u, int wr, int wc, int fr, int fq) const {
        const int b = u.pm >> 4; const int col0 = u.pn * BM + wc * 32 + 4 * fq; const long long* gp = gate + b * 6144 + col0;
        f32x4 gv[2][2];
#pragma unroll
        for (int bj = 0; bj < 2; ++bj)
#pragma unroll
            for (int n = 0; n < 2; ++n) { const long long* q = gp + bj * HALF + n * 16; gv[bj][n] = (f32x4){(float)q[0], (float)q[1], (float)q[2], (float)q[3]} * 9.094947017729282e-13f; }
#pragma unroll
        for (int ai = 0; ai < 2; ++ai)
#pragma unroll
            for (int m = 0; m < 4; ++m) { const size_t off = (size_t)(u.pm * BM + ai * HALF + wr * 64 + m * 16 + fr) * 1024 + col0;
#pragma unroll
                for (int bj = 0; bj < 2; ++bj)
#pragma unroll
                    for (int n = 0; n < 2; ++n) { const f32x4 bs = *(const f32x4*)(base + off + bj * HALF + n * 16); *(f32x4*)(out + off + bj * HALF + n * 16) = bs + gv[bj][n] * acc[ai][bj][m][n]; }
                if (m & 1) asm volatile("" ::: "memory"); }
    }
};
__device__ __forceinline__ float silu_mul(float g, float u) { return g * __builtin_amdgcn_rcpf(1.0f + __builtin_amdgcn_exp2f(-1.4426950408889634f * g)) * u; }
struct EpiSwiGLU {
    static constexpr bool PERM = true, AFTER_DRAIN = false;
    bf16_t* O; int ldo; int nNe; int pm0;
    __device__ __forceinline__ void operator()(const f32x4 (&acc)[2][2][4][2], const Unit& u, int wr, int wc, int fr, int fq) const {
        const int pnl = u.pn % nNe; const int col0 = pnl * HALF + wc * 32 + 8 * fq; const int row0 = (u.pm - pm0) * BM + wr * 64 + fr;
#pragma unroll
        for (int ai = 0; ai < 2; ++ai)
#pragma unroll
            for (int m = 0; m < 4; ++m) { bf16_t* rowp = O + (size_t)(row0 + ai * HALF + m * 16) * ldo + col0;
                const f32x4 g0 = acc[ai][0][m][0], g1 = acc[ai][0][m][1], u0 = acc[ai][1][m][0], u1 = acc[ai][1][m][1];
                u32x4 w; w.x = cvt_pk_bf16(silu_mul(g0[0], u0[0]), silu_mul(g0[1], u0[1])); w.y = cvt_pk_bf16(silu_mul(g0[2], u0[2]), silu_mul(g0[3], u0[3]));
                w.z = cvt_pk_bf16(silu_mul(g1[0], u1[0]), silu_mul(g1[1], u1[1])); w.w = cvt_pk_bf16(silu_mul(g1[2], u1[2]), silu_mul(g1[3], u1[3]));
                *(u32x4*)rowp = w; }
    }
};
struct EpiMoeDown {
    static constexpr bool PERM = true, AFTER_DRAIN = false;
    bf16_t* Y; const float* gs; int pm0;
    __device__ __forceinline__ void operator()(const f32x4 (&acc)[2][2][4][2], const Unit& u, int wr, int wc, int fr, int fq) const {
        const int pnl = u.pn & 3; const int col0 = pnl * BM + wc * 32 + 8 * fq; const int row0 = (u.pm + pm0) * BM + wr * 64 + fr;
#pragma unroll
        for (int ai = 0; ai < 2; ++ai)
#pragma unroll
            for (int m = 0; m < 4; ++m) { const int row = row0 + ai * HALF + m * 16; const float g = gs[row]; bf16_t* rowp = Y + (size_t)row * 1024 + col0;
#pragma unroll
                for (int bj = 0; bj < 2; ++bj) { const f32x4 v0 = acc[ai][bj][m][0] * g, v1 = acc[ai][bj][m][1] * g;
                    u32x4 w; w.x = cvt_pk_bf16(v0[0], v0[1]); w.y = cvt_pk_bf16(v0[2], v0[3]); w.z = cvt_pk_bf16(v1[0], v1[1]); w.w = cvt_pk_bf16(v1[2], v1[3]);
                    *(u32x4*)(rowp + bj * HALF) = w; } }
    }
};
struct MoeOrder {
    StaticOrder so; int nN, pmA, tile0; int pends[8];
    __device__ void init(int nM_, int nN_, int G_, int c_, int pmA_, int tile0_, const int* pe) { so.nM = nM_; so.nN = nN_; so.nwg = nM_ * nN_; so.G = G_; so.c = c_; nN = nN_; pmA = pmA_; tile0 = tile0_;
#pragma unroll
        for (int j = 0; j < 8; ++j) pends[j] = pe[j]; }
    __device__ bool next(int i, Unit& u) const {
        Unit v; if (!so.next(i, v)) return false;
        const int r0 = (tile0 + v.pm) * BM; int e = 0;
#pragma unroll
        for (int j = 0; j < 7; ++j) e += (r0 >= pends[j]) ? 1 : 0;
        u.pm = v.pm + pmA; u.pn = e * nN + v.pn; return true;
    }
    __device__ __forceinline__ void a_ready(const Unit&) const {}
    __device__ __forceinline__ void done(const Unit&) const {}
};
}

__device__ __forceinline__ void r7_phase(const Args& a, unsigned char* lds_g, int vcu, int G, int tid, int wave, int lane) {
    unsigned char* ws = a.ws; const float* x = a.out; const float* router = a.in[I_ROUTER];
    int* topk = (int*)(ws + WS_TOPK); float* gates = (float*)(ws + WS_GATES); int* blkcnt = (int*)(ws + WS_BLKCNT);
    int* hist = (int*)lds_g;
    float rw[4][4][8];
#pragma unroll
    for (int j = 0; j < 4; ++j)
#pragma unroll
        for (int i = 0; i < 4; ++i) { const int col = 4 * lane + 256 * j + i; const f32x4 r0 = *(const f32x4*)(router + col * 8), r1 = *(const f32x4*)(router + col * 8 + 4);
            rw[j][i][0] = r0.x; rw[j][i][1] = r0.y; rw[j][i][2] = r0.z; rw[j][i][3] = r0.w; rw[j][i][4] = r1.x; rw[j][i][5] = r1.y; rw[j][i][6] = r1.z; rw[j][i][7] = r1.w; }
    const modw_t* mod = (const modw_t*)(ws + WS_MOD) + 16 * 6144;
    for (int blk = vcu; blk < 256; blk += G) {
        if (tid < 8) hist[tid] = 0;
        __syncthreads();
        const int b = blk >> 4; ModPar mp; load_modpar(mp, a.in[I_NORM_O_FFN], mod + b * 6144, 3, 4, lane);
        unsigned long long cnt = 0ull;
        for (int r = 0; r < 32; ++r) { const int row = blk * 256 + wave * 32 + r; f32x4 h[4]; mod_row_f32(x + (size_t)row * 1024, mp, h, lane);
            float lg[8];
#pragma unroll
            for (int e = 0; e < 8; ++e) { float s = 0.f;
#pragma unroll
                for (int j = 0; j < 4; ++j) s += (h[j].x * rw[j][0][e] + h[j].y * rw[j][1][e]) + (h[j].z * rw[j][2][e] + h[j].w * rw[j][3][e]);
                lg[e] = wave_sum(s); }
            int e1 = 0; float v1 = lg[0];
#pragma unroll
            for (int e = 1; e < 8; ++e) if (lg[e] > v1) { v1 = lg[e]; e1 = e; }
            int e2 = -1; float v2 = -INFINITY;
#pragma unroll
            for (int e = 0; e < 8; ++e) if (e != e1 && lg[e] > v2) { v2 = lg[e]; e2 = e; }
            e1 = __builtin_amdgcn_readfirstlane(e1); e2 = __builtin_amdgcn_readfirstlane(e2);
            const float g1 = 1.0f / (1.0f + __expf(v2 - v1)), g2 = 1.0f - g1;
            if (lane == 0) { topk[row] = e1 | (e2 << 8); gates[2 * row] = g1; gates[2 * row + 1] = g2; }
            cnt += (1ull << (8 * e1)) + (1ull << (8 * e2));
        }
        if (lane < 8) atomicAdd(&hist[lane], (int)((cnt >> (8 * lane)) & 255ull));
        __syncthreads();
        if (tid < 8) blkcnt[blk * 8 + tid] = hist[tid];
        __syncthreads();
    }
}

__device__ __forceinline__ void r8_phase(const Args& a, unsigned char* lds_g, int vcu, int G, int tid, int wave, int lane) {
    unsigned char* ws = a.ws; const float* x = a.out;
    const int* topk = (const int*)(ws + WS_TOPK); const float* gates = (const float*)(ws + WS_GATES); const int* blkcnt = (const int*)(ws + WS_BLKCNT);
    int* slots = (int*)(ws + WS_SLOTS); float* gslot = (float*)(ws + WS_GSLOT); int* pends_g = (int*)(ws + WS_PENDS); bf16* HP = (bf16*)(ws + A_HP);
    int* tot = (int*)lds_g; int* base = tot + 8; int* pst = tot + 16; int* wcnt = tot + 32; int* sl = tot + 128;
    const modw_t* mod = (const modw_t*)(ws + WS_MOD) + 16 * 6144;
    if (tid < 8) tot[tid] = 0;
    __syncthreads();
    for (int idx = tid; idx < 2048; idx += 512) atomicAdd(&tot[idx & 7], blkcnt[idx]);
    __syncthreads();
    if (tid == 0) { int p = 0; for (int e = 0; e < 8; ++e) { pst[e] = p; p += (tot[e] + 255) & ~255; if (vcu == 0) pends_g[e] = p; } }
    __syncthreads();
    if (vcu < 8) { const int e = vcu, lo = pst[e] + tot[e], hi = pst[e] + ((tot[e] + 255) & ~255);
        for (int s = lo + wave; s < hi; s += NWAVES) { GAS unsigned long long* o8 = (GAS unsigned long long*)(HP + (size_t)s * 1024) + lane;
#pragma unroll
            for (int j = 0; j < 4; ++j) o8[64 * j] = 0ull;
            if (lane == 0) gslot[s] = 0.f; } }
    for (int blk = vcu; blk < 256; blk += G) {
        if (tid < 8) base[tid] = 0;
        __syncthreads();
        for (int idx = tid; idx < 2048; idx += 512) if ((idx >> 3) < blk) atomicAdd(&base[idx & 7], blkcnt[idx]);
        const int token = blk * 256 + (tid >> 1), k = tid & 1; const int pk = topk[token]; const int ea = k ? ((pk >> 8) & 255) : (pk & 255);
        int rank = 0;
#pragma unroll
        for (int e = 0; e < 8; ++e) { const unsigned long long mask = __ballot(ea == e); if (ea == e) rank = __popcll(mask & ((1ull << lane) - 1ull)); if (lane == 0) wcnt[wave * 8 + e] = __popcll(mask); }
        __syncthreads();
        int s = pst[ea] + base[ea] + rank;
        for (int w = 0; w < wave; ++w) s += wcnt[w * 8 + ea];
        slots[token * 2 + k] = s; gslot[s] = gates[token * 2 + k]; sl[tid] = s;
        __syncthreads();
        const int b = blk >> 4; ModPar mp; load_modpar(mp, a.in[I_NORM_O_FFN], mod + b * 6144, 3, 4, lane);
        for (int r = 0; r < 32; ++r) { const int tl = wave * 32 + r; const int row = blk * 256 + tl; f32x4 h[4]; mod_row_f32(x + (size_t)row * 1024, mp, h, lane);
            const int s1 = sl[2 * tl], s2 = sl[2 * tl + 1];
            store_row_bf16(HP + (size_t)s1 * 1024, h, lane); store_row_bf16(HP + (size_t)s2 * 1024, h, lane); }
        __syncthreads();
    }
}

__device__ __forceinline__ void r9_phase(const Args& a, int gw, int NGW, int lane) {
    unsigned char* ws = a.ws; float* out = a.out; const int* slots = (const int*)(ws + WS_SLOTS); const bf16* Y = (const bf16*)(ws + A_Y);
    const modw_t* mod = (const modw_t*)(ws + WS_MOD) + 16 * 6144;
    for (int bi = gw; bi < T / 32; bi += NGW) {
        const int b = bi >> 7; f32x4 gt[4];
#pragma unroll
        for (int j = 0; j < 4; ++j) gt[j] = modv4(mod + b * 6144 + 5 * 1024 + 4 * lane + 256 * j);
#pragma unroll 2
        for (int r = 0; r < 32; ++r) { const int row = bi * 32 + r; const int s1 = slots[2 * row], s2 = slots[2 * row + 1];
            const uint2* y1 = (const uint2*)(Y + (size_t)s1 * 1024) + lane; const uint2* y2 = (const uint2*)(Y + (size_t)s2 * 1024) + lane; f32x4* o = (f32x4*)(out + (size_t)row * 1024) + lane;
#pragma unroll
            for (int j = 0; j < 4; ++j) { const uint2 p = y1[64 * j], q = y2[64 * j]; f32x4 v = o[64 * j];
                v.x += gt[j].x * (bflo(p.x) + bflo(q.x)); v.y += gt[j].y * (bfhi(p.x) + bfhi(q.x)); v.z += gt[j].z * (bflo(p.y) + bflo(q.y)); v.w += gt[j].w * (bfhi(p.y) + bfhi(q.y)); o[64 * j] = v; } }
    }
}

#ifndef MK_PER_PHASE
#define MK_PER_PHASE 0
#endif
__global__ void __launch_bounds__(NWAVES * 64, 2) mega_fwd(Args args) {
    extern __shared__ __attribute__((aligned(16))) unsigned char lds_raw[];
    LAS unsigned char* lds = (LAS unsigned char*)lds_raw;
    volatile LAS unsigned* MISC = (volatile LAS unsigned*)(lds + MISC_OFF);
    const int G = gridDim.x, bx = blockIdx.x; const int vcu = (G % 8 == 0) ? (bx % 8) * (G / 8) + bx / 8 : bx;
    const int NGW = G * NWAVES;
    unsigned char* ws = args.ws;
    for (int u = threadIdx.x; u < (LDS_BYTES - RING_BYTES) / 4; u += NWAVES * 64) ((LAS unsigned*)(lds + RING_BYTES))[u] = 0u;
#define IDS() int tid = threadIdx.x; asm volatile("" : "+v"(tid)); const int lane = tid & 63, wave = __builtin_amdgcn_readfirstlane(tid >> 6); const int gw = vcu * NWAVES + wave; (void)lane; (void)gw
    __syncthreads();
    XcdBarrier bar; bar.bar = (unsigned*)(ws + WS_CTL) + CW_BAR; bar.x = 0; bar.st = nullptr;
    if (!MK_PER_PHASE) bar = xcd_barrier_post((unsigned*)(ws + WS_CTL) + CW_BAR, MISC + 8);
    const int lo = args.ph_lo, hi = args.ph_hi;
#define IN(k) (lo <= (k) && (k) < hi)
#define SEAM(k) do { if (!MK_PER_PHASE) { if (IN(k) && IN((k) + 1)) xcd_barrier(bar); } } while (0)
    const modw_t* mod_e = (const modw_t*)(ws + WS_MOD); const modw_t* mod_o = mod_e + 16 * 6144;
    bf16* H = (bf16*)(ws + A_H);

    if (IN(0)) { IDS(); p0_prologue(args, lds, gw, NGW, wave, lane); } SEAM(0);
    if (IN(1)) { IDS(); modulate_phase(args.in[I_X], args.in[I_NORM_E_MIX], mod_e, 0, 1, H, gw, NGW, lane); } SEAM(1);
    if (IN(2)) { pg8::Gemm g{H, (const bf16*)(ws + W_IN), T, 1280, 1024}; pg8::StaticOrder S; S.init(T, 1280, G, bx);
        pg8::EpiBf16<0> E{(bf16*)(ws + A_P), 1280, nullptr, 0, 0, 1.f};
        pg8::gemm_phase<pg8::EpiBf16<0>, pg8::StaticOrder, true, true>(lds, g, S, E); } SEAM(2);
    if (IN(3)) { IDS(); r2_phase(args, gw, NGW, lane); } SEAM(3);
    if (IN(4)) {
        { pg8::Gemm g{(const bf16*)(ws + A_CQ), (const bf16*)(ws + W_UQ), T, 768, 256}; pg8::StaticOrder S; S.init(T, 768, G, bx);
          pg8::EpiBf16<0> E{(bf16*)(ws + A_QA), 768, nullptr, 0, 0, 1.f};
          pg8::gemm_phase<pg8::EpiBf16<0>, pg8::StaticOrder, true, true>(lds, g, S, E); }
        __syncthreads();
        { pg8::Gemm g{(const bf16*)(ws + A_CKV), (const bf16*)(ws + W_UKV), T, 1024, 128}; pg8::StaticOrder S; S.init(T, 1024, G, bx);
          pg8::EpiBf16<0> E{(bf16*)(ws + A_KV), 1024, nullptr, 0, 0, 1.f};
          pg8::gemm_phase<pg8::EpiBf16<0>, pg8::StaticOrder, true, true>(lds, g, S, E); }
    } SEAM(4);
    if (IN(5)) { IDS(); r3_phase(args, gw, NGW, lane); } SEAM(5);
    if (IN(6)) {
        const att::Merge nomg{nullptr, nullptr, nullptr, nullptr};
        bf16* ATT = (bf16*)(ws + A_ATT0);
        for (int L = vcu; L < 4096; L += G) {
            const int u = L & 2047, b = u >> 7, h = (u >> 4) & 7, qb = u & 15; const size_t r0 = (size_t)b * SEQ, rq = r0 + 256 * qb;
            if (L < 2048) att::attn_unit<96, 0>((const bf16*)(ws + A_QA) + rq * 768 + h * 96, 768, (const bf16*)(ws + A_KA) + r0 * 768 + h * 96, 768, (const bf16*)(ws + A_KV) + r0 * 1024 + h * 128 + 64, 1024,
                                                0, 64, 0, ATT + rq * 1024 + h * 64, 1024, nullptr, 0, nomg, (LAS char*)lds);
            else att::attn_unit<64, 0>((const bf16*)(ws + A_QB) + rq * 512 + h * 64, 512, (const bf16*)(ws + A_KB) + r0 * 128 + (h >> 2) * 64, 128, (const bf16*)(ws + A_P) + r0 * 1280 + 1056 + (h >> 2) * 64, 1280,
                                       0, 64, 0, ATT + rq * 1024 + 512 + h * 64, 1024, nullptr, 0, nomg, (LAS char*)lds);
        }
    } SEAM(6);
    if (IN(7)) { pg8::Gemm g{(const bf16*)(ws + A_ATT0), (const bf16*)(ws + W_OUT), T, 1024, 1024}; pg8::StaticOrder S; S.init(T, 1024, G, bx);
        pg8::EpiResGate E{args.in[I_X], args.out, mod_e + 2 * 1024};
        pg8::gemm_phase<pg8::EpiResGate, pg8::StaticOrder, true, true>(lds, g, S, E); } SEAM(7);
    if (IN(8)) { IDS(); modulate_phase(args.out, args.in[I_NORM_E_FFN], mod_e, 3, 4, H, gw, NGW, lane); } SEAM(8);
    if (IN(9)) { pg8::Gemm g{H, (const bf16*)(ws + W_GU), T, 5632, 1024}; pg8::StaticOrder S; S.init(T, 5632, G, bx);
        pg8::EpiSwiGLU E{(bf16*)(ws + A_ACT), 2816, 1 << 30, 0};
        pg8::gemm_phase<pg8::EpiSwiGLU, pg8::StaticOrder, true, true>(lds, g, S, E); } SEAM(9);
    if (IN(10)) { pg8::Gemm g{(const bf16*)(ws + A_ACT), (const bf16*)(ws + W_D), T, 1024, 2816}; pg8::StaticOrder S; S.init(T, 1024, G, bx);
        pg8::EpiResGate E{args.out, args.out, mod_e + 5 * 1024};
        pg8::gemm_phase<pg8::EpiResGate, pg8::StaticOrder, true, true>(lds, g, S, E); } SEAM(10);
    if (IN(11)) { IDS(); modulate_phase(args.out, args.in[I_NORM_O_MIX], mod_o, 0, 1, H, gw, NGW, lane); } SEAM(11);
    if (IN(12)) { pg8::Gemm g{H, (const bf16*)(ws + W_QKV), T, 3072, 1024}; pg8::StaticOrder S; S.init(T, 3072, G, bx);
        pg8::EpiBf16<0> E{(bf16*)(ws + A_QKV), 3072, nullptr, 0, 0, 1.f};
        pg8::gemm_phase<pg8::EpiBf16<0>, pg8::StaticOrder, true, true>(lds, g, S, E); } SEAM(12);
    if (IN(13)) { IDS(); r6_phase(args, gw, NGW, lane); } SEAM(13);
    if (IN(14) || IN(15)) {
        const bf16* QKV = (const bf16*)(ws + A_QKV); bf16* O1 = (bf16*)(ws + A_ATT1); bf16* O2 = (bf16*)(ws + A_O2); float* L1 = (float*)(ws + A_LSE1); float* L2 = (float*)(ws + A_LSE2);
        const att::Merge nomg{nullptr, nullptr, nullptr, nullptr};
        if (IN(14)) {
            for (int L = vcu; L < 8192; L += G) {
                const int u = L & 4095, b = u >> 8, h = (u >> 4) & 15, sub = u & 15;
                int dil, r, qb, nt; bf16* O; float* LS;
                if (L < 4096) { dil = 1; r = 0; qb = sub; nt = 64; O = O1; LS = L1; } else { dil = 4; r = sub >> 2; qb = sub & 3; nt = 16; O = O2; LS = L2; }
                const size_t row0 = (size_t)b * SEQ + r, rowq = row0 + (size_t)256 * qb * dil;
                const int t0 = (4 * qb - 1 < 0) ? 0 : 4 * qb - 1, t1 = (4 * qb + 5 > nt) ? nt : 4 * qb + 5;
                att::attn_unit<64, 1>(QKV + rowq * 3072 + h * 64, (long)dil * 3072, QKV + row0 * 3072 + 1024 + h * 64, (long)dil * 3072, QKV + row0 * 3072 + 2048 + h * 64, (long)dil * 3072,
                                      t0, t1, 256 * qb, O + rowq * 1024 + h * 64, (long)dil * 1024, LS + rowq * 16 + h, (long)dil * 16, nomg, (LAS char*)lds);
            }
        }
        SEAM(14);
        if (IN(15)) {
            for (int L = vcu; L < 4096; L += G) {
                const int b = L >> 8, h = (L >> 4) & 15, r = L & 15; const size_t row0 = (size_t)b * SEQ + r;
                const att::Merge mg{O1 + row0 * 1024 + h * 64, O2 + row0 * 1024 + h * 64, L1 + row0 * 16 + h, L2 + row0 * 16 + h};
                att::attn_unit<64, 2>(QKV + row0 * 3072 + h * 64, 16L * 3072, QKV + row0 * 3072 + 1024 + h * 64, 16L * 3072, QKV + row0 * 3072 + 2048 + h * 64, 16L * 3072,
                                      0, 4, 0, O1 + row0 * 1024 + h * 64, 16L * 1024, nullptr, 16L * 16, mg, (LAS char*)lds);
            }
        }
    } SEAM(15);
    if (IN(16)) { pg8::Gemm g{(const bf16*)(ws + A_ATT1), (const bf16*)(ws + W_DO), T, 1024, 1024}; pg8::StaticOrder S; S.init(T, 1024, G, bx);
        pg8::EpiResGate E{args.out, args.out, mod_o + 2 * 1024};
        pg8::gemm_phase<pg8::EpiResGate, pg8::StaticOrder, true, true>(lds, g, S, E); } SEAM(16);
    if (IN(17)) { IDS(); r7_phase(args, lds_raw, vcu, G, tid, wave, lane); } SEAM(17);
    if (IN(18)) { IDS(); r8_phase(args, lds_raw, vcu, G, tid, wave, lane); } SEAM(18);
    for (int c = 0; c < 4; ++c) {
        const int* pe = (const int*)(ws + WS_PENDS);
        if (IN(19 + 2 * c)) { const int ntot = pe[7] >> 8, tile0 = 128 * c, nt = (c == 3) ? ntot - 384 : 128;
            pg8::Gemm g{(const bf16*)(ws + A_HP), (const bf16*)(ws + W_MGU), 0, 0, 1024}; pg8::MoeOrder S; S.init(nt, 28, G, bx, tile0, tile0, pe);
            pg8::EpiSwiGLU E{(bf16*)(ws + A_ACTM), 3584, 28, tile0};
            pg8::gemm_phase<pg8::EpiSwiGLU, pg8::MoeOrder, true, true>(lds, g, S, E); }
        SEAM(19 + 2 * c);
        if (IN(20 + 2 * c)) { const int ntot = pe[7] >> 8, tile0 = 128 * c, nt = (c == 3) ? ntot - 384 : 128;
            pg8::Gemm g{(const bf16*)(ws + A_ACTM), (const bf16*)(ws + W_MD), 0, 0, 3584}; pg8::MoeOrder S; S.init(nt, 4, G, bx, 0, tile0, pe);
            pg8::EpiMoeDown E{(bf16*)(ws + A_Y), (const float*)(ws + WS_GSLOT), tile0};
            pg8::gemm_phase<pg8::EpiMoeDown, pg8::MoeOrder, true, true>(lds, g, S, E); }
        SEAM(20 + 2 * c);
    }
    if (IN(27)) { IDS(); r9_phase(args, gw, NGW, lane); }
#undef IN
#undef SEAM
}

extern "C" void kernel_launch(void* const* d_in, const int* in_sizes, int n_in, void* d_out, int out_size, void* d_ws, size_t ws_size, hipStream_t stream) {
    static int grid = 0;
    if (grid == 0) {
        if (n_in != 31 || in_sizes[0] != T * DM || out_size != T * DM || ws_size < WS_NEED) {
            fprintf(stderr, "kernel_launch: expected 31 inputs, x/out of %d floats, >= %zu bytes of workspace; got n_in %d in0 %d out %d ws %zu\n", T * DM, (size_t)WS_NEED, n_in, n_in > 0 ? in_sizes[0] : -1, out_size, ws_size);
            grid = -1; return; }
        int dev = 0, cus = 0, per_cu = 0;
        if (hipGetDevice(&dev) != hipSuccess || hipDeviceGetAttribute(&cus, hipDeviceAttributeMultiprocessorCount, dev) != hipSuccess) { grid = -1; return; }
        if (hipFuncSetAttribute((const void*)mega_fwd, hipFuncAttributeMaxDynamicSharedMemorySize, LDS_BYTES) != hipSuccess) { fprintf(stderr, "kernel_launch: hipFuncSetAttribute failed\n"); grid = -1; return; }
        if (hipOccupancyMaxActiveBlocksPerMultiprocessor(&per_cu, (const void*)mega_fwd, NWAVES * 64, LDS_BYTES) != hipSuccess || per_cu < 1)
            fprintf(stderr, "kernel_launch: note: occupancy query reports %d workgroups per CU\n", per_cu);
        (void)hipGetLastError();
        grid = cus;
    }
    if (grid < 0) return;
    if (hipMemsetAsync((char*)d_ws + WS_CTL, 0, CTL_ZERO_BYTES, stream) != hipSuccess) { fprintf(stderr, "kernel_launch: memset failed\n"); return; }
    Args a{};
    for (int i = 0; i < 31; ++i) a.in[i] = (const float*)d_in[i];
    a.out = (float*)d_out; a.ws = (unsigned char*)d_ws;
#if MK_PER_PHASE
    for (int p = 0; p < NPH; ++p) { a.ph_lo = p; a.ph_hi = p + 1; hipLaunchKernelGGL(mega_fwd, dim3(grid), dim3(NWAVES * 64), LDS_BYTES, stream, a); }
#else
    a.ph_lo = 0; a.ph_hi = NPH;
    hipLaunchKernelGGL(mega_fwd, dim3(grid), dim3(NWAVES * 64), LDS_BYTES, stream, a);
#endif
    const hipError_t le = hipPeekAtLastError();
    if (le != hipSuccess) fprintf(stderr, "kernel_launch: launch failed: %s\n", hipGetErrorName(le));
}
```

```cpp
#define MK_PER_PHASE 0
#define REPMASK 0u
#define BAND_REP 1
#include <hip/hip_runtime.h>
#include <cstdio>
#include <cstdint>
namespace pg8 {
#define PG8_LAS __attribute__((address_space(3)))
typedef unsigned short bf16_t;
typedef short bf16x8 __attribute__((ext_vector_type(8)));
typedef float f32x4 __attribute__((ext_vector_type(4)));
typedef unsigned u32x4 __attribute__((ext_vector_type(4)));
constexpr int BM = 256, BK = 64, HALF = 128, HTB = HALF * BK * 2  , STAGE_BYTES = 8 * HTB, NXCD = 8, WGM = 8;

__host__ __device__ __forceinline__ int lds_byte(int r, int c) { const int st = (r >> 4) * 2 + (c >> 5), rr = r & 15, cc = c & 31, ob = rr * 64 + cc * 2; return st * 1024 + (ob ^ (((ob >> 9) & 1) << 5)); }
__host__ __device__ __forceinline__ void stage_rc(int b, int& R, int& C) { const int st = b / 1024, sb = b % 1024, swz = sb ^ (((sb >> 9) & 1) << 5); R = (st >> 1) * 16 + swz / 64; C = (st & 1) * 32 + (swz % 64) / 2; }
__host__ __device__ __forceinline__ int perm32(int rho) { const int n = rho >> 4, i = rho & 15; return 8 * (i >> 2) + 4 * n + (i & 3); }

struct Unit { int pm, pn; };
struct Gemm { const bf16_t* A; const bf16_t* Bt; int M, N, K; };

constexpr int PG8_NVM = 8;

struct StaticOrder {
    int nM, nN, nwg, G, c;
    __host__ __device__ void init(int M, int N, int G_, int c_) { nM = M / BM; nN = N / BM; nwg = nM * nN; G = G_; c = c_; }
    __host__ __device__ bool next(int i, Unit& u) const {
        const long L = (long)i * G + c; if (L >= nwg) return false;
        int wgid = (int)L; { const int q = nwg / NXCD, r = nwg % NXCD, xcd = wgid % NXCD, off = wgid / NXCD; wgid = (xcd < r ? xcd * (q + 1) : r * (q + 1) + (xcd - r) * q) + off; }
        const int nig = WGM * nN, gid = wgid / nig, fm = gid * WGM, gsz = (nM - fm) < WGM ? (nM - fm) : WGM;
        u.pm = fm + ((wgid % nig) % gsz); u.pn = (wgid % nig) / gsz; return true;
    }
    __device__ __forceinline__ void a_ready(const Unit&) const {}
    __device__ __forceinline__ void done(const Unit&) const {}
};

struct RowLocalOrder {
    int nM, nN, G, c;
    __host__ __device__ void init(int M, int N, int G_, int c_) { nM = M / BM; nN = N / BM; G = G_; c = c_; }
    __host__ __device__ bool next(int i, Unit& u) const { const int t = i / nN; const int pm = c + t * G; if (pm >= nM) return false; u.pm = pm; u.pn = i - t * nN; return true; }
    __device__ __forceinline__ void a_ready(const Unit&) const {}
    __device__ __forceinline__ void done(const Unit&) const {}
};

__device__ __forceinline__ unsigned cvt_pk_bf16(float lo, float hi) { unsigned r; asm volatile("v_cvt_pk_bf16_f32 %0, %1, %2" : "=v"(r) : "v"(lo), "v"(hi)); return r; }
typedef float f32x2 __attribute__((ext_vector_type(2)));
__device__ __forceinline__ f32x2 gelu_pk(f32x2 v) {
    const f32x2 av = __builtin_elementwise_abs(v), d = av * 0.2316418882f + 1.0f;
    f32x2 t; t.x = __builtin_amdgcn_rcpf(d.x); t.y = __builtin_amdgcn_rcpf(d.y);
    f32x2 q = t * 0.5307027145f + (-0.7265760135f); q = q * t + 0.7107068705f; q = q * t + (-0.142248368f); q = q * t + 0.127414796f; q = q * t;
    const f32x2 s = (v * v) * (-0.72134752044f);
    f32x2 e; e.x = __builtin_amdgcn_exp2f(s.x); e.y = __builtin_amdgcn_exp2f(s.y);
    const f32x2 m = v * (q * e), r = v - m;
    f32x2 o; o.x = v.x < 0.f ? m.x : r.x; o.y = v.y < 0.f ? m.y : r.y; return o;
}

template <int ACT  > struct EpiBf16 {
    static constexpr bool PERM = true, AFTER_DRAIN = false; static_assert(ACT == 0 || ACT == 1, "EpiBf16: ACT is 0 (none) or 1 (gelu_pk)");
    bf16_t* O; int ldc; const float* bias; int split_cols; size_t split_stride; float scale0;
    __device__ __forceinline__ void operator()(const f32x4 (&acc)[2][2][4][2], const Unit& u, int wr, int wc, int fr, int fq) const {
        const int row0 = u.pm * BM + wr * 64 + fr; int colt = u.pn * BM; bf16_t* base = O;
        float sc = 1.f; if (split_cols) { const int t = colt / split_cols; base += (size_t)t * split_stride; colt -= t * split_cols; if (t == 0) sc = scale0; }
        const int col0 = colt + wc * 32 + 8 * fq, bcol0 = u.pn * BM + wc * 32 + 8 * fq;
        f32x4 bv[2][2];
#pragma unroll
        for (int bj = 0; bj < 2; ++bj)
#pragma unroll
            for (int n = 0; n < 2; ++n) bv[bj][n] = bias ? *(const f32x4*)(bias + bcol0 + bj * HALF + 4 * n) : (f32x4){0.f, 0.f, 0.f, 0.f};
#pragma unroll
        for (int ai = 0; ai < 2; ++ai)
#pragma unroll
            for (int m = 0; m < 4; ++m) { bf16_t* rowp = base + (size_t)(row0 + ai * HALF + m * 16) * ldc + col0;
#pragma unroll
                for (int bj = 0; bj < 2; ++bj) { f32x4 v0 = acc[ai][bj][m][0] + bv[bj][0], v1 = acc[ai][bj][m][1] + bv[bj][1];
                    if (ACT == 1) { f32x2 a = gelu_pk((f32x2){v0[0], v0[1]}), b = gelu_pk((f32x2){v0[2], v0[3]}), c = gelu_pk((f32x2){v1[0], v1[1]}), d = gelu_pk((f32x2){v1[2], v1[3]});
                        v0 = (f32x4){a.x, a.y, b.x, b.y}; v1 = (f32x4){c.x, c.y, d.x, d.y}; }
                    v0 = v0 * sc; v1 = v1 * sc; u32x4 w; w.x = cvt_pk_bf16(v0[0], v0[1]); w.y = cvt_pk_bf16(v0[2], v0[3]); w.z = cvt_pk_bf16(v1[0], v1[1]); w.w = cvt_pk_bf16(v1[2], v1[3]);
                    *(u32x4*)(rowp + bj * HALF) = w; } }
    }
};
template <class Epi, class Sched, bool ALIGN_EPI = false, bool SP2 = false>
__device__ __forceinline__ void gemm_phase(PG8_LAS unsigned char* lds, const Gemm g, const Sched& S, const Epi& E) {
    int tid = threadIdx.x; asm volatile("" : "+v"(tid));
    const int wid = __builtin_amdgcn_readfirstlane(tid >> 6), lane = tid & 63, wr = wid >> 2, wc = wid & 3, fr = lane & 15, fq = lane >> 4;
    int K = g.K; asm volatile("" : "+s"(K));
    const int nt = K / BK;
    unsigned voffA[2], voffB[2];
#pragma unroll
    for (int i = 0; i < 2; ++i) { int R, C; stage_rc(tid * 16 + i * 8192, R, C); const int Rb = Epi::PERM ? ((R & ~31) + perm32(R & 31)) : R;
        voffA[i] = (unsigned)(R * K + C) * 2u; voffB[i] = (unsigned)(Rb * K + C) * 2u; }
    const size_t kstep = (size_t)(BK * 2);
    const size_t hstep = (size_t)HALF * K * 2;
    const size_t tstep = 2 * hstep;
    const unsigned ldsw = (unsigned)wid * 1024u;
    const int aoff = lds_byte(wr * 64 + fr, fq * 8), boff = lds_byte(wc * 32 + fr, fq * 8);
#define PG8_SA(b, h) (((b) * 2 + (h)) * HTB)
#define PG8_SB(b, h) ((4 + (b) * 2 + (h)) * HTB)
#define PG8_STAGE(bufoff, gbase, voff) do { _Pragma("unroll") for (int _i = 0; _i < 2; ++_i) \
        __builtin_amdgcn_global_load_lds((const unsigned*)((const char*)(gbase) + (voff)[_i]), (PG8_LAS unsigned*)(lds + (bufoff) + ldsw + _i * 8192), 16, 0, 0); } while (0)
#define PG8_LDA(dst, b, h) do { _Pragma("unroll") for (int m = 0; m < 4; ++m) _Pragma("unroll") for (int k = 0; k < 2; ++k) dst[m][k] = *(const PG8_LAS bf16x8*)(lds + PG8_SA(b, h) + aoff + m * 2048 + k * 1024); } while (0)
#define PG8_LDB(dst, b, h) do { _Pragma("unroll") for (int n = 0; n < 2; ++n) _Pragma("unroll") for (int k = 0; k < 2; ++k) dst[n][k] = *(const PG8_LAS bf16x8*)(lds + PG8_SB(b, h) + boff + n * 2048 + k * 1024); } while (0)
#define PG8_MMA(ai, bj, At, Bt) do { __builtin_amdgcn_s_setprio(1); _Pragma("unroll") for (int m = 0; m < 4; ++m) _Pragma("unroll") for (int n = 0; n < 2; ++n) _Pragma("unroll") for (int k = 0; k < 2; ++k) \
        acc[ai][bj][m][n] = __builtin_amdgcn_mfma_f32_16x16x32_bf16(Bt[n][k], At[m][k], acc[ai][bj][m][n], 0, 0, 0); __builtin_amdgcn_s_setprio(0); } while (0)
#define PG8_WAIT_V(n) asm volatile("s_waitcnt vmcnt(" #n ")" ::: "memory")
#define PG8_WAIT_L(n) asm volatile("s_waitcnt lgkmcnt(" #n ")" ::: "memory")
#define PG8_BAR __builtin_amdgcn_s_barrier()
#define PG8_SCHED __builtin_amdgcn_sched_barrier(0)
    Unit cur, nxt; int ui = 0;
    if (!S.next(0, cur)) return;
    f32x4 acc[2][2][4][2];
#pragma unroll
    for (int a = 0; a < 2; ++a)
#pragma unroll
        for (int b = 0; b < 2; ++b)
#pragma unroll
            for (int m = 0; m < 4; ++m)
#pragma unroll
                for (int n = 0; n < 2; ++n) acc[a][b][m][n] = (f32x4){0.f, 0.f, 0.f, 0.f};
    bf16x8 At[4][2], B0[2][2], B1[2][2];
    const char* cA = (const char*)g.A + (size_t)cur.pm * tstep; const char* cB = (const char*)g.Bt + (size_t)cur.pn * tstep;
    S.a_ready(cur);
    if constexpr (SP2) {
        PG8_STAGE(PG8_SB(0, 0), cB, voffB); PG8_STAGE(PG8_SB(0, 1), cB + hstep, voffB); PG8_STAGE(PG8_SA(0, 0), cA, voffA); PG8_STAGE(PG8_SA(0, 1), cA + hstep, voffA);
        if (wr == 1) PG8_BAR;
        PG8_WAIT_V(2); PG8_BAR;
        PG8_STAGE(PG8_SB(1, 0), cB + kstep, voffB); PG8_STAGE(PG8_SA(1, 0), cA + kstep, voffA); PG8_STAGE(PG8_SB(1, 1), cB + hstep + kstep, voffB);
        PG8_WAIT_V(6); PG8_BAR;
    } else {
        PG8_STAGE(PG8_SB(0, 0), cB, voffB); PG8_STAGE(PG8_SA(0, 0), cA, voffA); PG8_STAGE(PG8_SB(0, 1), cB + hstep, voffB); PG8_STAGE(PG8_SA(0, 1), cA + hstep, voffA);
        if (wr == 1) PG8_BAR;
        PG8_WAIT_V(4); PG8_BAR;
        PG8_STAGE(PG8_SB(1, 0), cB + kstep, voffB); PG8_STAGE(PG8_SA(1, 0), cA + kstep, voffA); PG8_STAGE(PG8_SB(1, 1), cB + hstep + kstep, voffB);
        PG8_WAIT_V(6); PG8_BAR;
    }
    for (;;) {
        const bool has_next = S.next(ui + 1, nxt);
        const char* nA = has_next ? (const char*)g.A + (size_t)nxt.pm * tstep : cA; const char* nB = has_next ? (const char*)g.Bt + (size_t)nxt.pn * tstep : cB;
        int t = 0;
#pragma unroll 1
        do {
            const bool last = (t == nt - 2);
            const char* a1 = cA + (size_t)(t + 1) * kstep;
            const char* a2 = last ? nA : cA + (size_t)(t + 2) * kstep; const char* b2 = last ? nB : cB + (size_t)(t + 2) * kstep;
            const char* a3 = a2 + kstep; const char* b3 = b2 + kstep;
            if (last && has_next) S.a_ready(nxt);
            if constexpr (SP2) {
            PG8_LDB(B0, 0, 0); PG8_LDB(B1, 0, 1); PG8_SCHED; PG8_LDA(At, 0, 0); PG8_STAGE(PG8_SA(1, 1), a1 + hstep, voffA);
            PG8_WAIT_V(8); PG8_WAIT_L(0); PG8_BAR; PG8_MMA(0, 0, At, B0); PG8_MMA(0, 1, At, B1); PG8_BAR; PG8_SCHED;
            PG8_LDA(At, 0, 1); PG8_STAGE(PG8_SB(0, 0), b2, voffB); PG8_STAGE(PG8_SB(0, 1), b2 + hstep, voffB); PG8_STAGE(PG8_SA(0, 0), a2, voffA);
            PG8_WAIT_V(8); PG8_WAIT_L(0); PG8_BAR; PG8_MMA(1, 0, At, B0); PG8_MMA(1, 1, At, B1); PG8_BAR; PG8_SCHED;
            PG8_LDB(B0, 1, 0); PG8_LDB(B1, 1, 1); PG8_SCHED; PG8_LDA(At, 1, 0); PG8_STAGE(PG8_SA(0, 1), a2 + hstep, voffA);
            PG8_WAIT_V(8); PG8_WAIT_L(0); PG8_BAR; PG8_MMA(0, 0, At, B0); PG8_MMA(0, 1, At, B1); PG8_BAR; PG8_SCHED;
            PG8_LDA(At, 1, 1); PG8_STAGE(PG8_SB(1, 0), b3, voffB); PG8_STAGE(PG8_SB(1, 1), b3 + hstep, voffB); PG8_STAGE(PG8_SA(1, 0), a3, voffA);
            PG8_WAIT_V(8); PG8_WAIT_L(0); PG8_BAR; PG8_MMA(1, 0, At, B0); PG8_MMA(1, 1, At, B1); PG8_BAR; PG8_SCHED;
            } else {
            PG8_LDB(B0, 0, 0); PG8_SCHED; PG8_LDA(At, 0, 0); PG8_STAGE(PG8_SA(1, 1), a1 + hstep, voffA);
            PG8_WAIT_L(8); PG8_BAR; PG8_WAIT_L(0); PG8_MMA(0, 0, At, B0); PG8_BAR; PG8_SCHED;
            PG8_LDB(B1, 0, 1); PG8_STAGE(PG8_SB(0, 0), b2, voffB);
            PG8_BAR; PG8_WAIT_L(0); PG8_MMA(0, 1, At, B1); PG8_BAR;
            PG8_LDA(At, 0, 1); PG8_STAGE(PG8_SA(0, 0), a2, voffA);
            PG8_BAR; PG8_WAIT_L(0); PG8_MMA(1, 0, At, B0); PG8_BAR; PG8_SCHED;
            PG8_STAGE(PG8_SB(0, 1), b2 + hstep, voffB);
            PG8_WAIT_V(6); PG8_BAR; PG8_MMA(1, 1, At, B1); PG8_BAR;
            PG8_LDB(B0, 1, 0); PG8_SCHED; PG8_LDA(At, 1, 0); PG8_STAGE(PG8_SA(0, 1), a2 + hstep, voffA);
            PG8_WAIT_L(8); PG8_BAR; PG8_WAIT_L(0); PG8_MMA(0, 0, At, B0); PG8_BAR; PG8_SCHED;
            PG8_LDB(B1, 1, 1); PG8_STAGE(PG8_SB(1, 0), b3, voffB);
            PG8_BAR; PG8_WAIT_L(0); PG8_MMA(0, 1, At, B1); PG8_BAR;
            PG8_LDA(At, 1, 1); PG8_STAGE(PG8_SA(1, 0), a3, voffA);
            PG8_BAR; PG8_WAIT_L(0); PG8_MMA(1, 0, At, B0); PG8_BAR; PG8_SCHED;
            PG8_STAGE(PG8_SB(1, 1), b3 + hstep, voffB);
            PG8_WAIT_V(6); PG8_BAR; PG8_MMA(1, 1, At, B1); PG8_BAR;
            }
            t += 2;
        } while (t < nt);
        if constexpr (ALIGN_EPI) { if (wr == 0) PG8_BAR; }
        if constexpr (!Epi::AFTER_DRAIN) { E(acc, cur, wr, wc, fr, fq); S.done(cur); }
        if (!has_next) break;
#pragma unroll
        for (int a = 0; a < 2; ++a)
#pragma unroll
            for (int b = 0; b < 2; ++b)
#pragma unroll
                for (int m = 0; m < 4; ++m)
#pragma unroll
                    for (int n = 0; n < 2; ++n) acc[a][b][m][n] = (f32x4){0.f, 0.f, 0.f, 0.f};
        cur = nxt; cA = nA; cB = nB; ++ui;
        if constexpr (ALIGN_EPI) { if (wr == 1) PG8_BAR; }
    }
    PG8_WAIT_V(0);
    if constexpr (!ALIGN_EPI) { if (wr == 0) PG8_BAR; }
    PG8_BAR;
    if constexpr (Epi::AFTER_DRAIN) { E.fused(acc, cur, wr, wc, fr, fq, lds, wid, lane); S.done(cur); }
#undef PG8_SA
#undef PG8_SB
#undef PG8_STAGE
#undef PG8_LDA
#undef PG8_LDB
#undef PG8_MMA
#undef PG8_WAIT_V
#undef PG8_WAIT_L
#undef PG8_BAR
#undef PG8_SCHED
}
typedef int v4i_t __attribute__((ext_vector_type(4)));
typedef int v8i_t __attribute__((ext_vector_type(8)));
template <class Epi, class Sched, bool ALIGN_EPI = false, bool SP2 = false>
__device__ __forceinline__ void gemm_phase8(PG8_LAS unsigned char* lds, const Gemm g, const Sched& S, const Epi& E) {
    int tid = threadIdx.x; asm volatile("" : "+v"(tid));
    const int wid = __builtin_amdgcn_readfirstlane(tid >> 6), lane = tid & 63, wr = wid >> 2, wc = wid & 3, fr = lane & 15, fq = lane >> 4;
    int K = g.K; asm volatile("" : "+s"(K));
    const int nt = K / BK;
    unsigned voffA[2], voffB[2];
#pragma unroll
    for (int i = 0; i < 2; ++i) { int R, C; stage_rc(tid * 16 + i * 8192, R, C); const int Rb = Epi::PERM ? ((R & ~31) + perm32(R & 31)) : R;
        voffA[i] = (unsigned)(R * K + C) * 2u; voffB[i] = (unsigned)(Rb * K + C) * 2u; }
    const size_t kstep = (size_t)(BK * 2);
    const size_t hstep = (size_t)HALF * K * 2;
    const size_t tstep = 2 * hstep;
    const unsigned ldsw = (unsigned)wid * 1024u;
    const int aoff = lds_byte(wr * 64 + fr, fq * 8), boff = lds_byte(wc * 32 + fr, fq * 8);
#define PG8_SA(b, h) (((b) * 2 + (h)) * HTB)
#define PG8_SB(b, h) ((4 + (b) * 2 + (h)) * HTB)
#define PG8_STAGE(bufoff, gbase, voff) do { _Pragma("unroll") for (int _i = 0; _i < 2; ++_i) \
        __builtin_amdgcn_global_load_lds((const unsigned*)((const char*)(gbase) + (voff)[_i]), (PG8_LAS unsigned*)(lds + (bufoff) + ldsw + _i * 8192), 16, 0, 0); } while (0)
#define PG8_LDA(dst, b, h) do { _Pragma("unroll") for (int m = 0; m < 4; ++m) { const v4i_t lo_ = *(const PG8_LAS v4i_t*)(lds + PG8_SA(b, h) + aoff + m * 2048), hi_ = *(const PG8_LAS v4i_t*)(lds + PG8_SA(b, h) + aoff + m * 2048 + 1024); dst[m] = __builtin_shufflevector(lo_, hi_, 0, 1, 2, 3, 4, 5, 6, 7); } } while (0)
#define PG8_LDB(dst, b, h) do { _Pragma("unroll") for (int n = 0; n < 2; ++n) { const v4i_t lo_ = *(const PG8_LAS v4i_t*)(lds + PG8_SB(b, h) + boff + n * 2048), hi_ = *(const PG8_LAS v4i_t*)(lds + PG8_SB(b, h) + boff + n * 2048 + 1024); dst[n] = __builtin_shufflevector(lo_, hi_, 0, 1, 2, 3, 4, 5, 6, 7); } } while (0)
#define PG8_MMA(ai, bj, At, Bt) do { __builtin_amdgcn_s_setprio(1); _Pragma("unroll") for (int m = 0; m < 4; ++m) _Pragma("unroll") for (int n = 0; n < 2; ++n) \
        asm volatile("v_mfma_scale_f32_16x16x128_f8f6f4 %0, %1, %2, %0, %3, %3 op_sel_hi:[0,0,0]" : "+v"(acc[ai][bj][m][n]) : "v"(Bt[n]), "v"(At[m]), "v"(sclv)); __builtin_amdgcn_s_setprio(0); } while (0)
#define PG8_WAIT_V(n) asm volatile("s_waitcnt vmcnt(" #n ")" ::: "memory")
#define PG8_WAIT_V_RELAXED(n) asm volatile("s_waitcnt vmcnt(%0)" :: "n"((n) + PG8_NVM) : "memory")
#define PG8_MMA0(ai, bj, At, Bt) do { __builtin_amdgcn_s_setprio(1); _Pragma("unroll") for (int m = 0; m < 4; ++m) _Pragma("unroll") for (int n = 0; n < 2; ++n) \
        asm volatile("v_mfma_scale_f32_16x16x128_f8f6f4 %0, %1, %2, 0, %3, %3 op_sel_hi:[0,0,0]" : "=&v"(acc[ai][bj][m][n]) : "v"(Bt[n]), "v"(At[m]), "v"(sclv)); __builtin_amdgcn_s_setprio(0); } while (0)
#define PG8_WAIT_L(n) asm volatile("s_waitcnt lgkmcnt(" #n ")" ::: "memory")
#define PG8_BAR __builtin_amdgcn_s_barrier()
#define PG8_SCHED __builtin_amdgcn_sched_barrier(0)
    Unit cur, nxt; int ui = 0;
    if (!S.next(0, cur)) return;
    f32x4 acc[2][2][4][2];
#pragma unroll
    for (int a = 0; a < 2; ++a)
#pragma unroll
        for (int b = 0; b < 2; ++b)
#pragma unroll
            for (int m = 0; m < 4; ++m)
#pragma unroll
                for (int n = 0; n < 2; ++n) acc[a][b][m][n] = (f32x4){0.f, 0.f, 0.f, 0.f};
    v8i_t At[4], B0[2], B1[2];
    int sclv = 0x7f7f7f7f; asm volatile("" : "+v"(sclv));
    const char* cA = (const char*)g.A + (size_t)cur.pm * tstep; const char* cB = (const char*)g.Bt + (size_t)cur.pn * tstep;
    S.a_ready(cur);
    if constexpr (SP2) {
        PG8_STAGE(PG8_SB(0, 0), cB, voffB); PG8_STAGE(PG8_SB(0, 1), cB + hstep, voffB); PG8_STAGE(PG8_SA(0, 0), cA, voffA); PG8_STAGE(PG8_SA(0, 1), cA + hstep, voffA);
        if (wr == 1) PG8_BAR;
        PG8_WAIT_V(2); PG8_BAR;
        PG8_STAGE(PG8_SB(1, 0), cB + kstep, voffB); PG8_STAGE(PG8_SA(1, 0), cA + kstep, voffA); PG8_STAGE(PG8_SB(1, 1), cB + hstep + kstep, voffB);
        PG8_WAIT_V(6); PG8_BAR;
    } else {
        PG8_STAGE(PG8_SB(0, 0), cB, voffB); PG8_STAGE(PG8_SA(0, 0), cA, voffA); PG8_STAGE(PG8_SB(0, 1), cB + hstep, voffB); PG8_STAGE(PG8_SA(0, 1), cA + hstep, voffA);
        if (wr == 1) PG8_BAR;
        PG8_WAIT_V(4); PG8_BAR;
        PG8_STAGE(PG8_SB(1, 0), cB + kstep, voffB); PG8_STAGE(PG8_SA(1, 0), cA + kstep, voffA); PG8_STAGE(PG8_SB(1, 1), cB + hstep + kstep, voffB);
        PG8_WAIT_V(6); PG8_BAR;
    }
    for (;;) {
        const bool has_next = S.next(ui + 1, nxt);
        const char* nA = has_next ? (const char*)g.A + (size_t)nxt.pm * tstep : cA; const char* nB = has_next ? (const char*)g.Bt + (size_t)nxt.pn * tstep : cB;
        int t = 0;
        if (ui > 0) {
            static_assert(SP2, "peeled first K-tile pair: SP2 loop only");
            const bool last = (t == nt - 2);
            const char* a1 = cA + (size_t)(t + 1) * kstep;
            const char* a2 = last ? nA : cA + (size_t)(t + 2) * kstep; const char* b2 = last ? nB : cB + (size_t)(t + 2) * kstep;
            const char* a3 = a2 + kstep; const char* b3 = b2 + kstep;
            if (last && has_next) S.a_ready(nxt);
            if constexpr (SP2) {
            PG8_LDB(B0, 0, 0); PG8_LDB(B1, 0, 1); PG8_SCHED; PG8_LDA(At, 0, 0); PG8_STAGE(PG8_SA(1, 1), a1 + hstep, voffA);
            PG8_WAIT_V_RELAXED(8); PG8_WAIT_L(0); PG8_BAR; PG8_MMA0(0, 0, At, B0); PG8_MMA0(0, 1, At, B1); PG8_BAR; PG8_SCHED;
            PG8_LDA(At, 0, 1); PG8_STAGE(PG8_SB(0, 0), b2, voffB); PG8_STAGE(PG8_SB(0, 1), b2 + hstep, voffB); PG8_STAGE(PG8_SA(0, 0), a2, voffA);
            PG8_WAIT_V_RELAXED(8); PG8_WAIT_L(0); PG8_BAR; PG8_MMA0(1, 0, At, B0); PG8_MMA0(1, 1, At, B1); PG8_BAR; PG8_SCHED;
            PG8_LDB(B0, 1, 0); PG8_LDB(B1, 1, 1); PG8_SCHED; PG8_LDA(At, 1, 0); PG8_STAGE(PG8_SA(0, 1), a2 + hstep, voffA);
            PG8_WAIT_V(8); PG8_WAIT_L(0); PG8_BAR; PG8_MMA(0, 0, At, B0); PG8_MMA(0, 1, At, B1); PG8_BAR; PG8_SCHED;
            PG8_LDA(At, 1, 1); PG8_STAGE(PG8_SB(1, 0), b3, voffB); PG8_STAGE(PG8_SB(1, 1), b3 + hstep, voffB); PG8_STAGE(PG8_SA(1, 0), a3, voffA);
            PG8_WAIT_V(8); PG8_WAIT_L(0); PG8_BAR; PG8_MMA(1, 0, At, B0); PG8_MMA(1, 1, At, B1); PG8_BAR; PG8_SCHED;
            } else {
            PG8_LDB(B0, 0, 0); PG8_SCHED; PG8_LDA(At, 0, 0); PG8_STAGE(PG8_SA(1, 1), a1 + hstep, voffA);
            PG8_WAIT_L(8); PG8_BAR; PG8_WAIT_L(0); PG8_MMA(0, 0, At, B0); PG8_BAR; PG8_SCHED;
            PG8_LDB(B1, 0, 1); PG8_STAGE(PG8_SB(0, 0), b2, voffB);
            PG8_BAR; PG8_WAIT_L(0); PG8_MMA(0, 1, At, B1); PG8_BAR;
            PG8_LDA(At, 0, 1); PG8_STAGE(PG8_SA(0, 0), a2, voffA);
            PG8_BAR; PG8_WAIT_L(0); PG8_MMA(1, 0, At, B0); PG8_BAR; PG8_SCHED;
            PG8_STAGE(PG8_SB(0, 1), b2 + hstep, voffB);
            PG8_WAIT_V(6); PG8_BAR; PG8_MMA(1, 1, At, B1); PG8_BAR;
            PG8_LDB(B0, 1, 0); PG8_SCHED; PG8_LDA(At, 1, 0); PG8_STAGE(PG8_SA(0, 1), a2 + hstep, voffA);
            PG8_WAIT_L(8); PG8_BAR; PG8_WAIT_L(0); PG8_MMA(0, 0, At, B0); PG8_BAR; PG8_SCHED;
            PG8_LDB(B1, 1, 1); PG8_STAGE(PG8_SB(1, 0), b3, voffB);
            PG8_BAR; PG8_WAIT_L(0); PG8_MMA(0, 1, At, B1); PG8_BAR;
            PG8_LDA(At, 1, 1); PG8_STAGE(PG8_SA(1, 0), a3, voffA);
            PG8_BAR; PG8_WAIT_L(0); PG8_MMA(1, 0, At, B0); PG8_BAR; PG8_SCHED;
            PG8_STAGE(PG8_SB(1, 1), b3 + hstep, voffB);
            PG8_WAIT_V(6); PG8_BAR; PG8_MMA(1, 1, At, B1); PG8_BAR;
            }
            t = 2;
        }
#pragma unroll 1
        while (t < nt) {
            const bool last = (t == nt - 2);
            const char* a1 = cA + (size_t)(t + 1) * kstep;
            const char* a2 = last ? nA : cA + (size_t)(t + 2) * kstep; const char* b2 = last ? nB : cB + (size_t)(t + 2) * kstep;
            const char* a3 = a2 + kstep; const char* b3 = b2 + kstep;
            if (last && has_next) S.a_ready(nxt);
            if constexpr (SP2) {
            PG8_LDB(B0, 0, 0); PG8_LDB(B1, 0, 1); PG8_SCHED; PG8_LDA(At, 0, 0); PG8_STAGE(PG8_SA(1, 1), a1 + hstep, voffA);
            PG8_WAIT_V(8); PG8_WAIT_L(0); PG8_BAR; PG8_MMA(0, 0, At, B0); PG8_MMA(0, 1, At, B1); PG8_BAR; PG8_SCHED;
            PG8_LDA(At, 0, 1); PG8_STAGE(PG8_SB(0, 0), b2, voffB); PG8_STAGE(PG8_SB(0, 1), b2 + hstep, voffB); PG8_STAGE(PG8_SA(0, 0), a2, voffA);
            PG8_WAIT_V(8); PG8_WAIT_L(0); PG8_BAR; PG8_MMA(1, 0, At, B0); PG8_MMA(1, 1, At, B1); PG8_BAR; PG8_SCHED;
            PG8_LDB(B0, 1, 0); PG8_LDB(B1, 1, 1); PG8_SCHED; PG8_LDA(At, 1, 0); PG8_STAGE(PG8_SA(0, 1), a2 + hstep, voffA);
            PG8_WAIT_V(8); PG8_WAIT_L(0); PG8_BAR; PG8_MMA(0, 0, At, B0); PG8_MMA(0, 1, At, B1); PG8_BAR; PG8_SCHED;
            PG8_LDA(At, 1, 1); PG8_STAGE(PG8_SB(1, 0), b3, voffB); PG8_STAGE(PG8_SB(1, 1), b3 + hstep, voffB); PG8_STAGE(PG8_SA(1, 0), a3, voffA);
            PG8_WAIT_V(8); PG8_WAIT_L(0); PG8_BAR; PG8_MMA(1, 0, At, B0); PG8_MMA(1, 1, At, B1); PG8_BAR; PG8_SCHED;
            } else {
            PG8_LDB(B0, 0, 0); PG8_SCHED; PG8_LDA(At, 0, 0); PG8_STAGE(PG8_SA(1, 1), a1 + hstep, voffA);
            PG8_WAIT_L(8); PG8_BAR; PG8_WAIT_L(0); PG8_MMA(0, 0, At, B0); PG8_BAR; PG8_SCHED;
            PG8_LDB(B1, 0, 1); PG8_STAGE(PG8_SB(0, 0), b2, voffB);
            PG8_BAR; PG8_WAIT_L(0); PG8_MMA(0, 1, At, B1); PG8_BAR;
            PG8_LDA(At, 0, 1); PG8_STAGE(PG8_SA(0, 0), a2, voffA);
            PG8_BAR; PG8_WAIT_L(0); PG8_MMA(1, 0, At, B0); PG8_BAR; PG8_SCHED;
            PG8_STAGE(PG8_SB(0, 1), b2 + hstep, voffB);
            PG8_WAIT_V(6); PG8_BAR; PG8_MMA(1, 1, At, B1); PG8_BAR;
            PG8_LDB(B0, 1, 0); PG8_SCHED; PG8_LDA(At, 1, 0); PG8_STAGE(PG8_SA(0, 1), a2 + hstep, voffA);
            PG8_WAIT_L(8); PG8_BAR; PG8_WAIT_L(0); PG8_MMA(0, 0, At, B0); PG8_BAR; PG8_SCHED;
            PG8_LDB(B1, 1, 1); PG8_STAGE(PG8_SB(1, 0), b3, voffB);
            PG8_BAR; PG8_WAIT_L(0); PG8_MMA(0, 1, At, B1); PG8_BAR;
            PG8_LDA(At, 1, 1); PG8_STAGE(PG8_SA(1, 0), a3, voffA);
            PG8_BAR; PG8_WAIT_L(0); PG8_MMA(1, 0, At, B0); PG8_BAR; PG8_SCHED;
            PG8_STAGE(PG8_SB(1, 1), b3 + hstep, voffB);
            PG8_WAIT_V(6); PG8_BAR; PG8_MMA(1, 1, At, B1); PG8_BAR;
            }
            t += 2;
        }
        if constexpr (ALIGN_EPI) { if (wr == 0) PG8_BAR; }
        asm volatile("s_nop 15\n\ts_nop 15" ::: "memory");
        if constexpr (!Epi::AFTER_DRAIN) { E(acc, cur, wr, wc, fr, fq); S.done(cur); }
        if (!has_next) break;
        cur = nxt; cA = nA; cB = nB; ++ui;
        if constexpr (ALIGN_EPI) { if (wr == 1) PG8_BAR; }
    }
    PG8_WAIT_V(0);
    if constexpr (!ALIGN_EPI) { if (wr == 0) PG8_BAR; }
    PG8_BAR;
    if constexpr (Epi::AFTER_DRAIN) { E.fused(acc, cur, wr, wc, fr, fq, lds, wid, lane); S.done(cur); }
#undef PG8_SA
#undef PG8_SB
#undef PG8_STAGE
#undef PG8_LDA
#undef PG8_LDB
#undef PG8_MMA
#undef PG8_WAIT_V
#undef PG8_WAIT_V_RELAXED
#undef PG8_MMA0
#undef PG8_WAIT_L
#undef PG8_BAR
#undef PG8_SCHED
}
struct GemmG { const void* A; const bf16_t* Bt; const int* rowidx; int K; int rowbytes; };
template <class Epi, class Sched, bool ALIGN_EPI = false, bool SP2 = false>
__device__ __forceinline__ void gemm_phase8g(PG8_LAS unsigned char* lds, const GemmG g, const Sched& S, const Epi& E) {
    int tid = threadIdx.x; asm volatile("" : "+v"(tid));
    const int wid = __builtin_amdgcn_readfirstlane(tid >> 6), lane = tid & 63, wr = wid >> 2, wc = wid & 3, fr = lane & 15, fq = lane >> 4;
    int K = g.K; asm volatile("" : "+s"(K));
    const int nt = K / BK;
    unsigned voffA[2], voffB[2];
    int Rl[2]; unsigned Cb[2];
#pragma unroll
    for (int i = 0; i < 2; ++i) { int R, C; stage_rc(tid * 16 + i * 8192, R, C); const int Rb = Epi::PERM ? ((R & ~31) + perm32(R & 31)) : R;
        voffA[i] = (unsigned)(R * K + C) * 2u; voffB[i] = (unsigned)(Rb * K + C) * 2u; Rl[i] = R; Cb[i] = (unsigned)C * 2u; }
    (void)voffA;
    unsigned gC0[2], gC1[2], gN0[2], gN1[2];
#define PG8_GOFF(d0, d1, pm_) do { _Pragma("unroll") for (int _i = 0; _i < 2; ++_i) { const int* ri_ = g.rowidx + (size_t)(pm_) * BM + Rl[_i]; \
        d0[_i] = (unsigned)ri_[0] * (unsigned)g.rowbytes + Cb[_i]; d1[_i] = (unsigned)ri_[HALF] * (unsigned)g.rowbytes + Cb[_i]; } } while (0)
#define PG8_GRAW(raw, pm_) do { _Pragma("unroll") for (int _i = 0; _i < 2; ++_i) { const int* ri_ = g.rowidx + (size_t)(pm_) * BM + Rl[_i]; \
        asm volatile("global_load_dword %0, %1, off" : "=v"(raw[2 * _i]) : "v"(ri_) : "memory"); asm volatile("global_load_dword %0, %1, off offset:512" : "=v"(raw[2 * _i + 1]) : "v"(ri_) : "memory"); } } while (0)
#define PG8_GWAIT(raw) asm volatile("s_waitcnt vmcnt(4)" : "+v"(raw[0]), "+v"(raw[1]), "+v"(raw[2]), "+v"(raw[3]) :: "memory")
#define PG8_GCVT(d0, d1, raw) do { _Pragma("unroll") for (int _i = 0; _i < 2; ++_i) { d0[_i] = (unsigned)raw[2 * _i] * (unsigned)g.rowbytes + Cb[_i]; d1[_i] = (unsigned)raw[2 * _i + 1] * (unsigned)g.rowbytes + Cb[_i]; } } while (0)
    static_assert(HALF * 4 == 512, "row-index load offset");
    const size_t kstep = (size_t)(BK * 2);
    const size_t hstep = (size_t)HALF * K * 2;
    const size_t tstep = 2 * hstep;
    const unsigned ldsw = (unsigned)wid * 1024u;
    const int aoff = lds_byte(wr * 64 + fr, fq * 8), boff = lds_byte(wc * 32 + fr, fq * 8);
#define PG8_SA(b, h) (((b) * 2 + (h)) * HTB)
#define PG8_SB(b, h) ((4 + (b) * 2 + (h)) * HTB)
#define PG8_STAGE(bufoff, gbase, voff) do { _Pragma("unroll") for (int _i = 0; _i < 2; ++_i) \
        __builtin_amdgcn_global_load_lds((const unsigned*)((const char*)(gbase) + (voff)[_i]), (PG8_LAS unsigned*)(lds + (bufoff) + ldsw + _i * 8192), 16, 0, 0); } while (0)
#define PG8_LDA(dst, b, h) do { _Pragma("unroll") for (int m = 0; m < 4; ++m) { const v4i_t lo_ = *(const PG8_LAS v4i_t*)(lds + PG8_SA(b, h) + aoff + m * 2048), hi_ = *(const PG8_LAS v4i_t*)(lds + PG8_SA(b, h) + aoff + m * 2048 + 1024); dst[m] = __builtin_shufflevector(lo_, hi_, 0, 1, 2, 3, 4, 5, 6, 7); } } while (0)
#define PG8_LDB(dst, b, h) do { _Pragma("unroll") for (int n = 0; n < 2; ++n) { const v4i_t lo_ = *(const PG8_LAS v4i_t*)(lds + PG8_SB(b, h) + boff + n * 2048), hi_ = *(const PG8_LAS v4i_t*)(lds + PG8_SB(b, h) + boff + n * 2048 + 1024); dst[n] = __builtin_shufflevector(lo_, hi_, 0, 1, 2, 3, 4, 5, 6, 7); } } while (0)
#define PG8_MMA(ai, bj, At, Bt) do { __builtin_amdgcn_s_setprio(1); _Pragma("unroll") for (int m = 0; m < 4; ++m) _Pragma("unroll") for (int n = 0; n < 2; ++n) \
        asm volatile("v_mfma_scale_f32_16x16x128_f8f6f4 %0, %1, %2, %0, %3, %3 op_sel_hi:[0,0,0]" : "+v"(acc[ai][bj][m][n]) : "v"(Bt[n]), "v"(At[m]), "v"(sclv)); __builtin_amdgcn_s_setprio(0); } while (0)
#define PG8_WAIT_V(n) asm volatile("s_waitcnt vmcnt(" #n ")" ::: "memory")
#define PG8_WAIT_V_RELAXED(n) asm volatile("s_waitcnt vmcnt(%0)" :: "n"((n) + PG8_NVM) : "memory")
#define PG8_MMA0(ai, bj, At, Bt) do { __builtin_amdgcn_s_setprio(1); _Pragma("unroll") for (int m = 0; m < 4; ++m) _Pragma("unroll") for (int n = 0; n < 2; ++n) \
        asm volatile("v_mfma_scale_f32_16x16x128_f8f6f4 %0, %1, %2, 0, %3, %3 op_sel_hi:[0,0,0]" : "=&v"(acc[ai][bj][m][n]) : "v"(Bt[n]), "v"(At[m]), "v"(sclv)); __builtin_amdgcn_s_setprio(0); } while (0)
#define PG8_WAIT_L(n) asm volatile("s_waitcnt lgkmcnt(" #n ")" ::: "memory")
#define PG8_BAR __builtin_amdgcn_s_barrier()
#define PG8_SCHED __builtin_amdgcn_sched_barrier(0)
    Unit cur, nxt, nn; int ui = 0;
    if (!S.next(0, cur)) return;
    bool has_next = S.next(1, nxt);
    int rawN[4] = {0, 0, 0, 0};
    f32x4 acc[2][2][4][2];
#pragma unroll
    for (int a = 0; a < 2; ++a)
#pragma unroll
        for (int b = 0; b < 2; ++b)
#pragma unroll
            for (int m = 0; m < 4; ++m)
#pragma unroll
                for (int n = 0; n < 2; ++n) acc[a][b][m][n] = (f32x4){0.f, 0.f, 0.f, 0.f};
    v8i_t At[4], B0[2], B1[2];
    int sclv = 0x7f7f7f7f; asm volatile("" : "+v"(sclv));
    const char* cA = (const char*)g.A; const char* cB = (const char*)g.Bt + (size_t)cur.pn * tstep;
    PG8_GOFF(gC0, gC1, cur.pm);
    if (has_next) PG8_GOFF(gN0, gN1, nxt.pm); else { _Pragma("unroll") for (int _i = 0; _i < 2; ++_i) { gN0[_i] = gC0[_i]; gN1[_i] = gC1[_i]; } }
    S.a_ready(cur);
    if constexpr (SP2) {
        PG8_STAGE(PG8_SB(0, 0), cB, voffB); PG8_STAGE(PG8_SB(0, 1), cB + hstep, voffB); PG8_STAGE(PG8_SA(0, 0), cA, gC0); PG8_STAGE(PG8_SA(0, 1), cA, gC1);
        if (wr == 1) PG8_BAR;
        PG8_WAIT_V(2); PG8_BAR;
        PG8_STAGE(PG8_SB(1, 0), cB + kstep, voffB); PG8_STAGE(PG8_SA(1, 0), cA + kstep, gC0); PG8_STAGE(PG8_SB(1, 1), cB + hstep + kstep, voffB);
        PG8_WAIT_V(6); PG8_BAR;
    } else {
        PG8_STAGE(PG8_SB(0, 0), cB, voffB); PG8_STAGE(PG8_SA(0, 0), cA, gC0); PG8_STAGE(PG8_SB(0, 1), cB + hstep, voffB); PG8_STAGE(PG8_SA(0, 1), cA, gC1);
        if (wr == 1) PG8_BAR;
        PG8_WAIT_V(4); PG8_BAR;
        PG8_STAGE(PG8_SB(1, 0), cB + kstep, voffB); PG8_STAGE(PG8_SA(1, 0), cA + kstep, gC0); PG8_STAGE(PG8_SB(1, 1), cB + hstep + kstep, voffB);
        PG8_WAIT_V(6); PG8_BAR;
    }
    for (;;) {
        const char* nA = cA; const char* nB = has_next ? (const char*)g.Bt + (size_t)nxt.pn * tstep : cB;
        int t = 0;
        if (ui > 0) {
            static_assert(SP2, "peeled first K-tile pair: SP2 loop only");
            const bool last = (t == nt - 2);
            const char* a1 = cA + (size_t)(t + 1) * kstep;
            const char* a2 = last ? nA : cA + (size_t)(t + 2) * kstep; const char* b2 = last ? nB : cB + (size_t)(t + 2) * kstep;
            const char* a3 = a2 + kstep; const char* b3 = b2 + kstep;
            unsigned v20[2], v21[2];
            _Pragma("unroll") for (int _i = 0; _i < 2; ++_i) { v20[_i] = last ? gN0[_i] : gC0[_i]; v21[_i] = last ? gN1[_i] : gC1[_i]; }
            if (last && has_next) S.a_ready(nxt);
            if constexpr (SP2) {
            PG8_LDB(B0, 0, 0); PG8_LDB(B1, 0, 1); PG8_SCHED; PG8_LDA(At, 0, 0); PG8_STAGE(PG8_SA(1, 1), a1, gC1);
            PG8_WAIT_V_RELAXED(8); PG8_WAIT_L(0); PG8_BAR; PG8_MMA0(0, 0, At, B0); PG8_MMA0(0, 1, At, B1); PG8_BAR; PG8_SCHED;
            PG8_LDA(At, 0, 1); PG8_STAGE(PG8_SB(0, 0), b2, voffB); PG8_STAGE(PG8_SB(0, 1), b2 + hstep, voffB); PG8_STAGE(PG8_SA(0, 0), a2, v20);
            PG8_WAIT_V_RELAXED(8); PG8_WAIT_L(0); PG8_BAR; PG8_MMA0(1, 0, At, B0); PG8_MMA0(1, 1, At, B1); PG8_BAR; PG8_SCHED;
            PG8_LDB(B0, 1, 0); PG8_LDB(B1, 1, 1); PG8_SCHED; PG8_LDA(At, 1, 0); PG8_STAGE(PG8_SA(0, 1), a2, v21);
            PG8_WAIT_V(8); PG8_WAIT_L(0); PG8_BAR; PG8_MMA(0, 0, At, B0); PG8_MMA(0, 1, At, B1); PG8_BAR; PG8_SCHED;
            PG8_LDA(At, 1, 1); PG8_STAGE(PG8_SB(1, 0), b3, voffB); PG8_STAGE(PG8_SB(1, 1), b3 + hstep, voffB); PG8_STAGE(PG8_SA(1, 0), a3, v20);
            PG8_WAIT_V(8); PG8_WAIT_L(0); PG8_BAR; PG8_MMA(1, 0, At, B0); PG8_MMA(1, 1, At, B1); PG8_BAR; PG8_SCHED;
            } else {
            PG8_LDB(B0, 0, 0); PG8_SCHED; PG8_LDA(At, 0, 0); PG8_STAGE(PG8_SA(1, 1), a1, gC1);
            PG8_WAIT_L(8); PG8_BAR; PG8_WAIT_L(0); PG8_MMA(0, 0, At, B0); PG8_BAR; PG8_SCHED;
            PG8_LDB(B1, 0, 1); PG8_STAGE(PG8_SB(0, 0), b2, voffB);
            PG8_BAR; PG8_WAIT_L(0); PG8_MMA(0, 1, At, B1); PG8_BAR;
            PG8_LDA(At, 0, 1); PG8_STAGE(PG8_SA(0, 0), a2, v20);
            PG8_BAR; PG8_WAIT_L(0); PG8_MMA(1, 0, At, B0); PG8_BAR; PG8_SCHED;
            PG8_STAGE(PG8_SB(0, 1), b2 + hstep, voffB);
            PG8_WAIT_V(6); PG8_BAR; PG8_MMA(1, 1, At, B1); PG8_BAR;
            PG8_LDB(B0, 1, 0); PG8_SCHED; PG8_LDA(At, 1, 0); PG8_STAGE(PG8_SA(0, 1), a2, v21);
            PG8_WAIT_L(8); PG8_BAR; PG8_WAIT_L(0); PG8_MMA(0, 0, At, B0); PG8_BAR; PG8_SCHED;
            PG8_LDB(B1, 1, 1); PG8_STAGE(PG8_SB(1, 0), b3, voffB);
            PG8_BAR; PG8_WAIT_L(0); PG8_MMA(0, 1, At, B1); PG8_BAR;
            PG8_LDA(At, 1, 1); PG8_STAGE(PG8_SA(1, 0), a3, v20);
            PG8_BAR; PG8_WAIT_L(0); PG8_MMA(1, 0, At, B0); PG8_BAR; PG8_SCHED;
            PG8_STAGE(PG8_SB(1, 1), b3 + hstep, voffB);
            PG8_WAIT_V(6); PG8_BAR; PG8_MMA(1, 1, At, B1); PG8_BAR;
            }
            t = 2;
        }
#pragma unroll 1
        while (t < nt) {
            const bool last = (t == nt - 2);
            const char* a1 = cA + (size_t)(t + 1) * kstep;
            const char* a2 = last ? nA : cA + (size_t)(t + 2) * kstep; const char* b2 = last ? nB : cB + (size_t)(t + 2) * kstep;
            const char* a3 = a2 + kstep; const char* b3 = b2 + kstep;
            unsigned v20[2], v21[2];
            _Pragma("unroll") for (int _i = 0; _i < 2; ++_i) { v20[_i] = last ? gN0[_i] : gC0[_i]; v21[_i] = last ? gN1[_i] : gC1[_i]; }
            if (last && has_next) S.a_ready(nxt);
            if constexpr (SP2) {
            PG8_LDB(B0, 0, 0); PG8_LDB(B1, 0, 1); PG8_SCHED; PG8_LDA(At, 0, 0); PG8_STAGE(PG8_SA(1, 1), a1, gC1);
            PG8_WAIT_V(8); PG8_WAIT_L(0); PG8_BAR; PG8_MMA(0, 0, At, B0); PG8_MMA(0, 1, At, B1); PG8_BAR; PG8_SCHED;
            PG8_LDA(At, 0, 1); PG8_STAGE(PG8_SB(0, 0), b2, voffB); PG8_STAGE(PG8_SB(0, 1), b2 + hstep, voffB); PG8_STAGE(PG8_SA(0, 0), a2, v20);
            PG8_WAIT_V(8); PG8_WAIT_L(0); PG8_BAR; PG8_MMA(1, 0, At, B0); PG8_MMA(1, 1, At, B1); PG8_BAR; PG8_SCHED;
            PG8_LDB(B0, 1, 0); PG8_LDB(B1, 1, 1); PG8_SCHED; PG8_LDA(At, 1, 0); PG8_STAGE(PG8_SA(0, 1), a2, v21);
            PG8_WAIT_V(8); PG8_WAIT_L(0); PG8_BAR; PG8_MMA(0, 0, At, B0); PG8_MMA(0, 1, At, B1); PG8_BAR; PG8_SCHED;
            PG8_LDA(At, 1, 1); PG8_STAGE(PG8_SB(1, 0), b3, voffB); PG8_STAGE(PG8_SB(1, 1), b3 + hstep, voffB); PG8_STAGE(PG8_SA(1, 0), a3, v20);
            PG8_WAIT_V(8); PG8_WAIT_L(0); PG8_BAR; PG8_MMA(1, 0, At, B0); PG8_MMA(1, 1, At, B1); PG8_BAR; PG8_SCHED;
            } else {
            PG8_LDB(B0, 0, 0); PG8_SCHED; PG8_LDA(At, 0, 0); PG8_STAGE(PG8_SA(1, 1), a1, gC1);
            PG8_WAIT_L(8); PG8_BAR; PG8_WAIT_L(0); PG8_MMA(0, 0, At, B0); PG8_BAR; PG8_SCHED;
            PG8_LDB(B1, 0, 1); PG8_STAGE(PG8_SB(0, 0), b2, voffB);
            PG8_BAR; PG8_WAIT_L(0); PG8_MMA(0, 1, At, B1); PG8_BAR;
            PG8_LDA(At, 0, 1); PG8_STAGE(PG8_SA(0, 0), a2, v20);
            PG8_BAR; PG8_WAIT_L(0); PG8_MMA(1, 0, At, B0); PG8_BAR; PG8_SCHED;
            PG8_STAGE(PG8_SB(0, 1), b2 + hstep, voffB);
            PG8_WAIT_V(6); PG8_BAR; PG8_MMA(1, 1, At, B1); PG8_BAR;
            PG8_LDB(B0, 1, 0); PG8_SCHED; PG8_LDA(At, 1, 0); PG8_STAGE(PG8_SA(0, 1), a2, v21);
            PG8_WAIT_L(8); PG8_BAR; PG8_WAIT_L(0); PG8_MMA(0, 0, At, B0); PG8_BAR; PG8_SCHED;
            PG8_LDB(B1, 1, 1); PG8_STAGE(PG8_SB(1, 0), b3, voffB);
            PG8_BAR; PG8_WAIT_L(0); PG8_MMA(0, 1, At, B1); PG8_BAR;
            PG8_LDA(At, 1, 1); PG8_STAGE(PG8_SA(1, 0), a3, v20);
            PG8_BAR; PG8_WAIT_L(0); PG8_MMA(1, 0, At, B0); PG8_BAR; PG8_SCHED;
            PG8_STAGE(PG8_SB(1, 1), b3 + hstep, voffB);
            PG8_WAIT_V(6); PG8_BAR; PG8_MMA(1, 1, At, B1); PG8_BAR;
            }
            t += 2;
        }
        const bool has_nn = has_next && S.next(ui + 2, nn);
        if (has_nn) PG8_GRAW(rawN, nn.pm);
        if constexpr (ALIGN_EPI) { if (wr == 0) PG8_BAR; }
        asm volatile("s_nop 15\n\ts_nop 15" ::: "memory");
        if constexpr (!Epi::AFTER_DRAIN) { E(acc, cur, wr, wc, fr, fq); S.done(cur); }
        if (!has_next) break;
        cur = nxt; nxt = nn; has_next = has_nn; cA = nA; cB = nB; ++ui;
        _Pragma("unroll") for (int _i = 0; _i < 2; ++_i) { gC0[_i] = gN0[_i]; gC1[_i] = gN1[_i]; }
        PG8_GWAIT(rawN);
        if (has_next) PG8_GCVT(gN0, gN1, rawN);
        if constexpr (ALIGN_EPI) { if (wr == 1) PG8_BAR; }
    }
    PG8_WAIT_V(0);
    if constexpr (!ALIGN_EPI) { if (wr == 0) PG8_BAR; }
    PG8_BAR;
    if constexpr (Epi::AFTER_DRAIN) { E.fused(acc, cur, wr, wc, fr, fq, lds, wid, lane); S.done(cur); }
#undef PG8_SA
#undef PG8_SB
#undef PG8_STAGE
#undef PG8_GOFF
#undef PG8_GRAW
#undef PG8_GWAIT
#undef PG8_GCVT
#undef PG8_LDA
#undef PG8_LDB
#undef PG8_MMA
#undef PG8_WAIT_V
#undef PG8_WAIT_V_RELAXED
#undef PG8_MMA0
#undef PG8_WAIT_L
#undef PG8_BAR
#undef PG8_SCHED
}
}
namespace pg8 {
typedef int i32x4_t __attribute__((ext_vector_type(4)));
template <class Epi, class Sched, bool ALIGN_EPI = false, bool SP2 = false>
__device__ __forceinline__ void gemm_phase_i8(PG8_LAS unsigned char* lds, const Gemm g, const Sched& S, const Epi& E) {
    int tid = threadIdx.x; asm volatile("" : "+v"(tid));
    const int wid = __builtin_amdgcn_readfirstlane(tid >> 6), lane = tid & 63, wr = wid >> 2, wc = wid & 3, fr = lane & 15, fq = lane >> 4;
    int K = g.K; asm volatile("" : "+s"(K));
    const int nt = K / BK;
    unsigned voffA[2], voffB[2];
#pragma unroll
    for (int i = 0; i < 2; ++i) { int R, C; stage_rc(tid * 16 + i * 8192, R, C); const int Rb = Epi::PERM ? ((R & ~31) + perm32(R & 31)) : R;
        voffA[i] = (unsigned)(R * K + C) * 2u; voffB[i] = (unsigned)(Rb * K + C) * 2u; }
    const size_t kstep = (size_t)(BK * 2);
    const size_t hstep = (size_t)HALF * K * 2;
    const size_t tstep = 2 * hstep;
    const unsigned ldsw = (unsigned)wid * 1024u;
    const int aoff = lds_byte(wr * 64 + fr, fq * 8), boff = lds_byte(wc * 32 + fr, fq * 8);
#define PG8_SA(b, h) (((b) * 2 + (h)) * HTB)
#define PG8_SB(b, h) ((4 + (b) * 2 + (h)) * HTB)
#define PG8_STAGE(bufoff, gbase, voff) do { _Pragma("unroll") for (int _i = 0; _i < 2; ++_i) \
        __builtin_amdgcn_global_load_lds((const unsigned*)((const char*)(gbase) + (voff)[_i]), (PG8_LAS unsigned*)(lds + (bufoff) + ldsw + _i * 8192), 16, 0, 0); } while (0)
#define PG8_LDA(dst, b, h) do { _Pragma("unroll") for (int m = 0; m < 4; ++m) _Pragma("unroll") for (int k = 0; k < 2; ++k) dst[m][k] = *(const PG8_LAS bf16x8*)(lds + PG8_SA(b, h) + aoff + m * 2048 + k * 1024); } while (0)
#define PG8_LDB(dst, b, h) do { _Pragma("unroll") for (int n = 0; n < 2; ++n) _Pragma("unroll") for (int k = 0; k < 2; ++k) dst[n][k] = *(const PG8_LAS bf16x8*)(lds + PG8_SB(b, h) + boff + n * 2048 + k * 1024); } while (0)
#define PG8_MMA(ai, bj, At, Bt) do { __builtin_amdgcn_s_setprio(1); _Pragma("unroll") for (int m = 0; m < 4; ++m) _Pragma("unroll") for (int n = 0; n < 2; ++n) _Pragma("unroll") for (int k = 0; k < 2; ++k) \
        acc[ai][bj][m][n] = __builtin_amdgcn_mfma_i32_16x16x64_i8(__builtin_bit_cast(i32x4_t, Bt[n][k]), __builtin_bit_cast(i32x4_t, At[m][k]), acc[ai][bj][m][n], 0, 0, 0); __builtin_amdgcn_s_setprio(0); } while (0)
#define PG8_WAIT_V(n) asm volatile("s_waitcnt vmcnt(" #n ")" ::: "memory")
#define PG8_WAIT_L(n) asm volatile("s_waitcnt lgkmcnt(" #n ")" ::: "memory")
#define PG8_BAR __builtin_amdgcn_s_barrier()
#define PG8_SCHED __builtin_amdgcn_sched_barrier(0)
    Unit cur, nxt; int ui = 0;
    if (!S.next(0, cur)) return;
    i32x4_t acc[2][2][4][2];
#pragma unroll
    for (int a = 0; a < 2; ++a)
#pragma unroll
        for (int b = 0; b < 2; ++b)
#pragma unroll
            for (int m = 0; m < 4; ++m)
#pragma unroll
                for (int n = 0; n < 2; ++n) acc[a][b][m][n] = (i32x4_t){0, 0, 0, 0};
    bf16x8 At[4][2], B0[2][2], B1[2][2];
    const char* cA = (const char*)g.A + (size_t)cur.pm * tstep; const char* cB = (const char*)g.Bt + (size_t)cur.pn * tstep;
    S.a_ready(cur);
    if constexpr (SP2) {
        PG8_STAGE(PG8_SB(0, 0), cB, voffB); PG8_STAGE(PG8_SB(0, 1), cB + hstep, voffB); PG8_STAGE(PG8_SA(0, 0), cA, voffA); PG8_STAGE(PG8_SA(0, 1), cA + hstep, voffA);
        if (wr == 1) PG8_BAR;
        PG8_WAIT_V(2); PG8_BAR;
        PG8_STAGE(PG8_SB(1, 0), cB + kstep, voffB); PG8_STAGE(PG8_SA(1, 0), cA + kstep, voffA); PG8_STAGE(PG8_SB(1, 1), cB + hstep + kstep, voffB);
        PG8_WAIT_V(6); PG8_BAR;
    } else {
        PG8_STAGE(PG8_SB(0, 0), cB, voffB); PG8_STAGE(PG8_SA(0, 0), cA, voffA); PG8_STAGE(PG8_SB(0, 1), cB + hstep, voffB); PG8_STAGE(PG8_SA(0, 1), cA + hstep, voffA);
        if (wr == 1) PG8_BAR;
        PG8_WAIT_V(4); PG8_BAR;
        PG8_STAGE(PG8_SB(1, 0), cB + kstep, voffB); PG8_STAGE(PG8_SA(1, 0), cA + kstep, voffA); PG8_STAGE(PG8_SB(1, 1), cB + hstep + kstep, voffB);
        PG8_WAIT_V(6); PG8_BAR;
    }
    for (;;) {
        const bool has_next = S.next(ui + 1, nxt);
        const char* nA = has_next ? (const char*)g.A + (size_t)nxt.pm * tstep : cA; const char* nB = has_next ? (const char*)g.Bt + (size_t)nxt.pn * tstep : cB;
        int t = 0;
#pragma unroll 1
        do {
            const bool last = (t == nt - 2);
            const char* a1 = cA + (size_t)(t + 1) * kstep;
            const char* a2 = last ? nA : cA + (size_t)(t + 2) * kstep; const char* b2 = last ? nB : cB + (size_t)(t + 2) * kstep;
            const char* a3 = a2 + kstep; const char* b3 = b2 + kstep;
            if (last && has_next) S.a_ready(nxt);
            if constexpr (SP2) {
            PG8_LDB(B0, 0, 0); PG8_LDB(B1, 0, 1); PG8_SCHED; PG8_LDA(At, 0, 0); PG8_STAGE(PG8_SA(1, 1), a1 + hstep, voffA);
            PG8_WAIT_V(8); PG8_WAIT_L(0); PG8_BAR; PG8_MMA(0, 0, At, B0); PG8_MMA(0, 1, At, B1); PG8_BAR; PG8_SCHED;
            PG8_LDA(At, 0, 1); PG8_STAGE(PG8_SB(0, 0), b2, voffB); PG8_STAGE(PG8_SB(0, 1), b2 + hstep, voffB); PG8_STAGE(PG8_SA(0, 0), a2, voffA);
            PG8_WAIT_V(8); PG8_WAIT_L(0); PG8_BAR; PG8_MMA(1, 0, At, B0); PG8_MMA(1, 1, At, B1); PG8_BAR; PG8_SCHED;
            PG8_LDB(B0, 1, 0); PG8_LDB(B1, 1, 1); PG8_SCHED; PG8_LDA(At, 1, 0); PG8_STAGE(PG8_SA(0, 1), a2 + hstep, voffA);
            PG8_WAIT_V(8); PG8_WAIT_L(0); PG8_BAR; PG8_MMA(0, 0, At, B0); PG8_MMA(0, 1, At, B1); PG8_BAR; PG8_SCHED;
            PG8_LDA(At, 1, 1); PG8_STAGE(PG8_SB(1, 0), b3, voffB); PG8_STAGE(PG8_SB(1, 1), b3 + hstep, voffB); PG8_STAGE(PG8_SA(1, 0), a3, voffA);
            PG8_WAIT_V(8); PG8_WAIT_L(0); PG8_BAR; PG8_MMA(1, 0, At, B0); PG8_MMA(1, 1, At, B1); PG8_BAR; PG8_SCHED;
            } else {
            PG8_LDB(B0, 0, 0); PG8_SCHED; PG8_LDA(At, 0, 0); PG8_STAGE(PG8_SA(1, 1), a1 + hstep, voffA);
            PG8_WAIT_L(8); PG8_BAR; PG8_WAIT_L(0); PG8_MMA(0, 0, At, B0); PG8_BAR; PG8_SCHED;
            PG8_LDB(B1, 0, 1); PG8_STAGE(PG8_SB(0, 0), b2, voffB);
            PG8_BAR; PG8_WAIT_L(0); PG8_MMA(0, 1, At, B1); PG8_BAR;
            PG8_LDA(At, 0, 1); PG8_STAGE(PG8_SA(0, 0), a2, voffA);
            PG8_BAR; PG8_WAIT_L(0); PG8_MMA(1, 0, At, B0); PG8_BAR; PG8_SCHED;
            PG8_STAGE(PG8_SB(0, 1), b2 + hstep, voffB);
            PG8_WAIT_V(6); PG8_BAR; PG8_MMA(1, 1, At, B1); PG8_BAR;
            PG8_LDB(B0, 1, 0); PG8_SCHED; PG8_LDA(At, 1, 0); PG8_STAGE(PG8_SA(0, 1), a2 + hstep, voffA);
            PG8_WAIT_L(8); PG8_BAR; PG8_WAIT_L(0); PG8_MMA(0, 0, At, B0); PG8_BAR; PG8_SCHED;
            PG8_LDB(B1, 1, 1); PG8_STAGE(PG8_SB(1, 0), b3, voffB);
            PG8_BAR; PG8_WAIT_L(0); PG8_MMA(0, 1, At, B1); PG8_BAR;
            PG8_LDA(At, 1, 1); PG8_STAGE(PG8_SA(1, 0), a3, voffA);
            PG8_BAR; PG8_WAIT_L(0); PG8_MMA(1, 0, At, B0); PG8_BAR; PG8_SCHED;
            PG8_STAGE(PG8_SB(1, 1), b3 + hstep, voffB);
            PG8_WAIT_V(6); PG8_BAR; PG8_MMA(1, 1, At, B1); PG8_BAR;
            }
            t += 2;
        } while (t < nt);
        if constexpr (ALIGN_EPI) { if (wr == 0) PG8_BAR; }
        if constexpr (!Epi::AFTER_DRAIN) { E(acc, cur, wr, wc, fr, fq); S.done(cur); }
        if (!has_next) break;
#pragma unroll
        for (int a = 0; a < 2; ++a)
#pragma unroll
            for (int b = 0; b < 2; ++b)
#pragma unroll
                for (int m = 0; m < 4; ++m)
#pragma unroll
                    for (int n = 0; n < 2; ++n) acc[a][b][m][n] = (i32x4_t){0, 0, 0, 0};
        cur = nxt; cA = nA; cB = nB; ++ui;
        if constexpr (ALIGN_EPI) { if (wr == 1) PG8_BAR; }
    }
    PG8_WAIT_V(0);
    if constexpr (!ALIGN_EPI) { if (wr == 0) PG8_BAR; }
    PG8_BAR;
    if constexpr (Epi::AFTER_DRAIN) { E.fused(acc, cur, wr, wc, fr, fq, lds, wid, lane); S.done(cur); }
#undef PG8_SA
#undef PG8_SB
#undef PG8_STAGE
#undef PG8_LDA
#undef PG8_LDB
#undef PG8_MMA
#undef PG8_WAIT_V
#undef PG8_WAIT_L
#undef PG8_BAR
#undef PG8_SCHED
}
}
#define GAS __attribute__((address_space(1)))
#define LAS __attribute__((address_space(3)))
typedef unsigned short bf16;
typedef unsigned v4u __attribute__((ext_vector_type(4)));
typedef float f32x4 __attribute__((ext_vector_type(4)));
typedef short bf16x8 __attribute__((ext_vector_type(8)));
typedef GAS unsigned gu32;
typedef GAS unsigned long long gu64;
#define RLX_AGENT __ATOMIC_RELAXED, __HIP_MEMORY_SCOPE_AGENT
#define LDS_WAIT() asm volatile("s_waitcnt lgkmcnt(0)" ::: "memory")
#define VM_WAIT() asm volatile("s_waitcnt vmcnt(0)" ::: "memory")
__device__ __forceinline__ unsigned long long rt() { return __builtin_amdgcn_s_memrealtime(); }
__device__ __forceinline__ unsigned f2bf(float f) { unsigned u = __builtin_bit_cast(unsigned, f); return (u + 0x7fffu + ((u >> 16) & 1u)) >> 16; }
__device__ __forceinline__ unsigned pk2(float lo, float hi) { return f2bf(lo) | (f2bf(hi) << 16); }

#define XB_TMO      128
#define XB_XCNT(j)  (256  + 64 * (j))
#define XB_XSUB(j)  (1280 + 64 * (j))
#define XB_XGEN(j)  (2304 + 64 * (j))
#define XB_TOP      3328
#define XB_TOPGEN   3392
#define XCD_BAR_WORDS 3456
#define XB_SPIN_CAP (1u << 18)

__device__ __forceinline__ unsigned xb_ld(unsigned* p)              { return __hip_atomic_load(p, __ATOMIC_RELAXED, __HIP_MEMORY_SCOPE_AGENT); }
__device__ __forceinline__ unsigned xb_add(unsigned* p, unsigned v) { return __hip_atomic_fetch_add(p, v, __ATOMIC_RELAXED, __HIP_MEMORY_SCOPE_AGENT); }
__device__ __forceinline__ unsigned xb_xcc_id() { return (unsigned)__builtin_amdgcn_s_getreg((3 << 11) | 20) & 0xFu; }
#define XB_SPIN(cond, bar) do { unsigned _sp = 0; while (cond) { __builtin_amdgcn_s_sleep(1); \
    if ((++_sp & 255u) == 0u) { if (xb_ld(&(bar)[XB_TMO])) break; if (_sp > XB_SPIN_CAP) { atomicAdd(&(bar)[XB_TMO], 1u); break; } } } } while (0)

struct XcdBarrier {
    unsigned* bar; unsigned x;
    volatile LAS unsigned* st;
};

__device__ __forceinline__ XcdBarrier xcd_barrier_post(unsigned* bar, volatile LAS unsigned* st) {
    XcdBarrier b; b.bar = bar; b.x = xb_xcc_id(); b.st = st;
    if (threadIdx.x == 0) (void)xb_add(&bar[XB_XCNT(b.x)], 1u);
    return b;
}
__device__ __forceinline__ void xcd_barrier_complete(unsigned* bar, unsigned x, unsigned& nloc, unsigned& nx) {
    const unsigned G = gridDim.x * gridDim.y * gridDim.z;
    unsigned sum, cnt, mine, sp = 0u;
    for (;;) {
        sum = 0u; cnt = 0u; mine = 0u;
#pragma unroll
        for (unsigned j = 0; j < 16; ++j) { const unsigned c = xb_ld(&bar[XB_XCNT(j)]); sum += c; cnt += (c > 0u) ? 1u : 0u; mine = (j == x) ? c : mine; }
        if (sum == G) break;
        __builtin_amdgcn_s_sleep(1);
        if ((++sp & 255u) == 0u) { if (xb_ld(&bar[XB_TMO])) break; if (sp > XB_SPIN_CAP) { atomicAdd(&bar[XB_TMO], 1u); break; } }
    }
    nloc = mine > 0u ? mine : 1u; nx = cnt > 0u ? cnt : 1u;
}

__device__ __forceinline__ void xcd_barrier(const XcdBarrier& b) {
    asm volatile("s_waitcnt vmcnt(0)" ::: "memory");
    __syncthreads();
    if (threadIdx.x == 0) {
        unsigned* bar = b.bar;
        __builtin_amdgcn_s_waitcnt(0);
        unsigned nloc = b.st[0], nx = b.st[1];
        if (nloc == 0u) { xcd_barrier_complete(bar, b.x, nloc, nx); b.st[0] = nloc; b.st[1] = nx; }
        const unsigned old = xb_add(&bar[XB_XSUB(b.x)], 1u);
        const unsigned gen = old / nloc;
        if (old + 1u == (gen + 1u) * nloc) {
            __builtin_amdgcn_fence(__ATOMIC_RELEASE, "agent");
            asm volatile("s_waitcnt vmcnt(0)" ::: "memory");
            const unsigned og = xb_add(&bar[XB_TOP], 1u);
            const unsigned tg = og / nx;
            if (og + 1u == (tg + 1u) * nx) xb_add(&bar[XB_TOPGEN], 1u);
            else XB_SPIN(xb_ld(&bar[XB_TOPGEN]) == tg, bar);
            __builtin_amdgcn_fence(__ATOMIC_ACQUIRE, "agent");
            xb_add(&bar[XB_XGEN(b.x)], 1u);
            asm volatile("s_waitcnt vmcnt(0)" ::: "memory");
        } else {
            XB_SPIN(xb_ld(&bar[XB_XGEN(b.x)]) == gen, bar);
            __builtin_amdgcn_fence(__ATOMIC_ACQUIRE, "agent");
            asm volatile("s_waitcnt vmcnt(0)" ::: "memory");
        }
    }
    __syncthreads();
}
constexpr int T = 65536, SEQ = 4096, DM = 1024;
constexpr int NWAVES = 8;
constexpr float EPS = 1e-6f;
constexpr float LOG2E = 1.4426950408889634f;
constexpr float QSCALE_A = 0.10206207261596575f * LOG2E;
constexpr float QSCALE_B = 0.125f * LOG2E;
constexpr float LOG2_THETA = 13.287712379549449f;
constexpr float INV_2PI = 0.15915494309189535f;

constexpr size_t MiB = 1u << 20;
constexpr size_t WS_CTL = 0, CTL_ZERO_BYTES = 4 * MiB;
constexpr size_t WS_MOD = 2 * MiB;
constexpr size_t WS_TOPK = 4 * MiB;
constexpr size_t WS_GATES = 4 * MiB + 512 * 1024;
constexpr size_t WS_SLOTS = 5 * MiB;
constexpr size_t WS_GSLOT = 5 * MiB + 512 * 1024;
constexpr size_t WS_BLKCNT = 6 * MiB + 128 * 1024;
constexpr size_t WS_PENDS = 6 * MiB + 256 * 1024;
constexpr size_t WS_TOKSLOT = 6 * MiB + 512 * 1024;
constexpr size_t WS_ROWSC = 7 * MiB + 256 * 1024;
constexpr size_t WS_WAMAX = 64 * 1024;
constexpr size_t WS_W = 8 * MiB;
constexpr size_t W_IN = WS_W;
constexpr size_t W_UQ = W_IN + (size_t)1280 * 1024 * 2;
constexpr size_t W_UKV = W_UQ + (size_t)768 * 256 * 2;
constexpr size_t W_OUT = W_UKV + (size_t)1024 * 128 * 2;
constexpr size_t W_GU = W_OUT + (size_t)1024 * 1024 * 2;
constexpr size_t W_D = W_GU + (size_t)5632 * 1024 * 2;
constexpr size_t W_QKV = W_D + (size_t)1024 * 2816 * 2;
constexpr size_t W_DO = W_QKV + (size_t)3072 * 1024 * 2;
constexpr size_t W_MGU = W_DO + (size_t)1024 * 1024 * 2;
constexpr size_t W_MD = W_MGU + (size_t)8 * 7168 * 1024 * 2;
constexpr size_t W_END = W_MD + (size_t)8 * 1024 * 3584 * 2;
static_assert(W_END <= 208 * MiB, "weights region");
constexpr size_t A_H = 208 * MiB;
constexpr size_t A_P = 336 * MiB;
constexpr size_t A_CQ = 496 * MiB;
constexpr size_t A_CKV = 528 * MiB;
constexpr size_t A_QB = 544 * MiB;
constexpr size_t A_KB = 608 * MiB;
constexpr size_t A_QA = 624 * MiB;
constexpr size_t A_KV = 720 * MiB;
constexpr size_t A_KA = 848 * MiB;
constexpr size_t A_ATT0 = A_H;
constexpr size_t A_ACT = 336 * MiB;
constexpr size_t A_QKV = 336 * MiB;
constexpr size_t A_ATT1 = 720 * MiB;
constexpr size_t A_O2 = 848 * MiB;
constexpr size_t A_LSE1 = 976 * MiB;
constexpr size_t A_LSE2 = 980 * MiB;
constexpr size_t A_HP = 208 * MiB;
constexpr size_t A_Y = 208 * MiB;
constexpr size_t A_ACTM = 468 * MiB;
constexpr size_t WS_NEED = 984 * MiB;

constexpr int CW_BAR = 4096;
constexpr int RING_BYTES = 131072;
constexpr int LDS_BYTES = 163840;
constexpr int MISC_OFF = LDS_BYTES - 512;
constexpr int LDS_ZERO_OFF = LDS_BYTES - 1024;

constexpr int NPH = 28;
#ifndef FFN_FP8
#define FFN_FP8 3
#endif

struct Args {
    const float* in[31];
    float* out;
    unsigned char* ws;
    int ph_lo, ph_hi;
};
enum { I_X = 0, I_C, I_ADA_E_W, I_ADA_E_B, I_NORM_E_MIX, I_NORM_E_FFN, I_W_IN, I_Q_NORM, I_W_UQ, I_KV_NORM, I_W_UKV, I_MLA_QG, I_MLA_KG, I_GQA_QG, I_GQA_KG,
       I_E_W_OUT, I_FFN_G, I_FFN_U, I_FFN_D, I_ADA_O_W, I_ADA_O_B, I_NORM_O_MIX, I_NORM_O_FFN, I_DIL_QKV, I_DIL_QG, I_DIL_KG, I_DIL_OUT, I_ROUTER, I_MOE_G, I_MOE_U, I_MOE_D };

__device__ __forceinline__ float bf2f(unsigned b) { return __builtin_bit_cast(float, b << 16); }
__device__ __forceinline__ float bflo(unsigned w) { return __builtin_bit_cast(float, w << 16); }
__device__ __forceinline__ float bfhi(unsigned w) { return __builtin_bit_cast(float, w & 0xffff0000u); }
__device__ __forceinline__ float wave_sum(float v) {
#pragma unroll
    for (int o = 1; o < 64; o <<= 1) v += __shfl_xor(v, o);
    return v;
}
typedef __bf16 bf16n2_t __attribute__((ext_vector_type(2)));
typedef float f32n2_t __attribute__((ext_vector_type(2)));
__device__ __forceinline__ unsigned cvtpk(float lo, float hi) { const f32n2_t v = {lo, hi}; return __builtin_bit_cast(unsigned, __builtin_convertvector(v, bf16n2_t)); }

__device__ __forceinline__ void transpose_item(const float* W, int N, int k0, int n0, bf16* dst, int Kd, LAS float* scr, int lane) {
#pragma unroll 4
    for (int i = 0; i < 32; ++i) { const int kk = 2 * i + (lane >> 5); scr[kk * 33 + (lane & 31)] = W[(size_t)(k0 + kk) * N + n0 + (lane & 31)]; }
    LDS_WAIT(); asm volatile("" ::: "memory");
    const int c = lane & 7;
#pragma unroll
    for (int j = 0; j < 4; ++j) { const int n = (lane >> 3) + 8 * j; const LAS float* s = scr + (8 * c) * 33 + n;
        v4u o; o.x = pk2(s[0 * 33], s[1 * 33]); o.y = pk2(s[2 * 33], s[3 * 33]); o.z = pk2(s[4 * 33], s[5 * 33]); o.w = pk2(s[6 * 33], s[7 * 33]);
        *(GAS v4u*)(dst + (size_t)n * Kd + k0 + 8 * c) = o; }
    LDS_WAIT(); asm volatile("" ::: "memory");
}
__device__ __forceinline__ void tr_plain(const float* W, int K, int N, bf16* WT, int r, LAS float* scr, int lane) {
    const int nblk = N / 32, kb = r / nblk, nb = r % nblk;
    transpose_item(W, N, 64 * kb, 32 * nb, WT + (size_t)(32 * nb) * K, K, scr, lane);
}
__device__ __forceinline__ void tr_gu(const float* W, int K, int N, bf16* WT, int upoff, int r, LAS float* scr, int lane) {
    const int nblk = N / 32, kb = r / nblk, nb = r % nblk, n0 = 32 * nb;
    const int drow = (n0 >> 7) * 256 + (n0 & 127) + upoff;
    transpose_item(W, N, 64 * kb, n0, WT + (size_t)drow * K, K, scr, lane);
}


typedef unsigned u32x2_t __attribute__((ext_vector_type(2)));
constexpr float F8_WS = 64.f, F8_HS = 4.f, F8_AS = 4.f;
__device__ __forceinline__ float clamp448(float v) { return fminf(fmaxf(v, -448.f), 448.f); }
__device__ __forceinline__ unsigned pk4_fp8(float a, float b, float c, float d) { int w = 0; w = __builtin_amdgcn_cvt_pk_fp8_f32(a, b, w, false); w = __builtin_amdgcn_cvt_pk_fp8_f32(c, d, w, true); return (unsigned)w; }
__device__ __forceinline__ void transpose_item8(const float* W, int N, int k0, int n0, unsigned char* dst8, int Kd, float sc, LAS float* scr, int lane) {
#pragma unroll 4
    for (int i = 0; i < 32; ++i) { const int kk = 2 * i + (lane >> 5); scr[kk * 33 + (lane & 31)] = W[(size_t)(k0 + kk) * N + n0 + (lane & 31)]; }
    LDS_WAIT(); asm volatile("" ::: "memory");
    const int c = lane & 7;
#pragma unroll
    for (int j = 0; j < 4; ++j) { const int n = (lane >> 3) + 8 * j; const LAS float* s = scr + (8 * c) * 33 + n;
        u32x2_t o; o.x = pk4_fp8(s[0 * 33] * sc, s[1 * 33] * sc, s[2 * 33] * sc, s[3 * 33] * sc); o.y = pk4_fp8(s[4 * 33] * sc, s[5 * 33] * sc, s[6 * 33] * sc, s[7 * 33] * sc);
        *(GAS u32x2_t*)(dst8 + (size_t)n * Kd + k0 + 8 * c) = o; }
    LDS_WAIT(); asm volatile("" ::: "memory");
}
__device__ __forceinline__ void tr_plain8(const float* W, int K, int N, unsigned char* WT, int r, LAS float* scr, int lane) {
    const int nblk = N / 32, kb = r / nblk, nb = r % nblk;
    transpose_item8(W, N, 64 * kb, 32 * nb, WT + (size_t)(32 * nb) * K, K, F8_WS, scr, lane);
}
__device__ __forceinline__ void tr_gu8(const float* W, int K, int N, unsigned char* WT, int upoff, int r, LAS float* scr, int lane) {
    const int nblk = N / 32, kb = r / nblk, nb = r % nblk, n0 = 32 * nb;
    const int drow = (n0 >> 7) * 256 + (n0 & 127) + upoff;
    transpose_item8(W, N, 64 * kb, n0, WT + (size_t)drow * K, K, F8_WS, scr, lane);
}


__device__ __forceinline__ unsigned pk4_i8(float a, float b, float c, float d) {
    const int ia = (int)__builtin_rintf(__builtin_amdgcn_fmed3f(a, -127.f, 127.f)), ib = (int)__builtin_rintf(__builtin_amdgcn_fmed3f(b, -127.f, 127.f));
    const int ic = (int)__builtin_rintf(__builtin_amdgcn_fmed3f(c, -127.f, 127.f)), id = (int)__builtin_rintf(__builtin_amdgcn_fmed3f(d, -127.f, 127.f));
    return (unsigned)(ia & 255) | ((unsigned)(ib & 255) << 8) | ((unsigned)(ic & 255) << 16) | ((unsigned)(id & 255) << 24);
}
__device__ __forceinline__ void transpose_item_i8(const float* W, int N, int k0, int n0, unsigned char* dst8, int Kd, float sc, LAS float* scr, int lane) {
#pragma unroll 4
    for (int i = 0; i < 32; ++i) { const int kk = 2 * i + (lane >> 5); scr[kk * 33 + (lane & 31)] = W[(size_t)(k0 + kk) * N + n0 + (lane & 31)]; }
    LDS_WAIT(); asm volatile("" ::: "memory");
    const int c = lane & 7;
#pragma unroll
    for (int j = 0; j < 4; ++j) { const int n = (lane >> 3) + 8 * j; const LAS float* s = scr + (8 * c) * 33 + n;
        u32x2_t o; o.x = pk4_i8(s[0 * 33] * sc, s[1 * 33] * sc, s[2 * 33] * sc, s[3 * 33] * sc); o.y = pk4_i8(s[4 * 33] * sc, s[5 * 33] * sc, s[6 * 33] * sc, s[7 * 33] * sc);
        *(GAS u32x2_t*)(dst8 + (size_t)n * Kd + k0 + 8 * c) = o; }
    LDS_WAIT(); asm volatile("" ::: "memory");
}
__device__ __forceinline__ void tr_gu_i8(const float* W, int K, int N, unsigned char* WT, int upoff, float sc, int r, LAS float* scr, int lane) {
    const int nblk = N / 32, kb = r / nblk, nb = r % nblk, n0 = 32 * nb;
    const int drow = (n0 >> 7) * 256 + (n0 & 127) + upoff;
    transpose_item_i8(W, N, 64 * kb, n0, WT + (size_t)drow * K, K, sc, scr, lane);
}
__device__ __forceinline__ void absmax_pass(const float* w, size_t n4, unsigned* slot, int gw, int NGW, int lane) {
    float mx = 0.f;
    for (size_t i = (size_t)gw * 64 + lane; i < n4; i += (size_t)NGW * 64) { const f32x4 v = ((const f32x4*)w)[i]; mx = fmaxf(fmaxf(mx, fmaxf(fabsf(v.x), fabsf(v.y))), fmaxf(fabsf(v.z), fabsf(v.w))); }
#pragma unroll
    for (int o = 1; o < 64; o <<= 1) mx = fmaxf(mx, __shfl_xor(mx, o));
    if (lane == 0) atomicMax(slot, __builtin_bit_cast(unsigned, mx));
}
__device__ __forceinline__ void p0_prologue(const Args& a, LAS unsigned char* lds, int gw, int NGW, int wave, int lane) {
    unsigned char* ws = a.ws;
    LAS float* scr = (LAS float*)(lds + wave * 16384);
    constexpr int I0 = 16 * 37, I1 = 4 * 24, I2 = 2 * 32, I3 = 16 * 32, I4 = 16 * 88, I6 = 44 * 32, I7 = 16 * 96, I8 = 16 * 32, IM = 16 * 112, IMD = 56 * 32;
    constexpr int NITEMS = I0 + I1 + I2 + I3 + 2 * I4 + I6 + I7 + I8 + 16 * IM + 8 * IMD;
    for (int it = gw; it < NITEMS; it += NGW) {
        int r = it;
        if (r < I0) continue;
        r -= I0;
        if (r < I1) { tr_plain(a.in[I_W_UQ], 256, 768, (bf16*)(ws + W_UQ), r, scr, lane); continue; } r -= I1;
        if (r < I2) {
            const int nblk = 1024 / 32, kb = r / nblk, nb = r % nblk, n0 = 32 * nb; const int hd = n0 >> 7, w = n0 & 127; const int drow = (w < 64) ? hd * 64 + w : 512 + hd * 64 + (w - 64);
            transpose_item(a.in[I_W_UKV], 1024, 64 * kb, n0, (bf16*)(ws + W_UKV) + (size_t)drow * 128, 128, scr, lane); continue; } r -= I2;
        if (r < I3) { tr_plain(a.in[I_E_W_OUT], 1024, 1024, (bf16*)(ws + W_OUT), r, scr, lane); continue; } r -= I3;
#if FFN_FP8 == 1
        if (r < I4) { tr_gu8(a.in[I_FFN_G], 1024, 2816, ws + W_GU, 0, r, scr, lane); continue; } r -= I4;
        if (r < I4) { tr_gu8(a.in[I_FFN_U], 1024, 2816, ws + W_GU, 128, r, scr, lane); continue; } r -= I4;
        if (r < I6) { tr_plain8(a.in[I_FFN_D], 2816, 1024, ws + W_D, r, scr, lane); continue; } r -= I6;
#elif FFN_FP8 == 2
        if (r < I4) { tr_gu(a.in[I_FFN_G], 1024, 2816, (bf16*)(ws + W_GU), 0, r, scr, lane); continue; } r -= I4;
        if (r < I4) { tr_gu(a.in[I_FFN_U], 1024, 2816, (bf16*)(ws + W_GU), 128, r, scr, lane); continue; } r -= I4;
        if (r < I6) { tr_plain8(a.in[I_FFN_D], 2816, 1024, ws + W_D, r, scr, lane); continue; } r -= I6;
#elif FFN_FP8 == 3
        if (r < 2 * I4) continue;
        r -= 2 * I4;
        if (r < I6) { tr_plain8(a.in[I_FFN_D], 2816, 1024, ws + W_D, r, scr, lane); continue; } r -= I6;
#else
        if (r < 2 * I4) continue;
        r -= 2 * I4;
        if (r < I6) { tr_plain(a.in[I_FFN_D], 2816, 1024, (bf16*)(ws + W_D), r, scr, lane); continue; } r -= I6;
#endif
        if (r < I7) continue;
        r -= I7;
        if (r < I8) { tr_plain(a.in[I_DIL_OUT], 1024, 1024, (bf16*)(ws + W_DO), r, scr, lane); continue; } r -= I8;
        if (r < 8 * IM) { const int e = r / IM; tr_gu8(a.in[I_MOE_G] + (size_t)e * 1024 * 3584, 1024, 3584, ws + W_MGU + (size_t)e * 7168 * 1024, 0, r % IM, scr, lane); continue; } r -= 8 * IM;
        if (r < 8 * IM) { const int e = r / IM; tr_gu8(a.in[I_MOE_U] + (size_t)e * 1024 * 3584, 1024, 3584, ws + W_MGU + (size_t)e * 7168 * 1024, 128, r % IM, scr, lane); continue; } r -= 8 * IM;
        { const int e = r / IMD; tr_plain8(a.in[I_MOE_D] + (size_t)e * 3584 * 1024, 3584, 1024, ws + W_MD + (size_t)e * 1024 * 3584, r % IMD, scr, lane); }
    }
    { GAS v4u* z = (GAS v4u*)(ws + W_IN + (size_t)1184 * 1024);
      for (int i = gw * 64 + lane; i < 6144; i += NGW * 64) z[i] = (v4u){0u, 0u, 0u, 0u}; }
#if FFN_FP8 == 0 || FFN_FP8 == 3
    absmax_pass(a.in[I_FFN_G], (size_t)1024 * 2816 / 4, (unsigned*)(ws + WS_WAMAX), gw, NGW, lane); absmax_pass(a.in[I_FFN_U], (size_t)1024 * 2816 / 4, (unsigned*)(ws + WS_WAMAX), gw, NGW, lane);
    absmax_pass(a.in[I_DIL_QKV], (size_t)1024 * 3072 / 4, (unsigned*)(ws + WS_WAMAX) + 1, gw, NGW, lane);
    absmax_pass(a.in[I_W_IN], (size_t)1024 * 1184 / 4, (unsigned*)(ws + WS_WAMAX) + 2, gw, NGW, lane);
#endif
    for (int u = gw; u < 2 * 96 * 16; u += NGW) {
        const int layer = u / 1536, rem = u % 1536, cg = rem >> 4, kc = rem & 15;
        const float* W = a.in[layer ? I_ADA_O_W : I_ADA_E_W]; const float* bia = a.in[layer ? I_ADA_O_B : I_ADA_E_B];
        unsigned long long* mod = (unsigned long long*)(ws + WS_MOD) + layer * 16 * 6144;
        const int n = cg * 64 + lane, k0 = kc * 64;
        float s[16], acc[16];
#pragma unroll
        for (int b = 0; b < 16; ++b) { const float cv = a.in[I_C][b * 1024 + k0 + lane]; s[b] = cv / (1.f + __expf(-cv)); acc[b] = 0.f; }
#pragma unroll 4
        for (int kk = 0; kk < 64; ++kk) { const float w = W[(size_t)(k0 + kk) * 6144 + n];
#pragma unroll
            for (int b = 0; b < 16; ++b) acc[b] += __builtin_bit_cast(float, __builtin_amdgcn_readlane(__builtin_bit_cast(int, s[b]), kk)) * w; }
        const float bv = (kc == 0) ? bia[n] : 0.f;
#pragma unroll
        for (int b = 0; b < 16; ++b) atomicAdd(mod + b * 6144 + n, (unsigned long long)(long long)((acc[b] + bv) * 1099511627776.0f));
    }
}

struct ModPar { f32x4 a[4], s[4]; };
typedef long long modw_t;
__device__ __forceinline__ float modv(const modw_t* p) { return (float)(*p) * 9.094947017729282e-13f; }
__device__ __forceinline__ f32x4 modv4(const modw_t* p) { return (f32x4){modv(p), modv(p + 1), modv(p + 2), modv(p + 3)}; }
__device__ __forceinline__ void load_modpar(ModPar& mp, const float* g, const modw_t* mod_b, int jshift, int jscale, int lane) {
#pragma unroll
    for (int j = 0; j < 4; ++j) { const int col = 4 * lane + 256 * j;
        const f32x4 gv = *(const f32x4*)(g + col), sc = modv4(mod_b + jscale * 1024 + col), sh = modv4(mod_b + jshift * 1024 + col);
        mp.a[j] = gv * (sc + 1.0f); mp.s[j] = sh; }
}
constexpr int XP = 2048;
template <bool BF = false>
__device__ __forceinline__ void mod_row_f32(const void* xrow, const ModPar& mp, f32x4 (&h)[4], int lane) {
    float ss = 0.f;
#pragma unroll
    for (int j = 0; j < 4; ++j) {
        if (BF) { const uint2 r = ((const uint2*)xrow)[lane + 64 * j]; h[j] = (f32x4){bflo(r.x), bfhi(r.x), bflo(r.y), bfhi(r.y)}; }
        else h[j] = ((const f32x4*)xrow)[lane + 64 * j];
        ss += (h[j].x * h[j].x + h[j].y * h[j].y) + (h[j].z * h[j].z + h[j].w * h[j].w); }
    const float rs = 1.0f / sqrtf(wave_sum(ss) * (1.f / 1024.f) + EPS);
#pragma unroll
    for (int j = 0; j < 4; ++j) h[j] = h[j] * rs * mp.a[j] + mp.s[j];
}
__device__ __forceinline__ void store_row_bf16(bf16* orow, const f32x4 (&h)[4], int lane) {
    unsigned long long* o8 = (unsigned long long*)orow + lane;
#pragma unroll
    for (int j = 0; j < 4; ++j) o8[64 * j] = (unsigned long long)pk2(h[j].x, h[j].y) | ((unsigned long long)pk2(h[j].z, h[j].w) << 32);
}
__device__ __forceinline__ void store_row_fp8(unsigned char* orow, const f32x4 (&h)[4], int lane) {
    unsigned* o4 = (unsigned*)orow + lane;
#pragma unroll
    for (int j = 0; j < 4; ++j) o4[64 * j] = pk4_fp8(clamp448(h[j].x * F8_HS), clamp448(h[j].y * F8_HS), clamp448(h[j].z * F8_HS), clamp448(h[j].w * F8_HS));
}
__device__ __forceinline__ void store_row_i8(unsigned char* orow, float* rowscale, const f32x4 (&h)[4], int lane) {
    float mx = 0.f;
#pragma unroll
    for (int j = 0; j < 4; ++j) mx = fmaxf(fmaxf(mx, fmaxf(fabsf(h[j].x), fabsf(h[j].y))), fmaxf(fabsf(h[j].z), fabsf(h[j].w)));
#pragma unroll
    for (int o = 1; o < 64; o <<= 1) mx = fmaxf(mx, __shfl_xor(mx, o));
    mx = fmaxf(mx, 1e-20f); const float inv = 127.f / mx;
    unsigned* o4 = (unsigned*)orow + lane;
#pragma unroll
    for (int j = 0; j < 4; ++j) o4[64 * j] = pk4_i8(h[j].x * inv, h[j].y * inv, h[j].z * inv, h[j].w * inv);
    if (lane == 0) *rowscale = mx * (1.f / 127.f);
}
template <bool F8OUT = false, bool BFIN = false, bool I8OUT = false>
__device__ __forceinline__ void modulate_phase(const void* xin, const float* g, const modw_t* mod_layer, int jshift, int jscale, bf16* H, int gw, int NGW, int lane, float* rowsc = nullptr) {
    for (int bi = gw; bi < T / 32; bi += NGW) {
        const int b = bi >> 7; ModPar mp; load_modpar(mp, g, mod_layer + b * 6144, jshift, jscale, lane);
#pragma unroll 4
        for (int r = 0; r < 32; ++r) { const size_t row = (size_t)bi * 32 + r; f32x4 h[4]; if (BFIN) mod_row_f32<true>((const bf16*)xin + row * XP, mp, h, lane); else mod_row_f32<false>((const float*)xin + row * 1024, mp, h, lane); if (I8OUT) store_row_i8((unsigned char*)H + row * 1024, rowsc + row, h, lane); else if (F8OUT) store_row_fp8((unsigned char*)H + row * 1024, h, lane); else store_row_bf16(H + row * 1024, h, lane); }
    }
}

__device__ __forceinline__ void cs_rev(float pos, float revf, float& c, float& s) { const float fr = __builtin_amdgcn_fractf(pos * revf); c = __builtin_amdgcn_cosf(fr); s = __builtin_amdgcn_sinf(fr); }
__device__ __forceinline__ void unpack8(const v4u& r, float (&v)[8]) { v[0] = bflo(r.x); v[1] = bfhi(r.x); v[2] = bflo(r.y); v[3] = bfhi(r.y); v[4] = bflo(r.z); v[5] = bfhi(r.z); v[6] = bflo(r.w); v[7] = bfhi(r.w); }
__device__ __forceinline__ v4u pack8(const float (&v)[8]) { v4u o; o.x = pk2(v[0], v[1]); o.y = pk2(v[2], v[3]); o.z = pk2(v[4], v[5]); o.w = pk2(v[6], v[7]); return o; }

__device__ __forceinline__ void r2_phase(const Args& a, int gw, int NGW, int lane) {
    unsigned char* ws = a.ws;
    const bf16* P = (const bf16*)(ws + A_P); bf16* CQ = (bf16*)(ws + A_CQ); bf16* CKV = (bf16*)(ws + A_CKV); bf16* QB = (bf16*)(ws + A_QB); bf16* KB = (bf16*)(ws + A_KB);
    const int sub = lane & 7;
    float qn[4], kvn[2], gq[8], gk[8], revf[8];
#pragma unroll
    for (int i = 0; i < 4; ++i) qn[i] = a.in[I_Q_NORM][4 * lane + i];
    kvn[0] = a.in[I_KV_NORM][2 * lane]; kvn[1] = a.in[I_KV_NORM][2 * lane + 1];
#pragma unroll
    for (int j = 0; j < 8; ++j) { gq[j] = a.in[I_GQA_QG][8 * sub + j]; gk[j] = a.in[I_GQA_KG][8 * sub + j];
        const int i = 8 * (sub & 1) + j; revf[j] = exp2f(-(float)i * (LOG2_THETA / 16.f)) * INV_2PI; }
    for (int row = gw; row < T; row += NGW) {
        const bf16* pr = P + (size_t)row * 1280; const int t = row & 4095; const float pos = (float)((sub & 4) ? (t & 63) : (t >> 6));
        { const uint2 raw = *(const uint2*)(pr + 4 * lane); float v0 = bflo(raw.x), v1 = bfhi(raw.x), v2 = bflo(raw.y), v3 = bfhi(raw.y);
          const float rs = 1.0f / sqrtf(wave_sum((v0 * v0 + v1 * v1) + (v2 * v2 + v3 * v3)) * (1.f / 256.f) + EPS);
          uint2 o; o.x = pk2(v0 * rs * qn[0], v1 * rs * qn[1]); o.y = pk2(v2 * rs * qn[2], v3 * rs * qn[3]); *(uint2*)(CQ + (size_t)row * 256 + 4 * lane) = o; }
        { const unsigned raw = *(const unsigned*)(pr + 256 + 2 * lane); float v0 = bflo(raw), v1 = bfhi(raw);
          const float rs = 1.0f / sqrtf(wave_sum(v0 * v0 + v1 * v1) * (1.f / 128.f) + EPS);
          *(unsigned*)(CKV + (size_t)row * 128 + 2 * lane) = pk2(v0 * rs * kvn[0], v1 * rs * kvn[1]); }
#pragma unroll
        for (int which = 1; which < 2; ++which) {
            const int l2 = which ? (lane & 15) : lane;
            const v4u raw = *(const v4u*)(pr + (which ? 928 : 416) + 8 * l2); float v[8]; unpack8(raw, v);
            float ss = 0.f;
#pragma unroll
            for (int j = 0; j < 8; ++j) ss += v[j] * v[j];
            ss += __shfl_xor(ss, 1); ss += __shfl_xor(ss, 2); ss += __shfl_xor(ss, 4);
            const float rs = 1.0f / sqrtf(ss * (1.f / 64.f) + EPS); float o[8];
#pragma unroll
            for (int j = 0; j < 8; ++j) { const float x = v[j] * rs * (which ? gk[j] : gq[j]); const float w = __shfl_xor(x, 2); float c, s; cs_rev(pos, revf[j], c, s);
                o[j] = (sub & 2) ? (x * c + w * s) : (x * c - w * s); if (!which) o[j] *= QSCALE_B; }
            if (!which) *(v4u*)(QB + (size_t)row * 512 + 8 * lane) = pack8(o);
            else if (lane < 16) *(v4u*)(KB + (size_t)row * 128 + 8 * lane) = pack8(o);
        }
    }
}

__device__ __forceinline__ void r3_phase(const Args& a, int gw, int NGW, int lane) {
    unsigned char* ws = a.ws;
    const bf16* P = (const bf16*)(ws + A_P); bf16* QA = (bf16*)(ws + A_QA); const bf16* KV = (const bf16*)(ws + A_KV); bf16* KA = (bf16*)(ws + A_KA);
    const int head = lane >> 3, sub = lane & 7;
    float gqn[8], gqr[4], gkn[8], gkr[4], revf[4];
#pragma unroll
    for (int j = 0; j < 8; ++j) { gqn[j] = a.in[I_MLA_QG][8 * sub + j]; gkn[j] = a.in[I_MLA_KG][8 * sub + j]; }
#pragma unroll
    for (int j = 0; j < 4; ++j) { gqr[j] = a.in[I_MLA_QG][64 + 4 * sub + j]; gkr[j] = a.in[I_MLA_KG][64 + 4 * sub + j];
        const int i = 4 * (sub & 3) + j; revf[j] = exp2f(-(float)i * (LOG2_THETA / 16.f)) * INV_2PI; }
    for (int row = gw; row < T; row += NGW) {
        const float pos = (float)(row & 4095);
#pragma unroll
        for (int which = 1; which < 2; ++which) {
            const bf16* np = which ? (KV + (size_t)row * 512 + head * 64 + 8 * sub) : (QA + (size_t)row * 768 + head * 96 + 8 * sub);
            const bf16* rp = which ? (P + (size_t)row * 1280 + 384 + 4 * sub) : (QA + (size_t)row * 768 + head * 96 + 64 + 4 * sub);
            const v4u rn = *(const v4u*)np; const uint2 rr = *(const uint2*)rp;
            float v[8], r4[4]; unpack8(rn, v); r4[0] = bflo(rr.x); r4[1] = bfhi(rr.x); r4[2] = bflo(rr.y); r4[3] = bfhi(rr.y);
            float ss = 0.f;
#pragma unroll
            for (int j = 0; j < 8; ++j) ss += v[j] * v[j];
#pragma unroll
            for (int j = 0; j < 4; ++j) ss += r4[j] * r4[j];
            ss += __shfl_xor(ss, 1); ss += __shfl_xor(ss, 2); ss += __shfl_xor(ss, 4);
            const float rs = 1.0f / sqrtf(ss * (1.f / 96.f) + EPS); const float qs = which ? 1.0f : QSCALE_A;
            float o[8], orp[4];
#pragma unroll
            for (int j = 0; j < 8; ++j) o[j] = v[j] * rs * (which ? gkn[j] : gqn[j]) * qs;
#pragma unroll
            for (int j = 0; j < 4; ++j) { const float x = r4[j] * rs * (which ? gkr[j] : gqr[j]); const float w = __shfl_xor(x, 4); float c, s; cs_rev(pos, revf[j], c, s);
                orp[j] = ((sub & 4) ? (x * c + w * s) : (x * c - w * s)) * qs; }
            bf16* on = (which ? KA : QA) + (size_t)row * 768 + head * 96;
            *(v4u*)(on + 8 * sub) = pack8(o);
            uint2 o2; o2.x = pk2(orp[0], orp[1]); o2.y = pk2(orp[2], orp[3]); *(uint2*)(on + 64 + 4 * sub) = o2;
        }
    }
}

__device__ __forceinline__ void r6_phase(const Args& a, int gw, int NGW, int lane) {
    bf16* QKV = (bf16*)(a.ws + A_QKV);
    const int sub = lane & 3;
    float gq[16], gk[16], revf[16];
#pragma unroll
    for (int j = 0; j < 16; ++j) { gq[j] = a.in[I_DIL_QG][16 * sub + j]; gk[j] = a.in[I_DIL_KG][16 * sub + j];
        const int i = 16 * (sub & 1) + j; revf[j] = exp2f(-(float)i * (LOG2_THETA / 32.f)) * INV_2PI; }
    for (int row = gw; row < T; row += NGW) {
        const float pos = (float)(row & 4095);
#pragma unroll
        for (int which = 0; which < 2; ++which) {
            bf16* p = QKV + (size_t)row * 3072 + which * 1024 + 16 * lane;
            const v4u r0 = *(const v4u*)p, r1 = *(const v4u*)(p + 8); float v0[8], v1[8]; unpack8(r0, v0); unpack8(r1, v1);
            float ss = 0.f;
#pragma unroll
            for (int j = 0; j < 8; ++j) ss += v0[j] * v0[j] + v1[j] * v1[j];
            ss += __shfl_xor(ss, 1); ss += __shfl_xor(ss, 2);
            const float rs = 1.0f / sqrtf(ss * (1.f / 64.f) + EPS); float o0[8], o1[8];
#pragma unroll
            for (int j = 0; j < 16; ++j) { const float xin = (j < 8) ? v0[j & 7] : v1[j & 7]; const float x = xin * rs * (which ? gk[j] : gq[j]); const float w = __shfl_xor(x, 2); float c, s; cs_rev(pos, revf[j], c, s);
                float o = (sub & 2) ? (x * c + w * s) : (x * c - w * s); if (!which) o *= QSCALE_B; if (j < 8) o0[j & 7] = o; else o1[j & 7] = o; }
            *(v4u*)p = pack8(o0); *(v4u*)(p + 8) = pack8(o1);
        }
    }
}
namespace att {
using f32x16 = __attribute__((ext_vector_type(16))) float;
using s16x4 = __attribute__((ext_vector_type(4))) short;
#define SBAR() __builtin_amdgcn_sched_barrier(0)
__device__ __forceinline__ int crow(int r, int hi) { return (r & 3) + 8 * (r >> 2) + 4 * hi; }
template <int DQ> struct Lay {
    static constexpr int KROW = DQ * 2 + 16;
    static constexpr int KBUF = 64 * KROW;
    static constexpr int VBUF = 8192;
    static constexpr int K_OFF = 0, V_OFF = 2 * KBUF, WS_OFF = V_OFF + 2 * VBUF, BYTES = WS_OFF + 8 * 512;
};
__device__ __forceinline__ int v_st(int k, int c) { const int kk = k; return ((kk >> 3) * 2 + (c >> 5)) * 512 + ((kk & 7) * 32 + (c & 31)) * 2; }
__device__ __forceinline__ int v_rd_base(int lane) { return ((lane & 3) << 3) | (((lane >> 2) & 3) << 6) | (((lane >> 4) & 1) << 5) | (((lane >> 5) & 1) << 8); }
template <int OFF> __device__ __forceinline__ s16x4 tr_read(int vb) { s16x4 r; asm volatile("ds_read_b64_tr_b16 %0, %1 offset:%2" : "=&v"(r) : "v"(vb), "i"(OFF) : "memory"); return r; }
template <int D0> __device__ __forceinline__ void pv_one(f32x16& od, int vb, bf16x8 pa0, bf16x8 pa1, bf16x8 pa2, bf16x8 pa3) {
    const s16x4 l0 = tr_read<D0 * 512 + 0 * 2048>(vb), h0 = tr_read<D0 * 512 + 0 * 2048 + 1024>(vb), l1 = tr_read<D0 * 512 + 1 * 2048>(vb), h1 = tr_read<D0 * 512 + 1 * 2048 + 1024>(vb);
    const s16x4 l2 = tr_read<D0 * 512 + 2 * 2048>(vb), h2 = tr_read<D0 * 512 + 2 * 2048 + 1024>(vb), l3 = tr_read<D0 * 512 + 3 * 2048>(vb), h3 = tr_read<D0 * 512 + 3 * 2048 + 1024>(vb);
    asm volatile("s_waitcnt lgkmcnt(0)" ::: "memory"); SBAR();
#define PKV(L, H) (bf16x8){L[0], L[1], L[2], L[3], H[0], H[1], H[2], H[3]}
    od = __builtin_amdgcn_mfma_f32_32x32x16_bf16(pa0, PKV(l0, h0), od, 0, 0, 0);
    od = __builtin_amdgcn_mfma_f32_32x32x16_bf16(pa1, PKV(l1, h1), od, 0, 0, 0);
    od = __builtin_amdgcn_mfma_f32_32x32x16_bf16(pa2, PKV(l2, h2), od, 0, 0, 0);
    od = __builtin_amdgcn_mfma_f32_32x32x16_bf16(pa3, PKV(l3, h3), od, 0, 0, 0);
#undef PKV
}
__device__ __forceinline__ float rowmax32(const f32x16& p0, const f32x16& p1) {
    float a = fmaxf(fmaxf(p0[0], p0[1]), p1[0]), b = fmaxf(fmaxf(p0[2], p0[3]), p1[1]); a = fmaxf(fmaxf(a, p1[2]), p1[3]);
#pragma unroll
    for (int r = 4; r < 16; r += 4) { a = fmaxf(fmaxf(a, p0[r]), p0[r + 1]); b = fmaxf(fmaxf(b, p0[r + 2]), p0[r + 3]); a = fmaxf(fmaxf(a, p1[r]), p1[r + 1]); b = fmaxf(fmaxf(b, p1[r + 2]), p1[r + 3]); }
    float m = fmaxf(a, b);
    auto rr = __builtin_amdgcn_permlane32_swap(__float_as_uint(m), __float_as_uint(m), false, false);
    return fmaxf(__uint_as_float(rr[0]), __uint_as_float(rr[1]));
}
template <int D0, int KH> __device__ __forceinline__ void pv_half(f32x16& od, int vb, bf16x8 paA, bf16x8 paB) {
    const s16x4 l0 = tr_read<D0 * 512 + (2 * KH) * 2048>(vb), h0 = tr_read<D0 * 512 + (2 * KH) * 2048 + 1024>(vb), l1 = tr_read<D0 * 512 + (2 * KH + 1) * 2048>(vb), h1 = tr_read<D0 * 512 + (2 * KH + 1) * 2048 + 1024>(vb);
    asm volatile("s_waitcnt lgkmcnt(0)" ::: "memory"); SBAR();
#define PKV(L, H) (bf16x8){L[0], L[1], L[2], L[3], H[0], H[1], H[2], H[3]}
    od = __builtin_amdgcn_mfma_f32_32x32x16_bf16(paA, PKV(l0, h0), od, 0, 0, 0);
    od = __builtin_amdgcn_mfma_f32_32x32x16_bf16(paB, PKV(l1, h1), od, 0, 0, 0);
#undef PKV
}
struct VF { s16x4 l0, h0, l1, h1, l2, h2, l3, h3; };
template <int D0> __device__ __forceinline__ void v_issue(VF& f, int vb) {
    f.l0 = tr_read<D0 * 512 + 0 * 2048>(vb); f.h0 = tr_read<D0 * 512 + 0 * 2048 + 1024>(vb); f.l1 = tr_read<D0 * 512 + 1 * 2048>(vb); f.h1 = tr_read<D0 * 512 + 1 * 2048 + 1024>(vb);
    f.l2 = tr_read<D0 * 512 + 2 * 2048>(vb); f.h2 = tr_read<D0 * 512 + 2 * 2048 + 1024>(vb); f.l3 = tr_read<D0 * 512 + 3 * 2048>(vb); f.h3 = tr_read<D0 * 512 + 3 * 2048 + 1024>(vb); }
__device__ __forceinline__ void pv_mm(f32x16& od, const VF& f, bf16x8 pa0, bf16x8 pa1, bf16x8 pa2, bf16x8 pa3) {
#define PKV(L, H) (bf16x8){L[0], L[1], L[2], L[3], H[0], H[1], H[2], H[3]}
    od = __builtin_amdgcn_mfma_f32_32x32x16_bf16(pa0, PKV(f.l0, f.h0), od, 0, 0, 0); od = __builtin_amdgcn_mfma_f32_32x32x16_bf16(pa1, PKV(f.l1, f.h1), od, 0, 0, 0);
    od = __builtin_amdgcn_mfma_f32_32x32x16_bf16(pa2, PKV(f.l2, f.h2), od, 0, 0, 0); od = __builtin_amdgcn_mfma_f32_32x32x16_bf16(pa3, PKV(f.l3, f.h3), od, 0, 0, 0);
#undef PKV
}
__device__ __forceinline__ void pv_ones(f32x16& os, bf16x8 pa0, bf16x8 pa1, bf16x8 pa2, bf16x8 pa3) {
    const bf16x8 one = {0x3F80, 0x3F80, 0x3F80, 0x3F80, 0x3F80, 0x3F80, 0x3F80, 0x3F80};
    os = __builtin_amdgcn_mfma_f32_32x32x16_bf16(pa0, one, os, 0, 0, 0); os = __builtin_amdgcn_mfma_f32_32x32x16_bf16(pa1, one, os, 0, 0, 0);
    os = __builtin_amdgcn_mfma_f32_32x32x16_bf16(pa2, one, os, 0, 0, 0); os = __builtin_amdgcn_mfma_f32_32x32x16_bf16(pa3, one, os, 0, 0, 0); }
struct LayB { static constexpr int KROW = 144, KBUF = 64 * KROW, VBUF = 8192, NS = 6, K_OFF = 0, V_OFF = NS * KBUF, WS_OFF = V_OFF + NS * VBUF, OST_OFF = WS_OFF + 8 * 512, BYTES = OST_OFF + 8 * 4096; };
struct BU { unsigned rowq; int t0, nt, q0; };
__device__ __forceinline__ BU band_unit(int dil, int sub) { BU u; const int r = (dil == 1) ? 0 : (dil == 4 ? (sub >> 2) : sub), qb = (dil == 1) ? sub : (dil == 4 ? (sub & 3) : 0), ntt = 64 / dil;
    u.rowq = (unsigned)(r + 256 * qb * dil); const int t0 = (4 * qb - 1 < 0) ? 0 : 4 * qb - 1, t1 = (4 * qb + 5 > ntt) ? ntt : 4 * qb + 5; u.t0 = t0; u.nt = t1 - t0; u.q0 = 256 * qb; return u; }
template <bool MERGE, bool FAST>
__device__ __forceinline__ void band_phase(const bf16* Qh, const bf16* Kh, const bf16* Vh, int dil, bf16* Ob, int ldo, float* Lb, const bf16* O1b, const bf16* O2b, const float* L1b, const float* L2b, LAS char* lds) {
    using LY = LayB;
    int tid = threadIdx.x; asm volatile("" : "+v"(tid));
    const int lane = tid & 63, r32 = lane & 31, hi = lane >> 5; const int wid = __builtin_amdgcn_readfirstlane(tid >> 6);
    LAS float* wsf = (LAS float*)(lds + LY::WS_OFF) + wid * 128;
    LAS char* ost = lds + LY::OST_OFF + wid * 4096;
    const int krow = tid >> 3, kch = tid & 7;
    const int vkey = 2 * (tid >> 4) + ((tid >> 2) & 1), vcol = 32 * ((tid >> 3) & 1) + 8 * (tid & 3);
    const int kst = krow * LY::KROW + kch * 16, vst = v_st(vkey, vcol);
    const int vb0 = (int)(unsigned)(size_t)(lds + LY::V_OFF) + v_rd_base(lane);
    const LAS char* kbase = lds + LY::K_OFF + r32 * LY::KROW + hi * 16;
    bf16x8 sk[6], sv[6], qr[4];
    const int ldb = dil * 128;
    const unsigned ko_ = (unsigned)(krow * ldb + kch * 16), vo_ = (unsigned)(vkey * ldb + vcol * 2), qo_ = (unsigned)((wid * 32 + r32) * ldb + hi * 16);
    BU cur = band_unit(dil, 0);
#define B_LOADS(U) do { const size_t sb_ = (size_t)((U).rowq % (unsigned)dil) * 128; \
        _Pragma("unroll") for (int s_ = 0; s_ < 6; ++s_) if (s_ < (U).nt) { const size_t o_ = sb_ + (size_t)((U).t0 + s_) * 64 * (size_t)ldb; \
            sk[s_] = *reinterpret_cast<const bf16x8*>((const char*)Kh + o_ + ko_); sv[s_] = *reinterpret_cast<const bf16x8*>((const char*)Vh + o_ + vo_); } } while (0)
#define B_LOAD1(U, s_) do { if ((s_) < (U).nt) { const size_t o_ = (size_t)((U).rowq % (unsigned)dil) * 128 + (size_t)((U).t0 + (s_)) * 64 * (size_t)ldb; \
        sk[s_] = *reinterpret_cast<const bf16x8*>((const char*)Kh + o_ + ko_); sv[s_] = *reinterpret_cast<const bf16x8*>((const char*)Vh + o_ + vo_); } } while (0)
    B_LOADS(cur);
    for (int L = 0; L < 16; ++L) {
        { const char* qb_ = (const char*)Qh + (size_t)cur.rowq * 128;
#pragma unroll
          for (int d0 = 0; d0 < 4; ++d0) qr[d0] = *reinterpret_cast<const bf16x8*>(qb_ + d0 * 32 + qo_); }
        asm volatile("s_waitcnt lgkmcnt(0)\n\ts_barrier" ::: "memory");
#pragma unroll
        for (int s_ = 0; s_ < 6; ++s_) if (s_ < cur.nt) { *(LAS bf16x8*)(lds + LY::K_OFF + s_ * LY::KBUF + kst) = sk[s_]; *(LAS bf16x8*)(lds + LY::V_OFF + s_ * LY::VBUF + vst) = sv[s_]; }
        asm volatile("s_waitcnt lgkmcnt(0)\n\ts_barrier" ::: "memory");
        const bool has_next = (L + 1 < 16);
        BU nxt = cur; if (has_next) { nxt = band_unit(dil, L + 1); if (FAST) { B_LOAD1(nxt, 0); B_LOAD1(nxt, 1); } else B_LOADS(nxt); }
        const int lo = cur.q0 + 32 * wid; int ta = (lo - 64) >> 6, tb = (lo + 95) >> 6; if (ta < cur.t0) ta = cur.t0; if (tb > cur.t0 + cur.nt - 1) tb = cur.t0 + cur.nt - 1;
        const int qi = lo + r32;
        float m_reg = -1e30f, l_reg = 0.f; f32x16 o[2]; o[0] = f32x16{}; o[1] = f32x16{};
#define PK4(P, BASE, OUT) do { v4u w = {cvtpk(P[BASE + 0], P[BASE + 1]), cvtpk(P[BASE + 2], P[BASE + 3]), cvtpk(P[BASE + 4], P[BASE + 5]), cvtpk(P[BASE + 6], P[BASE + 7])}; OUT = *reinterpret_cast<bf16x8*>(&w); } while (0)
        if constexpr (FAST) {
            const int kbeg = lo - 64, lstream = 4096 / dil, thr_ = r32 - 4 * hi;
#define BH_ADDR(j, KB, VB, OKJ) const int kh##j = kbeg + 32 * (j); const bool OKJ = (kh##j >= 0) && (kh##j < lstream); \
            int tj##j = kh##j >> 6; tj##j = tj##j < cur.t0 ? cur.t0 : (tj##j > cur.t0 + cur.nt - 1 ? cur.t0 + cur.nt - 1 : tj##j); const int hf##j = (kh##j >> 5) & 1; \
            const LAS char* KB = kbase + (tj##j - cur.t0) * LY::KBUF + hf##j * 32 * LY::KROW; const int VB = vb0 + (tj##j - cur.t0) * LY::VBUF + hf##j * 4096;
#define BH_QK(P, KB) do { P = f32x16{}; _Pragma("unroll") for (int d0 = 0; d0 < 4; ++d0) { const bf16x8 b_ = *(const LAS bf16x8*)((KB) + d0 * 32); P = __builtin_amdgcn_mfma_f32_32x32x16_bf16(b_, qr[d0], P, 0, 0, 0); } } while (0)
#define BH_SM(P, OKJ, MODE, PA, PB) do { \
            if ((MODE) == 1) { _Pragma("unroll") for (int r = 0; r < 16; ++r) { const int c_ = (r & 3) + 8 * (r >> 2); if (c_ < thr_) P[r] = -INFINITY; } } \
            if ((MODE) == 2) { _Pragma("unroll") for (int r = 0; r < 16; ++r) { const int c_ = (r & 3) + 8 * (r >> 2); if (c_ > thr_) P[r] = -INFINITY; } } \
            float ps_ = 0.f; _Pragma("unroll") for (int r = 0; r < 16; ++r) { const float e_ = __builtin_amdgcn_exp2f(P[r]); P[r] = (OKJ) ? e_ : 0.f; ps_ += P[r]; } l_reg += ps_; \
            PK4(P, 0, PA); PK4(P, 8, PB); } while (0)
#define BH_PV(VB, PA, PB) do { pv_half<0, 0>(o[0], VB, PA, PB); pv_half<1, 0>(o[1], VB, PA, PB); } while (0)
            BH_ADDR(0, kb0_, vbh0_, ok0_) BH_ADDR(1, kb1_, vbh1_, ok1_) BH_ADDR(2, kb2_, vbh2_, ok2_) BH_ADDR(3, kb3_, vbh3_, ok3_) BH_ADDR(4, kb4_, vbh4_, ok4_)
            f32x16 pX, pY; bf16x8 paA, paB;
            BH_QK(pX, kb0_);
            BH_QK(pY, kb1_); BH_SM(pX, ok0_, 1, paA, paB); BH_PV(vbh0_, paA, paB); if (has_next) B_LOAD1(nxt, 2);
            BH_QK(pX, kb2_); BH_SM(pY, ok1_, 0, paA, paB); BH_PV(vbh1_, paA, paB); if (has_next) B_LOAD1(nxt, 3);
            BH_QK(pY, kb3_); BH_SM(pX, ok2_, 0, paA, paB); BH_PV(vbh2_, paA, paB); if (has_next) B_LOAD1(nxt, 4);
            BH_QK(pX, kb4_); BH_SM(pY, ok3_, 0, paA, paB); BH_PV(vbh3_, paA, paB); if (has_next) B_LOAD1(nxt, 5);
            BH_SM(pX, ok4_, 2, paA, paB); BH_PV(vbh4_, paA, paB);
#undef BH_ADDR
#undef BH_QK
#undef BH_SM
#undef BH_PV
            { auto rr = __builtin_amdgcn_permlane32_swap(__float_as_uint(l_reg), __float_as_uint(l_reg), false, false); l_reg = __uint_as_float(rr[0]) + __uint_as_float(rr[1]); }
            m_reg = 0.f;
        } else
        for (int t = ta; t <= tb; ++t) {
            const int slot = t - cur.t0;
            f32x16 p0 = f32x16{}, p1 = f32x16{};
            { const LAS char* kb = kbase + slot * LY::KBUF;
#pragma unroll
              for (int d0 = 0; d0 < 4; ++d0) { const bf16x8 b0 = *(const LAS bf16x8*)(kb + d0 * 32); const bf16x8 b1 = *(const LAS bf16x8*)(kb + 32 * LY::KROW + d0 * 32);
                  p0 = __builtin_amdgcn_mfma_f32_32x32x16_bf16(b0, qr[d0], p0, 0, 0, 0); p1 = __builtin_amdgcn_mfma_f32_32x32x16_bf16(b1, qr[d0], p1, 0, 0, 0); } }
            if (64 * t < lo - 33) { const int a_ = qi - 64 - 64 * t - 4 * hi;
#pragma unroll
                for (int r = 0; r < 16; ++r) { const int c_ = (r & 3) + 8 * (r >> 2); if (c_ < a_) p0[r] = -INFINITY; if (c_ + 32 < a_) p1[r] = -INFINITY; } }
            else if (64 * t + 63 > lo + 64) { const int b_ = qi + 64 - 64 * t - 4 * hi;
#pragma unroll
                for (int r = 0; r < 16; ++r) { const int c_ = (r & 3) + 8 * (r >> 2); if (c_ > b_) p0[r] = -INFINITY; if (c_ + 32 > b_) p1[r] = -INFINITY; } }
            const float pmax = rowmax32(p0, p1);
            if (t == ta) { m_reg = fmaxf(pmax, -1e30f); }
            else if (__any(pmax > m_reg)) {
                const float mn = fmaxf(m_reg, pmax); const float alpha = __builtin_amdgcn_exp2f(m_reg - mn); m_reg = mn; l_reg *= alpha;
                if (hi == 0) wsf[r32] = alpha; asm volatile("s_waitcnt lgkmcnt(0)" ::: "memory");
#pragma unroll
                for (int r = 0; r < 16; ++r) { const float al = wsf[crow(r, hi)]; o[0][r] *= al; o[1][r] *= al; }
            }
#pragma unroll
            for (int r = 0; r < 16; ++r) { p0[r] = __builtin_amdgcn_exp2f(p0[r] - m_reg); p1[r] = __builtin_amdgcn_exp2f(p1[r] - m_reg); }
            float ps = 0.f;
#pragma unroll
            for (int r = 0; r < 16; ++r) ps += p0[r] + p1[r];
            { auto rr = __builtin_amdgcn_permlane32_swap(__float_as_uint(ps), __float_as_uint(ps), false, false); ps = __uint_as_float(rr[0]) + __uint_as_float(rr[1]); }
            l_reg += ps;
            bf16x8 pa0, pa1, pa2, pa3;
            PK4(p0, 0, pa0); PK4(p0, 8, pa1); PK4(p1, 0, pa2); PK4(p1, 8, pa3);
            const int vb = vb0 + slot * LY::VBUF;
            pv_one<0>(o[0], vb, pa0, pa1, pa2, pa3); pv_one<1>(o[1], vb, pa0, pa1, pa2, pa3);
        }
#undef PK4
        const float lse = m_reg + __builtin_amdgcn_logf(l_reg);
        if (hi == 0) { wsf[r32] = __builtin_amdgcn_rcpf(l_reg); wsf[32 + r32] = lse; }
        v4u a1[4], a2[4]; float L1v[4], L2v[4];
        if constexpr (MERGE) {
#pragma unroll
            for (int i = 0; i < 4; ++i) { const size_t tr_ = (size_t)cur.rowq + (size_t)(wid * 32 + (lane >> 3) + 8 * i) * dil;
                a1[i] = *(const v4u*)(O1b + tr_ * 64 + (lane & 7) * 8); a2[i] = *(const v4u*)(O2b + tr_ * 64 + (lane & 7) * 8); L1v[i] = L1b[tr_]; L2v[i] = L2b[tr_]; }
        }
        asm volatile("s_waitcnt lgkmcnt(0)" ::: "memory");
        { const int odd = lane & 1; const unsigned sel = odd ? 0x03020706u : 0x05040100u;
          LAS char* wb = ost + (4 * hi + odd) * 128 + (r32 & ~1) * 2;
#pragma unroll
          for (int k = 0; k < 8; ++k) { const int r0 = ((2 * k) & 3) + 8 * ((2 * k) >> 2);
              const float rl0 = wsf[r0 + 4 * hi], rl1 = wsf[r0 + 1 + 4 * hi];
#pragma unroll
              for (int d0 = 0; d0 < 2; ++d0) { const unsigned pk = cvtpk(o[d0][2 * k] * rl0, o[d0][2 * k + 1] * rl1);
                  const unsigned rc = (unsigned)__builtin_amdgcn_update_dpp(0, (int)pk, 0xB1, 0xF, 0xF, false);
                  *(LAS unsigned*)(wb + r0 * 128 + d0 * 64) = __builtin_amdgcn_perm(rc, pk, sel); } } }
        asm volatile("s_waitcnt lgkmcnt(0)" ::: "memory");
        if (!MERGE) { if (hi == 0) Lb[(size_t)cur.rowq + (size_t)(wid * 32 + r32) * dil] = lse; }
        v4u vv[4]; float L3v[4];
#pragma unroll
        for (int i = 0; i < 4; ++i) { const int row = (lane >> 3) + 8 * i; vv[i] = *(const LAS v4u*)(ost + row * 128 + (lane & 7) * 16); if (MERGE) L3v[i] = wsf[32 + row]; }
#pragma unroll
        for (int i = 0; i < 4; ++i) { const int row = (lane >> 3) + 8 * i, ch = lane & 7; const size_t tr_ = (size_t)cur.rowq + (size_t)(wid * 32 + row) * dil;
            v4u v = vv[i];
            if constexpr (MERGE) {
                const float L3 = L3v[i], L1 = L1v[i], L2 = L2v[i];
                const float M = fmaxf(L3, fmaxf(L1, L2)); float w1 = __builtin_amdgcn_exp2f(L1 - M), w2 = __builtin_amdgcn_exp2f(L2 - M), w3 = __builtin_amdgcn_exp2f(L3 - M);
                const float inv = __builtin_amdgcn_rcpf(w1 + w2 + w3); w1 *= inv; w2 *= inv; w3 *= inv;
                float x3[8], x1[8], x2[8], y[8]; unpack8(v, x3); unpack8(a1[i], x1); unpack8(a2[i], x2);
#pragma unroll
                for (int e = 0; e < 8; ++e) y[e] = w1 * x1[e] + w2 * x2[e] + w3 * x3[e];
                v = pack8(y);
            }
            *(v4u*)(Ob + tr_ * (size_t)ldo + ch * 8) = v; }
        cur = nxt;
    }
    __syncthreads();
#undef B_LOADS
#undef B_LOAD1
}


template <int DQ> __device__ __forceinline__ void q_finish(bf16x8 (&qr)[DQ / 16], const float* __restrict__ gain, int t, int hi) {
    constexpr int ND = DQ / 16; float v[ND][8]; float ss = 0.f;
#pragma unroll
    for (int d0 = 0; d0 < ND; ++d0) { const v4u r = __builtin_bit_cast(v4u, qr[d0]); unpack8(r, v[d0]);
#pragma unroll
        for (int j = 0; j < 8; ++j) ss += v[d0][j] * v[d0][j]; }
    { auto rr = __builtin_amdgcn_permlane32_swap(__float_as_uint(ss), __float_as_uint(ss), false, false); ss = __uint_as_float(rr[0]) + __uint_as_float(rr[1]); }
    const float rs = (1.0f / sqrtf(ss * (1.0f / DQ) + EPS)) * (DQ == 96 ? QSCALE_A : QSCALE_B);
#pragma unroll
    for (int d0 = 0; d0 < ND; ++d0) { const f32x4 g0 = *(const f32x4*)(gain + 16 * d0 + 8 * hi), g1 = *(const f32x4*)(gain + 16 * d0 + 8 * hi + 4);
        v[d0][0] *= rs * g0[0]; v[d0][1] *= rs * g0[1]; v[d0][2] *= rs * g0[2]; v[d0][3] *= rs * g0[3]; v[d0][4] *= rs * g1[0]; v[d0][5] *= rs * g1[1]; v[d0][6] *= rs * g1[2]; v[d0][7] *= rs * g1[3]; }
#pragma unroll
    for (int j = 0; j < 8; ++j) { const float revf = exp2f(-(float)(8 * hi + j) * (LOG2_THETA / 16.f)) * INV_2PI; float c, s;
        if (DQ == 96) { cs_rev((float)t, revf, c, s); const float a = v[4][j], b = v[5][j]; v[4][j] = a * c - b * s; v[5][j] = a * s + b * c; }
        else { cs_rev((float)(t >> 6), revf, c, s); float a = v[0][j], b = v[1][j]; v[0][j] = a * c - b * s; v[1][j] = a * s + b * c;
               cs_rev((float)(t & 63), revf, c, s); a = v[2][j]; b = v[3][j]; v[2][j] = a * c - b * s; v[3][j] = a * s + b * c; } }
#pragma unroll
    for (int d0 = 0; d0 < ND; ++d0) { const v4u w = pack8(v[d0]); qr[d0] = __builtin_bit_cast(bf16x8, w); }
}
constexpr float THR_L2 = 8.0f;
template <int DQ, int NS_ = 4> struct LayD {
    static constexpr int KROW = DQ * 2 + 16, KBUF = 64 * KROW, VBUF = 8192, NS = NS_;
    static constexpr int K_OFF = 0, V_OFF = NS * KBUF, WS_OFF = V_OFF + NS * VBUF, OST_OFF = WS_OFF + 8 * 512, BYTES_D = OST_OFF + 8 * 4096;
    static_assert(BYTES_D <= 160 * 1024 - 1024, "attention LDS");
};
template <int DQ>
__device__ __forceinline__ void attn_dense(const bf16* __restrict__ Qp, long ldq, const float* __restrict__ qgain, int tq0, const bf16* __restrict__ Kp, long ldk, const bf16* __restrict__ Vp, long ldv, int NT, bf16* Op, long ldo, LAS char* lds) {
    using LY = LayD<DQ>;
    int tid = threadIdx.x; asm volatile("" : "+v"(tid));
    const int lane = tid & 63, r32 = lane & 31, hi = lane >> 5; const int wid = __builtin_amdgcn_readfirstlane(tid >> 6);
    LAS float* wsf = (LAS float*)(lds + LY::WS_OFF) + wid * 128;
    bf16x8 qr[DQ / 16];
    { const bf16* Qw = Qp + (long)(wid * 32 + r32) * ldq + hi * 8;
#pragma unroll
      for (int d0 = 0; d0 < DQ / 16; ++d0) qr[d0] = *reinterpret_cast<const bf16x8*>(Qw + d0 * 16); }
    q_finish<DQ>(qr, qgain, tq0 + wid * 32 + r32, hi);
    constexpr int CPR = DQ / 8;
    const int kc0 = tid, krow0 = kc0 / CPR, kch0 = kc0 % CPR;
    const int kc1 = tid + 512, krow1 = kc1 / CPR, kch1 = kc1 % CPR;
    const bool k2 = (DQ == 96) && (wid < 4);
    const int vkey = 2 * (tid >> 4) + ((tid >> 2) & 1), vcol = 32 * ((tid >> 3) & 1) + 8 * (tid & 3);
    const int kst0 = krow0 * LY::KROW + kch0 * 16, kst1 = krow1 * LY::KROW + kch1 * 16, vst = v_st(vkey, vcol);
    const bf16* kg0 = Kp + (long)krow0 * ldk + kch0 * 8; const bf16* kg1 = Kp + (long)krow1 * ldk + kch1 * 8; const bf16* vg = Vp + (long)vkey * ldv + vcol;
    bf16x8 skE0, skE1 = {}, svE, skO0, skO1 = {}, svO;
#define D_LOAD(SK0, SK1, SV, t) do { const long ko = (long)(t) * 64 * ldk; SK0 = *reinterpret_cast<const bf16x8*>(kg0 + ko); if (k2) SK1 = *reinterpret_cast<const bf16x8*>(kg1 + ko); SV = *reinterpret_cast<const bf16x8*>(vg + (long)(t) * 64 * ldv); } while (0)
#define D_WRITE(b, SK0, SK1, SV) do { *(LAS bf16x8*)(lds + LY::K_OFF + (b) * LY::KBUF + kst0) = SK0; if (k2) *(LAS bf16x8*)(lds + LY::K_OFF + (b) * LY::KBUF + kst1) = SK1; \
        *(LAS bf16x8*)(lds + LY::V_OFF + (b) * LY::VBUF + vst) = SV; } while (0)
    const int vb0 = (int)(unsigned)(size_t)(lds + LY::V_OFF) + v_rd_base(lane);
    const LAS char* kbase = lds + LY::K_OFF + r32 * LY::KROW + hi * 16;
    float m_ref = 0.f, l_reg = 0.f; f32x16 o[2]; o[0] = f32x16{}; o[1] = f32x16{};
    f32x16 negm = f32x16{}; asm volatile("" : "+v"(negm));
    f32x16 pA0, pA1, pB0, pB1; float alA = 1.f, alB = 1.f; bf16x8 pa0, pa1, pa2, pa3;
#define D_QKT(P0, P1, b) do { const LAS char* kb_ = kbase + (b) * LY::KBUF; P0 = negm; P1 = negm; \
        _Pragma("unroll") for (int d0 = 0; d0 < DQ / 16; ++d0) { const bf16x8 b0_ = *(const LAS bf16x8*)(kb_ + d0 * 32); const bf16x8 b1_ = *(const LAS bf16x8*)(kb_ + 32 * LY::KROW + d0 * 32); \
            P0 = __builtin_amdgcn_mfma_f32_32x32x16_bf16(b0_, qr[d0], P0, 0, 0, 0); P1 = __builtin_amdgcn_mfma_f32_32x32x16_bf16(b1_, qr[d0], P1, 0, 0, 0); } } while (0)
#define D_PART(P0, P1, AL, FIRST) do { const float rm_ = rowmax32(P0, P1); AL = 1.f; \
        if ((FIRST) || __any(rm_ > THR_L2)) { const float dl_ = (FIRST) ? rm_ : fmaxf(rm_, 0.f); m_ref += dl_; \
            _Pragma("unroll") for (int r = 0; r < 16; ++r) { P0[r] -= dl_; P1[r] -= dl_; } \
            _Pragma("unroll") for (int r = 0; r < 16; ++r) negm[r] = -m_ref; asm volatile("" : "+v"(negm)); \
            AL = __builtin_amdgcn_exp2f(-dl_); } \
        _Pragma("unroll") for (int r = 0; r < 16; ++r) P0[r] = __builtin_amdgcn_exp2f(P0[r]); } while (0)
#define D_PK4(P, BASE, OUT) do { v4u w = {cvtpk(P[BASE + 0], P[BASE + 1]), cvtpk(P[BASE + 2], P[BASE + 3]), cvtpk(P[BASE + 4], P[BASE + 5]), cvtpk(P[BASE + 6], P[BASE + 7])}; OUT = *reinterpret_cast<bf16x8*>(&w); } while (0)
#define D_FIN(P0, P1, AL) do { _Pragma("unroll") for (int r = 0; r < 16; ++r) P1[r] = __builtin_amdgcn_exp2f(P1[r]); \
        float ps_ = 0.f; _Pragma("unroll") for (int r = 0; r < 16; ++r) ps_ += P0[r]; _Pragma("unroll") for (int r = 0; r < 16; ++r) ps_ += P1[r]; \
        { auto rr = __builtin_amdgcn_permlane32_swap(__float_as_uint(ps_), __float_as_uint(ps_), false, false); ps_ = __uint_as_float(rr[0]) + __uint_as_float(rr[1]); } \
        l_reg = l_reg * (AL) + ps_; D_PK4(P0, 0, pa0); D_PK4(P0, 8, pa1); D_PK4(P1, 0, pa2); D_PK4(P1, 8, pa3); } while (0)
#define D_RESC(AL) do { if (__any((AL) < 1.f)) { if (hi == 0) wsf[r32] = (AL); asm volatile("s_waitcnt lgkmcnt(0)" ::: "memory"); \
        _Pragma("unroll") for (int r = 0; r < 16; ++r) { const float a_ = wsf[crow(r, hi)]; o[0][r] *= a_; o[1][r] *= a_; } } } while (0)
#define D_PV(b) do { const int vb_ = vb0 + (b) * LY::VBUF; pv_one<0>(o[0], vb_, pa0, pa1, pa2, pa3); pv_one<1>(o[1], vb_, pa0, pa1, pa2, pa3); } while (0)
    D_LOAD(skE0, skE1, svE, 0); D_LOAD(skO0, skO1, svO, 1);
    D_WRITE(0, skE0, skE1, svE); D_WRITE(1, skO0, skO1, svO);
    D_LOAD(skE0, skE1, svE, 2); D_LOAD(skO0, skO1, svO, 3);
    __syncthreads();
    D_QKT(pA0, pA1, 0); D_PART(pA0, pA1, alA, true); alA = 1.f;
    for (int j = 1; j + 1 < NT; j += 2) {
        SBAR(); D_QKT(pB0, pB1, j & 3);
        D_FIN(pA0, pA1, alA); SBAR();
        D_PV((j - 1) & 3); D_PART(pB0, pB1, alB, false);
        D_WRITE((j + 1) & 3, skE0, skE1, svE);
        if (j + 3 < NT) D_LOAD(skE0, skE1, svE, j + 3);
        D_RESC(alB); __syncthreads();
        SBAR(); D_QKT(pA0, pA1, (j + 1) & 3);
        D_FIN(pB0, pB1, alB); SBAR();
        D_PV(j & 3); D_PART(pA0, pA1, alA, false);
        D_WRITE((j + 2) & 3, skO0, skO1, svO);
        if (j + 4 < NT) D_LOAD(skO0, skO1, svO, j + 4);
        D_RESC(alA); __syncthreads();
    }
    SBAR(); D_QKT(pB0, pB1, (NT - 1) & 3);
    D_FIN(pA0, pA1, alA); SBAR();
    D_PV((NT - 2) & 3); D_PART(pB0, pB1, alB, false);
    D_RESC(alB);
    D_FIN(pB0, pB1, alB); SBAR();
    D_PV((NT - 1) & 3);
    if (hi == 0) wsf[r32] = __builtin_amdgcn_rcpf(l_reg);
    asm volatile("s_waitcnt lgkmcnt(0)" ::: "memory");
    LAS char* ost = lds + LY::OST_OFF + wid * 4096;
#pragma unroll
    for (int r = 0; r < 16; ++r) { const int orow = crow(r, hi); const float rl = wsf[orow];
        *(LAS unsigned short*)(ost + orow * 128 + r32 * 2) = (unsigned short)f2bf(o[0][r] * rl); *(LAS unsigned short*)(ost + orow * 128 + 64 + r32 * 2) = (unsigned short)f2bf(o[1][r] * rl); }
    asm volatile("s_waitcnt lgkmcnt(0)" ::: "memory");
    bf16* Ow = Op + (long)(wid * 32) * ldo;
#pragma unroll
    for (int i = 0; i < 4; ++i) { const int row = (lane >> 3) + 8 * i, ch = lane & 7; const v4u v = *(const LAS v4u*)(ost + row * 128 + ch * 16); *(v4u*)(Ow + (long)row * ldo + ch * 8) = v; }
    __syncthreads();
#undef D_LOAD
#undef D_WRITE
#undef D_QKT
#undef D_PART
#undef D_PK4
#undef D_FIN
#undef D_RESC
#undef D_PV
}

template <int DQ>
__device__ __forceinline__ void attn_dense_fast(const bf16* __restrict__ Qp, long ldq, const float* __restrict__ qgain, int tq0, const bf16* __restrict__ Kp, long ldk, const bf16* __restrict__ Vp, long ldv, int NT, bf16* Op, long ldo, LAS char* lds) {
    using LY = LayD<DQ, 5>;
    int tid = threadIdx.x; asm volatile("" : "+v"(tid));
    const int lane = tid & 63, r32 = lane & 31, hi = lane >> 5; const int wid = __builtin_amdgcn_readfirstlane(tid >> 6);
    LAS float* wsf = (LAS float*)(lds + LY::WS_OFF) + wid * 128;
    bf16x8 qr[DQ / 16];
    { const bf16* Qw = Qp + (long)(wid * 32 + r32) * ldq + hi * 8;
#pragma unroll
      for (int d0 = 0; d0 < DQ / 16; ++d0) qr[d0] = *reinterpret_cast<const bf16x8*>(Qw + d0 * 16); }
    q_finish<DQ>(qr, qgain, tq0 + wid * 32 + r32, hi);
    constexpr int KCH = LY::KROW / 16, KPC = LY::KBUF / 1024; static_assert(LY::KBUF % 1024 == 0 && KPC <= 16 && KPC > 8, "K tile pieces");
    unsigned kofs[2]; int kpc[2];
#pragma unroll
    for (int i = 0; i < 2; ++i) { int pc = wid + 8 * i; if (pc > KPC - 1) pc = KPC - 1; const int c = pc * 64 + lane, row = c / KCH; int cc = c - row * KCH; if (cc > DQ / 8 - 1) cc = DQ / 8 - 1;
        kpc[i] = pc; kofs[i] = (unsigned)(row * (int)ldk + cc * 8) * 2u; }
    unsigned vofs; { const int pb = (wid * 64 + lane) * 16, sub = pb >> 9, within = (pb & 511) >> 1, key = (sub >> 1) * 8 + (within >> 5), col = (sub & 1) * 32 + (within & 31); vofs = (unsigned)(key * (int)ldv + col) * 2u; }
#define D_DMA(t, b) do { const char* kb_ = (const char*)Kp + (size_t)(t) * 128 * (size_t)ldk; const char* vp_ = (const char*)Vp + (size_t)(t) * 128 * (size_t)ldv; \
        __builtin_amdgcn_global_load_lds((const unsigned*)(kb_ + kofs[0]), (LAS unsigned*)(lds + LY::K_OFF + (b) * LY::KBUF + kpc[0] * 1024), 16, 0, 0); \
        __builtin_amdgcn_global_load_lds((const unsigned*)(kb_ + kofs[1]), (LAS unsigned*)(lds + LY::K_OFF + (b) * LY::KBUF + kpc[1] * 1024), 16, 0, 0); \
        __builtin_amdgcn_global_load_lds((const unsigned*)(vp_ + vofs), (LAS unsigned*)(lds + LY::V_OFF + (b) * LY::VBUF + wid * 1024), 16, 0, 0); } while (0)
#define D_BAR(N) asm volatile("s_waitcnt vmcnt(" #N ")\n\ts_barrier" ::: "memory")
    const int vb0 = (int)(unsigned)(size_t)(lds + LY::V_OFF) + v_rd_base(lane);
    const LAS char* kbase = lds + LY::K_OFF + r32 * LY::KROW + hi * 16;
    f32x16 o[2]; o[0] = f32x16{}; o[1] = f32x16{}; float l0 = 0.f, l1 = 0.f, l2 = 0.f, l3 = 0.f;
    f32x16 pA0, pA1, pB0, pB1; bf16x8 pa0, pa1, pa2, pa3;
#define D_QKT(P0, P1, b) do { const LAS char* kb_ = kbase + (b) * LY::KBUF; P0 = f32x16{}; P1 = f32x16{}; \
        _Pragma("unroll") for (int d0 = 0; d0 < DQ / 16; ++d0) { const bf16x8 b0_ = *(const LAS bf16x8*)(kb_ + d0 * 32); const bf16x8 b1_ = *(const LAS bf16x8*)(kb_ + 32 * LY::KROW + d0 * 32); \
            P0 = __builtin_amdgcn_mfma_f32_32x32x16_bf16(b0_, qr[d0], P0, 0, 0, 0); P1 = __builtin_amdgcn_mfma_f32_32x32x16_bf16(b1_, qr[d0], P1, 0, 0, 0); } } while (0)
#define D_PK4(P, BASE, OUT) do { v4u w = {cvtpk(P[BASE + 0], P[BASE + 1]), cvtpk(P[BASE + 2], P[BASE + 3]), cvtpk(P[BASE + 4], P[BASE + 5]), cvtpk(P[BASE + 6], P[BASE + 7])}; OUT = *reinterpret_cast<bf16x8*>(&w); } while (0)
#define D_FIN(P0, P1) do { _Pragma("unroll") for (int r = 0; r < 16; ++r) { P0[r] = __builtin_amdgcn_exp2f(P0[r]); P1[r] = __builtin_amdgcn_exp2f(P1[r]); } \
        D_PK4(P0, 0, pa0); D_PK4(P0, 8, pa1); D_PK4(P1, 0, pa2); D_PK4(P1, 8, pa3); } while (0)
#define PKVF(L, H) (bf16x8){L[0], L[1], L[2], L[3], H[0], H[1], H[2], H[3]}
#define D_ADDA(ACC, X) asm("v_add_f32 %0, %0, %1" : "+v"(ACC) : "v"(X))
#define D_MMA4(OD, PA, L, H, PC, R0) do { OD = __builtin_amdgcn_mfma_f32_32x32x16_bf16(PA, PKVF(L, H), OD, 0, 0, 0); \
        D_ADDA(l0, PC[R0]); D_ADDA(l1, PC[R0 + 1]); D_ADDA(l2, PC[R0 + 2]); D_ADDA(l3, PC[R0 + 3]); SBAR(); } while (0)
#define D_STEP(HAVEN, PN0, PN1, SN, PC0, PC1, SC) do { VF fa_, fb_; const int vb_ = vb0 + (SC) * LY::VBUF; \
        v_issue<0>(fa_, vb_); SBAR(); \
        if (HAVEN) D_QKT(PN0, PN1, SN); \
        D_FIN(PC0, PC1); \
        asm volatile("s_waitcnt lgkmcnt(0)" ::: "memory"); SBAR(); \
        v_issue<1>(fb_, vb_); \
        D_MMA4(o[0], pa0, fa_.l0, fa_.h0, PC0, 0); D_MMA4(o[0], pa1, fa_.l1, fa_.h1, PC0, 4); D_MMA4(o[0], pa2, fa_.l2, fa_.h2, PC0, 8); D_MMA4(o[0], pa3, fa_.l3, fa_.h3, PC0, 12); \
        asm volatile("s_waitcnt lgkmcnt(0)" ::: "memory"); SBAR(); \
        D_MMA4(o[1], pa0, fb_.l0, fb_.h0, PC1, 0); D_MMA4(o[1], pa1, fb_.l1, fb_.h1, PC1, 4); D_MMA4(o[1], pa2, fb_.l2, fb_.h2, PC1, 8); D_MMA4(o[1], pa3, fb_.l3, fb_.h3, PC1, 12); } while (0)
#define NEXT5(x) ((x) == 4 ? 0 : (x) + 1)
    D_DMA(0, 0); D_DMA(1, 1); D_DMA(2, 2); D_DMA(3, 3);
    D_BAR(6);
    D_QKT(pA0, pA1, 0);
    int sl_pv = 0, sl_qk = 1, sl_d = 4;
    for (int j = 1; j + 1 < NT; j += 2) {
        { const int tt = (j + 3 < NT) ? j + 3 : NT - 1; D_DMA(tt, sl_d); }
        D_STEP(true, pB0, pB1, sl_qk, pA0, pA1, sl_pv);
        D_BAR(6);
        sl_pv = sl_qk; sl_qk = NEXT5(sl_qk); sl_d = NEXT5(sl_d);
        { const int tt = (j + 4 < NT) ? j + 4 : NT - 1; D_DMA(tt, sl_d); }
        D_STEP(true, pA0, pA1, sl_qk, pB0, pB1, sl_pv);
        D_BAR(6);
        sl_pv = sl_qk; sl_qk = NEXT5(sl_qk); sl_d = NEXT5(sl_d);
    }
    D_STEP(true, pB0, pB1, sl_qk, pA0, pA1, sl_pv);
    D_STEP(false, pA0, pA1, 0, pB0, pB1, sl_qk);
#undef NEXT5
    LAS char* ost = lds + LY::OST_OFF + wid * 4096;
    float l_reg = (l0 + l1) + (l2 + l3);
    { auto rr = __builtin_amdgcn_permlane32_swap(__float_as_uint(l_reg), __float_as_uint(l_reg), false, false); l_reg = __uint_as_float(rr[0]) + __uint_as_float(rr[1]); }
    if (hi == 0) wsf[r32] = __builtin_amdgcn_rcpf(l_reg);
    asm volatile("s_waitcnt lgkmcnt(0)" ::: "memory");
#pragma unroll
    for (int r = 0; r < 16; ++r) { const int orow = crow(r, hi); const float rl = wsf[orow];
        *(LAS unsigned short*)(ost + orow * 128 + r32 * 2) = (unsigned short)f2bf(o[0][r] * rl); *(LAS unsigned short*)(ost + orow * 128 + 64 + r32 * 2) = (unsigned short)f2bf(o[1][r] * rl); }
    asm volatile("s_waitcnt lgkmcnt(0)" ::: "memory");
    bf16* Ow = Op + (long)(wid * 32) * ldo;
#pragma unroll
    for (int i = 0; i < 4; ++i) { const int row = (lane >> 3) + 8 * i, ch = lane & 7; const v4u v = *(const LAS v4u*)(ost + row * 128 + ch * 16); *(v4u*)(Ow + (long)row * ldo + ch * 8) = v; }
    asm volatile("s_waitcnt vmcnt(0)" ::: "memory");
    __syncthreads();
#undef D_DMA
#undef D_BAR
#undef D_QKT
#undef D_PK4
#undef D_FIN
#undef D_STEP
#undef D_MMA4
#undef D_ADDA
#undef PKVF
}
__device__ __forceinline__ float wave_absmax(const float* g, int n) { int tid = threadIdx.x; const int lane = tid & 63; float m = 0.f; for (int i = lane; i < n; i += 64) m = fmaxf(m, fabsf(g[i]));
#pragma unroll
    for (int o = 1; o < 64; o <<= 1) m = fmaxf(m, __shfl_xor(m, o));
    return __builtin_bit_cast(float, __builtin_amdgcn_readfirstlane(__builtin_bit_cast(int, m))); }
}
namespace pg8 {
struct EpiResGate {
    static constexpr bool PERM = false, AFTER_DRAIN = false;
    const float* base; float* out; const long long* gate; float sc;
    __device__ __forceinline__ void operator()(const f32x4 (&acc)[2][2][4][2], const Unit& u, int wr, int wc, int fr, int fq) const {
        const int b = u.pm >> 4; const int col0 = u.pn * BM + wc * 32 + 4 * fq; const long long* gp = gate + b * 6144 + col0;
        f32x4 gv[2][2];
#pragma unroll
        for (int bj = 0; bj < 2; ++bj)
#pragma unroll
            for (int n = 0; n < 2; ++n) { const long long* q = gp + bj * HALF + n * 16; gv[bj][n] = (f32x4){(float)q[0], (float)q[1], (float)q[2], (float)q[3]} * (9.094947017729282e-13f * sc); }
#pragma unroll
        for (int ai = 0; ai < 2; ++ai)
#pragma unroll
            for (int m = 0; m < 4; ++m) { const size_t off = (size_t)(u.pm * BM + ai * HALF + wr * 64 + m * 16 + fr) * 1024 + col0;
#pragma unroll
                for (int bj = 0; bj < 2; ++bj)
#pragma unroll
                    for (int n = 0; n < 2; ++n) { const f32x4 bs = *(const f32x4*)(base + off + bj * HALF + n * 16); *(f32x4*)(out + off + bj * HALF + n * 16) = bs + gv[bj][n] * acc[ai][bj][m][n]; }
                if (m & 1) asm volatile("" ::: "memory"); }
    }
};

template <bool BASEF32> struct EpiResB {
    static constexpr bool PERM = true, AFTER_DRAIN = false;
    const void* base; bf16_t* out; const long long* gate; float sc;
    __device__ __forceinline__ void operator()(const f32x4 (&acc)[2][2][4][2], const Unit& u, int wr, int wc, int fr, int fq) const {
        const int b = u.pm >> 4; const int col0 = u.pn * BM + wc * 32 + 8 * fq; const long long* gp = gate + b * 6144 + col0;
        float gv[2][8];
#pragma unroll
        for (int bj = 0; bj < 2; ++bj)
#pragma unroll
            for (int e = 0; e < 8; ++e) gv[bj][e] = (float)gp[bj * HALF + e] * (9.094947017729282e-13f * sc);
#pragma unroll
        for (int ai = 0; ai < 2; ++ai)
#pragma unroll
            for (int m = 0; m < 4; ++m) { const size_t row = (size_t)(u.pm * BM + ai * HALF + wr * 64 + m * 16 + fr);
#pragma unroll
                for (int bj = 0; bj < 2; ++bj) { float bs[8];
                    if (BASEF32) { const f32x4 b0 = *(const f32x4*)((const float*)base + row * 1024 + col0 + bj * HALF), b1 = *(const f32x4*)((const float*)base + row * 1024 + col0 + bj * HALF + 4);
                        bs[0] = b0[0]; bs[1] = b0[1]; bs[2] = b0[2]; bs[3] = b0[3]; bs[4] = b1[0]; bs[5] = b1[1]; bs[6] = b1[2]; bs[7] = b1[3]; }
                    else { const u32x4 r = *(const u32x4*)((const bf16_t*)base + row * 2048 + col0 + bj * HALF);
                        bs[0] = __builtin_bit_cast(float, r.x << 16); bs[1] = __builtin_bit_cast(float, r.x & 0xffff0000u); bs[2] = __builtin_bit_cast(float, r.y << 16); bs[3] = __builtin_bit_cast(float, r.y & 0xffff0000u);
                        bs[4] = __builtin_bit_cast(float, r.z << 16); bs[5] = __builtin_bit_cast(float, r.z & 0xffff0000u); bs[6] = __builtin_bit_cast(float, r.w << 16); bs[7] = __builtin_bit_cast(float, r.w & 0xffff0000u); }
                    const f32x4 a0 = acc[ai][bj][m][0], a1 = acc[ai][bj][m][1];
                    u32x4 w; w.x = cvt_pk_bf16(bs[0] + gv[bj][0] * a0[0], bs[1] + gv[bj][1] * a0[1]); w.y = cvt_pk_bf16(bs[2] + gv[bj][2] * a0[2], bs[3] + gv[bj][3] * a0[3]);
                    w.z = cvt_pk_bf16(bs[4] + gv[bj][4] * a1[0], bs[5] + gv[bj][5] * a1[1]); w.w = cvt_pk_bf16(bs[6] + gv[bj][6] * a1[2], bs[7] + gv[bj][7] * a1[3]);
                    *(u32x4*)(out + row * 2048 + col0 + bj * HALF) = w; }
                if (m & 1) asm volatile("" ::: "memory"); }
    }
};
__device__ __forceinline__ f32x2 silu2(f32x2 ag, f32x2 au, float c1, float k) {
    const f32x2 t = ag * c1; f32x2 e; e.x = __builtin_amdgcn_exp2f(t.x); e.y = __builtin_amdgcn_exp2f(t.y);
    const f32x2 d = e * k + k; f32x2 r; r.x = __builtin_amdgcn_rcpf(d.x); r.y = __builtin_amdgcn_rcpf(d.y);
    return (ag * au) * r;
}
__device__ __forceinline__ float silu_mul(float g, float u) { return g * __builtin_amdgcn_rcpf(1.0f + __builtin_amdgcn_exp2f(-1.4426950408889634f * g)) * u; }
struct EpiSwiGLU {
    static constexpr bool PERM = true, AFTER_DRAIN = false;
    bf16_t* O; int ldo; int nNe; int pm0;
    __device__ __forceinline__ void operator()(const f32x4 (&acc)[2][2][4][2], const Unit& u, int wr, int wc, int fr, int fq) const {
        const int pnl = u.pn % nNe; const int col0 = pnl * HALF + wc * 32 + 8 * fq; const int row0 = (u.pm - pm0) * BM + wr * 64 + fr;
#pragma unroll
        for (int ai = 0; ai < 2; ++ai)
#pragma unroll
            for (int m = 0; m < 4; ++m) { bf16_t* rowp = O + (size_t)(row0 + ai * HALF + m * 16) * ldo + col0;
                const f32x4 g0 = acc[ai][0][m][0], g1 = acc[ai][0][m][1], u0 = acc[ai][1][m][0], u1 = acc[ai][1][m][1];
                const f32x2 y0 = silu2((f32x2){g0[0], g0[1]}, (f32x2){u0[0], u0[1]}, -1.4426950408889634f, 1.0f), y1 = silu2((f32x2){g0[2], g0[3]}, (f32x2){u0[2], u0[3]}, -1.4426950408889634f, 1.0f);
                const f32x2 y2 = silu2((f32x2){g1[0], g1[1]}, (f32x2){u1[0], u1[1]}, -1.4426950408889634f, 1.0f), y3 = silu2((f32x2){g1[2], g1[3]}, (f32x2){u1[2], u1[3]}, -1.4426950408889634f, 1.0f);
                u32x4 w; w.x = cvt_pk_bf16(y0.x, y0.y); w.y = cvt_pk_bf16(y1.x, y1.y); w.z = cvt_pk_bf16(y2.x, y2.y); w.w = cvt_pk_bf16(y3.x, y3.y);
                *(u32x4*)rowp = w; }
    }
};

struct EpiSwiGLU8 {
    static constexpr bool PERM = true, AFTER_DRAIN = false;
    unsigned char* O; int ldo; int nNe; int pm0; float SI;
    __device__ __forceinline__ void operator()(const f32x4 (&acc)[2][2][4][2], const Unit& u, int wr, int wc, int fr, int fq) const {
        const int pnl = u.pn % nNe; const int col0 = pnl * HALF + wc * 32 + 8 * fq; const int row0 = (u.pm - pm0) * BM + wr * 64 + fr;
#pragma unroll
        for (int ai = 0; ai < 2; ++ai)
#pragma unroll
            for (int m = 0; m < 4; ++m) { unsigned char* rowp = O + (size_t)(row0 + ai * HALF + m * 16) * ldo + col0;
                const float C1 = -1.4426950408889634f * SI, KK = 1.0f / (SI * SI * F8_AS);
                const f32x4 g0 = acc[ai][0][m][0], g1 = acc[ai][0][m][1], u0 = acc[ai][1][m][0], u1 = acc[ai][1][m][1];
                const f32x2 y0 = silu2((f32x2){g0[0], g0[1]}, (f32x2){u0[0], u0[1]}, C1, KK), y1 = silu2((f32x2){g0[2], g0[3]}, (f32x2){u0[2], u0[3]}, C1, KK);
                const f32x2 y2 = silu2((f32x2){g1[0], g1[1]}, (f32x2){u1[0], u1[1]}, C1, KK), y3 = silu2((f32x2){g1[2], g1[3]}, (f32x2){u1[2], u1[3]}, C1, KK);
#define M448(v) __builtin_amdgcn_fmed3f((v), -448.f, 448.f)
                u32x2_t w; w.x = pk4_fp8(M448(y0.x), M448(y0.y), M448(y1.x), M448(y1.y)); w.y = pk4_fp8(M448(y2.x), M448(y2.y), M448(y3.x), M448(y3.y));
#undef M448
                *(u32x2_t*)rowp = w; }
    }
};
struct EpiMoeDown {
    static constexpr bool PERM = true, AFTER_DRAIN = false;
    bf16_t* Y; const float* gs; int pm0; float sc;
    __device__ __forceinline__ void operator()(const f32x4 (&acc)[2][2][4][2], const Unit& u, int wr, int wc, int fr, int fq) const {
        const int pnl = u.pn & 3; const int col0 = pnl * BM + wc * 32 + 8 * fq; const int row0 = (u.pm + pm0) * BM + wr * 64 + fr;
#pragma unroll
        for (int ai = 0; ai < 2; ++ai)
#pragma unroll
            for (int m = 0; m < 4; ++m) { const int row = row0 + ai * HALF + m * 16; const float g = gs[row] * sc; bf16_t* rowp = Y + (size_t)row * 1024 + col0;
#pragma unroll
                for (int bj = 0; bj < 2; ++bj) { const f32x4 v0 = acc[ai][bj][m][0] * g, v1 = acc[ai][bj][m][1] * g;
                    u32x4 w; w.x = cvt_pk_bf16(v0[0], v0[1]); w.y = cvt_pk_bf16(v0[2], v0[3]); w.z = cvt_pk_bf16(v1[0], v1[1]); w.w = cvt_pk_bf16(v1[2], v1[3]);
                    *(u32x4*)(rowp + bj * HALF) = w; } }
    }
};

struct EpiQKRope {
    static constexpr bool PERM = true, AFTER_DRAIN = false;
    bf16_t* O; const float* gq; const float* gk;
    static constexpr size_t HM = (size_t)65536 * 1024;
    __device__ __forceinline__ void operator()(const f32x4 (&acc)[2][2][4][2], const Unit& u, int wr, int wc, int fr, int fq) const {
        const int row0 = u.pm * BM + wr * 64 + fr;
        if (u.pn >= 8) {
#pragma unroll
            for (int ai = 0; ai < 2; ++ai)
#pragma unroll
                for (int m = 0; m < 4; ++m) { const int row = row0 + ai * HALF + m * 16; const size_t bt = (size_t)(row >> 12) * 16 * 4096 + (row & 4095);
#pragma unroll
                    for (int bj = 0; bj < 2; ++bj) { const f32x4 v0 = acc[ai][bj][m][0], v1 = acc[ai][bj][m][1]; const int head = (u.pn - 8) * 4 + 2 * bj + (wc >> 1);
                        u32x4 w; w.x = cvt_pk_bf16(v0[0], v0[1]); w.y = cvt_pk_bf16(v0[2], v0[3]); w.z = cvt_pk_bf16(v1[0], v1[1]); w.w = cvt_pk_bf16(v1[2], v1[3]);
                        *(u32x4*)(O + (size_t)2 * HM + (bt + (size_t)head * 4096) * 64 + 32 * (wc & 1) + 8 * fq) = w; } }
            return;
        }
        const bool isk = u.pn >= 4; const float* gp = isk ? gk : gq; const float qs = isk ? 1.0f : (0.125f * 1.4426950408889634f);
        const int head = 4 * (u.pn & 3) + wc; bf16_t* Ob = O + (isk ? HM : (size_t)0) + (size_t)head * 4096 * 64 + 8 * fq;
        float g1[8], g2[8], rv[8];
#pragma unroll
        for (int e = 0; e < 8; ++e) { g1[e] = gp[8 * fq + e] * qs; g2[e] = gp[32 + 8 * fq + e] * qs; rv[e] = __builtin_amdgcn_exp2f(-(float)(8 * fq + e) * (13.287712379549449f / 32.f)) * 0.15915494309189535f; }
#pragma unroll
        for (int ai = 0; ai < 2; ++ai)
#pragma unroll
            for (int m = 0; m < 4; ++m) { const int row = row0 + ai * HALF + m * 16; const float pos = (float)(row & 4095);
                float x1[8], x2[8]; float ss = 0.f;
#pragma unroll
                for (int n = 0; n < 2; ++n)
#pragma unroll
                    for (int i = 0; i < 4; ++i) { x1[4 * n + i] = acc[ai][0][m][n][i]; x2[4 * n + i] = acc[ai][1][m][n][i]; ss += x1[4 * n + i] * x1[4 * n + i] + x2[4 * n + i] * x2[4 * n + i]; }
                ss += __shfl_xor(ss, 16); ss += __shfl_xor(ss, 32);
                const float rs = __builtin_amdgcn_rsqf(ss * (1.f / 64.f) + 1e-6f);
                float o1[8], o2[8];
#pragma unroll
                for (int e = 0; e < 8; ++e) { const float fr_ = __builtin_amdgcn_fractf(pos * rv[e]); const float c = __builtin_amdgcn_cosf(fr_), s = __builtin_amdgcn_sinf(fr_);
                    const float a = x1[e] * rs * g1[e], b = x2[e] * rs * g2[e]; o1[e] = a * c - b * s; o2[e] = a * s + b * c; }
                bf16_t* rowp = Ob + ((size_t)(row >> 12) * 16 * 4096 + (row & 4095)) * 64;
                u32x4 w; w.x = cvt_pk_bf16(o1[0], o1[1]); w.y = cvt_pk_bf16(o1[2], o1[3]); w.z = cvt_pk_bf16(o1[4], o1[5]); w.w = cvt_pk_bf16(o1[6], o1[7]); *(u32x4*)rowp = w;
                w.x = cvt_pk_bf16(o2[0], o2[1]); w.y = cvt_pk_bf16(o2[2], o2[3]); w.z = cvt_pk_bf16(o2[4], o2[5]); w.w = cvt_pk_bf16(o2[6], o2[7]); *(u32x4*)(rowp + 32) = w; }
    }
};
struct EpiQKRopeI8 {
    static constexpr bool PERM = true, AFTER_DRAIN = false;
    bf16_t* O; const float* gq; const float* gk; const float* rowscale; const unsigned* wamax;
    static constexpr size_t HM = (size_t)65536 * 1024;
    __device__ __forceinline__ void operator()(const i32x4_t (&acc)[2][2][4][2], const Unit& u, int wr, int wc, int fr, int fq) const {
        const int row0 = u.pm * BM + wr * 64 + fr; const float ws_ = __builtin_bit_cast(float, *wamax) * (1.f / 127.f);
        if (u.pn >= 8) {
#pragma unroll
            for (int ai = 0; ai < 2; ++ai)
#pragma unroll
                for (int m = 0; m < 4; ++m) { const int row = row0 + ai * HALF + m * 16; const size_t bt = (size_t)(row >> 12) * 16 * 4096 + (row & 4095);
#pragma unroll
                    for (int bj = 0; bj < 2; ++bj) { const float s_ = rowscale[row] * ws_; const i32x4_t a0 = acc[ai][bj][m][0], a1 = acc[ai][bj][m][1]; const f32x4 v0 = (f32x4){(float)a0[0], (float)a0[1], (float)a0[2], (float)a0[3]} * s_, v1 = (f32x4){(float)a1[0], (float)a1[1], (float)a1[2], (float)a1[3]} * s_; const int head = (u.pn - 8) * 4 + 2 * bj + (wc >> 1);
                        u32x4 w; w.x = cvt_pk_bf16(v0[0], v0[1]); w.y = cvt_pk_bf16(v0[2], v0[3]); w.z = cvt_pk_bf16(v1[0], v1[1]); w.w = cvt_pk_bf16(v1[2], v1[3]);
                        *(u32x4*)(O + (size_t)2 * HM + (bt + (size_t)head * 4096) * 64 + 32 * (wc & 1) + 8 * fq) = w; } }
            return;
        }
        const bool isk = u.pn >= 4; const float* gp = isk ? gk : gq; const float qs = isk ? 1.0f : (0.125f * 1.4426950408889634f);
        const int head = 4 * (u.pn & 3) + wc; bf16_t* Ob = O + (isk ? HM : (size_t)0) + (size_t)head * 4096 * 64 + 8 * fq;
        float g1[8], g2[8], rv[8];
#pragma unroll
        for (int e = 0; e < 8; ++e) { g1[e] = gp[8 * fq + e] * qs; g2[e] = gp[32 + 8 * fq + e] * qs; rv[e] = __builtin_amdgcn_exp2f(-(float)(8 * fq + e) * (13.287712379549449f / 32.f)) * 0.15915494309189535f; }
#pragma unroll
        for (int ai = 0; ai < 2; ++ai)
#pragma unroll
            for (int m = 0; m < 4; ++m) { const int row = row0 + ai * HALF + m * 16; const float pos = (float)(row & 4095); const float s_ = rowscale[row] * ws_;
                float x1[8], x2[8]; float ss = 0.f;
#pragma unroll
                for (int n = 0; n < 2; ++n)
#pragma unroll
                    for (int i = 0; i < 4; ++i) { x1[4 * n + i] = (float)acc[ai][0][m][n][i] * s_; x2[4 * n + i] = (float)acc[ai][1][m][n][i] * s_; ss += x1[4 * n + i] * x1[4 * n + i] + x2[4 * n + i] * x2[4 * n + i]; }
                ss += __shfl_xor(ss, 16); ss += __shfl_xor(ss, 32);
                const float rs = __builtin_amdgcn_rsqf(ss * (1.f / 64.f) + 1e-6f);
                float o1[8], o2[8];
#pragma unroll
                for (int e = 0; e < 8; ++e) { const float fr_ = __builtin_amdgcn_fractf(pos * rv[e]); const float c = __builtin_amdgcn_cosf(fr_), s = __builtin_amdgcn_sinf(fr_);
                    const float a = x1[e] * rs * g1[e], b = x2[e] * rs * g2[e]; o1[e] = a * c - b * s; o2[e] = a * s + b * c; }
                bf16_t* rowp = Ob + ((size_t)(row >> 12) * 16 * 4096 + (row & 4095)) * 64;
                u32x4 w; w.x = cvt_pk_bf16(o1[0], o1[1]); w.y = cvt_pk_bf16(o1[2], o1[3]); w.z = cvt_pk_bf16(o1[4], o1[5]); w.w = cvt_pk_bf16(o1[6], o1[7]); *(u32x4*)rowp = w;
                w.x = cvt_pk_bf16(o2[0], o2[1]); w.y = cvt_pk_bf16(o2[2], o2[3]); w.z = cvt_pk_bf16(o2[4], o2[5]); w.w = cvt_pk_bf16(o2[6], o2[7]); *(u32x4*)(rowp + 32) = w; }
    }
};

struct EpiSwiGLUi8 {
    static constexpr bool PERM = true, AFTER_DRAIN = false;
    bf16_t* O; int ldo; const float* rowscale; const unsigned* wamax;
    __device__ __forceinline__ void operator()(const i32x4_t (&acc)[2][2][4][2], const Unit& u, int wr, int wc, int fr, int fq) const {
        const int col0 = u.pn * HALF + wc * 32 + 8 * fq; const int row0 = u.pm * BM + wr * 64 + fr;
        const float ws_ = __builtin_bit_cast(float, *wamax) * (1.f / 127.f);
#pragma unroll
        for (int ai = 0; ai < 2; ++ai)
#pragma unroll
            for (int m = 0; m < 4; ++m) { const int row = row0 + ai * HALF + m * 16; bf16_t* rowp = O + (size_t)row * ldo + col0;
                const float s = rowscale[row] * ws_; const float C1 = -1.4426950408889634f * s, KK = 1.0f / (s * s);
                const i32x4_t g0 = acc[ai][0][m][0], g1 = acc[ai][0][m][1], u0 = acc[ai][1][m][0], u1 = acc[ai][1][m][1];
                const f32x2 y0 = silu2((f32x2){(float)g0[0], (float)g0[1]}, (f32x2){(float)u0[0], (float)u0[1]}, C1, KK), y1 = silu2((f32x2){(float)g0[2], (float)g0[3]}, (f32x2){(float)u0[2], (float)u0[3]}, C1, KK);
                const f32x2 y2 = silu2((f32x2){(float)g1[0], (float)g1[1]}, (f32x2){(float)u1[0], (float)u1[1]}, C1, KK), y3 = silu2((f32x2){(float)g1[2], (float)g1[3]}, (f32x2){(float)u1[2], (float)u1[3]}, C1, KK);
                u32x4 w; w.x = cvt_pk_bf16(y0.x, y0.y); w.y = cvt_pk_bf16(y1.x, y1.y); w.z = cvt_pk_bf16(y2.x, y2.y); w.w = cvt_pk_bf16(y3.x, y3.y);
                *(u32x4*)rowp = w; }
    }
};

struct EpiSwiGLUi8f8 {
    static constexpr bool PERM = true, AFTER_DRAIN = false;
    unsigned char* O; int ldo; const float* rowscale; const unsigned* wamax;
    __device__ __forceinline__ void operator()(const i32x4_t (&acc)[2][2][4][2], const Unit& u, int wr, int wc, int fr, int fq) const {
        const int col0 = u.pn * HALF + wc * 32 + 8 * fq; const int row0 = u.pm * BM + wr * 64 + fr;
        const float ws_ = __builtin_bit_cast(float, *wamax) * (1.f / 127.f);
#pragma unroll
        for (int ai = 0; ai < 2; ++ai)
#pragma unroll
            for (int m = 0; m < 4; ++m) { const int row = row0 + ai * HALF + m * 16; unsigned char* rowp = O + (size_t)row * ldo + col0;
                const float s = rowscale[row] * ws_; const float C1 = -1.4426950408889634f * s, KK = 1.0f / (s * s * F8_AS);
                const i32x4_t g0 = acc[ai][0][m][0], g1 = acc[ai][0][m][1], u0 = acc[ai][1][m][0], u1 = acc[ai][1][m][1];
                const f32x2 y0 = silu2((f32x2){(float)g0[0], (float)g0[1]}, (f32x2){(float)u0[0], (float)u0[1]}, C1, KK), y1 = silu2((f32x2){(float)g0[2], (float)g0[3]}, (f32x2){(float)u0[2], (float)u0[3]}, C1, KK);
                const f32x2 y2 = silu2((f32x2){(float)g1[0], (float)g1[1]}, (f32x2){(float)u1[0], (float)u1[1]}, C1, KK), y3 = silu2((f32x2){(float)g1[2], (float)g1[3]}, (f32x2){(float)u1[2], (float)u1[3]}, C1, KK);
#define M448(v) __builtin_amdgcn_fmed3f((v), -448.f, 448.f)
                u32x2_t w; w.x = pk4_fp8(M448(y0.x), M448(y0.y), M448(y1.x), M448(y1.y)); w.y = pk4_fp8(M448(y2.x), M448(y2.y), M448(y3.x), M448(y3.y));
#undef M448
                *(u32x2_t*)rowp = w; }
    }
};

struct EpiBf16I8 {
    static constexpr bool PERM = true, AFTER_DRAIN = false;
    bf16_t* O; int ldc; const float* rowscale; const unsigned* wamax;
    __device__ __forceinline__ void operator()(const i32x4_t (&acc)[2][2][4][2], const Unit& u, int wr, int wc, int fr, int fq) const {
        const int row0 = u.pm * BM + wr * 64 + fr; const int col0 = u.pn * BM + wc * 32 + 8 * fq; const float ws_ = __builtin_bit_cast(float, *wamax) * (1.f / 127.f);
#pragma unroll
        for (int ai = 0; ai < 2; ++ai)
#pragma unroll
            for (int m = 0; m < 4; ++m) { const int row = row0 + ai * HALF + m * 16; const float s_ = rowscale[row] * ws_; bf16_t* rowp = O + (size_t)row * ldc + col0;
#pragma unroll
                for (int bj = 0; bj < 2; ++bj) { const i32x4_t a0 = acc[ai][bj][m][0], a1 = acc[ai][bj][m][1];
                    u32x4 w; w.x = cvt_pk_bf16((float)a0[0] * s_, (float)a0[1] * s_); w.y = cvt_pk_bf16((float)a0[2] * s_, (float)a0[3] * s_); w.z = cvt_pk_bf16((float)a1[0] * s_, (float)a1[1] * s_); w.w = cvt_pk_bf16((float)a1[2] * s_, (float)a1[3] * s_);
                    *(u32x4*)(rowp + bj * HALF) = w; } }
    }
};
struct MoeOrder {
    StaticOrder so; int nN, pmA, tile0; int pends[8];
    __device__ void init(int nM_, int nN_, int G_, int c_, int pmA_, int tile0_, const int* pe) { so.nM = nM_; so.nN = nN_; so.nwg = nM_ * nN_; so.G = G_; so.c = c_; nN = nN_; pmA = pmA_; tile0 = tile0_;
#pragma unroll
        for (int j = 0; j < 8; ++j) pends[j] = __builtin_amdgcn_readfirstlane(pe[j]); }
    __device__ bool next(int i, Unit& u) const {
        Unit v; if (!so.next(i, v)) return false;
        const int r0 = (tile0 + v.pm) * BM; int e = 0;
#pragma unroll
        for (int j = 0; j < 7; ++j) e += (r0 >= pends[j]) ? 1 : 0;
        u.pm = v.pm + pmA; u.pn = e * nN + v.pn; return true;
    }
    __device__ __forceinline__ void a_ready(const Unit&) const {}
    __device__ __forceinline__ void done(const Unit&) const {}
};
}

__device__ __forceinline__ void r7_phase(const Args& a, unsigned char* lds_g, int vcu, int G, int tid, int wave, int lane) {
    unsigned char* ws = a.ws; const bf16* x = (const bf16*)a.out; const float* router = a.in[I_ROUTER];
    int* topk = (int*)(ws + WS_TOPK); float* gates = (float*)(ws + WS_GATES); int* blkcnt = (int*)(ws + WS_BLKCNT);
    int* hist = (int*)lds_g;
    float rw[4][4][8];
#pragma unroll
    for (int j = 0; j < 4; ++j)
#pragma unroll
        for (int i = 0; i < 4; ++i) { const int col = 4 * lane + 256 * j + i; const f32x4 r0 = *(const f32x4*)(router + col * 8), r1 = *(const f32x4*)(router + col * 8 + 4);
            rw[j][i][0] = r0.x; rw[j][i][1] = r0.y; rw[j][i][2] = r0.z; rw[j][i][3] = r0.w; rw[j][i][4] = r1.x; rw[j][i][5] = r1.y; rw[j][i][6] = r1.z; rw[j][i][7] = r1.w; }
    const modw_t* mod = (const modw_t*)(ws + WS_MOD) + 16 * 6144;
    for (int blk = vcu; blk < 256; blk += G) {
        if (tid < 8) hist[tid] = 0;
        __syncthreads();
        const int b = blk >> 4; ModPar mp; load_modpar(mp, a.in[I_NORM_O_FFN], mod + b * 6144, 3, 4, lane);
        unsigned long long cnt = 0ull;
        for (int r = 0; r < 32; ++r) { const int row = blk * 256 + wave * 32 + r; f32x4 h[4]; mod_row_f32<true>(x + (size_t)row * XP, mp, h, lane);
            store_row_fp8(ws + A_HP + (size_t)row * 1024, h, lane);
            float lg[8];
#pragma unroll
            for (int e = 0; e < 8; ++e) { float s = 0.f;
#pragma unroll
                for (int j = 0; j < 4; ++j) s += (h[j].x * rw[j][0][e] + h[j].y * rw[j][1][e]) + (h[j].z * rw[j][2][e] + h[j].w * rw[j][3][e]);
                lg[e] = wave_sum(s); }
            int e1 = 0; float v1 = lg[0];
#pragma unroll
            for (int e = 1; e < 8; ++e) if (lg[e] > v1) { v1 = lg[e]; e1 = e; }
            int e2 = -1; float v2 = -INFINITY;
#pragma unroll
            for (int e = 0; e < 8; ++e) if (e != e1 && lg[e] > v2) { v2 = lg[e]; e2 = e; }
            e1 = __builtin_amdgcn_readfirstlane(e1); e2 = __builtin_amdgcn_readfirstlane(e2);
            const float g1 = 1.0f / (1.0f + __expf(v2 - v1)), g2 = 1.0f - g1;
            if (lane == 0) { topk[row] = e1 | (e2 << 8); gates[2 * row] = g1; gates[2 * row + 1] = g2; }
            cnt += (1ull << (8 * e1)) + (1ull << (8 * e2));
        }
        if (lane < 8) atomicAdd(&hist[lane], (int)((cnt >> (8 * lane)) & 255ull));
        __syncthreads();
        if (tid < 8) blkcnt[blk * 8 + tid] = hist[tid];
        __syncthreads();
    }
}

__device__ __forceinline__ void r8_phase(const Args& a, unsigned char* lds_g, int vcu, int G, int tid, int wave, int lane) {
    unsigned char* ws = a.ws;
    const int* topk = (const int*)(ws + WS_TOPK); const float* gates = (const float*)(ws + WS_GATES); const int* blkcnt = (const int*)(ws + WS_BLKCNT);
    int* slots = (int*)(ws + WS_SLOTS); float* gslot = (float*)(ws + WS_GSLOT); int* pends_g = (int*)(ws + WS_PENDS); int* tokslot = (int*)(ws + WS_TOKSLOT);
    int* tot = (int*)lds_g; int* base = tot + 8; int* pst = tot + 16; int* wcnt = tot + 32;
    if (tid < 8) tot[tid] = 0;
    __syncthreads();
    for (int idx = tid; idx < 2048; idx += 512) atomicAdd(&tot[idx & 7], blkcnt[idx]);
    __syncthreads();
    if (tid == 0) { int p = 0; for (int e = 0; e < 8; ++e) { pst[e] = p; p += (tot[e] + 255) & ~255; if (vcu == 0) pends_g[e] = p; } }
    __syncthreads();
    if (vcu < 8) { const int e = vcu, lo = pst[e] + tot[e], hi = pst[e] + ((tot[e] + 255) & ~255);
        for (int s = lo + tid; s < hi; s += NWAVES * 64) { tokslot[s] = 0; gslot[s] = 0.f; } }
    for (int blk = vcu; blk < 256; blk += G) {
        if (tid < 8) base[tid] = 0;
        __syncthreads();
        for (int idx = tid; idx < 2048; idx += 512) if ((idx >> 3) < blk) atomicAdd(&base[idx & 7], blkcnt[idx]);
        const int token = blk * 256 + (tid >> 1), k = tid & 1; const int pk = topk[token]; const int ea = k ? ((pk >> 8) & 255) : (pk & 255);
        int rank = 0;
#pragma unroll
        for (int e = 0; e < 8; ++e) { const unsigned long long mask = __ballot(ea == e); if (ea == e) rank = __popcll(mask & ((1ull << lane) - 1ull)); if (lane == 0) wcnt[wave * 8 + e] = __popcll(mask); }
        __syncthreads();
        int s = pst[ea] + base[ea] + rank;
        for (int w = 0; w < wave; ++w) s += wcnt[w * 8 + ea];
        slots[token * 2 + k] = s; gslot[s] = gates[token * 2 + k]; tokslot[s] = token;
        __syncthreads();
    }
}

__device__ __forceinline__ void r9_phase(const Args& a, int gw, int NGW, int lane) {
    unsigned char* ws = a.ws; float* out = a.out; const int* slots = (const int*)(ws + WS_SLOTS); const bf16* Y = (const bf16*)(ws + A_Y);
    const modw_t* mod = (const modw_t*)(ws + WS_MOD) + 16 * 6144;
    for (int bi = gw; bi < T / 32; bi += NGW) {
        const int b = bi >> 7; f32x4 gt[4];
#pragma unroll
        for (int j = 0; j < 4; ++j) gt[j] = modv4(mod + b * 6144 + 5 * 1024 + 4 * lane + 256 * j);
        for (int r = 0; r < 32; ++r) { const int row = bi * 32 + r; const int s1 = slots[2 * row], s2 = slots[2 * row + 1];
            const uint2* y1 = (const uint2*)(Y + (size_t)s1 * 1024) + lane; const uint2* y2 = (const uint2*)(Y + (size_t)s2 * 1024) + lane;
            const uint2* xb = (const uint2*)((const bf16*)out + (size_t)row * XP) + lane; f32x4* o = (f32x4*)(out + (size_t)row * 1024) + lane;
            f32x4 v[4];
#pragma unroll
            for (int j = 0; j < 4; ++j) { const uint2 p = y1[64 * j], q = y2[64 * j], x3 = xb[64 * j];
                v[j].x = bflo(x3.x) + gt[j].x * (bflo(p.x) + bflo(q.x)); v[j].y = bfhi(x3.x) + gt[j].y * (bfhi(p.x) + bfhi(q.x)); v[j].z = bflo(x3.y) + gt[j].z * (bflo(p.y) + bflo(q.y)); v[j].w = bfhi(x3.y) + gt[j].w * (bfhi(p.y) + bfhi(q.y)); }
            asm volatile("s_waitcnt vmcnt(0)" ::: "memory");
#pragma unroll
            for (int j = 0; j < 4; ++j) o[64 * j] = v[j];
            asm volatile("" ::: "memory"); }
    }
}

#ifndef MK_PER_PHASE
#define MK_PER_PHASE 0
#endif
__global__ void __launch_bounds__(NWAVES * 64, 2) mega_fwd(Args args) {
    extern __shared__ __attribute__((aligned(16))) unsigned char lds_raw[];
    LAS unsigned char* lds = (LAS unsigned char*)lds_raw;
    volatile LAS unsigned* MISC = (volatile LAS unsigned*)(lds + MISC_OFF);
    const int G = gridDim.x, bx = blockIdx.x; const int vcu = (G % 8 == 0) ? (bx % 8) * (G / 8) + bx / 8 : bx;
    const int NGW = G * NWAVES;
    unsigned char* ws = args.ws;
    for (int u = threadIdx.x; u < (LDS_BYTES - LDS_ZERO_OFF) / 4; u += NWAVES * 64) ((LAS unsigned*)(lds + LDS_ZERO_OFF))[u] = 0u;
#define IDS() int tid = threadIdx.x; asm volatile("" : "+v"(tid)); const int lane = tid & 63, wave = __builtin_amdgcn_readfirstlane(tid >> 6); const int gw = vcu * NWAVES + wave; (void)lane; (void)gw
    __syncthreads();
    XcdBarrier bar; bar.bar = (unsigned*)(ws + WS_CTL) + CW_BAR; bar.x = 0; bar.st = nullptr;
    if (!MK_PER_PHASE) bar = xcd_barrier_post((unsigned*)(ws + WS_CTL) + CW_BAR, MISC + 8);
    const int lo = args.ph_lo, hi = args.ph_hi;
#define IN(k) (lo <= (k) && (k) < hi)
#define SEAM(k) do { if (!MK_PER_PHASE) { if (IN(k) && IN((k) + 1)) xcd_barrier(bar); } } while (0)
    const bool ROWLOCAL = false && (G * 256 == T);
#define LOCAL_SEAM() do { __builtin_amdgcn_fence(__ATOMIC_RELEASE, "agent"); asm volatile("s_waitcnt vmcnt(0)" ::: "memory"); __syncthreads(); __builtin_amdgcn_fence(__ATOMIC_ACQUIRE, "agent"); } while (0)
    const modw_t* mod_e = (const modw_t*)(ws + WS_MOD); const modw_t* mod_o = mod_e + 16 * 6144;
    bf16* H = (bf16*)(ws + A_H);
    bf16* XB = (bf16*)args.out;

    if (IN(0)) { IDS(); p0_prologue(args, lds, gw, NGW, wave, lane); } SEAM(0);
    if (IN(1)) { IDS(); modulate_phase<false, false, true>(args.in[I_X], args.in[I_NORM_E_MIX], mod_e, 0, 1, H, gw, NGW, lane, (float*)(ws + WS_ROWSC));
#if FFN_FP8 == 0 || FFN_FP8 == 3
        {
            LAS float* scr = (LAS float*)(lds + wave * 16384); const float wsc = 127.f / fmaxf(__builtin_bit_cast(float, *(const unsigned*)(ws + WS_WAMAX)), 1e-30f);
            for (int it = gw; it < 2 * 1408; it += NGW) { const bool up = it >= 1408; tr_gu_i8(args.in[up ? I_FFN_U : I_FFN_G], 1024, 2816, ws + W_GU, up ? 128 : 0, wsc, up ? it - 1408 : it, scr, lane); }
            const float wsi = 127.f / fmaxf(__builtin_bit_cast(float, *((const unsigned*)(ws + WS_WAMAX) + 2)), 1e-30f);
            for (int it = gw; it < 16 * 37; it += NGW) { const int kb = it / 37, nb = it % 37; transpose_item_i8(args.in[I_W_IN], 1184, 64 * kb, 32 * nb, ws + W_IN + (size_t)(32 * nb) * 1024, 1024, wsi, scr, lane); }
            const float wsq = 127.f / fmaxf(__builtin_bit_cast(float, *((const unsigned*)(ws + WS_WAMAX) + 1)), 1e-30f);
            for (int it = gw; it < 16 * 96; it += NGW) { const int kb = it / 96, nb = it % 96, n0 = 32 * nb; int drow = n0;
                if (n0 < 2048) { const int tt = n0 >> 8, wc_ = (n0 & 255) >> 6, bj = (n0 & 63) >> 5; drow = tt * 256 + bj * 128 + wc_ * 32; }
                transpose_item_i8(args.in[I_DIL_QKV], 3072, 64 * kb, n0, ws + W_QKV + (size_t)drow * 1024, 1024, wsq, scr, lane); }
        }
#endif
    } SEAM(1);
    if (IN(2)) { pg8::Gemm g{H, (const bf16*)(ws + W_IN), T, 1280, 512}; pg8::StaticOrder S; S.init(T, 1280, G, bx);
        pg8::EpiBf16I8 E{(bf16*)(ws + A_P), 1280, (const float*)(ws + WS_ROWSC), (const unsigned*)(ws + WS_WAMAX) + 2};
        pg8::gemm_phase_i8<pg8::EpiBf16I8, pg8::StaticOrder, true, true>(lds, g, S, E); } SEAM(2);
    if (IN(3)) { IDS(); r2_phase(args, gw, NGW, lane); } SEAM(3);
    if (IN(4)) {
        { pg8::Gemm g{(const bf16*)(ws + A_CQ), (const bf16*)(ws + W_UQ), T, 768, 256}; pg8::StaticOrder S; S.init(T, 768, G, bx);
          pg8::EpiBf16<0> E{(bf16*)(ws + A_QA), 768, nullptr, 0, 0, 1.f};
          pg8::gemm_phase<pg8::EpiBf16<0>, pg8::StaticOrder, true, true>(lds, g, S, E); }
        __syncthreads();
        { pg8::Gemm g{(const bf16*)(ws + A_CKV), (const bf16*)(ws + W_UKV), T, 1024, 128}; pg8::StaticOrder S; S.init(T, 1024, G, bx);
          pg8::EpiBf16<0> E{(bf16*)(ws + A_KV), 512, nullptr, 512, (size_t)T * 512, 1.f};
          pg8::gemm_phase<pg8::EpiBf16<0>, pg8::StaticOrder, true, true>(lds, g, S, E); }
    } SEAM(4);
    if (IN(5)) { IDS(); r3_phase(args, gw, NGW, lane); } SEAM(5);
    if (IN(6)) {
        bf16* ATT = (bf16*)(ws + A_ATT0);
        const float bndA = 96.f * att::wave_absmax(args.in[I_MLA_QG], 96) * att::wave_absmax(args.in[I_MLA_KG], 96) * QSCALE_A;
        const float bndB = 64.f * att::wave_absmax(args.in[I_GQA_QG], 64) * att::wave_absmax(args.in[I_GQA_KG], 64) * QSCALE_B;
        for (int L = vcu; L < 2048; L += G) {
            const int u = L & 2047, b = u >> 7, h = (u >> 4) & 7, qb = u & 15; const size_t r0 = (size_t)b * SEQ, rq = r0 + 256 * qb;
            if (bndA < 64.f) att::attn_dense_fast<96>((const bf16*)(ws + A_QA) + rq * 768 + h * 96, 768, args.in[I_MLA_QG], 256 * qb, (const bf16*)(ws + A_KA) + r0 * 768 + h * 96, 768, (const bf16*)(ws + A_KV) + (size_t)T * 512 + r0 * 512 + h * 64, 512,
                                              64, ATT + rq * 1024 + h * 64, 1024, (LAS char*)lds);
            else att::attn_dense<96>((const bf16*)(ws + A_QA) + rq * 768 + h * 96, 768, args.in[I_MLA_QG], 256 * qb, (const bf16*)(ws + A_KA) + r0 * 768 + h * 96, 768, (const bf16*)(ws + A_KV) + (size_t)T * 512 + r0 * 512 + h * 64, 512,
                                              64, ATT + rq * 1024 + h * 64, 1024, (LAS char*)lds);
        }
        for (int L = vcu; L < 2048; L += G) {
            const int u = L & 2047, b = u >> 7, h = (u >> 4) & 7, qb = u & 15; const size_t r0 = (size_t)b * SEQ, rq = r0 + 256 * qb;
            if (bndB < 64.f) att::attn_dense_fast<64>((const bf16*)(ws + A_P) + rq * 1280 + 416 + h * 64, 1280, args.in[I_GQA_QG], 256 * qb, (const bf16*)(ws + A_KB) + r0 * 128 + (h >> 2) * 64, 128, (const bf16*)(ws + A_P) + r0 * 1280 + 1056 + (h >> 2) * 64, 1280,
                                     64, ATT + rq * 1024 + 512 + h * 64, 1024, (LAS char*)lds);
            else att::attn_dense<64>((const bf16*)(ws + A_P) + rq * 1280 + 416 + h * 64, 1280, args.in[I_GQA_QG], 256 * qb, (const bf16*)(ws + A_KB) + r0 * 128 + (h >> 2) * 64, 128, (const bf16*)(ws + A_P) + r0 * 1280 + 1056 + (h >> 2) * 64, 1280,
                                     64, ATT + rq * 1024 + 512 + h * 64, 1024, (LAS char*)lds);
        }
    } SEAM(6);
    if (IN(7)) { pg8::Gemm g{(const bf16*)(ws + A_ATT0), (const bf16*)(ws + W_OUT), T, 1024, 1024}; pg8::StaticOrder S; S.init(T, 1024, G, bx);
        pg8::EpiResB<true> E{args.in[I_X], XB, mod_e + 2 * 1024, 1.f};
        pg8::gemm_phase<pg8::EpiResB<true>, pg8::StaticOrder, true, true>(lds, g, S, E); } SEAM(7);
#if FFN_FP8 == 1
    if (IN(8)) { IDS(); modulate_phase<true, true>(XB, args.in[I_NORM_E_FFN], mod_e, 3, 4, H, gw, NGW, lane); } SEAM(8);
    if (IN(9)) { pg8::Gemm g{H, (const bf16*)(ws + W_GU), T, 5632, 512}; pg8::StaticOrder S; S.init(T, 5632, G, bx);
        pg8::EpiSwiGLU8 E{ws + A_ACT, 2816, 1 << 30, 0, 1.0f / (F8_HS * F8_WS)};
        pg8::gemm_phase8<pg8::EpiSwiGLU8, pg8::StaticOrder, true, true>(lds, g, S, E); } SEAM(9);
    if (IN(10)) { pg8::Gemm g{(const bf16*)(ws + A_ACT), (const bf16*)(ws + W_D), T, 1024, 1408}; pg8::StaticOrder S; S.init(T, 1024, G, bx);
        pg8::EpiResB<false> E{XB, XB, mod_e + 5 * 1024, 1.0f / (F8_AS * F8_WS)};
        pg8::gemm_phase8<pg8::EpiResB<false>, pg8::StaticOrder, true, true>(lds, g, S, E); } SEAM(10);
#elif FFN_FP8 == 2
    if (IN(8)) { IDS(); modulate_phase<false, true>(XB, args.in[I_NORM_E_FFN], mod_e, 3, 4, H, gw, NGW, lane); } SEAM(8);
    if (IN(9)) { pg8::Gemm g{H, (const bf16*)(ws + W_GU), T, 5632, 1024}; pg8::StaticOrder S; S.init(T, 5632, G, bx);
        pg8::EpiSwiGLU8 E{ws + A_ACT, 2816, 1 << 30, 0, 1.0f};
        pg8::gemm_phase<pg8::EpiSwiGLU8, pg8::StaticOrder, true, true>(lds, g, S, E); } SEAM(9);
    if (IN(10)) { pg8::Gemm g{(const bf16*)(ws + A_ACT), (const bf16*)(ws + W_D), T, 1024, 1408}; pg8::StaticOrder S; S.init(T, 1024, G, bx);
        pg8::EpiResB<false> E{XB, XB, mod_e + 5 * 1024, 1.0f / (F8_AS * F8_WS)};
        pg8::gemm_phase8<pg8::EpiResB<false>, pg8::StaticOrder, true, true>(lds, g, S, E); } SEAM(10);
#elif FFN_FP8 == 3
    if (IN(8)) { IDS(); modulate_phase<false, true, true>(XB, args.in[I_NORM_E_FFN], mod_e, 3, 4, H, gw, NGW, lane, (float*)(ws + WS_ROWSC)); }
    if (ROWLOCAL) { if (!MK_PER_PHASE && IN(8) && IN(9)) LOCAL_SEAM(); } else SEAM(8);
    if (IN(9)) { pg8::Gemm g{H, (const bf16*)(ws + W_GU), T, 5632, 512};
        pg8::EpiSwiGLUi8f8 E{ws + A_ACT, 2816, (const float*)(ws + WS_ROWSC), (const unsigned*)(ws + WS_WAMAX)};
        if (ROWLOCAL) { pg8::RowLocalOrder S; S.init(T, 5632, G, vcu); pg8::gemm_phase_i8<pg8::EpiSwiGLUi8f8, pg8::RowLocalOrder, true, true>(lds, g, S, E); }
        else { pg8::StaticOrder S; S.init(T, 5632, G, bx); pg8::gemm_phase_i8<pg8::EpiSwiGLUi8f8, pg8::StaticOrder, true, true>(lds, g, S, E); } } SEAM(9);
    if (IN(10)) { pg8::Gemm g{(const bf16*)(ws + A_ACT), (const bf16*)(ws + W_D), T, 1024, 1408}; pg8::StaticOrder S; S.init(T, 1024, G, bx);
        pg8::EpiResB<false> E{XB, XB, mod_e + 5 * 1024, 1.0f / (F8_AS * F8_WS)};
        pg8::gemm_phase8<pg8::EpiResB<false>, pg8::StaticOrder, true, true>(lds, g, S, E); } SEAM(10);
#else
    if (IN(8)) { IDS(); modulate_phase<false, true, true>(XB, args.in[I_NORM_E_FFN], mod_e, 3, 4, H, gw, NGW, lane, (float*)(ws + WS_ROWSC)); } SEAM(8);
    if (IN(9)) { pg8::Gemm g{H, (const bf16*)(ws + W_GU), T, 5632, 512}; pg8::StaticOrder S; S.init(T, 5632, G, bx);
        pg8::EpiSwiGLUi8 E{(bf16*)(ws + A_ACT), 2816, (const float*)(ws + WS_ROWSC), (const unsigned*)(ws + WS_WAMAX)};
        pg8::gemm_phase_i8<pg8::EpiSwiGLUi8, pg8::StaticOrder, true, true>(lds, g, S, E); } SEAM(9);
    if (IN(10)) { pg8::Gemm g{(const bf16*)(ws + A_ACT), (const bf16*)(ws + W_D), T, 1024, 2816}; pg8::StaticOrder S; S.init(T, 1024, G, bx);
        pg8::EpiResB<false> E{XB, XB, mod_e + 5 * 1024, 1.f};
        pg8::gemm_phase<pg8::EpiResB<false>, pg8::StaticOrder, true, true>(lds, g, S, E); } SEAM(10);
#endif
    if (IN(11)) { IDS(); modulate_phase<false, true, true>(XB, args.in[I_NORM_O_MIX], mod_o, 0, 1, H, gw, NGW, lane, (float*)(ws + WS_ROWSC)); }
    if (ROWLOCAL) { if (!MK_PER_PHASE && IN(11) && IN(12)) LOCAL_SEAM(); } else SEAM(11);
    if (IN(12)) { pg8::Gemm g{H, (const bf16*)(ws + W_QKV), T, 3072, 512};
        pg8::EpiQKRopeI8 E{(bf16*)(ws + A_QKV), args.in[I_DIL_QG], args.in[I_DIL_KG], (const float*)(ws + WS_ROWSC), (const unsigned*)(ws + WS_WAMAX) + 1};
        if (ROWLOCAL) { pg8::RowLocalOrder S; S.init(T, 3072, G, vcu); pg8::gemm_phase_i8<pg8::EpiQKRopeI8, pg8::RowLocalOrder, true, true>(lds, g, S, E); }
        else { pg8::StaticOrder S; S.init(T, 3072, G, bx); pg8::gemm_phase_i8<pg8::EpiQKRopeI8, pg8::StaticOrder, true, true>(lds, g, S, E); } }
      SEAM(13);
    if (IN(14)) {
        constexpr size_t HM = (size_t)T * 1024;
        const bf16* QH = (const bf16*)(ws + A_QKV); bf16* O1H = (bf16*)(ws + A_H); bf16* O2H = (bf16*)(ws + A_O2); float* L1 = (float*)(ws + A_LSE1); float* L2 = (float*)(ws + A_LSE2); bf16* ATT = (bf16*)(ws + A_ATT1);
        const float bndC = 64.f * att::wave_absmax(args.in[I_DIL_QG], 64) * att::wave_absmax(args.in[I_DIL_KG], 64) * QSCALE_B;
        for (int bh = vcu; bh < 256; bh += G) {
            const int b = bh >> 4, h = bh & 15; const size_t hb = (size_t)bh * 4096 * 64;
            const bf16* Qb_ = QH + hb; const bf16* Kb_ = QH + HM + hb; const bf16* Vb_ = QH + 2 * HM + hb;
            if (bndC < 100.f) {
            att::band_phase<false, true>(Qb_, Kb_, Vb_, 1, O1H + hb, 64, L1 + (size_t)bh * 4096, nullptr, nullptr, nullptr, nullptr, (LAS char*)lds);
            att::band_phase<false, true>(Qb_, Kb_, Vb_, 4, O2H + hb, 64, L2 + (size_t)bh * 4096, nullptr, nullptr, nullptr, nullptr, (LAS char*)lds);
            asm volatile("s_waitcnt vmcnt(0)" ::: "memory"); __syncthreads();
            att::band_phase<true, true>(Qb_, Kb_, Vb_, 16, ATT + (size_t)b * SEQ * 1024 + h * 64, 1024, nullptr, O1H + hb, O2H + hb, L1 + (size_t)bh * 4096, L2 + (size_t)bh * 4096, (LAS char*)lds);
            } else {
            att::band_phase<false, false>(Qb_, Kb_, Vb_, 1, O1H + hb, 64, L1 + (size_t)bh * 4096, nullptr, nullptr, nullptr, nullptr, (LAS char*)lds);
            att::band_phase<false, false>(Qb_, Kb_, Vb_, 4, O2H + hb, 64, L2 + (size_t)bh * 4096, nullptr, nullptr, nullptr, nullptr, (LAS char*)lds);
            asm volatile("s_waitcnt vmcnt(0)" ::: "memory"); __syncthreads();
            att::band_phase<true, false>(Qb_, Kb_, Vb_, 16, ATT + (size_t)b * SEQ * 1024 + h * 64, 1024, nullptr, O1H + hb, O2H + hb, L1 + (size_t)bh * 4096, L2 + (size_t)bh * 4096, (LAS char*)lds);
            }
        }
    }
      SEAM(15);
    if (IN(16)) { pg8::Gemm g{(const bf16*)(ws + A_ATT1), (const bf16*)(ws + W_DO), T, 1024, 1024}; pg8::StaticOrder S; S.init(T, 1024, G, bx);
        pg8::EpiResB<false> E{XB, XB, mod_o + 2 * 1024, 1.f};
        pg8::gemm_phase<pg8::EpiResB<false>, pg8::StaticOrder, true, true>(lds, g, S, E); } SEAM(16);
    if (IN(17)) { IDS(); r7_phase(args, lds_raw, vcu, G, tid, wave, lane); } SEAM(17);
    if (IN(18)) { IDS(); r8_phase(args, lds_raw, vcu, G, tid, wave, lane); } SEAM(18);
    {
        const int* pe = (const int*)(ws + WS_PENDS);
        if (IN(19)) { const int ntot = __builtin_amdgcn_readfirstlane(pe[7]) >> 8;
            pg8::GemmG g{ws + A_HP, (const bf16*)(ws + W_MGU), (const int*)(ws + WS_TOKSLOT), 512, 1024}; pg8::MoeOrder S; S.init(ntot, 28, G, bx, 0, 0, pe);
            pg8::EpiSwiGLU8 E{ws + A_ACTM, 3584, 28, 0, 1.0f / (F8_HS * F8_WS)};
            pg8::gemm_phase8g<pg8::EpiSwiGLU8, pg8::MoeOrder, true, true>(lds, g, S, E); }
        SEAM(19);
        if (IN(20)) { const int ntot = __builtin_amdgcn_readfirstlane(pe[7]) >> 8;
            pg8::Gemm g{(const bf16*)(ws + A_ACTM), (const bf16*)(ws + W_MD), 0, 0, 1792}; pg8::MoeOrder S; S.init(ntot, 4, G, bx, 0, 0, pe);
            pg8::EpiMoeDown E{(bf16*)(ws + A_Y), (const float*)(ws + WS_GSLOT), 0, 1.0f / (F8_AS * F8_WS)};
            pg8::gemm_phase8<pg8::EpiMoeDown, pg8::MoeOrder, true, true>(lds, g, S, E); }
        if (!MK_PER_PHASE) { if (IN(20) && IN(27)) xcd_barrier(bar); }
    }
    if (IN(27)) { IDS(); r9_phase(args, gw, NGW, lane); }
#undef IN
#undef SEAM
}

extern "C" void kernel_launch(void* const* d_in, const int* in_sizes, int n_in, void* d_out, int out_size, void* d_ws, size_t ws_size, hipStream_t stream) {
    static int grid = 0;
    if (grid == 0) {
        if (n_in != 31 || in_sizes[0] != T * DM || out_size != T * DM || ws_size < WS_NEED) {
            fprintf(stderr, "kernel_launch: expected 31 inputs, x/out of %d floats, >= %zu bytes of workspace; got n_in %d in0 %d out %d ws %zu\n", T * DM, (size_t)WS_NEED, n_in, n_in > 0 ? in_sizes[0] : -1, out_size, ws_size);
            grid = -1; return; }
        int dev = 0, cus = 0, per_cu = 0;
        if (hipGetDevice(&dev) != hipSuccess || hipDeviceGetAttribute(&cus, hipDeviceAttributeMultiprocessorCount, dev) != hipSuccess) { grid = -1; return; }
        if (hipFuncSetAttribute((const void*)mega_fwd, hipFuncAttributeMaxDynamicSharedMemorySize, LDS_BYTES) != hipSuccess) { fprintf(stderr, "kernel_launch: hipFuncSetAttribute failed\n"); grid = -1; return; }
        if (hipOccupancyMaxActiveBlocksPerMultiprocessor(&per_cu, (const void*)mega_fwd, NWAVES * 64, LDS_BYTES) != hipSuccess || per_cu < 1)
            fprintf(stderr, "kernel_launch: note: occupancy query reports %d workgroups per CU\n", per_cu);
        (void)hipGetLastError();
        grid = cus;
    }
    if (grid < 0) return;
    if (hipMemsetAsync((char*)d_ws + WS_CTL, 0, CTL_ZERO_BYTES, stream) != hipSuccess) { fprintf(stderr, "kernel_launch: memset failed\n"); return; }
    Args a{};
    for (int i = 0; i < 31; ++i) a.in[i] = (const float*)d_in[i];
    a.out = (float*)d_out; a.ws = (unsigned char*)d_ws;
#if MK_PER_PHASE
#ifndef REPMASK
#define REPMASK 0u
#endif
    for (int p = 0; p < NPH; ++p) { a.ph_lo = p; a.ph_hi = p + 1; hipLaunchKernelGGL(mega_fwd, dim3(grid), dim3(NWAVES * 64), LDS_BYTES, stream, a);
        if ((REPMASK >> p) & 1u) hipLaunchKernelGGL(mega_fwd, dim3(grid), dim3(NWAVES * 64), LDS_BYTES, stream, a); }
#else
    a.ph_lo = 0; a.ph_hi = NPH;
    hipLaunchKernelGGL(mega_fwd, dim3(grid), dim3(NWAVES * 64), LDS_BYTES, stream, a);
#endif
    const hipError_t le = hipPeekAtLastError();
    if (le != hipSuccess) fprintf(stderr, "kernel_launch: launch failed: %s\n", hipGetErrorName(le));
}
```

```cpp
#define MK_PER_PHASE 0
#define REPMASK 0u
#define BAND_REP 1
#define PROBE_REP 0u
#define PROBE_REPN 1
#define PROBE_P0N 0
#include <hip/hip_runtime.h>
#include <cstdio>
#include <cstdint>
namespace pg8 {
#define PG8_LAS __attribute__((address_space(3)))
typedef unsigned short bf16_t;
typedef short bf16x8 __attribute__((ext_vector_type(8)));
typedef float f32x4 __attribute__((ext_vector_type(4)));
typedef unsigned u32x4 __attribute__((ext_vector_type(4)));
constexpr int BM = 256, BK = 64, HALF = 128, HTB = HALF * BK * 2  , STAGE_BYTES = 8 * HTB, NXCD = 8, WGM = 8;

__host__ __device__ __forceinline__ int lds_byte(int r, int c) { const int st = (r >> 4) * 2 + (c >> 5), rr = r & 15, cc = c & 31, ob = rr * 64 + cc * 2; return st * 1024 + (ob ^ (((ob >> 9) & 1) << 5)); }
__host__ __device__ __forceinline__ void stage_rc(int b, int& R, int& C) { const int st = b / 1024, sb = b % 1024, swz = sb ^ (((sb >> 9) & 1) << 5); R = (st >> 1) * 16 + swz / 64; C = (st & 1) * 32 + (swz % 64) / 2; }
__host__ __device__ __forceinline__ int perm32(int rho) { const int n = rho >> 4, i = rho & 15; return 8 * (i >> 2) + 4 * n + (i & 3); }

struct Unit { int pm, pn; };
struct Gemm { const bf16_t* A; const bf16_t* Bt; int M, N, K; };

constexpr int PG8_NVM = 8;

struct StaticOrder {
    int nM, nN, nwg, G, c;
    __host__ __device__ void init(int M, int N, int G_, int c_) { nM = M / BM; nN = N / BM; nwg = nM * nN; G = G_; c = c_; }
    __host__ __device__ bool next(int i, Unit& u) const {
        const long L = (long)i * G + c; if (L >= nwg) return false;
        int wgid = (int)L; { const int q = nwg / NXCD, r = nwg % NXCD, xcd = wgid % NXCD, off = wgid / NXCD; wgid = (xcd < r ? xcd * (q + 1) : r * (q + 1) + (xcd - r) * q) + off; }
        const int nig = WGM * nN, gid = wgid / nig, fm = gid * WGM, gsz = (nM - fm) < WGM ? (nM - fm) : WGM;
        u.pm = fm + ((wgid % nig) % gsz); u.pn = (wgid % nig) / gsz; return true;
    }
    __device__ __forceinline__ void a_ready(const Unit&) const {}
    __device__ __forceinline__ void done(const Unit&) const {}
};

struct RowLocalOrder {
    int nM, nN, G, c;
    __host__ __device__ void init(int M, int N, int G_, int c_) { nM = M / BM; nN = N / BM; G = G_; c = c_; }
    __host__ __device__ bool next(int i, Unit& u) const { const int t = i / nN; const int pm = c + t * G; if (pm >= nM) return false; u.pm = pm; u.pn = i - t * nN; return true; }
    __device__ __forceinline__ void a_ready(const Unit&) const {}
    __device__ __forceinline__ void done(const Unit&) const {}
};

__device__ __forceinline__ unsigned cvt_pk_bf16(float lo, float hi) { unsigned r; asm volatile("v_cvt_pk_bf16_f32 %0, %1, %2" : "=v"(r) : "v"(lo), "v"(hi)); return r; }
typedef float f32x2 __attribute__((ext_vector_type(2)));
__device__ __forceinline__ f32x2 gelu_pk(f32x2 v) {
    const f32x2 av = __builtin_elementwise_abs(v), d = av * 0.2316418882f + 1.0f;
    f32x2 t; t.x = __builtin_amdgcn_rcpf(d.x); t.y = __builtin_amdgcn_rcpf(d.y);
    f32x2 q = t * 0.5307027145f + (-0.7265760135f); q = q * t + 0.7107068705f; q = q * t + (-0.142248368f); q = q * t + 0.127414796f; q = q * t;
    const f32x2 s = (v * v) * (-0.72134752044f);
    f32x2 e; e.x = __builtin_amdgcn_exp2f(s.x); e.y = __builtin_amdgcn_exp2f(s.y);
    const f32x2 m = v * (q * e), r = v - m;
    f32x2 o; o.x = v.x < 0.f ? m.x : r.x; o.y = v.y < 0.f ? m.y : r.y; return o;
}

template <int ACT  > struct EpiBf16 {
    static constexpr bool PERM = true, AFTER_DRAIN = false; static_assert(ACT == 0 || ACT == 1, "EpiBf16: ACT is 0 (none) or 1 (gelu_pk)");
    bf16_t* O; int ldc; const float* bias; int split_cols; size_t split_stride; float scale0;
    __device__ __forceinline__ void operator()(const f32x4 (&acc)[2][2][4][2], const Unit& u, int wr, int wc, int fr, int fq) const {
        const int row0 = u.pm * BM + wr * 64 + fr; int colt = u.pn * BM; bf16_t* base = O;
        float sc = 1.f; if (split_cols) { const int t = colt / split_cols; base += (size_t)t * split_stride; colt -= t * split_cols; if (t == 0) sc = scale0; }
        const int col0 = colt + wc * 32 + 8 * fq, bcol0 = u.pn * BM + wc * 32 + 8 * fq;
        f32x4 bv[2][2];
#pragma unroll
        for (int bj = 0; bj < 2; ++bj)
#pragma unroll
            for (int n = 0; n < 2; ++n) bv[bj][n] = bias ? *(const f32x4*)(bias + bcol0 + bj * HALF + 4 * n) : (f32x4){0.f, 0.f, 0.f, 0.f};
#pragma unroll
        for (int ai = 0; ai < 2; ++ai)
#pragma unroll
            for (int m = 0; m < 4; ++m) { bf16_t* rowp = base + (size_t)(row0 + ai * HALF + m * 16) * ldc + col0;
#pragma unroll
                for (int bj = 0; bj < 2; ++bj) { f32x4 v0 = acc[ai][bj][m][0] + bv[bj][0], v1 = acc[ai][bj][m][1] + bv[bj][1];
                    if (ACT == 1) { f32x2 a = gelu_pk((f32x2){v0[0], v0[1]}), b = gelu_pk((f32x2){v0[2], v0[3]}), c = gelu_pk((f32x2){v1[0], v1[1]}), d = gelu_pk((f32x2){v1[2], v1[3]});
                        v0 = (f32x4){a.x, a.y, b.x, b.y}; v1 = (f32x4){c.x, c.y, d.x, d.y}; }
                    v0 = v0 * sc; v1 = v1 * sc; u32x4 w; w.x = cvt_pk_bf16(v0[0], v0[1]); w.y = cvt_pk_bf16(v0[2], v0[3]); w.z = cvt_pk_bf16(v1[0], v1[1]); w.w = cvt_pk_bf16(v1[2], v1[3]);
                    *(u32x4*)(rowp + bj * HALF) = w; } }
    }
};
template <class Epi, class Sched, bool ALIGN_EPI = false, bool SP2 = false>
__device__ __forceinline__ void gemm_phase(PG8_LAS unsigned char* lds, const Gemm g, const Sched& S, const Epi& E) {
    int tid = threadIdx.x; asm volatile("" : "+v"(tid));
    const int wid = __builtin_amdgcn_readfirstlane(tid >> 6), lane = tid & 63, wr = wid >> 2, wc = wid & 3, fr = lane & 15, fq = lane >> 4;
    int K = g.K; asm volatile("" : "+s"(K));
    const int nt = K / BK;
    unsigned voffA[2], voffB[2];
#pragma unroll
    for (int i = 0; i < 2; ++i) { int R, C; stage_rc(tid * 16 + i * 8192, R, C); const int Rb = Epi::PERM ? ((R & ~31) + perm32(R & 31)) : R;
        voffA[i] = (unsigned)(R * K + C) * 2u; voffB[i] = (unsigned)(Rb * K + C) * 2u; }
    const size_t kstep = (size_t)(BK * 2);
    const size_t hstep = (size_t)HALF * K * 2;
    const size_t tstep = 2 * hstep;
    const unsigned ldsw = (unsigned)wid * 1024u;
    const int aoff = lds_byte(wr * 64 + fr, fq * 8), boff = lds_byte(wc * 32 + fr, fq * 8);
#define PG8_SA(b, h) (((b) * 2 + (h)) * HTB)
#define PG8_SB(b, h) ((4 + (b) * 2 + (h)) * HTB)
#define PG8_STAGE(bufoff, gbase, voff) do { _Pragma("unroll") for (int _i = 0; _i < 2; ++_i) \
        __builtin_amdgcn_global_load_lds((const unsigned*)((const char*)(gbase) + (voff)[_i]), (PG8_LAS unsigned*)(lds + (bufoff) + ldsw + _i * 8192), 16, 0, 0); } while (0)
#define PG8_LDA(dst, b, h) do { _Pragma("unroll") for (int m = 0; m < 4; ++m) _Pragma("unroll") for (int k = 0; k < 2; ++k) dst[m][k] = *(const PG8_LAS bf16x8*)(lds + PG8_SA(b, h) + aoff + m * 2048 + k * 1024); } while (0)
#define PG8_LDB(dst, b, h) do { _Pragma("unroll") for (int n = 0; n < 2; ++n) _Pragma("unroll") for (int k = 0; k < 2; ++k) dst[n][k] = *(const PG8_LAS bf16x8*)(lds + PG8_SB(b, h) + boff + n * 2048 + k * 1024); } while (0)
#define PG8_MMA(ai, bj, At, Bt) do { __builtin_amdgcn_s_setprio(1); _Pragma("unroll") for (int m = 0; m < 4; ++m) _Pragma("unroll") for (int n = 0; n < 2; ++n) _Pragma("unroll") for (int k = 0; k < 2; ++k) \
        acc[ai][bj][m][n] = __builtin_amdgcn_mfma_f32_16x16x32_bf16(Bt[n][k], At[m][k], acc[ai][bj][m][n], 0, 0, 0); __builtin_amdgcn_s_setprio(0); } while (0)
#define PG8_WAIT_V(n) asm volatile("s_waitcnt vmcnt(" #n ")" ::: "memory")
#define PG8_WAIT_L(n) asm volatile("s_waitcnt lgkmcnt(" #n ")" ::: "memory")
#define PG8_BAR __builtin_amdgcn_s_barrier()
#define PG8_SCHED __builtin_amdgcn_sched_barrier(0)
    Unit cur, nxt; int ui = 0;
    if (!S.next(0, cur)) return;
    f32x4 acc[2][2][4][2];
#pragma unroll
    for (int a = 0; a < 2; ++a)
#pragma unroll
        for (int b = 0; b < 2; ++b)
#pragma unroll
            for (int m = 0; m < 4; ++m)
#pragma unroll
                for (int n = 0; n < 2; ++n) acc[a][b][m][n] = (f32x4){0.f, 0.f, 0.f, 0.f};
    bf16x8 At[4][2], B0[2][2], B1[2][2];
    const char* cA = (const char*)g.A + (size_t)cur.pm * tstep; const char* cB = (const char*)g.Bt + (size_t)cur.pn * tstep;
    S.a_ready(cur);
    if constexpr (SP2) {
        PG8_STAGE(PG8_SB(0, 0), cB, voffB); PG8_STAGE(PG8_SB(0, 1), cB + hstep, voffB); PG8_STAGE(PG8_SA(0, 0), cA, voffA); PG8_STAGE(PG8_SA(0, 1), cA + hstep, voffA);
        if (wr == 1) PG8_BAR;
        PG8_WAIT_V(2); PG8_BAR;
        PG8_STAGE(PG8_SB(1, 0), cB + kstep, voffB); PG8_STAGE(PG8_SA(1, 0), cA + kstep, voffA); PG8_STAGE(PG8_SB(1, 1), cB + hstep + kstep, voffB);
        PG8_WAIT_V(6); PG8_BAR;
    } else {
        PG8_STAGE(PG8_SB(0, 0), cB, voffB); PG8_STAGE(PG8_SA(0, 0), cA, voffA); PG8_STAGE(PG8_SB(0, 1), cB + hstep, voffB); PG8_STAGE(PG8_SA(0, 1), cA + hstep, voffA);
        if (wr == 1) PG8_BAR;
        PG8_WAIT_V(4); PG8_BAR;
        PG8_STAGE(PG8_SB(1, 0), cB + kstep, voffB); PG8_STAGE(PG8_SA(1, 0), cA + kstep, voffA); PG8_STAGE(PG8_SB(1, 1), cB + hstep + kstep, voffB);
        PG8_WAIT_V(6); PG8_BAR;
    }
    for (;;) {
        const bool has_next = S.next(ui + 1, nxt);
        const char* nA = has_next ? (const char*)g.A + (size_t)nxt.pm * tstep : cA; const char* nB = has_next ? (const char*)g.Bt + (size_t)nxt.pn * tstep : cB;
        int t = 0;
#pragma unroll 1
        do {
            const bool last = (t == nt - 2);
            const char* a1 = cA + (size_t)(t + 1) * kstep;
            const char* a2 = last ? nA : cA + (size_t)(t + 2) * kstep; const char* b2 = last ? nB : cB + (size_t)(t + 2) * kstep;
            const char* a3 = a2 + kstep; const char* b3 = b2 + kstep;
            if (last && has_next) S.a_ready(nxt);
            if constexpr (SP2) {
            PG8_LDB(B0, 0, 0); PG8_LDB(B1, 0, 1); PG8_SCHED; PG8_LDA(At, 0, 0); PG8_STAGE(PG8_SA(1, 1), a1 + hstep, voffA);
            PG8_WAIT_V(8); PG8_WAIT_L(0); PG8_BAR; PG8_MMA(0, 0, At, B0); PG8_MMA(0, 1, At, B1); PG8_BAR; PG8_SCHED;
            PG8_LDA(At, 0, 1); PG8_STAGE(PG8_SB(0, 0), b2, voffB); PG8_STAGE(PG8_SB(0, 1), b2 + hstep, voffB); PG8_STAGE(PG8_SA(0, 0), a2, voffA);
            PG8_WAIT_V(8); PG8_WAIT_L(0); PG8_BAR; PG8_MMA(1, 0, At, B0); PG8_MMA(1, 1, At, B1); PG8_BAR; PG8_SCHED;
            PG8_LDB(B0, 1, 0); PG8_LDB(B1, 1, 1); PG8_SCHED; PG8_LDA(At, 1, 0); PG8_STAGE(PG8_SA(0, 1), a2 + hstep, voffA);
            PG8_WAIT_V(8); PG8_WAIT_L(0); PG8_BAR; PG8_MMA(0, 0, At, B0); PG8_MMA(0, 1, At, B1); PG8_BAR; PG8_SCHED;
            PG8_LDA(At, 1, 1); PG8_STAGE(PG8_SB(1, 0), b3, voffB); PG8_STAGE(PG8_SB(1, 1), b3 + hstep, voffB); PG8_STAGE(PG8_SA(1, 0), a3, voffA);
            PG8_WAIT_V(8); PG8_WAIT_L(0); PG8_BAR; PG8_MMA(1, 0, At, B0); PG8_MMA(1, 1, At, B1); PG8_BAR; PG8_SCHED;
            } else {
            PG8_LDB(B0, 0, 0); PG8_SCHED; PG8_LDA(At, 0, 0); PG8_STAGE(PG8_SA(1, 1), a1 + hstep, voffA);
            PG8_WAIT_L(8); PG8_BAR; PG8_WAIT_L(0); PG8_MMA(0, 0, At, B0); PG8_BAR; PG8_SCHED;
            PG8_LDB(B1, 0, 1); PG8_STAGE(PG8_SB(0, 0), b2, voffB);
            PG8_BAR; PG8_WAIT_L(0); PG8_MMA(0, 1, At, B1); PG8_BAR;
            PG8_LDA(At, 0, 1); PG8_STAGE(PG8_SA(0, 0), a2, voffA);
            PG8_BAR; PG8_WAIT_L(0); PG8_MMA(1, 0, At, B0); PG8_BAR; PG8_SCHED;
            PG8_STAGE(PG8_SB(0, 1), b2 + hstep, voffB);
            PG8_WAIT_V(6); PG8_BAR; PG8_MMA(1, 1, At, B1); PG8_BAR;
            PG8_LDB(B0, 1, 0); PG8_SCHED; PG8_LDA(At, 1, 0); PG8_STAGE(PG8_SA(0, 1), a2 + hstep, voffA);
            PG8_WAIT_L(8); PG8_BAR; PG8_WAIT_L(0); PG8_MMA(0, 0, At, B0); PG8_BAR; PG8_SCHED;
            PG8_LDB(B1, 1, 1); PG8_STAGE(PG8_SB(1, 0), b3, voffB);
            PG8_BAR; PG8_WAIT_L(0); PG8_MMA(0, 1, At, B1); PG8_BAR;
            PG8_LDA(At, 1, 1); PG8_STAGE(PG8_SA(1, 0), a3, voffA);
            PG8_BAR; PG8_WAIT_L(0); PG8_MMA(1, 0, At, B0); PG8_BAR; PG8_SCHED;
            PG8_STAGE(PG8_SB(1, 1), b3 + hstep, voffB);
            PG8_WAIT_V(6); PG8_BAR; PG8_MMA(1, 1, At, B1); PG8_BAR;
            }
            t += 2;
        } while (t < nt);
        if constexpr (ALIGN_EPI) { if (wr == 0) PG8_BAR; }
        if constexpr (!Epi::AFTER_DRAIN) { E(acc, cur, wr, wc, fr, fq); S.done(cur); }
        if (!has_next) break;
#pragma unroll
        for (int a = 0; a < 2; ++a)
#pragma unroll
            for (int b = 0; b < 2; ++b)
#pragma unroll
                for (int m = 0; m < 4; ++m)
#pragma unroll
                    for (int n = 0; n < 2; ++n) acc[a][b][m][n] = (f32x4){0.f, 0.f, 0.f, 0.f};
        cur = nxt; cA = nA; cB = nB; ++ui;
        if constexpr (ALIGN_EPI) { if (wr == 1) PG8_BAR; }
    }
    PG8_WAIT_V(0);
    if constexpr (!ALIGN_EPI) { if (wr == 0) PG8_BAR; }
    PG8_BAR;
    if constexpr (Epi::AFTER_DRAIN) { E.fused(acc, cur, wr, wc, fr, fq, lds, wid, lane); S.done(cur); }
#undef PG8_SA
#undef PG8_SB
#undef PG8_STAGE
#undef PG8_LDA
#undef PG8_LDB
#undef PG8_MMA
#undef PG8_WAIT_V
#undef PG8_WAIT_L
#undef PG8_BAR
#undef PG8_SCHED
}
typedef int v4i_t __attribute__((ext_vector_type(4)));
typedef int v8i_t __attribute__((ext_vector_type(8)));
template <class Epi, class Sched, bool ALIGN_EPI = false, bool SP2 = false>
__device__ __forceinline__ void gemm_phase8(PG8_LAS unsigned char* lds, const Gemm g, const Sched& S, const Epi& E) {
    int tid = threadIdx.x; asm volatile("" : "+v"(tid));
    const int wid = __builtin_amdgcn_readfirstlane(tid >> 6), lane = tid & 63, wr = wid >> 2, wc = wid & 3, fr = lane & 15, fq = lane >> 4;
    int K = g.K; asm volatile("" : "+s"(K));
    const int nt = K / BK;
    unsigned voffA[2], voffB[2];
#pragma unroll
    for (int i = 0; i < 2; ++i) { int R, C; stage_rc(tid * 16 + i * 8192, R, C); const int Rb = Epi::PERM ? ((R & ~31) + perm32(R & 31)) : R;
        voffA[i] = (unsigned)(R * K + C) * 2u; voffB[i] = (unsigned)(Rb * K + C) * 2u; }
    const size_t kstep = (size_t)(BK * 2);
    const size_t hstep = (size_t)HALF * K * 2;
    const size_t tstep = 2 * hstep;
    const unsigned ldsw = (unsigned)wid * 1024u;
    const int aoff = lds_byte(wr * 64 + fr, fq * 8), boff = lds_byte(wc * 32 + fr, fq * 8);
#define PG8_SA(b, h) (((b) * 2 + (h)) * HTB)
#define PG8_SB(b, h) ((4 + (b) * 2 + (h)) * HTB)
#define PG8_STAGE(bufoff, gbase, voff) do { _Pragma("unroll") for (int _i = 0; _i < 2; ++_i) \
        __builtin_amdgcn_global_load_lds((const unsigned*)((const char*)(gbase) + (voff)[_i]), (PG8_LAS unsigned*)(lds + (bufoff) + ldsw + _i * 8192), 16, 0, 0); } while (0)
#define PG8_LDA(dst, b, h) do { _Pragma("unroll") for (int m = 0; m < 4; ++m) { const v4i_t lo_ = *(const PG8_LAS v4i_t*)(lds + PG8_SA(b, h) + aoff + m * 2048), hi_ = *(const PG8_LAS v4i_t*)(lds + PG8_SA(b, h) + aoff + m * 2048 + 1024); dst[m] = __builtin_shufflevector(lo_, hi_, 0, 1, 2, 3, 4, 5, 6, 7); } } while (0)
#define PG8_LDB(dst, b, h) do { _Pragma("unroll") for (int n = 0; n < 2; ++n) { const v4i_t lo_ = *(const PG8_LAS v4i_t*)(lds + PG8_SB(b, h) + boff + n * 2048), hi_ = *(const PG8_LAS v4i_t*)(lds + PG8_SB(b, h) + boff + n * 2048 + 1024); dst[n] = __builtin_shufflevector(lo_, hi_, 0, 1, 2, 3, 4, 5, 6, 7); } } while (0)
#define PG8_MMA(ai, bj, At, Bt) do { __builtin_amdgcn_s_setprio(1); _Pragma("unroll") for (int m = 0; m < 4; ++m) _Pragma("unroll") for (int n = 0; n < 2; ++n) \
        asm volatile("v_mfma_scale_f32_16x16x128_f8f6f4 %0, %1, %2, %0, %3, %3 op_sel_hi:[0,0,0]" : "+v"(acc[ai][bj][m][n]) : "v"(Bt[n]), "v"(At[m]), "v"(sclv)); __builtin_amdgcn_s_setprio(0); } while (0)
#define PG8_WAIT_V(n) asm volatile("s_waitcnt vmcnt(" #n ")" ::: "memory")
#define PG8_WAIT_V_RELAXED(n) asm volatile("s_waitcnt vmcnt(%0)" :: "n"((n) + PG8_NVM) : "memory")
#define PG8_MMA0(ai, bj, At, Bt) do { __builtin_amdgcn_s_setprio(1); _Pragma("unroll") for (int m = 0; m < 4; ++m) _Pragma("unroll") for (int n = 0; n < 2; ++n) \
        asm volatile("v_mfma_scale_f32_16x16x128_f8f6f4 %0, %1, %2, 0, %3, %3 op_sel_hi:[0,0,0]" : "=&v"(acc[ai][bj][m][n]) : "v"(Bt[n]), "v"(At[m]), "v"(sclv)); __builtin_amdgcn_s_setprio(0); } while (0)
#define PG8_WAIT_L(n) asm volatile("s_waitcnt lgkmcnt(" #n ")" ::: "memory")
#define PG8_BAR __builtin_amdgcn_s_barrier()
#define PG8_SCHED __builtin_amdgcn_sched_barrier(0)
    Unit cur, nxt; int ui = 0;
    if (!S.next(0, cur)) return;
    f32x4 acc[2][2][4][2];
#pragma unroll
    for (int a = 0; a < 2; ++a)
#pragma unroll
        for (int b = 0; b < 2; ++b)
#pragma unroll
            for (int m = 0; m < 4; ++m)
#pragma unroll
                for (int n = 0; n < 2; ++n) acc[a][b][m][n] = (f32x4){0.f, 0.f, 0.f, 0.f};
    v8i_t At[4], B0[2], B1[2];
    int sclv = 0x7f7f7f7f; asm volatile("" : "+v"(sclv));
    const char* cA = (const char*)g.A + (size_t)cur.pm * tstep; const char* cB = (const char*)g.Bt + (size_t)cur.pn * tstep;
    S.a_ready(cur);
    if constexpr (SP2) {
        PG8_STAGE(PG8_SB(0, 0), cB, voffB); PG8_STAGE(PG8_SB(0, 1), cB + hstep, voffB); PG8_STAGE(PG8_SA(0, 0), cA, voffA); PG8_STAGE(PG8_SA(0, 1), cA + hstep, voffA);
        if (wr == 1) PG8_BAR;
        PG8_WAIT_V(2); PG8_BAR;
        PG8_STAGE(PG8_SB(1, 0), cB + kstep, voffB); PG8_STAGE(PG8_SA(1, 0), cA + kstep, voffA); PG8_STAGE(PG8_SB(1, 1), cB + hstep + kstep, voffB);
        PG8_WAIT_V(6); PG8_BAR;
    } else {
        PG8_STAGE(PG8_SB(0, 0), cB, voffB); PG8_STAGE(PG8_SA(0, 0), cA, voffA); PG8_STAGE(PG8_SB(0, 1), cB + hstep, voffB); PG8_STAGE(PG8_SA(0, 1), cA + hstep, voffA);
        if (wr == 1) PG8_BAR;
        PG8_WAIT_V(4); PG8_BAR;
        PG8_STAGE(PG8_SB(1, 0), cB + kstep, voffB); PG8_STAGE(PG8_SA(1, 0), cA + kstep, voffA); PG8_STAGE(PG8_SB(1, 1), cB + hstep + kstep, voffB);
        PG8_WAIT_V(6); PG8_BAR;
    }
    for (;;) {
        const bool has_next = S.next(ui + 1, nxt);
        const char* nA = has_next ? (const char*)g.A + (size_t)nxt.pm * tstep : cA; const char* nB = has_next ? (const char*)g.Bt + (size_t)nxt.pn * tstep : cB;
        int t = 0;
        if (ui > 0) {
            static_assert(SP2, "peeled first K-tile pair: SP2 loop only");
            const bool last = (t == nt - 2);
            const char* a1 = cA + (size_t)(t + 1) * kstep;
            const char* a2 = last ? nA : cA + (size_t)(t + 2) * kstep; const char* b2 = last ? nB : cB + (size_t)(t + 2) * kstep;
            const char* a3 = a2 + kstep; const char* b3 = b2 + kstep;
            if (last && has_next) S.a_ready(nxt);
            if constexpr (SP2) {
            PG8_LDB(B0, 0, 0); PG8_LDB(B1, 0, 1); PG8_SCHED; PG8_LDA(At, 0, 0); PG8_STAGE(PG8_SA(1, 1), a1 + hstep, voffA);
            PG8_WAIT_V_RELAXED(8); PG8_WAIT_L(0); PG8_BAR; PG8_MMA0(0, 0, At, B0); PG8_MMA0(0, 1, At, B1); PG8_BAR; PG8_SCHED;
            PG8_LDA(At, 0, 1); PG8_STAGE(PG8_SB(0, 0), b2, voffB); PG8_STAGE(PG8_SB(0, 1), b2 + hstep, voffB); PG8_STAGE(PG8_SA(0, 0), a2, voffA);
            PG8_WAIT_V_RELAXED(8); PG8_WAIT_L(0); PG8_BAR; PG8_MMA0(1, 0, At, B0); PG8_MMA0(1, 1, At, B1); PG8_BAR; PG8_SCHED;
            PG8_LDB(B0, 1, 0); PG8_LDB(B1, 1, 1); PG8_SCHED; PG8_LDA(At, 1, 0); PG8_STAGE(PG8_SA(0, 1), a2 + hstep, voffA);
            PG8_WAIT_V(8); PG8_WAIT_L(0); PG8_BAR; PG8_MMA(0, 0, At, B0); PG8_MMA(0, 1, At, B1); PG8_BAR; PG8_SCHED;
            PG8_LDA(At, 1, 1); PG8_STAGE(PG8_SB(1, 0), b3, voffB); PG8_STAGE(PG8_SB(1, 1), b3 + hstep, voffB); PG8_STAGE(PG8_SA(1, 0), a3, voffA);
            PG8_WAIT_V(8); PG8_WAIT_L(0); PG8_BAR; PG8_MMA(1, 0, At, B0); PG8_MMA(1, 1, At, B1); PG8_BAR; PG8_SCHED;
            } else {
            PG8_LDB(B0, 0, 0); PG8_SCHED; PG8_LDA(At, 0, 0); PG8_STAGE(PG8_SA(1, 1), a1 + hstep, voffA);
            PG8_WAIT_L(8); PG8_BAR; PG8_WAIT_L(0); PG8_MMA(0, 0, At, B0); PG8_BAR; PG8_SCHED;
            PG8_LDB(B1, 0, 1); PG8_STAGE(PG8_SB(0, 0), b2, voffB);
            PG8_BAR; PG8_WAIT_L(0); PG8_MMA(0, 1, At, B1); PG8_BAR;
            PG8_LDA(At, 0, 1); PG8_STAGE(PG8_SA(0, 0), a2, voffA);
            PG8_BAR; PG8_WAIT_L(0); PG8_MMA(1, 0, At, B0); PG8_BAR; PG8_SCHED;
            PG8_STAGE(PG8_SB(0, 1), b2 + hstep, voffB);
            PG8_WAIT_V(6); PG8_BAR; PG8_MMA(1, 1, At, B1); PG8_BAR;
            PG8_LDB(B0, 1, 0); PG8_SCHED; PG8_LDA(At, 1, 0); PG8_STAGE(PG8_SA(0, 1), a2 + hstep, voffA);
            PG8_WAIT_L(8); PG8_BAR; PG8_WAIT_L(0); PG8_MMA(0, 0, At, B0); PG8_BAR; PG8_SCHED;
            PG8_LDB(B1, 1, 1); PG8_STAGE(PG8_SB(1, 0), b3, voffB);
            PG8_BAR; PG8_WAIT_L(0); PG8_MMA(0, 1, At, B1); PG8_BAR;
            PG8_LDA(At, 1, 1); PG8_STAGE(PG8_SA(1, 0), a3, voffA);
            PG8_BAR; PG8_WAIT_L(0); PG8_MMA(1, 0, At, B0); PG8_BAR; PG8_SCHED;
            PG8_STAGE(PG8_SB(1, 1), b3 + hstep, voffB);
            PG8_WAIT_V(6); PG8_BAR; PG8_MMA(1, 1, At, B1); PG8_BAR;
            }
            t = 2;
        }
#pragma unroll 1
        while (t < nt) {
            const bool last = (t == nt - 2);
            const char* a1 = cA + (size_t)(t + 1) * kstep;
            const char* a2 = last ? nA : cA + (size_t)(t + 2) * kstep; const char* b2 = last ? nB : cB + (size_t)(t + 2) * kstep;
            const char* a3 = a2 + kstep; const char* b3 = b2 + kstep;
            if (last && has_next) S.a_ready(nxt);
            if constexpr (SP2) {
            PG8_LDB(B0, 0, 0); PG8_LDB(B1, 0, 1); PG8_SCHED; PG8_LDA(At, 0, 0); PG8_STAGE(PG8_SA(1, 1), a1 + hstep, voffA);
            PG8_WAIT_V(8); PG8_WAIT_L(0); PG8_BAR; PG8_MMA(0, 0, At, B0); PG8_MMA(0, 1, At, B1); PG8_BAR; PG8_SCHED;
            PG8_LDA(At, 0, 1); PG8_STAGE(PG8_SB(0, 0), b2, voffB); PG8_STAGE(PG8_SB(0, 1), b2 + hstep, voffB); PG8_STAGE(PG8_SA(0, 0), a2, voffA);
            PG8_WAIT_V(8); PG8_WAIT_L(0); PG8_BAR; PG8_MMA(1, 0, At, B0); PG8_MMA(1, 1, At, B1); PG8_BAR; PG8_SCHED;
            PG8_LDB(B0, 1, 0); PG8_LDB(B1, 1, 1); PG8_SCHED; PG8_LDA(At, 1, 0); PG8_STAGE(PG8_SA(0, 1), a2 + hstep, voffA);
            PG8_WAIT_V(8); PG8_WAIT_L(0); PG8_BAR; PG8_MMA(0, 0, At, B0); PG8_MMA(0, 1, At, B1); PG8_BAR; PG8_SCHED;
            PG8_LDA(At, 1, 1); PG8_STAGE(PG8_SB(1, 0), b3, voffB); PG8_STAGE(PG8_SB(1, 1), b3 + hstep, voffB); PG8_STAGE(PG8_SA(1, 0), a3, voffA);
            PG8_WAIT_V(8); PG8_WAIT_L(0); PG8_BAR; PG8_MMA(1, 0, At, B0); PG8_MMA(1, 1, At, B1); PG8_BAR; PG8_SCHED;
            } else {
            PG8_LDB(B0, 0, 0); PG8_SCHED; PG8_LDA(At, 0, 0); PG8_STAGE(PG8_SA(1, 1), a1 + hstep, voffA);
            PG8_WAIT_L(8); PG8_BAR; PG8_WAIT_L(0); PG8_MMA(0, 0, At, B0); PG8_BAR; PG8_SCHED;
            PG8_LDB(B1, 0, 1); PG8_STAGE(PG8_SB(0, 0), b2, voffB);
            PG8_BAR; PG8_WAIT_L(0); PG8_MMA(0, 1, At, B1); PG8_BAR;
            PG8_LDA(At, 0, 1); PG8_STAGE(PG8_SA(0, 0), a2, voffA);
            PG8_BAR; PG8_WAIT_L(0); PG8_MMA(1, 0, At, B0); PG8_BAR; PG8_SCHED;
            PG8_STAGE(PG8_SB(0, 1), b2 + hstep, voffB);
            PG8_WAIT_V(6); PG8_BAR; PG8_MMA(1, 1, At, B1); PG8_BAR;
            PG8_LDB(B0, 1, 0); PG8_SCHED; PG8_LDA(At, 1, 0); PG8_STAGE(PG8_SA(0, 1), a2 + hstep, voffA);
            PG8_WAIT_L(8); PG8_BAR; PG8_WAIT_L(0); PG8_MMA(0, 0, At, B0); PG8_BAR; PG8_SCHED;
            PG8_LDB(B1, 1, 1); PG8_STAGE(PG8_SB(1, 0), b3, voffB);
            PG8_BAR; PG8_WAIT_L(0); PG8_MMA(0, 1, At, B1); PG8_BAR;
            PG8_LDA(At, 1, 1); PG8_STAGE(PG8_SA(1, 0), a3, voffA);
            PG8_BAR; PG8_WAIT_L(0); PG8_MMA(1, 0, At, B0); PG8_BAR; PG8_SCHED;
            PG8_STAGE(PG8_SB(1, 1), b3 + hstep, voffB);
            PG8_WAIT_V(6); PG8_BAR; PG8_MMA(1, 1, At, B1); PG8_BAR;
            }
            t += 2;
        }
        if constexpr (ALIGN_EPI) { if (wr == 0) PG8_BAR; }
        asm volatile("s_nop 15\n\ts_nop 15" ::: "memory");
        if constexpr (!Epi::AFTER_DRAIN) { E(acc, cur, wr, wc, fr, fq); S.done(cur); }
        if (!has_next) break;
        cur = nxt; cA = nA; cB = nB; ++ui;
        if constexpr (ALIGN_EPI) { if (wr == 1) PG8_BAR; }
    }
    PG8_WAIT_V(0);
    if constexpr (!ALIGN_EPI) { if (wr == 0) PG8_BAR; }
    PG8_BAR;
    if constexpr (Epi::AFTER_DRAIN) { E.fused(acc, cur, wr, wc, fr, fq, lds, wid, lane); S.done(cur); }
#undef PG8_SA
#undef PG8_SB
#undef PG8_STAGE
#undef PG8_LDA
#undef PG8_LDB
#undef PG8_MMA
#undef PG8_WAIT_V
#undef PG8_WAIT_V_RELAXED
#undef PG8_MMA0
#undef PG8_WAIT_L
#undef PG8_BAR
#undef PG8_SCHED
}
struct GemmG { const void* A; const bf16_t* Bt; const int* rowidx; int K; int rowbytes; };
template <class Epi, class Sched, bool ALIGN_EPI = false, bool SP2 = false>
__device__ __forceinline__ void gemm_phase8g(PG8_LAS unsigned char* lds, const GemmG g, const Sched& S, const Epi& E) {
    int tid = threadIdx.x; asm volatile("" : "+v"(tid));
    const int wid = __builtin_amdgcn_readfirstlane(tid >> 6), lane = tid & 63, wr = wid >> 2, wc = wid & 3, fr = lane & 15, fq = lane >> 4;
    int K = g.K; asm volatile("" : "+s"(K));
    const int nt = K / BK;
    unsigned voffA[2], voffB[2];
    int Rl[2]; unsigned Cb[2];
#pragma unroll
    for (int i = 0; i < 2; ++i) { int R, C; stage_rc(tid * 16 + i * 8192, R, C); const int Rb = Epi::PERM ? ((R & ~31) + perm32(R & 31)) : R;
        voffA[i] = (unsigned)(R * K + C) * 2u; voffB[i] = (unsigned)(Rb * K + C) * 2u; Rl[i] = R; Cb[i] = (unsigned)C * 2u; }
    (void)voffA;
    unsigned gC0[2], gC1[2], gN0[2], gN1[2];
#define PG8_GOFF(d0, d1, pm_) do { _Pragma("unroll") for (int _i = 0; _i < 2; ++_i) { const int* ri_ = g.rowidx + (size_t)(pm_) * BM + Rl[_i]; \
        d0[_i] = (unsigned)ri_[0] * (unsigned)g.rowbytes + Cb[_i]; d1[_i] = (unsigned)ri_[HALF] * (unsigned)g.rowbytes + Cb[_i]; } } while (0)
#define PG8_GRAW(raw, pm_) do { _Pragma("unroll") for (int _i = 0; _i < 2; ++_i) { const int* ri_ = g.rowidx + (size_t)(pm_) * BM + Rl[_i]; \
        asm volatile("global_load_dword %0, %1, off" : "=v"(raw[2 * _i]) : "v"(ri_) : "memory"); asm volatile("global_load_dword %0, %1, off offset:512" : "=v"(raw[2 * _i + 1]) : "v"(ri_) : "memory"); } } while (0)
#define PG8_GWAIT(raw) asm volatile("s_waitcnt vmcnt(4)" : "+v"(raw[0]), "+v"(raw[1]), "+v"(raw[2]), "+v"(raw[3]) :: "memory")
#define PG8_GCVT(d0, d1, raw) do { _Pragma("unroll") for (int _i = 0; _i < 2; ++_i) { d0[_i] = (unsigned)raw[2 * _i] * (unsigned)g.rowbytes + Cb[_i]; d1[_i] = (unsigned)raw[2 * _i + 1] * (unsigned)g.rowbytes + Cb[_i]; } } while (0)
    static_assert(HALF * 4 == 512, "row-index load offset");
    const size_t kstep = (size_t)(BK * 2);
    const size_t hstep = (size_t)HALF * K * 2;
    const size_t tstep = 2 * hstep;
    const unsigned ldsw = (unsigned)wid * 1024u;
    const int aoff = lds_byte(wr * 64 + fr, fq * 8), boff = lds_byte(wc * 32 + fr, fq * 8);
#define PG8_SA(b, h) (((b) * 2 + (h)) * HTB)
#define PG8_SB(b, h) ((4 + (b) * 2 + (h)) * HTB)
#define PG8_STAGE(bufoff, gbase, voff) do { _Pragma("unroll") for (int _i = 0; _i < 2; ++_i) \
        __builtin_amdgcn_global_load_lds((const unsigned*)((const char*)(gbase) + (voff)[_i]), (PG8_LAS unsigned*)(lds + (bufoff) + ldsw + _i * 8192), 16, 0, 0); } while (0)
#define PG8_LDA(dst, b, h) do { _Pragma("unroll") for (int m = 0; m < 4; ++m) { const v4i_t lo_ = *(const PG8_LAS v4i_t*)(lds + PG8_SA(b, h) + aoff + m * 2048), hi_ = *(const PG8_LAS v4i_t*)(lds + PG8_SA(b, h) + aoff + m * 2048 + 1024); dst[m] = __builtin_shufflevector(lo_, hi_, 0, 1, 2, 3, 4, 5, 6, 7); } } while (0)
#define PG8_LDB(dst, b, h) do { _Pragma("unroll") for (int n = 0; n < 2; ++n) { const v4i_t lo_ = *(const PG8_LAS v4i_t*)(lds + PG8_SB(b, h) + boff + n * 2048), hi_ = *(const PG8_LAS v4i_t*)(lds + PG8_SB(b, h) + boff + n * 2048 + 1024); dst[n] = __builtin_shufflevector(lo_, hi_, 0, 1, 2, 3, 4, 5, 6, 7); } } while (0)
#define PG8_MMA(ai, bj, At, Bt) do { __builtin_amdgcn_s_setprio(1); _Pragma("unroll") for (int m = 0; m < 4; ++m) _Pragma("unroll") for (int n = 0; n < 2; ++n) \
        asm volatile("v_mfma_scale_f32_16x16x128_f8f6f4 %0, %1, %2, %0, %3, %3 op_sel_hi:[0,0,0]" : "+v"(acc[ai][bj][m][n]) : "v"(Bt[n]), "v"(At[m]), "v"(sclv)); __builtin_amdgcn_s_setprio(0); } while (0)
#define PG8_WAIT_V(n) asm volatile("s_waitcnt vmcnt(" #n ")" ::: "memory")
#define PG8_WAIT_V_RELAXED(n) asm volatile("s_waitcnt vmcnt(%0)" :: "n"((n) + PG8_NVM) : "memory")
#define PG8_MMA0(ai, bj, At, Bt) do { __builtin_amdgcn_s_setprio(1); _Pragma("unroll") for (int m = 0; m < 4; ++m) _Pragma("unroll") for (int n = 0; n < 2; ++n) \
        asm volatile("v_mfma_scale_f32_16x16x128_f8f6f4 %0, %1, %2, 0, %3, %3 op_sel_hi:[0,0,0]" : "=&v"(acc[ai][bj][m][n]) : "v"(Bt[n]), "v"(At[m]), "v"(sclv)); __builtin_amdgcn_s_setprio(0); } while (0)
#define PG8_WAIT_L(n) asm volatile("s_waitcnt lgkmcnt(" #n ")" ::: "memory")
#define PG8_BAR __builtin_amdgcn_s_barrier()
#define PG8_SCHED __builtin_amdgcn_sched_barrier(0)
    Unit cur, nxt, nn; int ui = 0;
    if (!S.next(0, cur)) return;
    bool has_next = S.next(1, nxt);
    int rawN[4] = {0, 0, 0, 0};
    f32x4 acc[2][2][4][2];
#pragma unroll
    for (int a = 0; a < 2; ++a)
#pragma unroll
        for (int b = 0; b < 2; ++b)
#pragma unroll
            for (int m = 0; m < 4; ++m)
#pragma unroll
                for (int n = 0; n < 2; ++n) acc[a][b][m][n] = (f32x4){0.f, 0.f, 0.f, 0.f};
    v8i_t At[4], B0[2], B1[2];
    int sclv = 0x7f7f7f7f; asm volatile("" : "+v"(sclv));
    const char* cA = (const char*)g.A; const char* cB = (const char*)g.Bt + (size_t)cur.pn * tstep;
    PG8_GOFF(gC0, gC1, cur.pm);
    if (has_next) PG8_GOFF(gN0, gN1, nxt.pm); else { _Pragma("unroll") for (int _i = 0; _i < 2; ++_i) { gN0[_i] = gC0[_i]; gN1[_i] = gC1[_i]; } }
    S.a_ready(cur);
    if constexpr (SP2) {
        PG8_STAGE(PG8_SB(0, 0), cB, voffB); PG8_STAGE(PG8_SB(0, 1), cB + hstep, voffB); PG8_STAGE(PG8_SA(0, 0), cA, gC0); PG8_STAGE(PG8_SA(0, 1), cA, gC1);
        if (wr == 1) PG8_BAR;
        PG8_WAIT_V(2); PG8_BAR;
        PG8_STAGE(PG8_SB(1, 0), cB + kstep, voffB); PG8_STAGE(PG8_SA(1, 0), cA + kstep, gC0); PG8_STAGE(PG8_SB(1, 1), cB + hstep + kstep, voffB);
        PG8_WAIT_V(6); PG8_BAR;
    } else {
        PG8_STAGE(PG8_SB(0, 0), cB, voffB); PG8_STAGE(PG8_SA(0, 0), cA, gC0); PG8_STAGE(PG8_SB(0, 1), cB + hstep, voffB); PG8_STAGE(PG8_SA(0, 1), cA, gC1);
        if (wr == 1) PG8_BAR;
        PG8_WAIT_V(4); PG8_BAR;
        PG8_STAGE(PG8_SB(1, 0), cB + kstep, voffB); PG8_STAGE(PG8_SA(1, 0), cA + kstep, gC0); PG8_STAGE(PG8_SB(1, 1), cB + hstep + kstep, voffB);
        PG8_WAIT_V(6); PG8_BAR;
    }
    for (;;) {
        const char* nA = cA; const char* nB = has_next ? (const char*)g.Bt + (size_t)nxt.pn * tstep : cB;
        int t = 0;
        if (ui > 0) {
            static_assert(SP2, "peeled first K-tile pair: SP2 loop only");
            const bool last = (t == nt - 2);
            const char* a1 = cA + (size_t)(t + 1) * kstep;
            const char* a2 = last ? nA : cA + (size_t)(t + 2) * kstep; const char* b2 = last ? nB : cB + (size_t)(t + 2) * kstep;
            const char* a3 = a2 + kstep; const char* b3 = b2 + kstep;
            unsigned v20[2], v21[2];
            _Pragma("unroll") for (int _i = 0; _i < 2; ++_i) { v20[_i] = last ? gN0[_i] : gC0[_i]; v21[_i] = last ? gN1[_i] : gC1[_i]; }
            if (last && has_next) S.a_ready(nxt);
            if constexpr (SP2) {
            PG8_LDB(B0, 0, 0); PG8_LDB(B1, 0, 1); PG8_SCHED; PG8_LDA(At, 0, 0); PG8_STAGE(PG8_SA(1, 1), a1, gC1);
            PG8_WAIT_V_RELAXED(8); PG8_WAIT_L(0); PG8_BAR; PG8_MMA0(0, 0, At, B0); PG8_MMA0(0, 1, At, B1); PG8_BAR; PG8_SCHED;
            PG8_LDA(At, 0, 1); PG8_STAGE(PG8_SB(0, 0), b2, voffB); PG8_STAGE(PG8_SB(0, 1), b2 + hstep, voffB); PG8_STAGE(PG8_SA(0, 0), a2, v20);
            PG8_WAIT_V_RELAXED(8); PG8_WAIT_L(0); PG8_BAR; PG8_MMA0(1, 0, At, B0); PG8_MMA0(1, 1, At, B1); PG8_BAR; PG8_SCHED;
            PG8_LDB(B0, 1, 0); PG8_LDB(B1, 1, 1); PG8_SCHED; PG8_LDA(At, 1, 0); PG8_STAGE(PG8_SA(0, 1), a2, v21);
            PG8_WAIT_V(8); PG8_WAIT_L(0); PG8_BAR; PG8_MMA(0, 0, At, B0); PG8_MMA(0, 1, At, B1); PG8_BAR; PG8_SCHED;
            PG8_LDA(At, 1, 1); PG8_STAGE(PG8_SB(1, 0), b3, voffB); PG8_STAGE(PG8_SB(1, 1), b3 + hstep, voffB); PG8_STAGE(PG8_SA(1, 0), a3, v20);
            PG8_WAIT_V(8); PG8_WAIT_L(0); PG8_BAR; PG8_MMA(1, 0, At, B0); PG8_MMA(1, 1, At, B1); PG8_BAR; PG8_SCHED;
            } else {
            PG8_LDB(B0, 0, 0); PG8_SCHED; PG8_LDA(At, 0, 0); PG8_STAGE(PG8_SA(1, 1), a1, gC1);
            PG8_WAIT_L(8); PG8_BAR; PG8_WAIT_L(0); PG8_MMA(0, 0, At, B0); PG8_BAR; PG8_SCHED;
            PG8_LDB(B1, 0, 1); PG8_STAGE(PG8_SB(0, 0), b2, voffB);
            PG8_BAR; PG8_WAIT_L(0); PG8_MMA(0, 1, At, B1); PG8_BAR;
            PG8_LDA(At, 0, 1); PG8_STAGE(PG8_SA(0, 0), a2, v20);
            PG8_BAR; PG8_WAIT_L(0); PG8_MMA(1, 0, At, B0); PG8_BAR; PG8_SCHED;
            PG8_STAGE(PG8_SB(0, 1), b2 + hstep, voffB);
            PG8_WAIT_V(6); PG8_BAR; PG8_MMA(1, 1, At, B1); PG8_BAR;
            PG8_LDB(B0, 1, 0); PG8_SCHED; PG8_LDA(At, 1, 0); PG8_STAGE(PG8_SA(0, 1), a2, v21);
            PG8_WAIT_L(8); PG8_BAR; PG8_WAIT_L(0); PG8_MMA(0, 0, At, B0); PG8_BAR; PG8_SCHED;
            PG8_LDB(B1, 1, 1); PG8_STAGE(PG8_SB(1, 0), b3, voffB);
            PG8_BAR; PG8_WAIT_L(0); PG8_MMA(0, 1, At, B1); PG8_BAR;
            PG8_LDA(At, 1, 1); PG8_STAGE(PG8_SA(1, 0), a3, v20);
            PG8_BAR; PG8_WAIT_L(0); PG8_MMA(1, 0, At, B0); PG8_BAR; PG8_SCHED;
            PG8_STAGE(PG8_SB(1, 1), b3 + hstep, voffB);
            PG8_WAIT_V(6); PG8_BAR; PG8_MMA(1, 1, At, B1); PG8_BAR;
            }
            t = 2;
        }
#pragma unroll 1
        while (t < nt) {
            const bool last = (t == nt - 2);
            const char* a1 = cA + (size_t)(t + 1) * kstep;
            const char* a2 = last ? nA : cA + (size_t)(t + 2) * kstep; const char* b2 = last ? nB : cB + (size_t)(t + 2) * kstep;
            const char* a3 = a2 + kstep; const char* b3 = b2 + kstep;
            unsigned v20[2], v21[2];
            _Pragma("unroll") for (int _i = 0; _i < 2; ++_i) { v20[_i] = last ? gN0[_i] : gC0[_i]; v21[_i] = last ? gN1[_i] : gC1[_i]; }
            if (last && has_next) S.a_ready(nxt);
            if constexpr (SP2) {
            PG8_LDB(B0, 0, 0); PG8_LDB(B1, 0, 1); PG8_SCHED; PG8_LDA(At, 0, 0); PG8_STAGE(PG8_SA(1, 1), a1, gC1);
            PG8_WAIT_V(8); PG8_WAIT_L(0); PG8_BAR; PG8_MMA(0, 0, At, B0); PG8_MMA(0, 1, At, B1); PG8_BAR; PG8_SCHED;
            PG8_LDA(At, 0, 1); PG8_STAGE(PG8_SB(0, 0), b2, voffB); PG8_STAGE(PG8_SB(0, 1), b2 + hstep, voffB); PG8_STAGE(PG8_SA(0, 0), a2, v20);
            PG8_WAIT_V(8); PG8_WAIT_L(0); PG8_BAR; PG8_MMA(1, 0, At, B0); PG8_MMA(1, 1, At, B1); PG8_BAR; PG8_SCHED;
            PG8_LDB(B0, 1, 0); PG8_LDB(B1, 1, 1); PG8_SCHED; PG8_LDA(At, 1, 0); PG8_STAGE(PG8_SA(0, 1), a2, v21);
            PG8_WAIT_V(8); PG8_WAIT_L(0); PG8_BAR; PG8_MMA(0, 0, At, B0); PG8_MMA(0, 1, At, B1); PG8_BAR; PG8_SCHED;
            PG8_LDA(At, 1, 1); PG8_STAGE(PG8_SB(1, 0), b3, voffB); PG8_STAGE(PG8_SB(1, 1), b3 + hstep, voffB); PG8_STAGE(PG8_SA(1, 0), a3, v20);
            PG8_WAIT_V(8); PG8_WAIT_L(0); PG8_BAR; PG8_MMA(1, 0, At, B0); PG8_MMA(1, 1, At, B1); PG8_BAR; PG8_SCHED;
            } else {
            PG8_LDB(B0, 0, 0); PG8_SCHED; PG8_LDA(At, 0, 0); PG8_STAGE(PG8_SA(1, 1), a1, gC1);
            PG8_WAIT_L(8); PG8_BAR; PG8_WAIT_L(0); PG8_MMA(0, 0, At, B0); PG8_BAR; PG8_SCHED;
            PG8_LDB(B1, 0, 1); PG8_STAGE(PG8_SB(0, 0), b2, voffB);
            PG8_BAR; PG8_WAIT_L(0); PG8_MMA(0, 1, At, B1); PG8_BAR;
            PG8_LDA(At, 0, 1); PG8_STAGE(PG8_SA(0, 0), a2, v20);
            PG8_BAR; PG8_WAIT_L(0); PG8_MMA(1, 0, At, B0); PG8_BAR; PG8_SCHED;
            PG8_STAGE(PG8_SB(0, 1), b2 + hstep, voffB);
            PG8_WAIT_V(6); PG8_BAR; PG8_MMA(1, 1, At, B1); PG8_BAR;
            PG8_LDB(B0, 1, 0); PG8_SCHED; PG8_LDA(At, 1, 0); PG8_STAGE(PG8_SA(0, 1), a2, v21);
            PG8_WAIT_L(8); PG8_BAR; PG8_WAIT_L(0); PG8_MMA(0, 0, At, B0); PG8_BAR; PG8_SCHED;
            PG8_LDB(B1, 1, 1); PG8_STAGE(PG8_SB(1, 0), b3, voffB);
            PG8_BAR; PG8_WAIT_L(0); PG8_MMA(0, 1, At, B1); PG8_BAR;
            PG8_LDA(At, 1, 1); PG8_STAGE(PG8_SA(1, 0), a3, v20);
            PG8_BAR; PG8_WAIT_L(0); PG8_MMA(1, 0, At, B0); PG8_BAR; PG8_SCHED;
            PG8_STAGE(PG8_SB(1, 1), b3 + hstep, voffB);
            PG8_WAIT_V(6); PG8_BAR; PG8_MMA(1, 1, At, B1); PG8_BAR;
            }
            t += 2;
        }
        const bool has_nn = has_next && S.next(ui + 2, nn);
        if (has_nn) PG8_GRAW(rawN, nn.pm);
        if constexpr (ALIGN_EPI) { if (wr == 0) PG8_BAR; }
        asm volatile("s_nop 15\n\ts_nop 15" ::: "memory");
        if constexpr (!Epi::AFTER_DRAIN) { E(acc, cur, wr, wc, fr, fq); S.done(cur); }
        if (!has_next) break;
        cur = nxt; nxt = nn; has_next = has_nn; cA = nA; cB = nB; ++ui;
        _Pragma("unroll") for (int _i = 0; _i < 2; ++_i) { gC0[_i] = gN0[_i]; gC1[_i] = gN1[_i]; }
        PG8_GWAIT(rawN);
        if (has_next) PG8_GCVT(gN0, gN1, rawN);
        if constexpr (ALIGN_EPI) { if (wr == 1) PG8_BAR; }
    }
    PG8_WAIT_V(0);
    if constexpr (!ALIGN_EPI) { if (wr == 0) PG8_BAR; }
    PG8_BAR;
    if constexpr (Epi::AFTER_DRAIN) { E.fused(acc, cur, wr, wc, fr, fq, lds, wid, lane); S.done(cur); }
#undef PG8_SA
#undef PG8_SB
#undef PG8_STAGE
#undef PG8_GOFF
#undef PG8_GRAW
#undef PG8_GWAIT
#undef PG8_GCVT
#undef PG8_LDA
#undef PG8_LDB
#undef PG8_MMA
#undef PG8_WAIT_V
#undef PG8_WAIT_V_RELAXED
#undef PG8_MMA0
#undef PG8_WAIT_L
#undef PG8_BAR
#undef PG8_SCHED
}
}
namespace pg8 {
typedef int i32x4_t __attribute__((ext_vector_type(4)));
template <class Epi, class Sched, bool ALIGN_EPI = false, bool SP2 = false>
__device__ __forceinline__ void gemm_phase_i8(PG8_LAS unsigned char* lds, const Gemm g, const Sched& S, const Epi& E) {
    int tid = threadIdx.x; asm volatile("" : "+v"(tid));
    const int wid = __builtin_amdgcn_readfirstlane(tid >> 6), lane = tid & 63, wr = wid >> 2, wc = wid & 3, fr = lane & 15, fq = lane >> 4;
    int K = g.K; asm volatile("" : "+s"(K));
    const int nt = K / BK;
    unsigned voffA[2], voffB[2];
#pragma unroll
    for (int i = 0; i < 2; ++i) { int R, C; stage_rc(tid * 16 + i * 8192, R, C); const int Rb = Epi::PERM ? ((R & ~31) + perm32(R & 31)) : R;
        voffA[i] = (unsigned)(R * K + C) * 2u; voffB[i] = (unsigned)(Rb * K + C) * 2u; }
    const size_t kstep = (size_t)(BK * 2);
    const size_t hstep = (size_t)HALF * K * 2;
    const size_t tstep = 2 * hstep;
    const unsigned ldsw = (unsigned)wid * 1024u;
    const int aoff = lds_byte(wr * 64 + fr, fq * 8), boff = lds_byte(wc * 32 + fr, fq * 8);
#define PG8_SA(b, h) (((b) * 2 + (h)) * HTB)
#define PG8_SB(b, h) ((4 + (b) * 2 + (h)) * HTB)
#define PG8_STAGE(bufoff, gbase, voff) do { _Pragma("unroll") for (int _i = 0; _i < 2; ++_i) \
        __builtin_amdgcn_global_load_lds((const unsigned*)((const char*)(gbase) + (voff)[_i]), (PG8_LAS unsigned*)(lds + (bufoff) + ldsw + _i * 8192), 16, 0, 0); } while (0)
#define PG8_LDA(dst, b, h) do { _Pragma("unroll") for (int m = 0; m < 4; ++m) _Pragma("unroll") for (int k = 0; k < 2; ++k) dst[m][k] = *(const PG8_LAS bf16x8*)(lds + PG8_SA(b, h) + aoff + m * 2048 + k * 1024); } while (0)
#define PG8_LDB(dst, b, h) do { _Pragma("unroll") for (int n = 0; n < 2; ++n) _Pragma("unroll") for (int k = 0; k < 2; ++k) dst[n][k] = *(const PG8_LAS bf16x8*)(lds + PG8_SB(b, h) + boff + n * 2048 + k * 1024); } while (0)
#define PG8_MMA(ai, bj, At, Bt) do { __builtin_amdgcn_s_setprio(1); _Pragma("unroll") for (int m = 0; m < 4; ++m) _Pragma("unroll") for (int n = 0; n < 2; ++n) _Pragma("unroll") for (int k = 0; k < 2; ++k) \
        acc[ai][bj][m][n] = __builtin_amdgcn_mfma_i32_16x16x64_i8(__builtin_bit_cast(i32x4_t, Bt[n][k]), __builtin_bit_cast(i32x4_t, At[m][k]), acc[ai][bj][m][n], 0, 0, 0); __builtin_amdgcn_s_setprio(0); } while (0)
#define PG8_WAIT_V(n) asm volatile("s_waitcnt vmcnt(" #n ")" ::: "memory")
#define PG8_WAIT_L(n) asm volatile("s_waitcnt lgkmcnt(" #n ")" ::: "memory")
#define PG8_BAR __builtin_amdgcn_s_barrier()
#define PG8_SCHED __builtin_amdgcn_sched_barrier(0)
    Unit cur, nxt; int ui = 0;
    if (!S.next(0, cur)) return;
    i32x4_t acc[2][2][4][2];
#pragma unroll
    for (int a = 0; a < 2; ++a)
#pragma unroll
        for (int b = 0; b < 2; ++b)
#pragma unroll
            for (int m = 0; m < 4; ++m)
#pragma unroll
                for (int n = 0; n < 2; ++n) acc[a][b][m][n] = (i32x4_t){0, 0, 0, 0};
    bf16x8 At[4][2], B0[2][2], B1[2][2];
    const char* cA = (const char*)g.A + (size_t)cur.pm * tstep; const char* cB = (const char*)g.Bt + (size_t)cur.pn * tstep;
    S.a_ready(cur);
    if constexpr (SP2) {
        PG8_STAGE(PG8_SB(0, 0), cB, voffB); PG8_STAGE(PG8_SB(0, 1), cB + hstep, voffB); PG8_STAGE(PG8_SA(0, 0), cA, voffA); PG8_STAGE(PG8_SA(0, 1), cA + hstep, voffA);
        if (wr == 1) PG8_BAR;
        PG8_WAIT_V(2); PG8_BAR;
        PG8_STAGE(PG8_SB(1, 0), cB + kstep, voffB); PG8_STAGE(PG8_SA(1, 0), cA + kstep, voffA); PG8_STAGE(PG8_SB(1, 1), cB + hstep + kstep, voffB);
        PG8_WAIT_V(6); PG8_BAR;
    } else {
        PG8_STAGE(PG8_SB(0, 0), cB, voffB); PG8_STAGE(PG8_SA(0, 0), cA, voffA); PG8_STAGE(PG8_SB(0, 1), cB + hstep, voffB); PG8_STAGE(PG8_SA(0, 1), cA + hstep, voffA);
        if (wr == 1) PG8_BAR;
        PG8_WAIT_V(4); PG8_BAR;
        PG8_STAGE(PG8_SB(1, 0), cB + kstep, voffB); PG8_STAGE(PG8_SA(1, 0), cA + kstep, voffA); PG8_STAGE(PG8_SB(1, 1), cB + hstep + kstep, voffB);
        PG8_WAIT_V(6); PG8_BAR;
    }
    for (;;) {
        const bool has_next = S.next(ui + 1, nxt);
        const char* nA = has_next ? (const char*)g.A + (size_t)nxt.pm * tstep : cA; const char* nB = has_next ? (const char*)g.Bt + (size_t)nxt.pn * tstep : cB;
        int t = 0;
#pragma unroll 1
        do {
            const bool last = (t == nt - 2);
            const char* a1 = cA + (size_t)(t + 1) * kstep;
            const char* a2 = last ? nA : cA + (size_t)(t + 2) * kstep; const char* b2 = last ? nB : cB + (size_t)(t + 2) * kstep;
            const char* a3 = a2 + kstep; const char* b3 = b2 + kstep;
            if (last && has_next) S.a_ready(nxt);
            if constexpr (SP2) {
            PG8_LDB(B0, 0, 0); PG8_LDB(B1, 0, 1); PG8_SCHED; PG8_LDA(At, 0, 0); PG8_STAGE(PG8_SA(1, 1), a1 + hstep, voffA);
            PG8_WAIT_V(8); PG8_WAIT_L(0); PG8_BAR; PG8_MMA(0, 0, At, B0); PG8_MMA(0, 1, At, B1); PG8_BAR; PG8_SCHED;
            PG8_LDA(At, 0, 1); PG8_STAGE(PG8_SB(0, 0), b2, voffB); PG8_STAGE(PG8_SB(0, 1), b2 + hstep, voffB); PG8_STAGE(PG8_SA(0, 0), a2, voffA);
            PG8_WAIT_V(8); PG8_WAIT_L(0); PG8_BAR; PG8_MMA(1, 0, At, B0); PG8_MMA(1, 1, At, B1); PG8_BAR; PG8_SCHED;
            PG8_LDB(B0, 1, 0); PG8_LDB(B1, 1, 1); PG8_SCHED; PG8_LDA(At, 1, 0); PG8_STAGE(PG8_SA(0, 1), a2 + hstep, voffA);
            PG8_WAIT_V(8); PG8_WAIT_L(0); PG8_BAR; PG8_MMA(0, 0, At, B0); PG8_MMA(0, 1, At, B1); PG8_BAR; PG8_SCHED;
            PG8_LDA(At, 1, 1); PG8_STAGE(PG8_SB(1, 0), b3, voffB); PG8_STAGE(PG8_SB(1, 1), b3 + hstep, voffB); PG8_STAGE(PG8_SA(1, 0), a3, voffA);
            PG8_WAIT_V(8); PG8_WAIT_L(0); PG8_BAR; PG8_MMA(1, 0, At, B0); PG8_MMA(1, 1, At, B1); PG8_BAR; PG8_SCHED;
            } else {
            PG8_LDB(B0, 0, 0); PG8_SCHED; PG8_LDA(At, 0, 0); PG8_STAGE(PG8_SA(1, 1), a1 + hstep, voffA);
            PG8_WAIT_L(8); PG8_BAR; PG8_WAIT_L(0); PG8_MMA(0, 0, At, B0); PG8_BAR; PG8_SCHED;
            PG8_LDB(B1, 0, 1); PG8_STAGE(PG8_SB(0, 0), b2, voffB);
            PG8_BAR; PG8_WAIT_L(0); PG8_MMA(0, 1, At, B1); PG8_BAR;
            PG8_LDA(At, 0, 1); PG8_STAGE(PG8_SA(0, 0), a2, voffA);
            PG8_BAR; PG8_WAIT_L(0); PG8_MMA(1, 0, At, B0); PG8_BAR; PG8_SCHED;
            PG8_STAGE(PG8_SB(0, 1), b2 + hstep, voffB);
            PG8_WAIT_V(6); PG8_BAR; PG8_MMA(1, 1, At, B1); PG8_BAR;
            PG8_LDB(B0, 1, 0); PG8_SCHED; PG8_LDA(At, 1, 0); PG8_STAGE(PG8_SA(0, 1), a2 + hstep, voffA);
            PG8_WAIT_L(8); PG8_BAR; PG8_WAIT_L(0); PG8_MMA(0, 0, At, B0); PG8_BAR; PG8_SCHED;
            PG8_LDB(B1, 1, 1); PG8_STAGE(PG8_SB(1, 0), b3, voffB);
            PG8_BAR; PG8_WAIT_L(0); PG8_MMA(0, 1, At, B1); PG8_BAR;
            PG8_LDA(At, 1, 1); PG8_STAGE(PG8_SA(1, 0), a3, voffA);
            PG8_BAR; PG8_WAIT_L(0); PG8_MMA(1, 0, At, B0); PG8_BAR; PG8_SCHED;
            PG8_STAGE(PG8_SB(1, 1), b3 + hstep, voffB);
            PG8_WAIT_V(6); PG8_BAR; PG8_MMA(1, 1, At, B1); PG8_BAR;
            }
            t += 2;
        } while (t < nt);
        if constexpr (ALIGN_EPI) { if (wr == 0) PG8_BAR; }
        if constexpr (!Epi::AFTER_DRAIN) { E(acc, cur, wr, wc, fr, fq); S.done(cur); }
        if (!has_next) break;
#pragma unroll
        for (int a = 0; a < 2; ++a)
#pragma unroll
            for (int b = 0; b < 2; ++b)
#pragma unroll
                for (int m = 0; m < 4; ++m)
#pragma unroll
                    for (int n = 0; n < 2; ++n) acc[a][b][m][n] = (i32x4_t){0, 0, 0, 0};
        cur = nxt; cA = nA; cB = nB; ++ui;
        if constexpr (ALIGN_EPI) { if (wr == 1) PG8_BAR; }
    }
    PG8_WAIT_V(0);
    if constexpr (!ALIGN_EPI) { if (wr == 0) PG8_BAR; }
    PG8_BAR;
    if constexpr (Epi::AFTER_DRAIN) { E.fused(acc, cur, wr, wc, fr, fq, lds, wid, lane); S.done(cur); }
#undef PG8_SA
#undef PG8_SB
#undef PG8_STAGE
#undef PG8_LDA
#undef PG8_LDB
#undef PG8_MMA
#undef PG8_WAIT_V
#undef PG8_WAIT_L
#undef PG8_BAR
#undef PG8_SCHED
}
}
#define GAS __attribute__((address_space(1)))
#define LAS __attribute__((address_space(3)))
typedef unsigned short bf16;
typedef unsigned v4u __attribute__((ext_vector_type(4)));
typedef float f32x4 __attribute__((ext_vector_type(4)));
typedef short bf16x8 __attribute__((ext_vector_type(8)));
typedef GAS unsigned gu32;
typedef GAS unsigned long long gu64;
#define RLX_AGENT __ATOMIC_RELAXED, __HIP_MEMORY_SCOPE_AGENT
#define LDS_WAIT() asm volatile("s_waitcnt lgkmcnt(0)" ::: "memory")
#define VM_WAIT() asm volatile("s_waitcnt vmcnt(0)" ::: "memory")
__device__ __forceinline__ unsigned long long rt() { return __builtin_amdgcn_s_memrealtime(); }
__device__ __forceinline__ unsigned f2bf(float f) { unsigned u = __builtin_bit_cast(unsigned, f); return (u + 0x7fffu + ((u >> 16) & 1u)) >> 16; }
__device__ __forceinline__ unsigned pk2(float lo, float hi) { return f2bf(lo) | (f2bf(hi) << 16); }

#define XB_TMO      128
#define XB_XCNT(j)  (256  + 64 * (j))
#define XB_XSUB(j)  (1280 + 64 * (j))
#define XB_XGEN(j)  (2304 + 64 * (j))
#define XB_TOP      3328
#define XB_TOPGEN   3392
#define XCD_BAR_WORDS 3456
#define XB_SPIN_CAP (1u << 18)

__device__ __forceinline__ unsigned xb_ld(unsigned* p)              { return __hip_atomic_load(p, __ATOMIC_RELAXED, __HIP_MEMORY_SCOPE_AGENT); }
__device__ __forceinline__ unsigned xb_add(unsigned* p, unsigned v) { return __hip_atomic_fetch_add(p, v, __ATOMIC_RELAXED, __HIP_MEMORY_SCOPE_AGENT); }
__device__ __forceinline__ unsigned xb_xcc_id() { return (unsigned)__builtin_amdgcn_s_getreg((3 << 11) | 20) & 0xFu; }
#define XB_SPIN(cond, bar) do { unsigned _sp = 0; while (cond) { __builtin_amdgcn_s_sleep(1); \
    if ((++_sp & 255u) == 0u) { if (xb_ld(&(bar)[XB_TMO])) break; if (_sp > XB_SPIN_CAP) { atomicAdd(&(bar)[XB_TMO], 1u); break; } } } } while (0)

struct XcdBarrier {
    unsigned* bar; unsigned x;
    volatile LAS unsigned* st;
};

__device__ __forceinline__ XcdBarrier xcd_barrier_post(unsigned* bar, volatile LAS unsigned* st) {
    XcdBarrier b; b.bar = bar; b.x = xb_xcc_id(); b.st = st;
    if (threadIdx.x == 0) (void)xb_add(&bar[XB_XCNT(b.x)], 1u);
    return b;
}
__device__ __forceinline__ void xcd_barrier_complete(unsigned* bar, unsigned x, unsigned& nloc, unsigned& nx) {
    const unsigned G = gridDim.x * gridDim.y * gridDim.z;
    unsigned sum, cnt, mine, sp = 0u;
    for (;;) {
        sum = 0u; cnt = 0u; mine = 0u;
#pragma unroll
        for (unsigned j = 0; j < 16; ++j) { const unsigned c = xb_ld(&bar[XB_XCNT(j)]); sum += c; cnt += (c > 0u) ? 1u : 0u; mine = (j == x) ? c : mine; }
        if (sum == G) break;
        __builtin_amdgcn_s_sleep(1);
        if ((++sp & 255u) == 0u) { if (xb_ld(&bar[XB_TMO])) break; if (sp > XB_SPIN_CAP) { atomicAdd(&bar[XB_TMO], 1u); break; } }
    }
    nloc = mine > 0u ? mine : 1u; nx = cnt > 0u ? cnt : 1u;
}

__device__ __forceinline__ void xcd_barrier(const XcdBarrier& b) {
    asm volatile("s_waitcnt vmcnt(0)" ::: "memory");
    __syncthreads();
    if (threadIdx.x == 0) {
        unsigned* bar = b.bar;
        __builtin_amdgcn_s_waitcnt(0);
        unsigned nloc = b.st[0], nx = b.st[1];
        if (nloc == 0u) { xcd_barrier_complete(bar, b.x, nloc, nx); b.st[0] = nloc; b.st[1] = nx; }
        const unsigned old = xb_add(&bar[XB_XSUB(b.x)], 1u);
        const unsigned gen = old / nloc;
        if (old + 1u == (gen + 1u) * nloc) {
            __builtin_amdgcn_fence(__ATOMIC_RELEASE, "agent");
            asm volatile("s_waitcnt vmcnt(0)" ::: "memory");
            const unsigned og = xb_add(&bar[XB_TOP], 1u);
            const unsigned tg = og / nx;
            if (og + 1u == (tg + 1u) * nx) xb_add(&bar[XB_TOPGEN], 1u);
            else XB_SPIN(xb_ld(&bar[XB_TOPGEN]) == tg, bar);
            __builtin_amdgcn_fence(__ATOMIC_ACQUIRE, "agent");
            xb_add(&bar[XB_XGEN(b.x)], 1u);
            asm volatile("s_waitcnt vmcnt(0)" ::: "memory");
        } else {
            XB_SPIN(xb_ld(&bar[XB_XGEN(b.x)]) == gen, bar);
            __builtin_amdgcn_fence(__ATOMIC_ACQUIRE, "agent");
            asm volatile("s_waitcnt vmcnt(0)" ::: "memory");
        }
    }
    __syncthreads();
}
constexpr int T = 65536, SEQ = 4096, DM = 1024;
constexpr int NWAVES = 8;
constexpr float EPS = 1e-6f;
constexpr float LOG2E = 1.4426950408889634f;
constexpr float QSCALE_A = 0.10206207261596575f * LOG2E;
constexpr float QSCALE_B = 0.125f * LOG2E;
constexpr float LOG2_THETA = 13.287712379549449f;
constexpr float INV_2PI = 0.15915494309189535f;

constexpr size_t MiB = 1u << 20;
constexpr size_t WS_CTL = 0, CTL_ZERO_BYTES = 4 * MiB;
constexpr size_t WS_MOD = 2 * MiB;
constexpr size_t WS_TOPK = 4 * MiB;
constexpr size_t WS_GATES = 4 * MiB + 512 * 1024;
constexpr size_t WS_SLOTS = 5 * MiB;
constexpr size_t WS_GSLOT = 5 * MiB + 512 * 1024;
constexpr size_t WS_BLKCNT = 6 * MiB + 128 * 1024;
constexpr size_t WS_PENDS = 6 * MiB + 256 * 1024;
constexpr size_t WS_TOKSLOT = 6 * MiB + 512 * 1024;
constexpr size_t WS_ROWSC = 7 * MiB + 256 * 1024;
constexpr size_t WS_WAMAX = 64 * 1024;
constexpr size_t WS_W = 8 * MiB;
constexpr size_t W_IN = WS_W;
constexpr size_t W_UQ = W_IN + (size_t)1280 * 1024 * 2;
constexpr size_t W_UKV = W_UQ + (size_t)768 * 256 * 2;
constexpr size_t W_OUT = W_UKV + (size_t)1024 * 128 * 2;
constexpr size_t W_GU = W_OUT + (size_t)1024 * 1024 * 2;
constexpr size_t W_D = W_GU + (size_t)5632 * 1024 * 2;
constexpr size_t W_QKV = W_D + (size_t)1024 * 2816 * 2;
constexpr size_t W_DO = W_QKV + (size_t)3072 * 1024 * 2;
constexpr size_t W_MGU = W_DO + (size_t)1024 * 1024 * 2;
constexpr size_t W_MD = W_MGU + (size_t)8 * 7168 * 1024 * 2;
constexpr size_t W_END = W_MD + (size_t)8 * 1024 * 3584 * 2;
static_assert(W_END <= 208 * MiB, "weights region");
constexpr size_t A_H = 208 * MiB;
constexpr size_t A_P = 336 * MiB;
constexpr size_t A_CQ = 496 * MiB;
constexpr size_t A_CKV = 528 * MiB;
constexpr size_t A_QB = 544 * MiB;
constexpr size_t A_KB = 608 * MiB;
constexpr size_t A_QA = 624 * MiB;
constexpr size_t A_KV = 720 * MiB;
constexpr size_t A_KA = 848 * MiB;
constexpr size_t A_ATT0 = A_H;
constexpr size_t A_ACT = 336 * MiB;
constexpr size_t A_QKV = 336 * MiB;
constexpr size_t A_ATT1 = 720 * MiB;
constexpr size_t A_O2 = 848 * MiB;
constexpr size_t A_LSE1 = 976 * MiB;
constexpr size_t A_LSE2 = 980 * MiB;
constexpr size_t A_HP = 208 * MiB;
constexpr size_t A_Y = 208 * MiB;
constexpr size_t A_ACTM = 468 * MiB;
constexpr size_t WS_NEED = 984 * MiB;

constexpr int CW_BAR = 4096;
constexpr int RING_BYTES = 131072;
constexpr int LDS_BYTES = 163840;
constexpr int MISC_OFF = LDS_BYTES - 512;
constexpr int LDS_ZERO_OFF = LDS_BYTES - 1024;

constexpr int NPH = 28;
#ifndef FFN_FP8
#define FFN_FP8 3
#endif

struct Args {
    const float* in[31];
    float* out;
    unsigned char* ws;
    int ph_lo, ph_hi;
};
enum { I_X = 0, I_C, I_ADA_E_W, I_ADA_E_B, I_NORM_E_MIX, I_NORM_E_FFN, I_W_IN, I_Q_NORM, I_W_UQ, I_KV_NORM, I_W_UKV, I_MLA_QG, I_MLA_KG, I_GQA_QG, I_GQA_KG,
       I_E_W_OUT, I_FFN_G, I_FFN_U, I_FFN_D, I_ADA_O_W, I_ADA_O_B, I_NORM_O_MIX, I_NORM_O_FFN, I_DIL_QKV, I_DIL_QG, I_DIL_KG, I_DIL_OUT, I_ROUTER, I_MOE_G, I_MOE_U, I_MOE_D };

__device__ __forceinline__ float bf2f(unsigned b) { return __builtin_bit_cast(float, b << 16); }
__device__ __forceinline__ float bflo(unsigned w) { return __builtin_bit_cast(float, w << 16); }
__device__ __forceinline__ float bfhi(unsigned w) { return __builtin_bit_cast(float, w & 0xffff0000u); }
template <int CTRL> __device__ __forceinline__ float dppf(float v) { return __builtin_bit_cast(float, __builtin_amdgcn_update_dpp(0, __builtin_bit_cast(int, v), CTRL, 0xF, 0xF, false)); }
__device__ __forceinline__ float rdl(float v, int l) { return __builtin_bit_cast(float, __builtin_amdgcn_readlane(__builtin_bit_cast(int, v), l)); }
__device__ __forceinline__ float wave_sum(float v) {
    v += dppf<0xB1>(v); v += dppf<0x4E>(v); v += dppf<0x141>(v); v += dppf<0x140>(v);
    return (rdl(v, 0) + rdl(v, 16)) + (rdl(v, 32) + rdl(v, 48));
}
__device__ __forceinline__ float wave_max(float v) {
    v = fmaxf(v, dppf<0xB1>(v)); v = fmaxf(v, dppf<0x4E>(v)); v = fmaxf(v, dppf<0x141>(v)); v = fmaxf(v, dppf<0x140>(v));
    return fmaxf(fmaxf(rdl(v, 0), rdl(v, 16)), fmaxf(rdl(v, 32), rdl(v, 48)));
}
typedef __bf16 bf16n2_t __attribute__((ext_vector_type(2)));
typedef float f32n2_t __attribute__((ext_vector_type(2)));
__device__ __forceinline__ unsigned cvtpk(float lo, float hi) { const f32n2_t v = {lo, hi}; return __builtin_bit_cast(unsigned, __builtin_convertvector(v, bf16n2_t)); }

__device__ __forceinline__ void transpose_item(const float* W, int N, int k0, int n0, bf16* dst, int Kd, LAS float* scr, int lane) {
#pragma unroll 4
    for (int i = 0; i < 32; ++i) { const int kk = 2 * i + (lane >> 5); scr[kk * 33 + (lane & 31)] = W[(size_t)(k0 + kk) * N + n0 + (lane & 31)]; }
    LDS_WAIT(); asm volatile("" ::: "memory");
    const int c = lane & 7;
#pragma unroll
    for (int j = 0; j < 4; ++j) { const int n = (lane >> 3) + 8 * j; const LAS float* s = scr + (8 * c) * 33 + n;
        v4u o; o.x = pk2(s[0 * 33], s[1 * 33]); o.y = pk2(s[2 * 33], s[3 * 33]); o.z = pk2(s[4 * 33], s[5 * 33]); o.w = pk2(s[6 * 33], s[7 * 33]);
        *(GAS v4u*)(dst + (size_t)n * Kd + k0 + 8 * c) = o; }
    LDS_WAIT(); asm volatile("" ::: "memory");
}
__device__ __forceinline__ void tr_plain(const float* W, int K, int N, bf16* WT, int r, LAS float* scr, int lane) {
    const int nblk = N / 32, kb = r / nblk, nb = r % nblk;
    transpose_item(W, N, 64 * kb, 32 * nb, WT + (size_t)(32 * nb) * K, K, scr, lane);
}
__device__ __forceinline__ void tr_gu(const float* W, int K, int N, bf16* WT, int upoff, int r, LAS float* scr, int lane) {
    const int nblk = N / 32, kb = r / nblk, nb = r % nblk, n0 = 32 * nb;
    const int drow = (n0 >> 7) * 256 + (n0 & 127) + upoff;
    transpose_item(W, N, 64 * kb, n0, WT + (size_t)drow * K, K, scr, lane);
}


typedef unsigned u32x2_t __attribute__((ext_vector_type(2)));
constexpr float F8_WS = 64.f, F8_HS = 4.f, F8_AS = 4.f;
__device__ __forceinline__ float clamp448(float v) { return fminf(fmaxf(v, -448.f), 448.f); }
__device__ __forceinline__ unsigned pk4_fp8(float a, float b, float c, float d) { int w = 0; w = __builtin_amdgcn_cvt_pk_fp8_f32(a, b, w, false); w = __builtin_amdgcn_cvt_pk_fp8_f32(c, d, w, true); return (unsigned)w; }
__device__ __forceinline__ void transpose_item8(const float* W, int N, int k0, int n0, unsigned char* dst8, int Kd, float sc, LAS float* scr, int lane) {
#pragma unroll 4
    for (int i = 0; i < 32; ++i) { const int kk = 2 * i + (lane >> 5); scr[kk * 33 + (lane & 31)] = W[(size_t)(k0 + kk) * N + n0 + (lane & 31)]; }
    LDS_WAIT(); asm volatile("" ::: "memory");
    const int c = lane & 7;
#pragma unroll
    for (int j = 0; j < 4; ++j) { const int n = (lane >> 3) + 8 * j; const LAS float* s = scr + (8 * c) * 33 + n;
        u32x2_t o; o.x = pk4_fp8(s[0 * 33] * sc, s[1 * 33] * sc, s[2 * 33] * sc, s[3 * 33] * sc); o.y = pk4_fp8(s[4 * 33] * sc, s[5 * 33] * sc, s[6 * 33] * sc, s[7 * 33] * sc);
        *(GAS u32x2_t*)(dst8 + (size_t)n * Kd + k0 + 8 * c) = o; }
    LDS_WAIT(); asm volatile("" ::: "memory");
}
__device__ __forceinline__ void tr_plain8(const float* W, int K, int N, unsigned char* WT, int r, LAS float* scr, int lane) {
    const int nblk = N / 32, kb = r / nblk, nb = r % nblk;
    transpose_item8(W, N, 64 * kb, 32 * nb, WT + (size_t)(32 * nb) * K, K, F8_WS, scr, lane);
}
__device__ __forceinline__ void tr_gu8(const float* W, int K, int N, unsigned char* WT, int upoff, int r, LAS float* scr, int lane) {
    const int nblk = N / 32, kb = r / nblk, nb = r % nblk, n0 = 32 * nb;
    const int drow = (n0 >> 7) * 256 + (n0 & 127) + upoff;
    transpose_item8(W, N, 64 * kb, n0, WT + (size_t)drow * K, K, F8_WS, scr, lane);
}


__device__ __forceinline__ unsigned pk4_i8(float a, float b, float c, float d) {
    const int ia = (int)__builtin_rintf(__builtin_amdgcn_fmed3f(a, -127.f, 127.f)), ib = (int)__builtin_rintf(__builtin_amdgcn_fmed3f(b, -127.f, 127.f));
    const int ic = (int)__builtin_rintf(__builtin_amdgcn_fmed3f(c, -127.f, 127.f)), id = (int)__builtin_rintf(__builtin_amdgcn_fmed3f(d, -127.f, 127.f));
    return (unsigned)(ia & 255) | ((unsigned)(ib & 255) << 8) | ((unsigned)(ic & 255) << 16) | ((unsigned)(id & 255) << 24);
}
__device__ __forceinline__ void transpose_item_i8(const float* W, int N, int k0, int n0, unsigned char* dst8, int Kd, float sc, LAS float* scr, int lane) {
#pragma unroll 4
    for (int i = 0; i < 32; ++i) { const int kk = 2 * i + (lane >> 5); scr[kk * 33 + (lane & 31)] = W[(size_t)(k0 + kk) * N + n0 + (lane & 31)]; }
    LDS_WAIT(); asm volatile("" ::: "memory");
    const int c = lane & 7;
#pragma unroll
    for (int j = 0; j < 4; ++j) { const int n = (lane >> 3) + 8 * j; const LAS float* s = scr + (8 * c) * 33 + n;
        u32x2_t o; o.x = pk4_i8(s[0 * 33] * sc, s[1 * 33] * sc, s[2 * 33] * sc, s[3 * 33] * sc); o.y = pk4_i8(s[4 * 33] * sc, s[5 * 33] * sc, s[6 * 33] * sc, s[7 * 33] * sc);
        *(GAS u32x2_t*)(dst8 + (size_t)n * Kd + k0 + 8 * c) = o; }
    LDS_WAIT(); asm volatile("" ::: "memory");
}
__device__ __forceinline__ void tr_gu_i8(const float* W, int K, int N, unsigned char* WT, int upoff, float sc, int r, LAS float* scr, int lane) {
    const int nblk = N / 32, kb = r / nblk, nb = r % nblk, n0 = 32 * nb;
    const int drow = (n0 >> 7) * 256 + (n0 & 127) + upoff;
    transpose_item_i8(W, N, 64 * kb, n0, WT + (size_t)drow * K, K, sc, scr, lane);
}
__device__ __forceinline__ void absmax_pass(const float* w, size_t n4, unsigned* slot, int gw, int NGW, int lane) {
    float mx = 0.f;
    for (size_t i = (size_t)gw * 64 + lane; i < n4; i += (size_t)NGW * 64) { const f32x4 v = ((const f32x4*)w)[i]; mx = fmaxf(fmaxf(mx, fmaxf(fabsf(v.x), fabsf(v.y))), fmaxf(fabsf(v.z), fabsf(v.w))); }
#pragma unroll
    for (int o = 1; o < 64; o <<= 1) mx = fmaxf(mx, __shfl_xor(mx, o));
    if (lane == 0) atomicMax(slot, __builtin_bit_cast(unsigned, mx));
}
__device__ __forceinline__ void p0_prologue(const Args& a, LAS unsigned char* lds, int gw, int NGW, int wave, int lane) {
    unsigned char* ws = a.ws;
    LAS float* scr = (LAS float*)(lds + wave * 16384);
    constexpr int I0 = 16 * 37, I1 = 4 * 24, I2 = 2 * 32, I3 = 16 * 32, I4 = 16 * 88, I6 = 44 * 32, I7 = 16 * 96, I8 = 16 * 32, IM = 16 * 112, IMD = 56 * 32;
    constexpr int NITEMS = I0 + I1 + I2 + I3 + 2 * I4 + I6 + I7 + I8 + 16 * IM + 8 * IMD;
#ifndef PROBE_P0N
#define PROBE_P0N 0
#endif
    for (int rp0_ = 0; rp0_ <= PROBE_P0N; ++rp0_)
    for (int it = gw; it < NITEMS; it += NGW) {
        int r = it;
        if (r < I0) continue;
        r -= I0;
        if (r < I1) { tr_plain(a.in[I_W_UQ], 256, 768, (bf16*)(ws + W_UQ), r, scr, lane); continue; } r -= I1;
        if (r < I2) {
            const int nblk = 1024 / 32, kb = r / nblk, nb = r % nblk, n0 = 32 * nb; const int hd = n0 >> 7, w = n0 & 127; const int drow = (w < 64) ? hd * 64 + w : 512 + hd * 64 + (w - 64);
            transpose_item(a.in[I_W_UKV], 1024, 64 * kb, n0, (bf16*)(ws + W_UKV) + (size_t)drow * 128, 128, scr, lane); continue; } r -= I2;
        if (r < I3) { tr_plain(a.in[I_E_W_OUT], 1024, 1024, (bf16*)(ws + W_OUT), r, scr, lane); continue; } r -= I3;
#if FFN_FP8 == 1
        if (r < I4) { tr_gu8(a.in[I_FFN_G], 1024, 2816, ws + W_GU, 0, r, scr, lane); continue; } r -= I4;
        if (r < I4) { tr_gu8(a.in[I_FFN_U], 1024, 2816, ws + W_GU, 128, r, scr, lane); continue; } r -= I4;
        if (r < I6) { tr_plain8(a.in[I_FFN_D], 2816, 1024, ws + W_D, r, scr, lane); continue; } r -= I6;
#elif FFN_FP8 == 2
        if (r < I4) { tr_gu(a.in[I_FFN_G], 1024, 2816, (bf16*)(ws + W_GU), 0, r, scr, lane); continue; } r -= I4;
        if (r < I4) { tr_gu(a.in[I_FFN_U], 1024, 2816, (bf16*)(ws + W_GU), 128, r, scr, lane); continue; } r -= I4;
        if (r < I6) { tr_plain8(a.in[I_FFN_D], 2816, 1024, ws + W_D, r, scr, lane); continue; } r -= I6;
#elif FFN_FP8 == 3
        if (r < 2 * I4) continue;
        r -= 2 * I4;
        if (r < I6) { tr_plain8(a.in[I_FFN_D], 2816, 1024, ws + W_D, r, scr, lane); continue; } r -= I6;
#else
        if (r < 2 * I4) continue;
        r -= 2 * I4;
        if (r < I6) { tr_plain(a.in[I_FFN_D], 2816, 1024, (bf16*)(ws + W_D), r, scr, lane); continue; } r -= I6;
#endif
        if (r < I7) continue;
        r -= I7;
        if (r < I8) { tr_plain(a.in[I_DIL_OUT], 1024, 1024, (bf16*)(ws + W_DO), r, scr, lane); continue; } r -= I8;
        if (r < 8 * IM) { const int e = r / IM; tr_gu8(a.in[I_MOE_G] + (size_t)e * 1024 * 3584, 1024, 3584, ws + W_MGU + (size_t)e * 7168 * 1024, 0, r % IM, scr, lane); continue; } r -= 8 * IM;
        if (r < 8 * IM) { const int e = r / IM; tr_gu8(a.in[I_MOE_U] + (size_t)e * 1024 * 3584, 1024, 3584, ws + W_MGU + (size_t)e * 7168 * 1024, 128, r % IM, scr, lane); continue; } r -= 8 * IM;
        { const int e = r / IMD; tr_plain8(a.in[I_MOE_D] + (size_t)e * 3584 * 1024, 3584, 1024, ws + W_MD + (size_t)e * 1024 * 3584, r % IMD, scr, lane); }
    }
    { GAS v4u* z = (GAS v4u*)(ws + W_IN + (size_t)1184 * 1024);
      for (int i = gw * 64 + lane; i < 6144; i += NGW * 64) z[i] = (v4u){0u, 0u, 0u, 0u}; }
#if FFN_FP8 == 0 || FFN_FP8 == 3
    absmax_pass(a.in[I_FFN_G], (size_t)1024 * 2816 / 4, (unsigned*)(ws + WS_WAMAX), gw, NGW, lane); absmax_pass(a.in[I_FFN_U], (size_t)1024 * 2816 / 4, (unsigned*)(ws + WS_WAMAX), gw, NGW, lane);
    absmax_pass(a.in[I_DIL_QKV], (size_t)1024 * 3072 / 4, (unsigned*)(ws + WS_WAMAX) + 1, gw, NGW, lane);
    absmax_pass(a.in[I_W_IN], (size_t)1024 * 1184 / 4, (unsigned*)(ws + WS_WAMAX) + 2, gw, NGW, lane);
#endif
    for (int u = gw; u < 2 * 96 * 16; u += NGW) {
        const int layer = u / 1536, rem = u % 1536, cg = rem >> 4, kc = rem & 15;
        const float* W = a.in[layer ? I_ADA_O_W : I_ADA_E_W]; const float* bia = a.in[layer ? I_ADA_O_B : I_ADA_E_B];
        unsigned long long* mod = (unsigned long long*)(ws + WS_MOD) + layer * 16 * 6144;
        const int n = cg * 64 + lane, k0 = kc * 64;
        float s[16], acc[16];
#pragma unroll
        for (int b = 0; b < 16; ++b) { const float cv = a.in[I_C][b * 1024 + k0 + lane]; s[b] = cv / (1.f + __expf(-cv)); acc[b] = 0.f; }
#pragma unroll 4
        for (int kk = 0; kk < 64; ++kk) { const float w = W[(size_t)(k0 + kk) * 6144 + n];
#pragma unroll
            for (int b = 0; b < 16; ++b) acc[b] += __builtin_bit_cast(float, __builtin_amdgcn_readlane(__builtin_bit_cast(int, s[b]), kk)) * w; }
        const float bv = (kc == 0) ? bia[n] : 0.f;
#pragma unroll
        for (int b = 0; b < 16; ++b) atomicAdd(mod + b * 6144 + n, (unsigned long long)(long long)((acc[b] + bv) * 1099511627776.0f));
    }
}

struct ModPar { f32x4 a[4], s[4]; };
typedef long long modw_t;
__device__ __forceinline__ float modv(const modw_t* p) { return (float)(*p) * 9.094947017729282e-13f; }
__device__ __forceinline__ f32x4 modv4(const modw_t* p) { return (f32x4){modv(p), modv(p + 1), modv(p + 2), modv(p + 3)}; }
__device__ __forceinline__ void load_modpar(ModPar& mp, const float* g, const modw_t* mod_b, int jshift, int jscale, int lane) {
#pragma unroll
    for (int j = 0; j < 4; ++j) { const int col = 4 * lane + 256 * j;
        const f32x4 gv = *(const f32x4*)(g + col), sc = modv4(mod_b + jscale * 1024 + col), sh = modv4(mod_b + jshift * 1024 + col);
        mp.a[j] = gv * (sc + 1.0f); mp.s[j] = sh; }
}
constexpr int XP = 2048;
template <bool BF = false>
__device__ __forceinline__ void mod_row_f32(const void* xrow, const ModPar& mp, f32x4 (&h)[4], int lane) {
    float ss = 0.f;
#pragma unroll
    for (int j = 0; j < 4; ++j) {
        if (BF) { const uint2 r = ((const uint2*)xrow)[lane + 64 * j]; h[j] = (f32x4){bflo(r.x), bfhi(r.x), bflo(r.y), bfhi(r.y)}; }
        else h[j] = ((const f32x4*)xrow)[lane + 64 * j];
        ss += (h[j].x * h[j].x + h[j].y * h[j].y) + (h[j].z * h[j].z + h[j].w * h[j].w); }
    const float rs = 1.0f / sqrtf(wave_sum(ss) * (1.f / 1024.f) + EPS);
#pragma unroll
    for (int j = 0; j < 4; ++j) h[j] = h[j] * rs * mp.a[j] + mp.s[j];
}
__device__ __forceinline__ void store_row_bf16(bf16* orow, const f32x4 (&h)[4], int lane) {
    unsigned long long* o8 = (unsigned long long*)orow + lane;
#pragma unroll
    for (int j = 0; j < 4; ++j) o8[64 * j] = (unsigned long long)pk2(h[j].x, h[j].y) | ((unsigned long long)pk2(h[j].z, h[j].w) << 32);
}
__device__ __forceinline__ void store_row_fp8(unsigned char* orow, const f32x4 (&h)[4], int lane) {
    unsigned* o4 = (unsigned*)orow + lane;
#pragma unroll
    for (int j = 0; j < 4; ++j) o4[64 * j] = pk4_fp8(clamp448(h[j].x * F8_HS), clamp448(h[j].y * F8_HS), clamp448(h[j].z * F8_HS), clamp448(h[j].w * F8_HS));
}
__device__ __forceinline__ void store_row_i8(unsigned char* orow, float* rowscale, const f32x4 (&h)[4], int lane) {
    float mx = 0.f;
#pragma unroll
    for (int j = 0; j < 4; ++j) mx = fmaxf(fmaxf(mx, fmaxf(fabsf(h[j].x), fabsf(h[j].y))), fmaxf(fabsf(h[j].z), fabsf(h[j].w)));
    mx = wave_max(mx);
    mx = fmaxf(mx, 1e-20f); const float inv = 127.f / mx;
    unsigned* o4 = (unsigned*)orow + lane;
#pragma unroll
    for (int j = 0; j < 4; ++j) o4[64 * j] = pk4_i8(h[j].x * inv, h[j].y * inv, h[j].z * inv, h[j].w * inv);
    if (lane == 0) *rowscale = mx * (1.f / 127.f);
}
template <bool F8OUT = false, bool BFIN = false, bool I8OUT = false>
__device__ __forceinline__ void modulate_phase(const void* xin, const float* g, const modw_t* mod_layer, int jshift, int jscale, bf16* H, int gw, int NGW, int lane, float* rowsc = nullptr) {
    for (int bi = gw; bi < T / 32; bi += NGW) {
        const int b = bi >> 7; ModPar mp; load_modpar(mp, g, mod_layer + b * 6144, jshift, jscale, lane);
#pragma unroll 8
        for (int r = 0; r < 32; ++r) { const size_t row = (size_t)bi * 32 + r; f32x4 h[4]; if (BFIN) mod_row_f32<true>((const bf16*)xin + row * XP, mp, h, lane); else mod_row_f32<false>((const float*)xin + row * 1024, mp, h, lane); if (I8OUT) store_row_i8((unsigned char*)H + row * 1024, rowsc + row, h, lane); else if (F8OUT) store_row_fp8((unsigned char*)H + row * 1024, h, lane); else store_row_bf16(H + row * 1024, h, lane); }
    }
}

__device__ __forceinline__ void cs_rev(float pos, float revf, float& c, float& s) { const float fr = __builtin_amdgcn_fractf(pos * revf); c = __builtin_amdgcn_cosf(fr); s = __builtin_amdgcn_sinf(fr); }
__device__ __forceinline__ void unpack8(const v4u& r, float (&v)[8]) { v[0] = bflo(r.x); v[1] = bfhi(r.x); v[2] = bflo(r.y); v[3] = bfhi(r.y); v[4] = bflo(r.z); v[5] = bfhi(r.z); v[6] = bflo(r.w); v[7] = bfhi(r.w); }
__device__ __forceinline__ v4u pack8(const float (&v)[8]) { v4u o; o.x = pk2(v[0], v[1]); o.y = pk2(v[2], v[3]); o.z = pk2(v[4], v[5]); o.w = pk2(v[6], v[7]); return o; }

__device__ __forceinline__ void r2_phase(const Args& a, int gw, int NGW, int lane) {
    unsigned char* ws = a.ws;
    const bf16* P = (const bf16*)(ws + A_P); bf16* CQ = (bf16*)(ws + A_CQ); bf16* CKV = (bf16*)(ws + A_CKV); bf16* QB = (bf16*)(ws + A_QB); bf16* KB = (bf16*)(ws + A_KB);
    const int sub = lane & 7;
    float qn[4], kvn[2], gq[8], gk[8], revf[8];
#pragma unroll
    for (int i = 0; i < 4; ++i) qn[i] = a.in[I_Q_NORM][4 * lane + i];
    kvn[0] = a.in[I_KV_NORM][2 * lane]; kvn[1] = a.in[I_KV_NORM][2 * lane + 1];
#pragma unroll
    for (int j = 0; j < 8; ++j) { gq[j] = a.in[I_GQA_QG][8 * sub + j]; gk[j] = a.in[I_GQA_KG][8 * sub + j];
        const int i = 8 * (sub & 1) + j; revf[j] = exp2f(-(float)i * (LOG2_THETA / 16.f)) * INV_2PI; }
#pragma unroll 2
    for (int row = gw; row < T; row += NGW) {
        const bf16* pr = P + (size_t)row * 1280; const int t = row & 4095; const float pos = (float)((sub & 4) ? (t & 63) : (t >> 6));
        { const uint2 raw = *(const uint2*)(pr + 4 * lane); float v0 = bflo(raw.x), v1 = bfhi(raw.x), v2 = bflo(raw.y), v3 = bfhi(raw.y);
          const float rs = 1.0f / sqrtf(wave_sum((v0 * v0 + v1 * v1) + (v2 * v2 + v3 * v3)) * (1.f / 256.f) + EPS);
          uint2 o; o.x = pk2(v0 * rs * qn[0], v1 * rs * qn[1]); o.y = pk2(v2 * rs * qn[2], v3 * rs * qn[3]); *(uint2*)(CQ + (size_t)row * 256 + 4 * lane) = o; }
        { const unsigned raw = *(const unsigned*)(pr + 256 + 2 * lane); float v0 = bflo(raw), v1 = bfhi(raw);
          const float rs = 1.0f / sqrtf(wave_sum(v0 * v0 + v1 * v1) * (1.f / 128.f) + EPS);
          *(unsigned*)(CKV + (size_t)row * 128 + 2 * lane) = pk2(v0 * rs * kvn[0], v1 * rs * kvn[1]); }
#pragma unroll
        for (int which = 1; which < 2; ++which) {
            const int l2 = which ? (lane & 15) : lane;
            const v4u raw = *(const v4u*)(pr + (which ? 928 : 416) + 8 * l2); float v[8]; unpack8(raw, v);
            float ss = 0.f;
#pragma unroll
            for (int j = 0; j < 8; ++j) ss += v[j] * v[j];
            ss += __shfl_xor(ss, 1); ss += __shfl_xor(ss, 2); ss += __shfl_xor(ss, 4);
            const float rs = 1.0f / sqrtf(ss * (1.f / 64.f) + EPS); float o[8];
#pragma unroll
            for (int j = 0; j < 8; ++j) { const float x = v[j] * rs * (which ? gk[j] : gq[j]); const float w = __shfl_xor(x, 2); float c, s; cs_rev(pos, revf[j], c, s);
                o[j] = (sub & 2) ? (x * c + w * s) : (x * c - w * s); if (!which) o[j] *= QSCALE_B; }
            if (!which) *(v4u*)(QB + (size_t)row * 512 + 8 * lane) = pack8(o);
            else if (lane < 16) *(v4u*)(KB + (size_t)row * 128 + 8 * lane) = pack8(o);
        }
    }
}

__device__ __forceinline__ void r3_phase(const Args& a, int gw, int NGW, int lane) {
    unsigned char* ws = a.ws;
    const bf16* P = (const bf16*)(ws + A_P); bf16* QA = (bf16*)(ws + A_QA); const bf16* KV = (const bf16*)(ws + A_KV); bf16* KA = (bf16*)(ws + A_KA);
    const int head = lane >> 3, sub = lane & 7;
    float gqn[8], gqr[4], gkn[8], gkr[4], revf[4];
#pragma unroll
    for (int j = 0; j < 8; ++j) { gqn[j] = a.in[I_MLA_QG][8 * sub + j]; gkn[j] = a.in[I_MLA_KG][8 * sub + j]; }
#pragma unroll
    for (int j = 0; j < 4; ++j) { gqr[j] = a.in[I_MLA_QG][64 + 4 * sub + j]; gkr[j] = a.in[I_MLA_KG][64 + 4 * sub + j];
        const int i = 4 * (sub & 3) + j; revf[j] = exp2f(-(float)i * (LOG2_THETA / 16.f)) * INV_2PI; }
#pragma unroll 2
    for (int row = gw; row < T; row += NGW) {
        const float pos = (float)(row & 4095);
#pragma unroll
        for (int which = 1; which < 2; ++which) {
            const bf16* np = which ? (KV + (size_t)row * 512 + head * 64 + 8 * sub) : (QA + (size_t)row * 768 + head * 96 + 8 * sub);
            const bf16* rp = which ? (P + (size_t)row * 1280 + 384 + 4 * sub) : (QA + (size_t)row * 768 + head * 96 + 64 + 4 * sub);
            const v4u rn = *(const v4u*)np; const uint2 rr = *(const uint2*)rp;
            float v[8], r4[4]; unpack8(rn, v); r4[0] = bflo(rr.x); r4[1] = bfhi(rr.x); r4[2] = bflo(rr.y); r4[3] = bfhi(rr.y);
            float ss = 0.f;
#pragma unroll
            for (int j = 0; j < 8; ++j) ss += v[j] * v[j];
#pragma unroll
            for (int j = 0; j < 4; ++j) ss += r4[j] * r4[j];
            ss += __shfl_xor(ss, 1); ss += __shfl_xor(ss, 2); ss += __shfl_xor(ss, 4);
            const float rs = 1.0f / sqrtf(ss * (1.f / 96.f) + EPS); const float qs = which ? 1.0f : QSCALE_A;
            float o[8], orp[4];
#pragma unroll
            for (int j = 0; j < 8; ++j) o[j] = v[j] * rs * (which ? gkn[j] : gqn[j]) * qs;
#pragma unroll
            for (int j = 0; j < 4; ++j) { const float x = r4[j] * rs * (which ? gkr[j] : gqr[j]); const float w = __shfl_xor(x, 4); float c, s; cs_rev(pos, revf[j], c, s);
                orp[j] = ((sub & 4) ? (x * c + w * s) : (x * c - w * s)) * qs; }
            bf16* on = (which ? KA : QA) + (size_t)row * 768 + head * 96;
            *(v4u*)(on + 8 * sub) = pack8(o);
            uint2 o2; o2.x = pk2(orp[0], orp[1]); o2.y = pk2(orp[2], orp[3]); *(uint2*)(on + 64 + 4 * sub) = o2;
        }
    }
}

__device__ __forceinline__ void r6_phase(const Args& a, int gw, int NGW, int lane) {
    bf16* QKV = (bf16*)(a.ws + A_QKV);
    const int sub = lane & 3;
    float gq[16], gk[16], revf[16];
#pragma unroll
    for (int j = 0; j < 16; ++j) { gq[j] = a.in[I_DIL_QG][16 * sub + j]; gk[j] = a.in[I_DIL_KG][16 * sub + j];
        const int i = 16 * (sub & 1) + j; revf[j] = exp2f(-(float)i * (LOG2_THETA / 32.f)) * INV_2PI; }
    for (int row = gw; row < T; row += NGW) {
        const float pos = (float)(row & 4095);
#pragma unroll
        for (int which = 0; which < 2; ++which) {
            bf16* p = QKV + (size_t)row * 3072 + which * 1024 + 16 * lane;
            const v4u r0 = *(const v4u*)p, r1 = *(const v4u*)(p + 8); float v0[8], v1[8]; unpack8(r0, v0); unpack8(r1, v1);
            float ss = 0.f;
#pragma unroll
            for (int j = 0; j < 8; ++j) ss += v0[j] * v0[j] + v1[j] * v1[j];
            ss += __shfl_xor(ss, 1); ss += __shfl_xor(ss, 2);
            const float rs = 1.0f / sqrtf(ss * (1.f / 64.f) + EPS); float o0[8], o1[8];
#pragma unroll
            for (int j = 0; j < 16; ++j) { const float xin = (j < 8) ? v0[j & 7] : v1[j & 7]; const float x = xin * rs * (which ? gk[j] : gq[j]); const float w = __shfl_xor(x, 2); float c, s; cs_rev(pos, revf[j], c, s);
                float o = (sub & 2) ? (x * c + w * s) : (x * c - w * s); if (!which) o *= QSCALE_B; if (j < 8) o0[j & 7] = o; else o1[j & 7] = o; }
            *(v4u*)p = pack8(o0); *(v4u*)(p + 8) = pack8(o1);
        }
    }
}
namespace att {
using f32x16 = __attribute__((ext_vector_type(16))) float;
using s16x4 = __attribute__((ext_vector_type(4))) short;
#define SBAR() __builtin_amdgcn_sched_barrier(0)
__device__ __forceinline__ int crow(int r, int hi) { return (r & 3) + 8 * (r >> 2) + 4 * hi; }
template <int DQ> struct Lay {
    static constexpr int KROW = DQ * 2 + 16;
    static constexpr int KBUF = 64 * KROW;
    static constexpr int VBUF = 8192;
    static constexpr int K_OFF = 0, V_OFF = 2 * KBUF, WS_OFF = V_OFF + 2 * VBUF, BYTES = WS_OFF + 8 * 512;
};
__device__ __forceinline__ int v_st(int k, int c) { const int kk = k; return ((kk >> 3) * 2 + (c >> 5)) * 512 + ((kk & 7) * 32 + (c & 31)) * 2; }
__device__ __forceinline__ int v_rd_base(int lane) { return ((lane & 3) << 3) | (((lane >> 2) & 3) << 6) | (((lane >> 4) & 1) << 5) | (((lane >> 5) & 1) << 8); }
template <int OFF> __device__ __forceinline__ s16x4 tr_read(int vb) { s16x4 r; asm volatile("ds_read_b64_tr_b16 %0, %1 offset:%2" : "=&v"(r) : "v"(vb), "i"(OFF) : "memory"); return r; }
template <int D0> __device__ __forceinline__ void pv_one(f32x16& od, int vb, bf16x8 pa0, bf16x8 pa1, bf16x8 pa2, bf16x8 pa3) {
    const s16x4 l0 = tr_read<D0 * 512 + 0 * 2048>(vb), h0 = tr_read<D0 * 512 + 0 * 2048 + 1024>(vb), l1 = tr_read<D0 * 512 + 1 * 2048>(vb), h1 = tr_read<D0 * 512 + 1 * 2048 + 1024>(vb);
    const s16x4 l2 = tr_read<D0 * 512 + 2 * 2048>(vb), h2 = tr_read<D0 * 512 + 2 * 2048 + 1024>(vb), l3 = tr_read<D0 * 512 + 3 * 2048>(vb), h3 = tr_read<D0 * 512 + 3 * 2048 + 1024>(vb);
    asm volatile("s_waitcnt lgkmcnt(0)" ::: "memory"); SBAR();
#define PKV(L, H) (bf16x8){L[0], L[1], L[2], L[3], H[0], H[1], H[2], H[3]}
    od = __builtin_amdgcn_mfma_f32_32x32x16_bf16(pa0, PKV(l0, h0), od, 0, 0, 0);
    od = __builtin_amdgcn_mfma_f32_32x32x16_bf16(pa1, PKV(l1, h1), od, 0, 0, 0);
    od = __builtin_amdgcn_mfma_f32_32x32x16_bf16(pa2, PKV(l2, h2), od, 0, 0, 0);
    od = __builtin_amdgcn_mfma_f32_32x32x16_bf16(pa3, PKV(l3, h3), od, 0, 0, 0);
#undef PKV
}
__device__ __forceinline__ float rowmax32(const f32x16& p0, const f32x16& p1) {
    float a = fmaxf(fmaxf(p0[0], p0[1]), p1[0]), b = fmaxf(fmaxf(p0[2], p0[3]), p1[1]); a = fmaxf(fmaxf(a, p1[2]), p1[3]);
#pragma unroll
    for (int r = 4; r < 16; r += 4) { a = fmaxf(fmaxf(a, p0[r]), p0[r + 1]); b = fmaxf(fmaxf(b, p0[r + 2]), p0[r + 3]); a = fmaxf(fmaxf(a, p1[r]), p1[r + 1]); b = fmaxf(fmaxf(b, p1[r + 2]), p1[r + 3]); }
    float m = fmaxf(a, b);
    auto rr = __builtin_amdgcn_permlane32_swap(__float_as_uint(m), __float_as_uint(m), false, false);
    return fmaxf(__uint_as_float(rr[0]), __uint_as_float(rr[1]));
}
template <int D0, int KH> __device__ __forceinline__ void pv_half(f32x16& od, int vb, bf16x8 paA, bf16x8 paB) {
    const s16x4 l0 = tr_read<D0 * 512 + (2 * KH) * 2048>(vb), h0 = tr_read<D0 * 512 + (2 * KH) * 2048 + 1024>(vb), l1 = tr_read<D0 * 512 + (2 * KH + 1) * 2048>(vb), h1 = tr_read<D0 * 512 + (2 * KH + 1) * 2048 + 1024>(vb);
    asm volatile("s_waitcnt lgkmcnt(0)" ::: "memory"); SBAR();
#define PKV(L, H) (bf16x8){L[0], L[1], L[2], L[3], H[0], H[1], H[2], H[3]}
    od = __builtin_amdgcn_mfma_f32_32x32x16_bf16(paA, PKV(l0, h0), od, 0, 0, 0);
    od = __builtin_amdgcn_mfma_f32_32x32x16_bf16(paB, PKV(l1, h1), od, 0, 0, 0);
#undef PKV
}
struct VF { s16x4 l0, h0, l1, h1, l2, h2, l3, h3; };
template <int D0> __device__ __forceinline__ void v_issue(VF& f, int vb) {
    f.l0 = tr_read<D0 * 512 + 0 * 2048>(vb); f.h0 = tr_read<D0 * 512 + 0 * 2048 + 1024>(vb); f.l1 = tr_read<D0 * 512 + 1 * 2048>(vb); f.h1 = tr_read<D0 * 512 + 1 * 2048 + 1024>(vb);
    f.l2 = tr_read<D0 * 512 + 2 * 2048>(vb); f.h2 = tr_read<D0 * 512 + 2 * 2048 + 1024>(vb); f.l3 = tr_read<D0 * 512 + 3 * 2048>(vb); f.h3 = tr_read<D0 * 512 + 3 * 2048 + 1024>(vb); }
__device__ __forceinline__ void pv_mm(f32x16& od, const VF& f, bf16x8 pa0, bf16x8 pa1, bf16x8 pa2, bf16x8 pa3) {
#define PKV(L, H) (bf16x8){L[0], L[1], L[2], L[3], H[0], H[1], H[2], H[3]}
    od = __builtin_amdgcn_mfma_f32_32x32x16_bf16(pa0, PKV(f.l0, f.h0), od, 0, 0, 0); od = __builtin_amdgcn_mfma_f32_32x32x16_bf16(pa1, PKV(f.l1, f.h1), od, 0, 0, 0);
    od = __builtin_amdgcn_mfma_f32_32x32x16_bf16(pa2, PKV(f.l2, f.h2), od, 0, 0, 0); od = __builtin_amdgcn_mfma_f32_32x32x16_bf16(pa3, PKV(f.l3, f.h3), od, 0, 0, 0);
#undef PKV
}
__device__ __forceinline__ void pv_ones(f32x16& os, bf16x8 pa0, bf16x8 pa1, bf16x8 pa2, bf16x8 pa3) {
    const bf16x8 one = {0x3F80, 0x3F80, 0x3F80, 0x3F80, 0x3F80, 0x3F80, 0x3F80, 0x3F80};
    os = __builtin_amdgcn_mfma_f32_32x32x16_bf16(pa0, one, os, 0, 0, 0); os = __builtin_amdgcn_mfma_f32_32x32x16_bf16(pa1, one, os, 0, 0, 0);
    os = __builtin_amdgcn_mfma_f32_32x32x16_bf16(pa2, one, os, 0, 0, 0); os = __builtin_amdgcn_mfma_f32_32x32x16_bf16(pa3, one, os, 0, 0, 0); }
struct LayB { static constexpr int KROW = 144, KBUF = 64 * KROW, VBUF = 8192, NS = 6, K_OFF = 0, V_OFF = NS * KBUF, WS_OFF = V_OFF + NS * VBUF, OST_OFF = WS_OFF + 8 * 512, BYTES = OST_OFF + 8 * 4096; };
struct BU { unsigned rowq; int t0, nt, q0; };
__device__ __forceinline__ BU band_unit(int dil, int sub) { BU u; const int r = (dil == 1) ? 0 : (dil == 4 ? (sub >> 2) : sub), qb = (dil == 1) ? sub : (dil == 4 ? (sub & 3) : 0), ntt = 64 / dil;
    u.rowq = (unsigned)(r + 256 * qb * dil); const int t0 = (4 * qb - 1 < 0) ? 0 : 4 * qb - 1, t1 = (4 * qb + 5 > ntt) ? ntt : 4 * qb + 5; u.t0 = t0; u.nt = t1 - t0; u.q0 = 256 * qb; return u; }
template <bool MERGE, bool FAST>
__device__ __forceinline__ void band_phase(const bf16* Qh, const bf16* Kh, const bf16* Vh, int dil, bf16* Ob, int ldo, float* Lb, const bf16* O1b, const bf16* O2b, const float* L1b, const float* L2b, LAS char* lds) {
    using LY = LayB;
    int tid = threadIdx.x; asm volatile("" : "+v"(tid));
    const int lane = tid & 63, r32 = lane & 31, hi = lane >> 5; const int wid = __builtin_amdgcn_readfirstlane(tid >> 6);
    LAS float* wsf = (LAS float*)(lds + LY::WS_OFF) + wid * 128;
    LAS char* ost = lds + LY::OST_OFF + wid * 4096;
    const int krow = tid >> 3, kch = tid & 7;
    const int vkey = 2 * (tid >> 4) + ((tid >> 2) & 1), vcol = 32 * ((tid >> 3) & 1) + 8 * (tid & 3);
    const int kst = krow * LY::KROW + kch * 16, vst = v_st(vkey, vcol);
    const int vb0 = (int)(unsigned)(size_t)(lds + LY::V_OFF) + v_rd_base(lane);
    const LAS char* kbase = lds + LY::K_OFF + r32 * LY::KROW + hi * 16;
    bf16x8 sk[6], sv[6], qr[4];
    const int ldb = dil * 128;
    const unsigned ko_ = (unsigned)(krow * ldb + kch * 16), vo_ = (unsigned)(vkey * ldb + vcol * 2), qo_ = (unsigned)((wid * 32 + r32) * ldb + hi * 16);
    BU cur = band_unit(dil, 0);
#define B_LOADS(U) do { const size_t sb_ = (size_t)((U).rowq % (unsigned)dil) * 128; \
        _Pragma("unroll") for (int s_ = 0; s_ < 6; ++s_) if (s_ < (U).nt) { const size_t o_ = sb_ + (size_t)((U).t0 + s_) * 64 * (size_t)ldb; \
            sk[s_] = *reinterpret_cast<const bf16x8*>((const char*)Kh + o_ + ko_); sv[s_] = *reinterpret_cast<const bf16x8*>((const char*)Vh + o_ + vo_); } } while (0)
    B_LOADS(cur);
    for (int L = 0; L < 16; ++L) {
        { const char* qb_ = (const char*)Qh + (size_t)cur.rowq * 128;
#pragma unroll
          for (int d0 = 0; d0 < 4; ++d0) qr[d0] = *reinterpret_cast<const bf16x8*>(qb_ + d0 * 32 + qo_); }
        asm volatile("s_waitcnt lgkmcnt(0)\n\ts_barrier" ::: "memory");
#pragma unroll
        for (int s_ = 0; s_ < 6; ++s_) if (s_ < cur.nt) { *(LAS bf16x8*)(lds + LY::K_OFF + s_ * LY::KBUF + kst) = sk[s_]; *(LAS bf16x8*)(lds + LY::V_OFF + s_ * LY::VBUF + vst) = sv[s_]; }
        asm volatile("s_waitcnt lgkmcnt(0)\n\ts_barrier" ::: "memory");
        const bool has_next = (L + 1 < 16);
        BU nxt = cur; if (has_next) { nxt = band_unit(dil, L + 1); B_LOADS(nxt); }
        const int lo = cur.q0 + 32 * wid; int ta = (lo - 64) >> 6, tb = (lo + 95) >> 6; if (ta < cur.t0) ta = cur.t0; if (tb > cur.t0 + cur.nt - 1) tb = cur.t0 + cur.nt - 1;
        const int qi = lo + r32;
        float m_reg = -1e30f, l_reg = 0.f; f32x16 o[2]; o[0] = f32x16{}; o[1] = f32x16{};
#define PK4(P, BASE, OUT) do { v4u w = {cvtpk(P[BASE + 0], P[BASE + 1]), cvtpk(P[BASE + 2], P[BASE + 3]), cvtpk(P[BASE + 4], P[BASE + 5]), cvtpk(P[BASE + 6], P[BASE + 7])}; OUT = *reinterpret_cast<bf16x8*>(&w); } while (0)
        if constexpr (FAST) {
            const int kbeg = lo - 64, lstream = 4096 / dil, thr_ = r32 - 4 * hi;
#define BH_ADDR(j, KB, VB, OKJ) const int kh##j = kbeg + 32 * (j); const bool OKJ = (kh##j >= 0) && (kh##j < lstream); \
            int tj##j = kh##j >> 6; tj##j = tj##j < cur.t0 ? cur.t0 : (tj##j > cur.t0 + cur.nt - 1 ? cur.t0 + cur.nt - 1 : tj##j); const int hf##j = (kh##j >> 5) & 1; \
            const LAS char* KB = kbase + (tj##j - cur.t0) * LY::KBUF + hf##j * 32 * LY::KROW; const int VB = vb0 + (tj##j - cur.t0) * LY::VBUF + hf##j * 4096;
#define BH_QK(P, KB) do { P = f32x16{}; _Pragma("unroll") for (int d0 = 0; d0 < 4; ++d0) { const bf16x8 b_ = *(const LAS bf16x8*)((KB) + d0 * 32); P = __builtin_amdgcn_mfma_f32_32x32x16_bf16(b_, qr[d0], P, 0, 0, 0); } } while (0)
#define BH_SM(P, OKJ, MODE, PA, PB) do { \
            if ((MODE) == 1) { _Pragma("unroll") for (int r = 0; r < 16; ++r) { const int c_ = (r & 3) + 8 * (r >> 2); if (c_ < thr_) P[r] = -INFINITY; } } \
            if ((MODE) == 2) { _Pragma("unroll") for (int r = 0; r < 16; ++r) { const int c_ = (r & 3) + 8 * (r >> 2); if (c_ > thr_) P[r] = -INFINITY; } } \
            float ps_ = 0.f; _Pragma("unroll") for (int r = 0; r < 16; ++r) { const float e_ = __builtin_amdgcn_exp2f(P[r]); P[r] = (OKJ) ? e_ : 0.f; ps_ += P[r]; } l_reg += ps_; \
            PK4(P, 0, PA); PK4(P, 8, PB); } while (0)
#define BH_PV(VB, PA, PB) do { pv_half<0, 0>(o[0], VB, PA, PB); pv_half<1, 0>(o[1], VB, PA, PB); } while (0)
            BH_ADDR(0, kb0_, vbh0_, ok0_) BH_ADDR(1, kb1_, vbh1_, ok1_) BH_ADDR(2, kb2_, vbh2_, ok2_) BH_ADDR(3, kb3_, vbh3_, ok3_) BH_ADDR(4, kb4_, vbh4_, ok4_)
            f32x16 pX, pY; bf16x8 paA, paB;
            BH_QK(pX, kb0_);
            BH_QK(pY, kb1_); BH_SM(pX, ok0_, 1, paA, paB); BH_PV(vbh0_, paA, paB);
            BH_QK(pX, kb2_); BH_SM(pY, ok1_, 0, paA, paB); BH_PV(vbh1_, paA, paB);
            BH_QK(pY, kb3_); BH_SM(pX, ok2_, 0, paA, paB); BH_PV(vbh2_, paA, paB);
            BH_QK(pX, kb4_); BH_SM(pY, ok3_, 0, paA, paB); BH_PV(vbh3_, paA, paB);
            BH_SM(pX, ok4_, 2, paA, paB); BH_PV(vbh4_, paA, paB);
#undef BH_ADDR
#undef BH_QK
#undef BH_SM
#undef BH_PV
            { auto rr = __builtin_amdgcn_permlane32_swap(__float_as_uint(l_reg), __float_as_uint(l_reg), false, false); l_reg = __uint_as_float(rr[0]) + __uint_as_float(rr[1]); }
            m_reg = 0.f;
        } else
        for (int t = ta; t <= tb; ++t) {
            const int slot = t - cur.t0;
            f32x16 p0 = f32x16{}, p1 = f32x16{};
            { const LAS char* kb = kbase + slot * LY::KBUF;
#pragma unroll
              for (int d0 = 0; d0 < 4; ++d0) { const bf16x8 b0 = *(const LAS bf16x8*)(kb + d0 * 32); const bf16x8 b1 = *(const LAS bf16x8*)(kb + 32 * LY::KROW + d0 * 32);
                  p0 = __builtin_amdgcn_mfma_f32_32x32x16_bf16(b0, qr[d0], p0, 0, 0, 0); p1 = __builtin_amdgcn_mfma_f32_32x32x16_bf16(b1, qr[d0], p1, 0, 0, 0); } }
            if (64 * t < lo - 33) { const int a_ = qi - 64 - 64 * t - 4 * hi;
#pragma unroll
                for (int r = 0; r < 16; ++r) { const int c_ = (r & 3) + 8 * (r >> 2); if (c_ < a_) p0[r] = -INFINITY; if (c_ + 32 < a_) p1[r] = -INFINITY; } }
            else if (64 * t + 63 > lo + 64) { const int b_ = qi + 64 - 64 * t - 4 * hi;
#pragma unroll
                for (int r = 0; r < 16; ++r) { const int c_ = (r & 3) + 8 * (r >> 2); if (c_ > b_) p0[r] = -INFINITY; if (c_ + 32 > b_) p1[r] = -INFINITY; } }
            const float pmax = rowmax32(p0, p1);
            if (t == ta) { m_reg = fmaxf(pmax, -1e30f); }
            else if (__any(pmax > m_reg)) {
                const float mn = fmaxf(m_reg, pmax); const float alpha = __builtin_amdgcn_exp2f(m_reg - mn); m_reg = mn; l_reg *= alpha;
                if (hi == 0) wsf[r32] = alpha; asm volatile("s_waitcnt lgkmcnt(0)" ::: "memory");
#pragma unroll
                for (int r = 0; r < 16; ++r) { const float al = wsf[crow(r, hi)]; o[0][r] *= al; o[1][r] *= al; }
            }
#pragma unroll
            for (int r = 0; r < 16; ++r) { p0[r] = __builtin_amdgcn_exp2f(p0[r] - m_reg); p1[r] = __builtin_amdgcn_exp2f(p1[r] - m_reg); }
            float ps = 0.f;
#pragma unroll
            for (int r = 0; r < 16; ++r) ps += p0[r] + p1[r];
            { auto rr = __builtin_amdgcn_permlane32_swap(__float_as_uint(ps), __float_as_uint(ps), false, false); ps = __uint_as_float(rr[0]) + __uint_as_float(rr[1]); }
            l_reg += ps;
            bf16x8 pa0, pa1, pa2, pa3;
            PK4(p0, 0, pa0); PK4(p0, 8, pa1); PK4(p1, 0, pa2); PK4(p1, 8, pa3);
            const int vb = vb0 + slot * LY::VBUF;
            pv_one<0>(o[0], vb, pa0, pa1, pa2, pa3); pv_one<1>(o[1], vb, pa0, pa1, pa2, pa3);
        }
#undef PK4
        const float lse = m_reg + __builtin_amdgcn_logf(l_reg);
        if (hi == 0) { wsf[r32] = __builtin_amdgcn_rcpf(l_reg); wsf[32 + r32] = lse; }
        v4u a1[4], a2[4]; float L1v[4], L2v[4];
        if constexpr (MERGE) {
#pragma unroll
            for (int i = 0; i < 4; ++i) { const size_t tr_ = (size_t)cur.rowq + (size_t)(wid * 32 + (lane >> 3) + 8 * i) * dil;
                a1[i] = *(const v4u*)(O1b + tr_ * 64 + (lane & 7) * 8); a2[i] = *(const v4u*)(O2b + tr_ * 64 + (lane & 7) * 8); L1v[i] = L1b[tr_]; L2v[i] = L2b[tr_]; }
        }
        asm volatile("s_waitcnt lgkmcnt(0)" ::: "memory");
        { const int odd = lane & 1; const unsigned sel = odd ? 0x03020706u : 0x05040100u;
          LAS char* wb = ost + (4 * hi + odd) * 128 + (r32 & ~1) * 2;
#pragma unroll
          for (int k = 0; k < 8; ++k) { const int r0 = ((2 * k) & 3) + 8 * ((2 * k) >> 2);
              const float rl0 = wsf[r0 + 4 * hi], rl1 = wsf[r0 + 1 + 4 * hi];
#pragma unroll
              for (int d0 = 0; d0 < 2; ++d0) { const unsigned pk = cvtpk(o[d0][2 * k] * rl0, o[d0][2 * k + 1] * rl1);
                  const unsigned rc = (unsigned)__builtin_amdgcn_update_dpp(0, (int)pk, 0xB1, 0xF, 0xF, false);
                  *(LAS unsigned*)(wb + r0 * 128 + d0 * 64) = __builtin_amdgcn_perm(rc, pk, sel); } } }
        asm volatile("s_waitcnt lgkmcnt(0)" ::: "memory");
        if (!MERGE) { if (hi == 0) Lb[(size_t)cur.rowq + (size_t)(wid * 32 + r32) * dil] = lse; }
        v4u vv[4]; float L3v[4];
#pragma unroll
        for (int i = 0; i < 4; ++i) { const int row = (lane >> 3) + 8 * i; vv[i] = *(const LAS v4u*)(ost + row * 128 + (lane & 7) * 16); if (MERGE) L3v[i] = wsf[32 + row]; }
#pragma unroll
        for (int i = 0; i < 4; ++i) { const int row = (lane >> 3) + 8 * i, ch = lane & 7; const size_t tr_ = (size_t)cur.rowq + (size_t)(wid * 32 + row) * dil;
            v4u v = vv[i];
            if constexpr (MERGE) {
                const float L3 = L3v[i], L1 = L1v[i], L2 = L2v[i];
                const float M = fmaxf(L3, fmaxf(L1, L2)); float w1 = __builtin_amdgcn_exp2f(L1 - M), w2 = __builtin_amdgcn_exp2f(L2 - M), w3 = __builtin_amdgcn_exp2f(L3 - M);
                const float inv = __builtin_amdgcn_rcpf(w1 + w2 + w3); w1 *= inv; w2 *= inv; w3 *= inv;
                float x3[8], x1[8], x2[8], y[8]; unpack8(v, x3); unpack8(a1[i], x1); unpack8(a2[i], x2);
#pragma unroll
                for (int e = 0; e < 8; ++e) y[e] = w1 * x1[e] + w2 * x2[e] + w3 * x3[e];
                v = pack8(y);
            }
            *(v4u*)(Ob + tr_ * (size_t)ldo + ch * 8) = v; }
        cur = nxt;
    }
    __syncthreads();
#undef B_LOADS
}


template <int DQ> __device__ __forceinline__ void q_finish(bf16x8 (&qr)[DQ / 16], const float* __restrict__ gain, int t, int hi) {
    constexpr int ND = DQ / 16; float v[ND][8]; float ss = 0.f;
#pragma unroll
    for (int d0 = 0; d0 < ND; ++d0) { const v4u r = __builtin_bit_cast(v4u, qr[d0]); unpack8(r, v[d0]);
#pragma unroll
        for (int j = 0; j < 8; ++j) ss += v[d0][j] * v[d0][j]; }
    { auto rr = __builtin_amdgcn_permlane32_swap(__float_as_uint(ss), __float_as_uint(ss), false, false); ss = __uint_as_float(rr[0]) + __uint_as_float(rr[1]); }
    const float rs = (1.0f / sqrtf(ss * (1.0f / DQ) + EPS)) * (DQ == 96 ? QSCALE_A : QSCALE_B);
#pragma unroll
    for (int d0 = 0; d0 < ND; ++d0) { const f32x4 g0 = *(const f32x4*)(gain + 16 * d0 + 8 * hi), g1 = *(const f32x4*)(gain + 16 * d0 + 8 * hi + 4);
        v[d0][0] *= rs * g0[0]; v[d0][1] *= rs * g0[1]; v[d0][2] *= rs * g0[2]; v[d0][3] *= rs * g0[3]; v[d0][4] *= rs * g1[0]; v[d0][5] *= rs * g1[1]; v[d0][6] *= rs * g1[2]; v[d0][7] *= rs * g1[3]; }
#pragma unroll
    for (int j = 0; j < 8; ++j) { const float revf = exp2f(-(float)(8 * hi + j) * (LOG2_THETA / 16.f)) * INV_2PI; float c, s;
        if (DQ == 96) { cs_rev((float)t, revf, c, s); const float a = v[4][j], b = v[5][j]; v[4][j] = a * c - b * s; v[5][j] = a * s + b * c; }
        else { cs_rev((float)(t >> 6), revf, c, s); float a = v[0][j], b = v[1][j]; v[0][j] = a * c - b * s; v[1][j] = a * s + b * c;
               cs_rev((float)(t & 63), revf, c, s); a = v[2][j]; b = v[3][j]; v[2][j] = a * c - b * s; v[3][j] = a * s + b * c; } }
#pragma unroll
    for (int d0 = 0; d0 < ND; ++d0) { const v4u w = pack8(v[d0]); qr[d0] = __builtin_bit_cast(bf16x8, w); }
}
constexpr float THR_L2 = 8.0f;
template <int DQ, int NS_ = 4> struct LayD {
    static constexpr int KROW = DQ * 2 + 16, KBUF = 64 * KROW, VBUF = 8192, NS = NS_;
    static constexpr int K_OFF = 0, V_OFF = NS * KBUF, WS_OFF = V_OFF + NS * VBUF, OST_OFF = WS_OFF + 8 * 512, BYTES_D = OST_OFF + 8 * 4096;
    static_assert(BYTES_D <= 160 * 1024 - 1024, "attention LDS");
};
template <int DQ>
__device__ __forceinline__ void attn_dense(const bf16* __restrict__ Qp, long ldq, const float* __restrict__ qgain, int tq0, const bf16* __restrict__ Kp, long ldk, const bf16* __restrict__ Vp, long ldv, int NT, bf16* Op, long ldo, LAS char* lds) {
    using LY = LayD<DQ>;
    int tid = threadIdx.x; asm volatile("" : "+v"(tid));
    const int lane = tid & 63, r32 = lane & 31, hi = lane >> 5; const int wid = __builtin_amdgcn_readfirstlane(tid >> 6);
    LAS float* wsf = (LAS float*)(lds + LY::WS_OFF) + wid * 128;
    bf16x8 qr[DQ / 16];
    { const bf16* Qw = Qp + (long)(wid * 32 + r32) * ldq + hi * 8;
#pragma unroll
      for (int d0 = 0; d0 < DQ / 16; ++d0) qr[d0] = *reinterpret_cast<const bf16x8*>(Qw + d0 * 16); }
    q_finish<DQ>(qr, qgain, tq0 + wid * 32 + r32, hi);
    constexpr int CPR = DQ / 8;
    const int kc0 = tid, krow0 = kc0 / CPR, kch0 = kc0 % CPR;
    const int kc1 = tid + 512, krow1 = kc1 / CPR, kch1 = kc1 % CPR;
    const bool k2 = (DQ == 96) && (wid < 4);
    const int vkey = 2 * (tid >> 4) + ((tid >> 2) & 1), vcol = 32 * ((tid >> 3) & 1) + 8 * (tid & 3);
    const int kst0 = krow0 * LY::KROW + kch0 * 16, kst1 = krow1 * LY::KROW + kch1 * 16, vst = v_st(vkey, vcol);
    const bf16* kg0 = Kp + (long)krow0 * ldk + kch0 * 8; const bf16* kg1 = Kp + (long)krow1 * ldk + kch1 * 8; const bf16* vg = Vp + (long)vkey * ldv + vcol;
    bf16x8 skE0, skE1 = {}, svE, skO0, skO1 = {}, svO;
#define D_LOAD(SK0, SK1, SV, t) do { const long ko = (long)(t) * 64 * ldk; SK0 = *reinterpret_cast<const bf16x8*>(kg0 + ko); if (k2) SK1 = *reinterpret_cast<const bf16x8*>(kg1 + ko); SV = *reinterpret_cast<const bf16x8*>(vg + (long)(t) * 64 * ldv); } while (0)
#define D_WRITE(b, SK0, SK1, SV) do { *(LAS bf16x8*)(lds + LY::K_OFF + (b) * LY::KBUF + kst0) = SK0; if (k2) *(LAS bf16x8*)(lds + LY::K_OFF + (b) * LY::KBUF + kst1) = SK1; \
        *(LAS bf16x8*)(lds + LY::V_OFF + (b) * LY::VBUF + vst) = SV; } while (0)
    const int vb0 = (int)(unsigned)(size_t)(lds + LY::V_OFF) + v_rd_base(lane);
    const LAS char* kbase = lds + LY::K_OFF + r32 * LY::KROW + hi * 16;
    float m_ref = 0.f, l_reg = 0.f; f32x16 o[2]; o[0] = f32x16{}; o[1] = f32x16{};
    f32x16 negm = f32x16{}; asm volatile("" : "+v"(negm));
    f32x16 pA0, pA1, pB0, pB1; float alA = 1.f, alB = 1.f; bf16x8 pa0, pa1, pa2, pa3;
#define D_QKT(P0, P1, b) do { const LAS char* kb_ = kbase + (b) * LY::KBUF; P0 = negm; P1 = negm; \
        _Pragma("unroll") for (int d0 = 0; d0 < DQ / 16; ++d0) { const bf16x8 b0_ = *(const LAS bf16x8*)(kb_ + d0 * 32); const bf16x8 b1_ = *(const LAS bf16x8*)(kb_ + 32 * LY::KROW + d0 * 32); \
            P0 = __builtin_amdgcn_mfma_f32_32x32x16_bf16(b0_, qr[d0], P0, 0, 0, 0); P1 = __builtin_amdgcn_mfma_f32_32x32x16_bf16(b1_, qr[d0], P1, 0, 0, 0); } } while (0)
#define D_PART(P0, P1, AL, FIRST) do { const float rm_ = rowmax32(P0, P1); AL = 1.f; \
        if ((FIRST) || __any(rm_ > THR_L2)) { const float dl_ = (FIRST) ? rm_ : fmaxf(rm_, 0.f); m_ref += dl_; \
            _Pragma("unroll") for (int r = 0; r < 16; ++r) { P0[r] -= dl_; P1[r] -= dl_; } \
            _Pragma("unroll") for (int r = 0; r < 16; ++r) negm[r] = -m_ref; asm volatile("" : "+v"(negm)); \
            AL = __builtin_amdgcn_exp2f(-dl_); } \
        _Pragma("unroll") for (int r = 0; r < 16; ++r) P0[r] = __builtin_amdgcn_exp2f(P0[r]); } while (0)
#define D_PK4(P, BASE, OUT) do { v4u w = {cvtpk(P[BASE + 0], P[BASE + 1]), cvtpk(P[BASE + 2], P[BASE + 3]), cvtpk(P[BASE + 4], P[BASE + 5]), cvtpk(P[BASE + 6], P[BASE + 7])}; OUT = *reinterpret_cast<bf16x8*>(&w); } while (0)
#define D_FIN(P0, P1, AL) do { _Pragma("unroll") for (int r = 0; r < 16; ++r) P1[r] = __builtin_amdgcn_exp2f(P1[r]); \
        float ps_ = 0.f; _Pragma("unroll") for (int r = 0; r < 16; ++r) ps_ += P0[r]; _Pragma("unroll") for (int r = 0; r < 16; ++r) ps_ += P1[r]; \
        { auto rr = __builtin_amdgcn_permlane32_swap(__float_as_uint(ps_), __float_as_uint(ps_), false, false); ps_ = __uint_as_float(rr[0]) + __uint_as_float(rr[1]); } \
        l_reg = l_reg * (AL) + ps_; D_PK4(P0, 0, pa0); D_PK4(P0, 8, pa1); D_PK4(P1, 0, pa2); D_PK4(P1, 8, pa3); } while (0)
#define D_RESC(AL) do { if (__any((AL) < 1.f)) { if (hi == 0) wsf[r32] = (AL); asm volatile("s_waitcnt lgkmcnt(0)" ::: "memory"); \
        _Pragma("unroll") for (int r = 0; r < 16; ++r) { const float a_ = wsf[crow(r, hi)]; o[0][r] *= a_; o[1][r] *= a_; } } } while (0)
#define D_PV(b) do { const int vb_ = vb0 + (b) * LY::VBUF; pv_one<0>(o[0], vb_, pa0, pa1, pa2, pa3); pv_one<1>(o[1], vb_, pa0, pa1, pa2, pa3); } while (0)
    D_LOAD(skE0, skE1, svE, 0); D_LOAD(skO0, skO1, svO, 1);
    D_WRITE(0, skE0, skE1, svE); D_WRITE(1, skO0, skO1, svO);
    D_LOAD(skE0, skE1, svE, 2); D_LOAD(skO0, skO1, svO, 3);
    __syncthreads();
    D_QKT(pA0, pA1, 0); D_PART(pA0, pA1, alA, true); alA = 1.f;
    for (int j = 1; j + 1 < NT; j += 2) {
        SBAR(); D_QKT(pB0, pB1, j & 3);
        D_FIN(pA0, pA1, alA); SBAR();
        D_PV((j - 1) & 3); D_PART(pB0, pB1, alB, false);
        D_WRITE((j + 1) & 3, skE0, skE1, svE);
        if (j + 3 < NT) D_LOAD(skE0, skE1, svE, j + 3);
        D_RESC(alB); __syncthreads();
        SBAR(); D_QKT(pA0, pA1, (j + 1) & 3);
        D_FIN(pB0, pB1, alB); SBAR();
        D_PV(j & 3); D_PART(pA0, pA1, alA, false);
        D_WRITE((j + 2) & 3, skO0, skO1, svO);
        if (j + 4 < NT) D_LOAD(skO0, skO1, svO, j + 4);
        D_RESC(alA); __syncthreads();
    }
    SBAR(); D_QKT(pB0, pB1, (NT - 1) & 3);
    D_FIN(pA0, pA1, alA); SBAR();
    D_PV((NT - 2) & 3); D_PART(pB0, pB1, alB, false);
    D_RESC(alB);
    D_FIN(pB0, pB1, alB); SBAR();
    D_PV((NT - 1) & 3);
    if (hi == 0) wsf[r32] = __builtin_amdgcn_rcpf(l_reg);
    asm volatile("s_waitcnt lgkmcnt(0)" ::: "memory");
    LAS char* ost = lds + LY::OST_OFF + wid * 4096;
#pragma unroll
    for (int r = 0; r < 16; ++r) { const int orow = crow(r, hi); const float rl = wsf[orow];
        *(LAS unsigned short*)(ost + orow * 128 + r32 * 2) = (unsigned short)f2bf(o[0][r] * rl); *(LAS unsigned short*)(ost + orow * 128 + 64 + r32 * 2) = (unsigned short)f2bf(o[1][r] * rl); }
    asm volatile("s_waitcnt lgkmcnt(0)" ::: "memory");
    bf16* Ow = Op + (long)(wid * 32) * ldo;
#pragma unroll
    for (int i = 0; i < 4; ++i) { const int row = (lane >> 3) + 8 * i, ch = lane & 7; const v4u v = *(const LAS v4u*)(ost + row * 128 + ch * 16); *(v4u*)(Ow + (long)row * ldo + ch * 8) = v; }
    __syncthreads();
#undef D_LOAD
#undef D_WRITE
#undef D_QKT
#undef D_PART
#undef D_PK4
#undef D_FIN
#undef D_RESC
#undef D_PV
}

template <int DQ>
__device__ __forceinline__ void attn_dense_fast(const bf16* __restrict__ Qp, long ldq, const float* __restrict__ qgain, int tq0, const bf16* __restrict__ Kp, long ldk, const bf16* __restrict__ Vp, long ldv, int NT, bf16* Op, long ldo, LAS char* lds) {
    using LY = LayD<DQ, 5>;
    int tid = threadIdx.x; asm volatile("" : "+v"(tid));
    const int lane = tid & 63, r32 = lane & 31, hi = lane >> 5; const int wid = __builtin_amdgcn_readfirstlane(tid >> 6);
    LAS float* wsf = (LAS float*)(lds + LY::WS_OFF) + wid * 128;
    bf16x8 qr[DQ / 16];
    { const bf16* Qw = Qp + (long)(wid * 32 + r32) * ldq + hi * 8;
#pragma unroll
      for (int d0 = 0; d0 < DQ / 16; ++d0) qr[d0] = *reinterpret_cast<const bf16x8*>(Qw + d0 * 16); }
    q_finish<DQ>(qr, qgain, tq0 + wid * 32 + r32, hi);
    constexpr int KCH = LY::KROW / 16, KPC = LY::KBUF / 1024; static_assert(LY::KBUF % 1024 == 0 && KPC <= 16 && KPC > 8, "K tile pieces");
    unsigned kofs[2]; int kpc[2];
#pragma unroll
    for (int i = 0; i < 2; ++i) { int pc = wid + 8 * i; if (pc > KPC - 1) pc = KPC - 1; const int c = pc * 64 + lane, row = c / KCH; int cc = c - row * KCH; if (cc > DQ / 8 - 1) cc = DQ / 8 - 1;
        kpc[i] = pc; kofs[i] = (unsigned)(row * (int)ldk + cc * 8) * 2u; }
    unsigned vofs; { const int pb = (wid * 64 + lane) * 16, sub = pb >> 9, within = (pb & 511) >> 1, key = (sub >> 1) * 8 + (within >> 5), col = (sub & 1) * 32 + (within & 31); vofs = (unsigned)(key * (int)ldv + col) * 2u; }
#define D_DMA(t, b) do { const char* kb_ = (const char*)Kp + (size_t)(t) * 128 * (size_t)ldk; const char* vp_ = (const char*)Vp + (size_t)(t) * 128 * (size_t)ldv; \
        __builtin_amdgcn_global_load_lds((const unsigned*)(kb_ + kofs[0]), (LAS unsigned*)(lds + LY::K_OFF + (b) * LY::KBUF + kpc[0] * 1024), 16, 0, 0); \
        __builtin_amdgcn_global_load_lds((const unsigned*)(kb_ + kofs[1]), (LAS unsigned*)(lds + LY::K_OFF + (b) * LY::KBUF + kpc[1] * 1024), 16, 0, 0); \
        __builtin_amdgcn_global_load_lds((const unsigned*)(vp_ + vofs), (LAS unsigned*)(lds + LY::V_OFF + (b) * LY::VBUF + wid * 1024), 16, 0, 0); } while (0)
#define D_BAR(N) asm volatile("s_waitcnt vmcnt(" #N ")\n\ts_barrier" ::: "memory")
    const int vb0 = (int)(unsigned)(size_t)(lds + LY::V_OFF) + v_rd_base(lane);
    const LAS char* kbase = lds + LY::K_OFF + r32 * LY::KROW + hi * 16;
    f32x16 o[2]; o[0] = f32x16{}; o[1] = f32x16{}; float l0 = 0.f, l1 = 0.f, l2 = 0.f, l3 = 0.f;
    f32x16 pA0, pA1, pB0, pB1; bf16x8 pa0, pa1, pa2, pa3;
#define D_QKT(P0, P1, b) do { const LAS char* kb_ = kbase + (b) * LY::KBUF; P0 = f32x16{}; P1 = f32x16{}; \
        _Pragma("unroll") for (int d0 = 0; d0 < DQ / 16; ++d0) { const bf16x8 b0_ = *(const LAS bf16x8*)(kb_ + d0 * 32); const bf16x8 b1_ = *(const LAS bf16x8*)(kb_ + 32 * LY::KROW + d0 * 32); \
            P0 = __builtin_amdgcn_mfma_f32_32x32x16_bf16(b0_, qr[d0], P0, 0, 0, 0); P1 = __builtin_amdgcn_mfma_f32_32x32x16_bf16(b1_, qr[d0], P1, 0, 0, 0); } } while (0)
#define D_PK4(P, BASE, OUT) do { v4u w = {cvtpk(P[BASE + 0], P[BASE + 1]), cvtpk(P[BASE + 2], P[BASE + 3]), cvtpk(P[BASE + 4], P[BASE + 5]), cvtpk(P[BASE + 6], P[BASE + 7])}; OUT = *reinterpret_cast<bf16x8*>(&w); } while (0)
#define D_FIN(P0, P1) do { _Pragma("unroll") for (int r = 0; r < 16; ++r) { P0[r] = __builtin_amdgcn_exp2f(P0[r]); P1[r] = __builtin_amdgcn_exp2f(P1[r]); } \
        D_PK4(P0, 0, pa0); D_PK4(P0, 8, pa1); D_PK4(P1, 0, pa2); D_PK4(P1, 8, pa3); } while (0)
#define PKVF(L, H) (bf16x8){L[0], L[1], L[2], L[3], H[0], H[1], H[2], H[3]}
#define D_ADDA(ACC, X) asm("v_add_f32 %0, %0, %1" : "+v"(ACC) : "v"(X))
#define D_MMA4(OD, PA, L, H, PC, R0) do { OD = __builtin_amdgcn_mfma_f32_32x32x16_bf16(PA, PKVF(L, H), OD, 0, 0, 0); \
        D_ADDA(l0, PC[R0]); D_ADDA(l1, PC[R0 + 1]); D_ADDA(l2, PC[R0 + 2]); D_ADDA(l3, PC[R0 + 3]); SBAR(); } while (0)
#define D_STEP(HAVEN, PN0, PN1, SN, PC0, PC1, SC) do { VF fa_, fb_; const int vb_ = vb0 + (SC) * LY::VBUF; \
        v_issue<0>(fa_, vb_); SBAR(); \
        if (HAVEN) D_QKT(PN0, PN1, SN); \
        D_FIN(PC0, PC1); \
        asm volatile("s_waitcnt lgkmcnt(0)" ::: "memory"); SBAR(); \
        v_issue<1>(fb_, vb_); \
        D_MMA4(o[0], pa0, fa_.l0, fa_.h0, PC0, 0); D_MMA4(o[0], pa1, fa_.l1, fa_.h1, PC0, 4); D_MMA4(o[0], pa2, fa_.l2, fa_.h2, PC0, 8); D_MMA4(o[0], pa3, fa_.l3, fa_.h3, PC0, 12); \
        asm volatile("s_waitcnt lgkmcnt(0)" ::: "memory"); SBAR(); \
        D_MMA4(o[1], pa0, fb_.l0, fb_.h0, PC1, 0); D_MMA4(o[1], pa1, fb_.l1, fb_.h1, PC1, 4); D_MMA4(o[1], pa2, fb_.l2, fb_.h2, PC1, 8); D_MMA4(o[1], pa3, fb_.l3, fb_.h3, PC1, 12); } while (0)
#define NEXT5(x) ((x) == 4 ? 0 : (x) + 1)
    D_DMA(0, 0); D_DMA(1, 1); D_DMA(2, 2); D_DMA(3, 3);
    D_BAR(6);
    D_QKT(pA0, pA1, 0);
    int sl_pv = 0, sl_qk = 1, sl_d = 4;
    for (int j = 1; j + 1 < NT; j += 2) {
        { const int tt = (j + 3 < NT) ? j + 3 : NT - 1; D_DMA(tt, sl_d); }
        D_STEP(true, pB0, pB1, sl_qk, pA0, pA1, sl_pv);
        D_BAR(6);
        sl_pv = sl_qk; sl_qk = NEXT5(sl_qk); sl_d = NEXT5(sl_d);
        { const int tt = (j + 4 < NT) ? j + 4 : NT - 1; D_DMA(tt, sl_d); }
        D_STEP(true, pA0, pA1, sl_qk, pB0, pB1, sl_pv);
        D_BAR(6);
        sl_pv = sl_qk; sl_qk = NEXT5(sl_qk); sl_d = NEXT5(sl_d);
    }
    D_STEP(true, pB0, pB1, sl_qk, pA0, pA1, sl_pv);
    D_STEP(false, pA0, pA1, 0, pB0, pB1, sl_qk);
#undef NEXT5
    LAS char* ost = lds + LY::OST_OFF + wid * 4096;
    float l_reg = (l0 + l1) + (l2 + l3);
    { auto rr = __builtin_amdgcn_permlane32_swap(__float_as_uint(l_reg), __float_as_uint(l_reg), false, false); l_reg = __uint_as_float(rr[0]) + __uint_as_float(rr[1]); }
    if (hi == 0) wsf[r32] = __builtin_amdgcn_rcpf(l_reg);
    asm volatile("s_waitcnt lgkmcnt(0)" ::: "memory");
#pragma unroll
    for (int r = 0; r < 16; ++r) { const int orow = crow(r, hi); const float rl = wsf[orow];
        *(LAS unsigned short*)(ost + orow * 128 + r32 * 2) = (unsigned short)f2bf(o[0][r] * rl); *(LAS unsigned short*)(ost + orow * 128 + 64 + r32 * 2) = (unsigned short)f2bf(o[1][r] * rl); }
    asm volatile("s_waitcnt lgkmcnt(0)" ::: "memory");
    bf16* Ow = Op + (long)(wid * 32) * ldo;
#pragma unroll
    for (int i = 0; i < 4; ++i) { const int row = (lane >> 3) + 8 * i, ch = lane & 7; const v4u v = *(const LAS v4u*)(ost + row * 128 + ch * 16); *(v4u*)(Ow + (long)row * ldo + ch * 8) = v; }
    asm volatile("s_waitcnt vmcnt(0)" ::: "memory");
    __syncthreads();
#undef D_DMA
#undef D_BAR
#undef D_QKT
#undef D_PK4
#undef D_FIN
#undef D_STEP
#undef D_MMA4
#undef D_ADDA
#undef PKVF
}
__device__ __forceinline__ float wave_absmax(const float* g, int n) { int tid = threadIdx.x; const int lane = tid & 63; float m = 0.f; for (int i = lane; i < n; i += 64) m = fmaxf(m, fabsf(g[i]));
#pragma unroll
    for (int o = 1; o < 64; o <<= 1) m = fmaxf(m, __shfl_xor(m, o));
    return __builtin_bit_cast(float, __builtin_amdgcn_readfirstlane(__builtin_bit_cast(int, m))); }
}
namespace pg8 {
struct EpiResGate {
    static constexpr bool PERM = false, AFTER_DRAIN = false;
    const float* base; float* out; const long long* gate; float sc;
    __device__ __forceinline__ void operator()(const f32x4 (&acc)[2][2][4][2], const Unit& u, int wr, int wc, int fr, int fq) const {
        const int b = u.pm >> 4; const int col0 = u.pn * BM + wc * 32 + 4 * fq; const long long* gp = gate + b * 6144 + col0;
        f32x4 gv[2][2];
#pragma unroll
        for (int bj = 0; bj < 2; ++bj)
#pragma unroll
            for (int n = 0; n < 2; ++n) { const long long* q = gp + bj * HALF + n * 16; gv[bj][n] = (f32x4){(float)q[0], (float)q[1], (float)q[2], (float)q[3]} * (9.094947017729282e-13f * sc); }
#pragma unroll
        for (int ai = 0; ai < 2; ++ai)
#pragma unroll
            for (int m = 0; m < 4; ++m) { const size_t off = (size_t)(u.pm * BM + ai * HALF + wr * 64 + m * 16 + fr) * 1024 + col0;
#pragma unroll
                for (int bj = 0; bj < 2; ++bj)
#pragma unroll
                    for (int n = 0; n < 2; ++n) { const f32x4 bs = *(const f32x4*)(base + off + bj * HALF + n * 16); *(f32x4*)(out + off + bj * HALF + n * 16) = bs + gv[bj][n] * acc[ai][bj][m][n]; }
                if (m & 1) asm volatile("" ::: "memory"); }
    }
};

template <bool BASEF32> struct EpiResB {
    static constexpr bool PERM = true, AFTER_DRAIN = false;
    const void* base; bf16_t* out; const long long* gate; float sc;
    __device__ __forceinline__ void operator()(const f32x4 (&acc)[2][2][4][2], const Unit& u, int wr, int wc, int fr, int fq) const {
        const int b = u.pm >> 4; const int col0 = u.pn * BM + wc * 32 + 8 * fq; const long long* gp = gate + b * 6144 + col0;
        float gv[2][8];
#pragma unroll
        for (int bj = 0; bj < 2; ++bj)
#pragma unroll
            for (int e = 0; e < 8; ++e) gv[bj][e] = (float)gp[bj * HALF + e] * (9.094947017729282e-13f * sc);
#pragma unroll
        for (int ai = 0; ai < 2; ++ai)
#pragma unroll
            for (int m = 0; m < 4; ++m) { const size_t row = (size_t)(u.pm * BM + ai * HALF + wr * 64 + m * 16 + fr);
#pragma unroll
                for (int bj = 0; bj < 2; ++bj) { float bs[8];
                    if (BASEF32) { const f32x4 b0 = *(const f32x4*)((const float*)base + row * 1024 + col0 + bj * HALF), b1 = *(const f32x4*)((const float*)base + row * 1024 + col0 + bj * HALF + 4);
                        bs[0] = b0[0]; bs[1] = b0[1]; bs[2] = b0[2]; bs[3] = b0[3]; bs[4] = b1[0]; bs[5] = b1[1]; bs[6] = b1[2]; bs[7] = b1[3]; }
                    else { const u32x4 r = *(const u32x4*)((const bf16_t*)base + row * 2048 + col0 + bj * HALF);
                        bs[0] = __builtin_bit_cast(float, r.x << 16); bs[1] = __builtin_bit_cast(float, r.x & 0xffff0000u); bs[2] = __builtin_bit_cast(float, r.y << 16); bs[3] = __builtin_bit_cast(float, r.y & 0xffff0000u);
                        bs[4] = __builtin_bit_cast(float, r.z << 16); bs[5] = __builtin_bit_cast(float, r.z & 0xffff0000u); bs[6] = __builtin_bit_cast(float, r.w << 16); bs[7] = __builtin_bit_cast(float, r.w & 0xffff0000u); }
                    const f32x4 a0 = acc[ai][bj][m][0], a1 = acc[ai][bj][m][1];
                    u32x4 w; w.x = cvt_pk_bf16(bs[0] + gv[bj][0] * a0[0], bs[1] + gv[bj][1] * a0[1]); w.y = cvt_pk_bf16(bs[2] + gv[bj][2] * a0[2], bs[3] + gv[bj][3] * a0[3]);
                    w.z = cvt_pk_bf16(bs[4] + gv[bj][4] * a1[0], bs[5] + gv[bj][5] * a1[1]); w.w = cvt_pk_bf16(bs[6] + gv[bj][6] * a1[2], bs[7] + gv[bj][7] * a1[3]);
                    *(u32x4*)(out + row * 2048 + col0 + bj * HALF) = w; }
                if (m & 1) asm volatile("" ::: "memory"); }
    }
};
__device__ __forceinline__ f32x2 silu2(f32x2 ag, f32x2 au, float c1, float k) {
    const f32x2 t = ag * c1; f32x2 e; e.x = __builtin_amdgcn_exp2f(t.x); e.y = __builtin_amdgcn_exp2f(t.y);
    const f32x2 d = e * k + k; f32x2 r; r.x = __builtin_amdgcn_rcpf(d.x); r.y = __builtin_amdgcn_rcpf(d.y);
    return (ag * au) * r;
}
__device__ __forceinline__ float silu_mul(float g, float u) { return g * __builtin_amdgcn_rcpf(1.0f + __builtin_amdgcn_exp2f(-1.4426950408889634f * g)) * u; }
struct EpiSwiGLU {
    static constexpr bool PERM = true, AFTER_DRAIN = false;
    bf16_t* O; int ldo; int nNe; int pm0;
    __device__ __forceinline__ void operator()(const f32x4 (&acc)[2][2][4][2], const Unit& u, int wr, int wc, int fr, int fq) const {
        const int pnl = u.pn % nNe; const int col0 = pnl * HALF + wc * 32 + 8 * fq; const int row0 = (u.pm - pm0) * BM + wr * 64 + fr;
#pragma unroll
        for (int ai = 0; ai < 2; ++ai)
#pragma unroll
            for (int m = 0; m < 4; ++m) { bf16_t* rowp = O + (size_t)(row0 + ai * HALF + m * 16) * ldo + col0;
                const f32x4 g0 = acc[ai][0][m][0], g1 = acc[ai][0][m][1], u0 = acc[ai][1][m][0], u1 = acc[ai][1][m][1];
                const f32x2 y0 = silu2((f32x2){g0[0], g0[1]}, (f32x2){u0[0], u0[1]}, -1.4426950408889634f, 1.0f), y1 = silu2((f32x2){g0[2], g0[3]}, (f32x2){u0[2], u0[3]}, -1.4426950408889634f, 1.0f);
                const f32x2 y2 = silu2((f32x2){g1[0], g1[1]}, (f32x2){u1[0], u1[1]}, -1.4426950408889634f, 1.0f), y3 = silu2((f32x2){g1[2], g1[3]}, (f32x2){u1[2], u1[3]}, -1.4426950408889634f, 1.0f);
                u32x4 w; w.x = cvt_pk_bf16(y0.x, y0.y); w.y = cvt_pk_bf16(y1.x, y1.y); w.z = cvt_pk_bf16(y2.x, y2.y); w.w = cvt_pk_bf16(y3.x, y3.y);
                *(u32x4*)rowp = w; }
    }
};

struct EpiSwiGLU8 {
    static constexpr bool PERM = true, AFTER_DRAIN = false;
    unsigned char* O; int ldo; int nNe; int pm0; float SI;
    __device__ __forceinline__ void operator()(const f32x4 (&acc)[2][2][4][2], const Unit& u, int wr, int wc, int fr, int fq) const {
        const int pnl = u.pn % nNe; const int col0 = pnl * HALF + wc * 32 + 8 * fq; const int row0 = (u.pm - pm0) * BM + wr * 64 + fr;
#pragma unroll
        for (int ai = 0; ai < 2; ++ai)
#pragma unroll
            for (int m = 0; m < 4; ++m) { unsigned char* rowp = O + (size_t)(row0 + ai * HALF + m * 16) * ldo + col0;
                const float C1 = -1.4426950408889634f * SI, KK = 1.0f / (SI * SI * F8_AS);
                const f32x4 g0 = acc[ai][0][m][0], g1 = acc[ai][0][m][1], u0 = acc[ai][1][m][0], u1 = acc[ai][1][m][1];
                const f32x2 y0 = silu2((f32x2){g0[0], g0[1]}, (f32x2){u0[0], u0[1]}, C1, KK), y1 = silu2((f32x2){g0[2], g0[3]}, (f32x2){u0[2], u0[3]}, C1, KK);
                const f32x2 y2 = silu2((f32x2){g1[0], g1[1]}, (f32x2){u1[0], u1[1]}, C1, KK), y3 = silu2((f32x2){g1[2], g1[3]}, (f32x2){u1[2], u1[3]}, C1, KK);
#define M448(v) __builtin_amdgcn_fmed3f((v), -448.f, 448.f)
                u32x2_t w; w.x = pk4_fp8(M448(y0.x), M448(y0.y), M448(y1.x), M448(y1.y)); w.y = pk4_fp8(M448(y2.x), M448(y2.y), M448(y3.x), M448(y3.y));
#undef M448
                *(u32x2_t*)rowp = w; }
    }
};
struct EpiMoeDown {
    static constexpr bool PERM = true, AFTER_DRAIN = false;
    bf16_t* Y; const float* gs; int pm0; float sc;
    __device__ __forceinline__ void operator()(const f32x4 (&acc)[2][2][4][2], const Unit& u, int wr, int wc, int fr, int fq) const {
        const int pnl = u.pn & 3; const int col0 = pnl * BM + wc * 32 + 8 * fq; const int row0 = (u.pm + pm0) * BM + wr * 64 + fr;
#pragma unroll
        for (int ai = 0; ai < 2; ++ai)
#pragma unroll
            for (int m = 0; m < 4; ++m) { const int row = row0 + ai * HALF + m * 16; const float g = gs[row] * sc; bf16_t* rowp = Y + (size_t)row * 1024 + col0;
#pragma unroll
                for (int bj = 0; bj < 2; ++bj) { const f32x4 v0 = acc[ai][bj][m][0] * g, v1 = acc[ai][bj][m][1] * g;
                    u32x4 w; w.x = cvt_pk_bf16(v0[0], v0[1]); w.y = cvt_pk_bf16(v0[2], v0[3]); w.z = cvt_pk_bf16(v1[0], v1[1]); w.w = cvt_pk_bf16(v1[2], v1[3]);
                    *(u32x4*)(rowp + bj * HALF) = w; } }
    }
};

struct EpiQKRope {
    static constexpr bool PERM = true, AFTER_DRAIN = false;
    bf16_t* O; const float* gq; const float* gk;
    static constexpr size_t HM = (size_t)65536 * 1024;
    __device__ __forceinline__ void operator()(const f32x4 (&acc)[2][2][4][2], const Unit& u, int wr, int wc, int fr, int fq) const {
        const int row0 = u.pm * BM + wr * 64 + fr;
        if (u.pn >= 8) {
#pragma unroll
            for (int ai = 0; ai < 2; ++ai)
#pragma unroll
                for (int m = 0; m < 4; ++m) { const int row = row0 + ai * HALF + m * 16; const size_t bt = (size_t)(row >> 12) * 16 * 4096 + (row & 4095);
#pragma unroll
                    for (int bj = 0; bj < 2; ++bj) { const f32x4 v0 = acc[ai][bj][m][0], v1 = acc[ai][bj][m][1]; const int head = (u.pn - 8) * 4 + 2 * bj + (wc >> 1);
                        u32x4 w; w.x = cvt_pk_bf16(v0[0], v0[1]); w.y = cvt_pk_bf16(v0[2], v0[3]); w.z = cvt_pk_bf16(v1[0], v1[1]); w.w = cvt_pk_bf16(v1[2], v1[3]);
                        *(u32x4*)(O + (size_t)2 * HM + (bt + (size_t)head * 4096) * 64 + 32 * (wc & 1) + 8 * fq) = w; } }
            return;
        }
        const bool isk = u.pn >= 4; const float* gp = isk ? gk : gq; const float qs = isk ? 1.0f : (0.125f * 1.4426950408889634f);
        const int head = 4 * (u.pn & 3) + wc; bf16_t* Ob = O + (isk ? HM : (size_t)0) + (size_t)head * 4096 * 64 + 8 * fq;
        float g1[8], g2[8], rv[8];
#pragma unroll
        for (int e = 0; e < 8; ++e) { g1[e] = gp[8 * fq + e] * qs; g2[e] = gp[32 + 8 * fq + e] * qs; rv[e] = __builtin_amdgcn_exp2f(-(float)(8 * fq + e) * (13.287712379549449f / 32.f)) * 0.15915494309189535f; }
#pragma unroll
        for (int ai = 0; ai < 2; ++ai)
#pragma unroll
            for (int m = 0; m < 4; ++m) { const int row = row0 + ai * HALF + m * 16; const float pos = (float)(row & 4095);
                float x1[8], x2[8]; float ss = 0.f;
#pragma unroll
                for (int n = 0; n < 2; ++n)
#pragma unroll
                    for (int i = 0; i < 4; ++i) { x1[4 * n + i] = acc[ai][0][m][n][i]; x2[4 * n + i] = acc[ai][1][m][n][i]; ss += x1[4 * n + i] * x1[4 * n + i] + x2[4 * n + i] * x2[4 * n + i]; }
                ss += __shfl_xor(ss, 16); ss += __shfl_xor(ss, 32);
                const float rs = __builtin_amdgcn_rsqf(ss * (1.f / 64.f) + 1e-6f);
                float o1[8], o2[8];
#pragma unroll
                for (int e = 0; e < 8; ++e) { const float fr_ = __builtin_amdgcn_fractf(pos * rv[e]); const float c = __builtin_amdgcn_cosf(fr_), s = __builtin_amdgcn_sinf(fr_);
                    const float a = x1[e] * rs * g1[e], b = x2[e] * rs * g2[e]; o1[e] = a * c - b * s; o2[e] = a * s + b * c; }
                bf16_t* rowp = Ob + ((size_t)(row >> 12) * 16 * 4096 + (row & 4095)) * 64;
                u32x4 w; w.x = cvt_pk_bf16(o1[0], o1[1]); w.y = cvt_pk_bf16(o1[2], o1[3]); w.z = cvt_pk_bf16(o1[4], o1[5]); w.w = cvt_pk_bf16(o1[6], o1[7]); *(u32x4*)rowp = w;
                w.x = cvt_pk_bf16(o2[0], o2[1]); w.y = cvt_pk_bf16(o2[2], o2[3]); w.z = cvt_pk_bf16(o2[4], o2[5]); w.w = cvt_pk_bf16(o2[6], o2[7]); *(u32x4*)(rowp + 32) = w; }
    }
};
struct EpiQKRopeI8 {
    static constexpr bool PERM = true, AFTER_DRAIN = false;
    bf16_t* O; const float* gq; const float* gk; const float* rowscale; const unsigned* wamax;
    static constexpr size_t HM = (size_t)65536 * 1024;
    __device__ __forceinline__ void operator()(const i32x4_t (&acc)[2][2][4][2], const Unit& u, int wr, int wc, int fr, int fq) const {
        const int row0 = u.pm * BM + wr * 64 + fr; const float ws_ = __builtin_bit_cast(float, *wamax) * (1.f / 127.f);
        if (u.pn >= 8) {
#pragma unroll
            for (int ai = 0; ai < 2; ++ai)
#pragma unroll
                for (int m = 0; m < 4; ++m) { const int row = row0 + ai * HALF + m * 16; const size_t bt = (size_t)(row >> 12) * 16 * 4096 + (row & 4095);
#pragma unroll
                    for (int bj = 0; bj < 2; ++bj) { const float s_ = rowscale[row] * ws_; const i32x4_t a0 = acc[ai][bj][m][0], a1 = acc[ai][bj][m][1]; const f32x4 v0 = (f32x4){(float)a0[0], (float)a0[1], (float)a0[2], (float)a0[3]} * s_, v1 = (f32x4){(float)a1[0], (float)a1[1], (float)a1[2], (float)a1[3]} * s_; const int head = (u.pn - 8) * 4 + 2 * bj + (wc >> 1);
                        u32x4 w; w.x = cvt_pk_bf16(v0[0], v0[1]); w.y = cvt_pk_bf16(v0[2], v0[3]); w.z = cvt_pk_bf16(v1[0], v1[1]); w.w = cvt_pk_bf16(v1[2], v1[3]);
                        *(u32x4*)(O + (size_t)2 * HM + (bt + (size_t)head * 4096) * 64 + 32 * (wc & 1) + 8 * fq) = w; } }
            return;
        }
        const bool isk = u.pn >= 4; const float* gp = isk ? gk : gq; const float qs = isk ? 1.0f : (0.125f * 1.4426950408889634f);
        const int head = 4 * (u.pn & 3) + wc; bf16_t* Ob = O + (isk ? HM : (size_t)0) + (size_t)head * 4096 * 64 + 8 * fq;
        float g1[8], g2[8], rv[8];
#pragma unroll
        for (int e = 0; e < 8; ++e) { g1[e] = gp[8 * fq + e] * qs; g2[e] = gp[32 + 8 * fq + e] * qs; rv[e] = __builtin_amdgcn_exp2f(-(float)(8 * fq + e) * (13.287712379549449f / 32.f)) * 0.15915494309189535f; }
#pragma unroll
        for (int ai = 0; ai < 2; ++ai)
#pragma unroll
            for (int m = 0; m < 4; ++m) { const int row = row0 + ai * HALF + m * 16; const float pos = (float)(row & 4095); const float s_ = rowscale[row] * ws_;
                float x1[8], x2[8]; float ss = 0.f;
#pragma unroll
                for (int n = 0; n < 2; ++n)
#pragma unroll
                    for (int i = 0; i < 4; ++i) { x1[4 * n + i] = (float)acc[ai][0][m][n][i] * s_; x2[4 * n + i] = (float)acc[ai][1][m][n][i] * s_; ss += x1[4 * n + i] * x1[4 * n + i] + x2[4 * n + i] * x2[4 * n + i]; }
                ss += __shfl_xor(ss, 16); ss += __shfl_xor(ss, 32);
                const float rs = __builtin_amdgcn_rsqf(ss * (1.f / 64.f) + 1e-6f);
                float o1[8], o2[8];
#pragma unroll
                for (int e = 0; e < 8; ++e) { const float fr_ = __builtin_amdgcn_fractf(pos * rv[e]); const float c = __builtin_amdgcn_cosf(fr_), s = __builtin_amdgcn_sinf(fr_);
                    const float a = x1[e] * rs * g1[e], b = x2[e] * rs * g2[e]; o1[e] = a * c - b * s; o2[e] = a * s + b * c; }
                bf16_t* rowp = Ob + ((size_t)(row >> 12) * 16 * 4096 + (row & 4095)) * 64;
                u32x4 w; w.x = cvt_pk_bf16(o1[0], o1[1]); w.y = cvt_pk_bf16(o1[2], o1[3]); w.z = cvt_pk_bf16(o1[4], o1[5]); w.w = cvt_pk_bf16(o1[6], o1[7]); *(u32x4*)rowp = w;
                w.x = cvt_pk_bf16(o2[0], o2[1]); w.y = cvt_pk_bf16(o2[2], o2[3]); w.z = cvt_pk_bf16(o2[4], o2[5]); w.w = cvt_pk_bf16(o2[6], o2[7]); *(u32x4*)(rowp + 32) = w; }
    }
};

struct EpiSwiGLUi8 {
    static constexpr bool PERM = true, AFTER_DRAIN = false;
    bf16_t* O; int ldo; const float* rowscale; const unsigned* wamax;
    __device__ __forceinline__ void operator()(const i32x4_t (&acc)[2][2][4][2], const Unit& u, int wr, int wc, int fr, int fq) const {
        const int col0 = u.pn * HALF + wc * 32 + 8 * fq; const int row0 = u.pm * BM + wr * 64 + fr;
        const float ws_ = __builtin_bit_cast(float, *wamax) * (1.f / 127.f);
#pragma unroll
        for (int ai = 0; ai < 2; ++ai)
#pragma unroll
            for (int m = 0; m < 4; ++m) { const int row = row0 + ai * HALF + m * 16; bf16_t* rowp = O + (size_t)row * ldo + col0;
                const float s = rowscale[row] * ws_; const float C1 = -1.4426950408889634f * s, KK = 1.0f / (s * s);
                const i32x4_t g0 = acc[ai][0][m][0], g1 = acc[ai][0][m][1], u0 = acc[ai][1][m][0], u1 = acc[ai][1][m][1];
                const f32x2 y0 = silu2((f32x2){(float)g0[0], (float)g0[1]}, (f32x2){(float)u0[0], (float)u0[1]}, C1, KK), y1 = silu2((f32x2){(float)g0[2], (float)g0[3]}, (f32x2){(float)u0[2], (float)u0[3]}, C1, KK);
                const f32x2 y2 = silu2((f32x2){(float)g1[0], (float)g1[1]}, (f32x2){(float)u1[0], (float)u1[1]}, C1, KK), y3 = silu2((f32x2){(float)g1[2], (float)g1[3]}, (f32x2){(float)u1[2], (float)u1[3]}, C1, KK);
                u32x4 w; w.x = cvt_pk_bf16(y0.x, y0.y); w.y = cvt_pk_bf16(y1.x, y1.y); w.z = cvt_pk_bf16(y2.x, y2.y); w.w = cvt_pk_bf16(y3.x, y3.y);
                *(u32x4*)rowp = w; }
    }
};

struct EpiSwiGLUi8f8 {
    static constexpr bool PERM = true, AFTER_DRAIN = false;
    unsigned char* O; int ldo; const float* rowscale; const unsigned* wamax;
    __device__ __forceinline__ void operator()(const i32x4_t (&acc)[2][2][4][2], const Unit& u, int wr, int wc, int fr, int fq) const {
        const int col0 = u.pn * HALF + wc * 32 + 8 * fq; const int row0 = u.pm * BM + wr * 64 + fr;
        const float ws_ = __builtin_bit_cast(float, *wamax) * (1.f / 127.f);
#pragma unroll
        for (int ai = 0; ai < 2; ++ai)
#pragma unroll
            for (int m = 0; m < 4; ++m) { const int row = row0 + ai * HALF + m * 16; unsigned char* rowp = O + (size_t)row * ldo + col0;
                const float s = rowscale[row] * ws_; const float C1 = -1.4426950408889634f * s, KK = 1.0f / (s * s * F8_AS);
                const i32x4_t g0 = acc[ai][0][m][0], g1 = acc[ai][0][m][1], u0 = acc[ai][1][m][0], u1 = acc[ai][1][m][1];
                const f32x2 y0 = silu2((f32x2){(float)g0[0], (float)g0[1]}, (f32x2){(float)u0[0], (float)u0[1]}, C1, KK), y1 = silu2((f32x2){(float)g0[2], (float)g0[3]}, (f32x2){(float)u0[2], (float)u0[3]}, C1, KK);
                const f32x2 y2 = silu2((f32x2){(float)g1[0], (float)g1[1]}, (f32x2){(float)u1[0], (float)u1[1]}, C1, KK), y3 = silu2((f32x2){(float)g1[2], (float)g1[3]}, (f32x2){(float)u1[2], (float)u1[3]}, C1, KK);
#define M448(v) __builtin_amdgcn_fmed3f((v), -448.f, 448.f)
                u32x2_t w; w.x = pk4_fp8(M448(y0.x), M448(y0.y), M448(y1.x), M448(y1.y)); w.y = pk4_fp8(M448(y2.x), M448(y2.y), M448(y3.x), M448(y3.y));
#undef M448
                *(u32x2_t*)rowp = w; }
    }
};

struct EpiBf16I8 {
    static constexpr bool PERM = true, AFTER_DRAIN = false;
    bf16_t* O; int ldc; const float* rowscale; const unsigned* wamax;
    __device__ __forceinline__ void operator()(const i32x4_t (&acc)[2][2][4][2], const Unit& u, int wr, int wc, int fr, int fq) const {
        const int row0 = u.pm * BM + wr * 64 + fr; const int col0 = u.pn * BM + wc * 32 + 8 * fq; const float ws_ = __builtin_bit_cast(float, *wamax) * (1.f / 127.f);
#pragma unroll
        for (int ai = 0; ai < 2; ++ai)
#pragma unroll
            for (int m = 0; m < 4; ++m) { const int row = row0 + ai * HALF + m * 16; const float s_ = rowscale[row] * ws_; bf16_t* rowp = O + (size_t)row * ldc + col0;
#pragma unroll
                for (int bj = 0; bj < 2; ++bj) { const i32x4_t a0 = acc[ai][bj][m][0], a1 = acc[ai][bj][m][1];
                    u32x4 w; w.x = cvt_pk_bf16((float)a0[0] * s_, (float)a0[1] * s_); w.y = cvt_pk_bf16((float)a0[2] * s_, (float)a0[3] * s_); w.z = cvt_pk_bf16((float)a1[0] * s_, (float)a1[1] * s_); w.w = cvt_pk_bf16((float)a1[2] * s_, (float)a1[3] * s_);
                    *(u32x4*)(rowp + bj * HALF) = w; } }
    }
};
struct MoeOrder {
    StaticOrder so; int nN, pmA, tile0; int pends[8];
    __device__ void init(int nM_, int nN_, int G_, int c_, int pmA_, int tile0_, const int* pe) { so.nM = nM_; so.nN = nN_; so.nwg = nM_ * nN_; so.G = G_; so.c = c_; nN = nN_; pmA = pmA_; tile0 = tile0_;
#pragma unroll
        for (int j = 0; j < 8; ++j) pends[j] = __builtin_amdgcn_readfirstlane(pe[j]); }
    __device__ bool next(int i, Unit& u) const {
        Unit v; if (!so.next(i, v)) return false;
        const int r0 = (tile0 + v.pm) * BM; int e = 0;
#pragma unroll
        for (int j = 0; j < 7; ++j) e += (r0 >= pends[j]) ? 1 : 0;
        u.pm = v.pm + pmA; u.pn = e * nN + v.pn; return true;
    }
    __device__ __forceinline__ void a_ready(const Unit&) const {}
    __device__ __forceinline__ void done(const Unit&) const {}
};
}

__device__ __forceinline__ void r7_phase(const Args& a, unsigned char* lds_g, int vcu, int G, int tid, int wave, int lane) {
    unsigned char* ws = a.ws; const bf16* x = (const bf16*)a.out; const float* router = a.in[I_ROUTER];
    int* topk = (int*)(ws + WS_TOPK); float* gates = (float*)(ws + WS_GATES); int* blkcnt = (int*)(ws + WS_BLKCNT);
    int* hist = (int*)lds_g;
    float rw[4][4][8];
#pragma unroll
    for (int j = 0; j < 4; ++j)
#pragma unroll
        for (int i = 0; i < 4; ++i) { const int col = 4 * lane + 256 * j + i; const f32x4 r0 = *(const f32x4*)(router + col * 8), r1 = *(const f32x4*)(router + col * 8 + 4);
            rw[j][i][0] = r0.x; rw[j][i][1] = r0.y; rw[j][i][2] = r0.z; rw[j][i][3] = r0.w; rw[j][i][4] = r1.x; rw[j][i][5] = r1.y; rw[j][i][6] = r1.z; rw[j][i][7] = r1.w; }
    const modw_t* mod = (const modw_t*)(ws + WS_MOD) + 16 * 6144;
    for (int blk = vcu; blk < 256; blk += G) {
        if (tid < 8) hist[tid] = 0;
        __syncthreads();
        const int b = blk >> 4; ModPar mp; load_modpar(mp, a.in[I_NORM_O_FFN], mod + b * 6144, 3, 4, lane);
        unsigned long long cnt = 0ull;
#pragma unroll 2
        for (int r = 0; r < 32; ++r) { const int row = blk * 256 + wave * 32 + r; f32x4 h[4]; mod_row_f32<true>(x + (size_t)row * XP, mp, h, lane);
            store_row_fp8(ws + A_HP + (size_t)row * 1024, h, lane);
            float lg[8];
#pragma unroll
            for (int e = 0; e < 8; ++e) { float s = 0.f;
#pragma unroll
                for (int j = 0; j < 4; ++j) s += (h[j].x * rw[j][0][e] + h[j].y * rw[j][1][e]) + (h[j].z * rw[j][2][e] + h[j].w * rw[j][3][e]);
                lg[e] = wave_sum(s); }
            int e1 = 0; float v1 = lg[0];
#pragma unroll
            for (int e = 1; e < 8; ++e) if (lg[e] > v1) { v1 = lg[e]; e1 = e; }
            int e2 = -1; float v2 = -INFINITY;
#pragma unroll
            for (int e = 0; e < 8; ++e) if (e != e1 && lg[e] > v2) { v2 = lg[e]; e2 = e; }
            e1 = __builtin_amdgcn_readfirstlane(e1); e2 = __builtin_amdgcn_readfirstlane(e2);
            const float g1 = 1.0f / (1.0f + __expf(v2 - v1)), g2 = 1.0f - g1;
            if (lane == 0) { topk[row] = e1 | (e2 << 8); gates[2 * row] = g1; gates[2 * row + 1] = g2; }
            cnt += (1ull << (8 * e1)) + (1ull << (8 * e2));
        }
        if (lane < 8) atomicAdd(&hist[lane], (int)((cnt >> (8 * lane)) & 255ull));
        __syncthreads();
        if (tid < 8) blkcnt[blk * 8 + tid] = hist[tid];
        __syncthreads();
    }
}

__device__ __forceinline__ void r8_phase(const Args& a, unsigned char* lds_g, int vcu, int G, int tid, int wave, int lane) {
    unsigned char* ws = a.ws;
    const int* topk = (const int*)(ws + WS_TOPK); const float* gates = (const float*)(ws + WS_GATES); const int* blkcnt = (const int*)(ws + WS_BLKCNT);
    int* slots = (int*)(ws + WS_SLOTS); float* gslot = (float*)(ws + WS_GSLOT); int* pends_g = (int*)(ws + WS_PENDS); int* tokslot = (int*)(ws + WS_TOKSLOT);
    int* tot = (int*)lds_g; int* base = tot + 8; int* pst = tot + 16; int* wcnt = tot + 32;
    if (tid < 8) tot[tid] = 0;
    __syncthreads();
    for (int idx = tid; idx < 2048; idx += 512) atomicAdd(&tot[idx & 7], blkcnt[idx]);
    __syncthreads();
    if (tid == 0) { int p = 0; for (int e = 0; e < 8; ++e) { pst[e] = p; p += (tot[e] + 255) & ~255; if (vcu == 0) pends_g[e] = p; } }
    __syncthreads();
    if (vcu < 8) { const int e = vcu, lo = pst[e] + tot[e], hi = pst[e] + ((tot[e] + 255) & ~255);
        for (int s = lo + tid; s < hi; s += NWAVES * 64) { tokslot[s] = 0; gslot[s] = 0.f; } }
    for (int blk = vcu; blk < 256; blk += G) {
        if (tid < 8) base[tid] = 0;
        __syncthreads();
        for (int idx = tid; idx < 2048; idx += 512) if ((idx >> 3) < blk) atomicAdd(&base[idx & 7], blkcnt[idx]);
        const int token = blk * 256 + (tid >> 1), k = tid & 1; const int pk = topk[token]; const int ea = k ? ((pk >> 8) & 255) : (pk & 255);
        int rank = 0;
#pragma unroll
        for (int e = 0; e < 8; ++e) { const unsigned long long mask = __ballot(ea == e); if (ea == e) rank = __popcll(mask & ((1ull << lane) - 1ull)); if (lane == 0) wcnt[wave * 8 + e] = __popcll(mask); }
        __syncthreads();
        int s = pst[ea] + base[ea] + rank;
        for (int w = 0; w < wave; ++w) s += wcnt[w * 8 + ea];
        slots[token * 2 + k] = s; gslot[s] = gates[token * 2 + k]; tokslot[s] = token;
        __syncthreads();
    }
}

__device__ __forceinline__ void r9_phase(const Args& a, int gw, int NGW, int lane) {
    unsigned char* ws = a.ws; float* out = a.out; const int* slots = (const int*)(ws + WS_SLOTS); const bf16* Y = (const bf16*)(ws + A_Y);
    const modw_t* mod = (const modw_t*)(ws + WS_MOD) + 16 * 6144;
    for (int bi = gw; bi < T / 32; bi += NGW) {
        const int b = bi >> 7; f32x4 gt[4];
#pragma unroll
        for (int j = 0; j < 4; ++j) gt[j] = modv4(mod + b * 6144 + 5 * 1024 + 4 * lane + 256 * j);
        for (int r = 0; r < 32; ++r) { const int row = bi * 32 + r; const int s1 = slots[2 * row], s2 = slots[2 * row + 1];
            const uint2* y1 = (const uint2*)(Y + (size_t)s1 * 1024) + lane; const uint2* y2 = (const uint2*)(Y + (size_t)s2 * 1024) + lane;
            const uint2* xb = (const uint2*)((const bf16*)out + (size_t)row * XP) + lane; f32x4* o = (f32x4*)(out + (size_t)row * 1024) + lane;
            f32x4 v[4];
#pragma unroll
            for (int j = 0; j < 4; ++j) { const uint2 p = y1[64 * j], q = y2[64 * j], x3 = xb[64 * j];
                v[j].x = bflo(x3.x) + gt[j].x * (bflo(p.x) + bflo(q.x)); v[j].y = bfhi(x3.x) + gt[j].y * (bfhi(p.x) + bfhi(q.x)); v[j].z = bflo(x3.y) + gt[j].z * (bflo(p.y) + bflo(q.y)); v[j].w = bfhi(x3.y) + gt[j].w * (bfhi(p.y) + bfhi(q.y)); }
            asm volatile("s_waitcnt vmcnt(0)" ::: "memory");
#pragma unroll
            for (int j = 0; j < 4; ++j) o[64 * j] = v[j];
            asm volatile("" ::: "memory"); }
    }
}

#ifndef MK_PER_PHASE
#define MK_PER_PHASE 0
#endif
__global__ void __launch_bounds__(NWAVES * 64, 2) mega_fwd(Args args) {
    extern __shared__ __attribute__((aligned(16))) unsigned char lds_raw[];
    LAS unsigned char* lds = (LAS unsigned char*)lds_raw;
    volatile LAS unsigned* MISC = (volatile LAS unsigned*)(lds + MISC_OFF);
    const int G = gridDim.x, bx = blockIdx.x; const int vcu = (G % 8 == 0) ? (bx % 8) * (G / 8) + bx / 8 : bx;
    const int NGW = G * NWAVES;
    unsigned char* ws = args.ws;
    for (int u = threadIdx.x; u < (LDS_BYTES - LDS_ZERO_OFF) / 4; u += NWAVES * 64) ((LAS unsigned*)(lds + LDS_ZERO_OFF))[u] = 0u;
#define IDS() int tid = threadIdx.x; asm volatile("" : "+v"(tid)); const int lane = tid & 63, wave = __builtin_amdgcn_readfirstlane(tid >> 6); const int gw = vcu * NWAVES + wave; (void)lane; (void)gw
    __syncthreads();
    XcdBarrier bar; bar.bar = (unsigned*)(ws + WS_CTL) + CW_BAR; bar.x = 0; bar.st = nullptr;
    if (!MK_PER_PHASE) bar = xcd_barrier_post((unsigned*)(ws + WS_CTL) + CW_BAR, MISC + 8);
    const int lo = args.ph_lo, hi = args.ph_hi;
#define IN(k) (lo <= (k) && (k) < hi)
#ifndef PROBE_REP
#define PROBE_REP 0u
#endif
#ifndef PROBE_REPN
#define PROBE_REPN 1
#endif
#define PREP(k) for (int rp_ = 0; rp_ < 1 + PROBE_REPN * (int)((PROBE_REP >> (k)) & 1u); ++rp_)
#define SEAM(k) do { if (!MK_PER_PHASE) { if (IN(k) && IN((k) + 1)) xcd_barrier(bar); } } while (0)
    const bool ROWLOCAL = false && (G * 256 == T);
#define LOCAL_SEAM() do { __builtin_amdgcn_fence(__ATOMIC_RELEASE, "agent"); asm volatile("s_waitcnt vmcnt(0)" ::: "memory"); __syncthreads(); __builtin_amdgcn_fence(__ATOMIC_ACQUIRE, "agent"); } while (0)
    const modw_t* mod_e = (const modw_t*)(ws + WS_MOD); const modw_t* mod_o = mod_e + 16 * 6144;
    bf16* H = (bf16*)(ws + A_H);
    bf16* XB = (bf16*)args.out;

    if (IN(0)) { IDS(); p0_prologue(args, lds, gw, NGW, wave, lane); } SEAM(0);
    if (IN(1)) PREP(1) { IDS(); modulate_phase<false, false, true>(args.in[I_X], args.in[I_NORM_E_MIX], mod_e, 0, 1, H, gw, NGW, lane, (float*)(ws + WS_ROWSC));
#if FFN_FP8 == 0 || FFN_FP8 == 3
        {
            LAS float* scr = (LAS float*)(lds + wave * 16384); const float wsc = 127.f / fmaxf(__builtin_bit_cast(float, *(const unsigned*)(ws + WS_WAMAX)), 1e-30f);
            for (int it = gw; it < 2 * 1408; it += NGW) { const bool up = it >= 1408; tr_gu_i8(args.in[up ? I_FFN_U : I_FFN_G], 1024, 2816, ws + W_GU, up ? 128 : 0, wsc, up ? it - 1408 : it, scr, lane); }
            const float wsi = 127.f / fmaxf(__builtin_bit_cast(float, *((const unsigned*)(ws + WS_WAMAX) + 2)), 1e-30f);
            for (int it = gw; it < 16 * 37; it += NGW) { const int kb = it / 37, nb = it % 37; transpose_item_i8(args.in[I_W_IN], 1184, 64 * kb, 32 * nb, ws + W_IN + (size_t)(32 * nb) * 1024, 1024, wsi, scr, lane); }
            const float wsq = 127.f / fmaxf(__builtin_bit_cast(float, *((const unsigned*)(ws + WS_WAMAX) + 1)), 1e-30f);
            for (int it = gw; it < 16 * 96; it += NGW) { const int kb = it / 96, nb = it % 96, n0 = 32 * nb; int drow = n0;
                if (n0 < 2048) { const int tt = n0 >> 8, wc_ = (n0 & 255) >> 6, bj = (n0 & 63) >> 5; drow = tt * 256 + bj * 128 + wc_ * 32; }
                transpose_item_i8(args.in[I_DIL_QKV], 3072, 64 * kb, n0, ws + W_QKV + (size_t)drow * 1024, 1024, wsq, scr, lane); }
        }
#endif
    } SEAM(1);
    if (IN(2)) { pg8::Gemm g{H, (const bf16*)(ws + W_IN), T, 1280, 512}; pg8::StaticOrder S; S.init(T, 1280, G, bx);
        pg8::EpiBf16I8 E{(bf16*)(ws + A_P), 1280, (const float*)(ws + WS_ROWSC), (const unsigned*)(ws + WS_WAMAX) + 2};
        pg8::gemm_phase_i8<pg8::EpiBf16I8, pg8::StaticOrder, true, true>(lds, g, S, E); } SEAM(2);
    if (IN(3)) PREP(3) { IDS(); r2_phase(args, gw, NGW, lane); } SEAM(3);
    if (IN(4)) {
        { pg8::Gemm g{(const bf16*)(ws + A_CQ), (const bf16*)(ws + W_UQ), T, 768, 256}; pg8::StaticOrder S; S.init(T, 768, G, bx);
          pg8::EpiBf16<0> E{(bf16*)(ws + A_QA), 768, nullptr, 0, 0, 1.f};
          pg8::gemm_phase<pg8::EpiBf16<0>, pg8::StaticOrder, true, true>(lds, g, S, E); }
        __syncthreads();
        { pg8::Gemm g{(const bf16*)(ws + A_CKV), (const bf16*)(ws + W_UKV), T, 1024, 128}; pg8::StaticOrder S; S.init(T, 1024, G, bx);
          pg8::EpiBf16<0> E{(bf16*)(ws + A_KV), 512, nullptr, 512, (size_t)T * 512, 1.f};
          pg8::gemm_phase<pg8::EpiBf16<0>, pg8::StaticOrder, true, true>(lds, g, S, E); }
    } SEAM(4);
    if (IN(5)) PREP(5) { IDS(); r3_phase(args, gw, NGW, lane); } SEAM(5);
    if (IN(6)) {
        bf16* ATT = (bf16*)(ws + A_ATT0);
        const float bndA = 96.f * att::wave_absmax(args.in[I_MLA_QG], 96) * att::wave_absmax(args.in[I_MLA_KG], 96) * QSCALE_A;
        const float bndB = 64.f * att::wave_absmax(args.in[I_GQA_QG], 64) * att::wave_absmax(args.in[I_GQA_KG], 64) * QSCALE_B;
        for (int L = vcu; L < 2048; L += G) {
            const int u = L & 2047, b = u >> 7, h = (u >> 4) & 7, qb = u & 15; const size_t r0 = (size_t)b * SEQ, rq = r0 + 256 * qb;
            if (bndA < 64.f) att::attn_dense_fast<96>((const bf16*)(ws + A_QA) + rq * 768 + h * 96, 768, args.in[I_MLA_QG], 256 * qb, (const bf16*)(ws + A_KA) + r0 * 768 + h * 96, 768, (const bf16*)(ws + A_KV) + (size_t)T * 512 + r0 * 512 + h * 64, 512,
                                              64, ATT + rq * 1024 + h * 64, 1024, (LAS char*)lds);
            else att::attn_dense<96>((const bf16*)(ws + A_QA) + rq * 768 + h * 96, 768, args.in[I_MLA_QG], 256 * qb, (const bf16*)(ws + A_KA) + r0 * 768 + h * 96, 768, (const bf16*)(ws + A_KV) + (size_t)T * 512 + r0 * 512 + h * 64, 512,
                                              64, ATT + rq * 1024 + h * 64, 1024, (LAS char*)lds);
        }
        for (int L = vcu; L < 2048; L += G) {
            const int u = L & 2047, b = u >> 7, h = (u >> 4) & 7, qb = u & 15; const size_t r0 = (size_t)b * SEQ, rq = r0 + 256 * qb;
            if (bndB < 64.f) att::attn_dense_fast<64>((const bf16*)(ws + A_P) + rq * 1280 + 416 + h * 64, 1280, args.in[I_GQA_QG], 256 * qb, (const bf16*)(ws + A_KB) + r0 * 128 + (h >> 2) * 64, 128, (const bf16*)(ws + A_P) + r0 * 1280 + 1056 + (h >> 2) * 64, 1280,
                                     64, ATT + rq * 1024 + 512 + h * 64, 1024, (LAS char*)lds);
            else att::attn_dense<64>((const bf16*)(ws + A_P) + rq * 1280 + 416 + h * 64, 1280, args.in[I_GQA_QG], 256 * qb, (const bf16*)(ws + A_KB) + r0 * 128 + (h >> 2) * 64, 128, (const bf16*)(ws + A_P) + r0 * 1280 + 1056 + (h >> 2) * 64, 1280,
                                     64, ATT + rq * 1024 + 512 + h * 64, 1024, (LAS char*)lds);
        }
    } SEAM(6);
    if (IN(7)) { pg8::Gemm g{(const bf16*)(ws + A_ATT0), (const bf16*)(ws + W_OUT), T, 1024, 1024}; pg8::StaticOrder S; S.init(T, 1024, G, bx);
        pg8::EpiResB<true> E{args.in[I_X], XB, mod_e + 2 * 1024, 1.f};
        pg8::gemm_phase<pg8::EpiResB<true>, pg8::StaticOrder, true, true>(lds, g, S, E); } SEAM(7);
#if FFN_FP8 == 1
    if (IN(8)) { IDS(); modulate_phase<true, true>(XB, args.in[I_NORM_E_FFN], mod_e, 3, 4, H, gw, NGW, lane); } SEAM(8);
    if (IN(9)) { pg8::Gemm g{H, (const bf16*)(ws + W_GU), T, 5632, 512}; pg8::StaticOrder S; S.init(T, 5632, G, bx);
        pg8::EpiSwiGLU8 E{ws + A_ACT, 2816, 1 << 30, 0, 1.0f / (F8_HS * F8_WS)};
        pg8::gemm_phase8<pg8::EpiSwiGLU8, pg8::StaticOrder, true, true>(lds, g, S, E); } SEAM(9);
    if (IN(10)) { pg8::Gemm g{(const bf16*)(ws + A_ACT), (const bf16*)(ws + W_D), T, 1024, 1408}; pg8::StaticOrder S; S.init(T, 1024, G, bx);
        pg8::EpiResB<false> E{XB, XB, mod_e + 5 * 1024, 1.0f / (F8_AS * F8_WS)};
        pg8::gemm_phase8<pg8::EpiResB<false>, pg8::StaticOrder, true, true>(lds, g, S, E); } SEAM(10);
#elif FFN_FP8 == 2
    if (IN(8)) { IDS(); modulate_phase<false, true>(XB, args.in[I_NORM_E_FFN], mod_e, 3, 4, H, gw, NGW, lane); } SEAM(8);
    if (IN(9)) { pg8::Gemm g{H, (const bf16*)(ws + W_GU), T, 5632, 1024}; pg8::StaticOrder S; S.init(T, 5632, G, bx);
        pg8::EpiSwiGLU8 E{ws + A_ACT, 2816, 1 << 30, 0, 1.0f};
        pg8::gemm_phase<pg8::EpiSwiGLU8, pg8::StaticOrder, true, true>(lds, g, S, E); } SEAM(9);
    if (IN(10)) { pg8::Gemm g{(const bf16*)(ws + A_ACT), (const bf16*)(ws + W_D), T, 1024, 1408}; pg8::StaticOrder S; S.init(T, 1024, G, bx);
        pg8::EpiResB<false> E{XB, XB, mod_e + 5 * 1024, 1.0f / (F8_AS * F8_WS)};
        pg8::gemm_phase8<pg8::EpiResB<false>, pg8::StaticOrder, true, true>(lds, g, S, E); } SEAM(10);
#elif FFN_FP8 == 3
    if (IN(8)) PREP(8) { IDS(); modulate_phase<false, true, true>(XB, args.in[I_NORM_E_FFN], mod_e, 3, 4, H, gw, NGW, lane, (float*)(ws + WS_ROWSC)); }
    if (ROWLOCAL) { if (!MK_PER_PHASE && IN(8) && IN(9)) LOCAL_SEAM(); } else SEAM(8);
    if (IN(9)) { pg8::Gemm g{H, (const bf16*)(ws + W_GU), T, 5632, 512};
        pg8::EpiSwiGLUi8f8 E{ws + A_ACT, 2816, (const float*)(ws + WS_ROWSC), (const unsigned*)(ws + WS_WAMAX)};
        if (ROWLOCAL) { pg8::RowLocalOrder S; S.init(T, 5632, G, vcu); pg8::gemm_phase_i8<pg8::EpiSwiGLUi8f8, pg8::RowLocalOrder, true, true>(lds, g, S, E); }
        else { pg8::StaticOrder S; S.init(T, 5632, G, bx); pg8::gemm_phase_i8<pg8::EpiSwiGLUi8f8, pg8::StaticOrder, true, true>(lds, g, S, E); } } SEAM(9);
    if (IN(10)) { pg8::Gemm g{(const bf16*)(ws + A_ACT), (const bf16*)(ws + W_D), T, 1024, 1408}; pg8::StaticOrder S; S.init(T, 1024, G, bx);
        pg8::EpiResB<false> E{XB, XB, mod_e + 5 * 1024, 1.0f / (F8_AS * F8_WS)};
        pg8::gemm_phase8<pg8::EpiResB<false>, pg8::StaticOrder, true, true>(lds, g, S, E); } SEAM(10);
#else
    if (IN(8)) { IDS(); modulate_phase<false, true, true>(XB, args.in[I_NORM_E_FFN], mod_e, 3, 4, H, gw, NGW, lane, (float*)(ws + WS_ROWSC)); } SEAM(8);
    if (IN(9)) { pg8::Gemm g{H, (const bf16*)(ws + W_GU), T, 5632, 512}; pg8::StaticOrder S; S.init(T, 5632, G, bx);
        pg8::EpiSwiGLUi8 E{(bf16*)(ws + A_ACT), 2816, (const float*)(ws + WS_ROWSC), (const unsigned*)(ws + WS_WAMAX)};
        pg8::gemm_phase_i8<pg8::EpiSwiGLUi8, pg8::StaticOrder, true, true>(lds, g, S, E); } SEAM(9);
    if (IN(10)) { pg8::Gemm g{(const bf16*)(ws + A_ACT), (const bf16*)(ws + W_D), T, 1024, 2816}; pg8::StaticOrder S; S.init(T, 1024, G, bx);
        pg8::EpiResB<false> E{XB, XB, mod_e + 5 * 1024, 1.f};
        pg8::gemm_phase<pg8::EpiResB<false>, pg8::StaticOrder, true, true>(lds, g, S, E); } SEAM(10);
#endif
    if (IN(11)) PREP(11) { IDS(); modulate_phase<false, true, true>(XB, args.in[I_NORM_O_MIX], mod_o, 0, 1, H, gw, NGW, lane, (float*)(ws + WS_ROWSC)); }
    if (ROWLOCAL) { if (!MK_PER_PHASE && IN(11) && IN(12)) LOCAL_SEAM(); } else SEAM(11);
    if (IN(12)) { pg8::Gemm g{H, (const bf16*)(ws + W_QKV), T, 3072, 512};
        pg8::EpiQKRopeI8 E{(bf16*)(ws + A_QKV), args.in[I_DIL_QG], args.in[I_DIL_KG], (const float*)(ws + WS_ROWSC), (const unsigned*)(ws + WS_WAMAX) + 1};
        if (ROWLOCAL) { pg8::RowLocalOrder S; S.init(T, 3072, G, vcu); pg8::gemm_phase_i8<pg8::EpiQKRopeI8, pg8::RowLocalOrder, true, true>(lds, g, S, E); }
        else { pg8::StaticOrder S; S.init(T, 3072, G, bx); pg8::gemm_phase_i8<pg8::EpiQKRopeI8, pg8::StaticOrder, true, true>(lds, g, S, E); } }
      SEAM(13);
    if (IN(14)) {
        constexpr size_t HM = (size_t)T * 1024;
        const bf16* QH = (const bf16*)(ws + A_QKV); bf16* O1H = (bf16*)(ws + A_H); bf16* O2H = (bf16*)(ws + A_O2); float* L1 = (float*)(ws + A_LSE1); float* L2 = (float*)(ws + A_LSE2); bf16* ATT = (bf16*)(ws + A_ATT1);
        const float bndC = 64.f * att::wave_absmax(args.in[I_DIL_QG], 64) * att::wave_absmax(args.in[I_DIL_KG], 64) * QSCALE_B;
        for (int bh = vcu; bh < 256; bh += G) {
            const int b = bh >> 4, h = bh & 15; const size_t hb = (size_t)bh * 4096 * 64;
            const bf16* Qb_ = QH + hb; const bf16* Kb_ = QH + HM + hb; const bf16* Vb_ = QH + 2 * HM + hb;
            if (bndC < 100.f) {
            att::band_phase<false, true>(Qb_, Kb_, Vb_, 1, O1H + hb, 64, L1 + (size_t)bh * 4096, nullptr, nullptr, nullptr, nullptr, (LAS char*)lds);
            att::band_phase<false, true>(Qb_, Kb_, Vb_, 4, O2H + hb, 64, L2 + (size_t)bh * 4096, nullptr, nullptr, nullptr, nullptr, (LAS char*)lds);
            asm volatile("s_waitcnt vmcnt(0)" ::: "memory"); __syncthreads();
            att::band_phase<true, true>(Qb_, Kb_, Vb_, 16, ATT + (size_t)b * SEQ * 1024 + h * 64, 1024, nullptr, O1H + hb, O2H + hb, L1 + (size_t)bh * 4096, L2 + (size_t)bh * 4096, (LAS char*)lds);
            } else {
            att::band_phase<false, false>(Qb_, Kb_, Vb_, 1, O1H + hb, 64, L1 + (size_t)bh * 4096, nullptr, nullptr, nullptr, nullptr, (LAS char*)lds);
            att::band_phase<false, false>(Qb_, Kb_, Vb_, 4, O2H + hb, 64, L2 + (size_t)bh * 4096, nullptr, nullptr, nullptr, nullptr, (LAS char*)lds);
            asm volatile("s_waitcnt vmcnt(0)" ::: "memory"); __syncthreads();
            att::band_phase<true, false>(Qb_, Kb_, Vb_, 16, ATT + (size_t)b * SEQ * 1024 + h * 64, 1024, nullptr, O1H + hb, O2H + hb, L1 + (size_t)bh * 4096, L2 + (size_t)bh * 4096, (LAS char*)lds);
            }
        }
    }
      SEAM(15);
    if (IN(16)) { pg8::Gemm g{(const bf16*)(ws + A_ATT1), (const bf16*)(ws + W_DO), T, 1024, 1024}; pg8::StaticOrder S; S.init(T, 1024, G, bx);
        pg8::EpiResB<false> E{XB, XB, mod_o + 2 * 1024, 1.f};
        pg8::gemm_phase<pg8::EpiResB<false>, pg8::StaticOrder, true, true>(lds, g, S, E); } SEAM(16);
    if (IN(17)) PREP(17) { IDS(); r7_phase(args, lds_raw, vcu, G, tid, wave, lane); } SEAM(17);
    if (IN(18)) { IDS(); r8_phase(args, lds_raw, vcu, G, tid, wave, lane); } SEAM(18);
    {
        const int* pe = (const int*)(ws + WS_PENDS);
        if (IN(19)) { const int ntot = __builtin_amdgcn_readfirstlane(pe[7]) >> 8;
            pg8::GemmG g{ws + A_HP, (const bf16*)(ws + W_MGU), (const int*)(ws + WS_TOKSLOT), 512, 1024}; pg8::MoeOrder S; S.init(ntot, 28, G, bx, 0, 0, pe);
            pg8::EpiSwiGLU8 E{ws + A_ACTM, 3584, 28, 0, 1.0f / (F8_HS * F8_WS)};
            pg8::gemm_phase8g<pg8::EpiSwiGLU8, pg8::MoeOrder, true, true>(lds, g, S, E); }
        SEAM(19);
        if (IN(20)) { const int ntot = __builtin_amdgcn_readfirstlane(pe[7]) >> 8;
            pg8::Gemm g{(const bf16*)(ws + A_ACTM), (const bf16*)(ws + W_MD), 0, 0, 1792}; pg8::MoeOrder S; S.init(ntot, 4, G, bx, 0, 0, pe);
            pg8::EpiMoeDown E{(bf16*)(ws + A_Y), (const float*)(ws + WS_GSLOT), 0, 1.0f / (F8_AS * F8_WS)};
            pg8::gemm_phase8<pg8::EpiMoeDown, pg8::MoeOrder, true, true>(lds, g, S, E); }
        if (!MK_PER_PHASE) { if (IN(20) && IN(27)) xcd_barrier(bar); }
    }
    if (IN(27)) { IDS(); r9_phase(args, gw, NGW, lane); }
#undef IN
#undef SEAM
}

extern "C" void kernel_launch(void* const* d_in, const int* in_sizes, int n_in, void* d_out, int out_size, void* d_ws, size_t ws_size, hipStream_t stream) {
    static int grid = 0;
    if (grid == 0) {
        if (n_in != 31 || in_sizes[0] != T * DM || out_size != T * DM || ws_size < WS_NEED) {
            fprintf(stderr, "kernel_launch: expected 31 inputs, x/out of %d floats, >= %zu bytes of workspace; got n_in %d in0 %d out %d ws %zu\n", T * DM, (size_t)WS_NEED, n_in, n_in > 0 ? in_sizes[0] : -1, out_size, ws_size);
            grid = -1; return; }
        int dev = 0, cus = 0, per_cu = 0;
        if (hipGetDevice(&dev) != hipSuccess || hipDeviceGetAttribute(&cus, hipDeviceAttributeMultiprocessorCount, dev) != hipSuccess) { grid = -1; return; }
        if (hipFuncSetAttribute((const void*)mega_fwd, hipFuncAttributeMaxDynamicSharedMemorySize, LDS_BYTES) != hipSuccess) { fprintf(stderr, "kernel_launch: hipFuncSetAttribute failed\n"); grid = -1; return; }
        if (hipOccupancyMaxActiveBlocksPerMultiprocessor(&per_cu, (const void*)mega_fwd, NWAVES * 64, LDS_BYTES) != hipSuccess || per_cu < 1)
            fprintf(stderr, "kernel_launch: note: occupancy query reports %d workgroups per CU\n", per_cu);
        (void)hipGetLastError();
        grid = cus;
    }
    if (grid < 0) return;
    if (hipMemsetAsync((char*)d_ws + WS_CTL, 0, CTL_ZERO_BYTES, stream) != hipSuccess) { fprintf(stderr, "kernel_launch: memset failed\n"); return; }
    Args a{};
    for (int i = 0; i < 31; ++i) a.in[i] = (const float*)d_in[i];
    a.out = (float*)d_out; a.ws = (unsigned char*)d_ws;
#if MK_PER_PHASE
#ifndef REPMASK
#define REPMASK 0u
#endif
    for (int p = 0; p < NPH; ++p) { a.ph_lo = p; a.ph_hi = p + 1; hipLaunchKernelGGL(mega_fwd, dim3(grid), dim3(NWAVES * 64), LDS_BYTES, stream, a);
        if ((REPMASK >> p) & 1u) hipLaunchKernelGGL(mega_fwd, dim3(grid), dim3(NWAVES * 64), LDS_BYTES, stream, a); }
#else
    a.ph_lo = 0; a.ph_hi = NPH;
    hipLaunchKernelGGL(mega_fwd, dim3(grid), dim3(NWAVES * 64), LDS_BYTES, stream, a);
#endif
    const hipError_t le = hipPeekAtLastError();
    if (le != hipSuccess) fprintf(stderr, "kernel_launch: launch failed: %s\n", hipGetErrorName(le));
}
```

```cpp
#define MK_PER_PHASE 0
#define REPMASK 0u
#define BAND_REP 1
#define PROBE_REP 0u
#define PROBE_REPN 1
#define PROBE_P0N 0
#include <hip/hip_runtime.h>
#include <cstdio>
#include <cstdint>
namespace pg8 {
#define PG8_LAS __attribute__((address_space(3)))
typedef unsigned short bf16_t;
typedef short bf16x8 __attribute__((ext_vector_type(8)));
typedef float f32x4 __attribute__((ext_vector_type(4)));
typedef unsigned u32x4 __attribute__((ext_vector_type(4)));
constexpr int BM = 256, BK = 64, HALF = 128, HTB = HALF * BK * 2  , STAGE_BYTES = 8 * HTB, NXCD = 8, WGM = 8;

__host__ __device__ __forceinline__ int lds_byte(int r, int c) { const int st = (r >> 4) * 2 + (c >> 5), rr = r & 15, cc = c & 31, ob = rr * 64 + cc * 2; return st * 1024 + (ob ^ (((ob >> 9) & 1) << 5)); }
__host__ __device__ __forceinline__ void stage_rc(int b, int& R, int& C) { const int st = b / 1024, sb = b % 1024, swz = sb ^ (((sb >> 9) & 1) << 5); R = (st >> 1) * 16 + swz / 64; C = (st & 1) * 32 + (swz % 64) / 2; }
__host__ __device__ __forceinline__ int perm32(int rho) { const int n = rho >> 4, i = rho & 15; return 8 * (i >> 2) + 4 * n + (i & 3); }

struct Unit { int pm, pn; };
struct Gemm { const bf16_t* A; const bf16_t* Bt; int M, N, K; };

constexpr int PG8_NVM = 8;

struct StaticOrder {
    int nM, nN, nwg, G, c;
    __host__ __device__ void init(int M, int N, int G_, int c_) { nM = M / BM; nN = N / BM; nwg = nM * nN; G = G_; c = c_; }
    __host__ __device__ bool next(int i, Unit& u) const {
        const long L = (long)i * G + c; if (L >= nwg) return false;
        int wgid = (int)L; { const int q = nwg / NXCD, r = nwg % NXCD, xcd = wgid % NXCD, off = wgid / NXCD; wgid = (xcd < r ? xcd * (q + 1) : r * (q + 1) + (xcd - r) * q) + off; }
        const int nig = WGM * nN, gid = wgid / nig, fm = gid * WGM, gsz = (nM - fm) < WGM ? (nM - fm) : WGM;
        u.pm = fm + ((wgid % nig) % gsz); u.pn = (wgid % nig) / gsz; return true;
    }
    __device__ __forceinline__ void a_ready(const Unit&) const {}
    __device__ __forceinline__ void done(const Unit&) const {}
};

struct RowLocalOrder {
    int nM, nN, G, c;
    __host__ __device__ void init(int M, int N, int G_, int c_) { nM = M / BM; nN = N / BM; G = G_; c = c_; }
    __host__ __device__ bool next(int i, Unit& u) const { const int t = i / nN; const int pm = c + t * G; if (pm >= nM) return false; u.pm = pm; u.pn = i - t * nN; return true; }
    __device__ __forceinline__ void a_ready(const Unit&) const {}
    __device__ __forceinline__ void done(const Unit&) const {}
};

__device__ __forceinline__ unsigned cvt_pk_bf16(float lo, float hi) { unsigned r; asm volatile("v_cvt_pk_bf16_f32 %0, %1, %2" : "=v"(r) : "v"(lo), "v"(hi)); return r; }
typedef float f32x2 __attribute__((ext_vector_type(2)));
__device__ __forceinline__ f32x2 gelu_pk(f32x2 v) {
    const f32x2 av = __builtin_elementwise_abs(v), d = av * 0.2316418882f + 1.0f;
    f32x2 t; t.x = __builtin_amdgcn_rcpf(d.x); t.y = __builtin_amdgcn_rcpf(d.y);
    f32x2 q = t * 0.5307027145f + (-0.7265760135f); q = q * t + 0.7107068705f; q = q * t + (-0.142248368f); q = q * t + 0.127414796f; q = q * t;
    const f32x2 s = (v * v) * (-0.72134752044f);
    f32x2 e; e.x = __builtin_amdgcn_exp2f(s.x); e.y = __builtin_amdgcn_exp2f(s.y);
    const f32x2 m = v * (q * e), r = v - m;
    f32x2 o; o.x = v.x < 0.f ? m.x : r.x; o.y = v.y < 0.f ? m.y : r.y; return o;
}

template <int ACT  > struct EpiBf16 {
    static constexpr bool PERM = true, AFTER_DRAIN = false; static_assert(ACT == 0 || ACT == 1, "EpiBf16: ACT is 0 (none) or 1 (gelu_pk)");
    bf16_t* O; int ldc; const float* bias; int split_cols; size_t split_stride; float scale0;
    __device__ __forceinline__ void operator()(const f32x4 (&acc)[2][2][4][2], const Unit& u, int wr, int wc, int fr, int fq) const {
        const int row0 = u.pm * BM + wr * 64 + fr; int colt = u.pn * BM; bf16_t* base = O;
        float sc = 1.f; if (split_cols) { const int t = colt / split_cols; base += (size_t)t * split_stride; colt -= t * split_cols; if (t == 0) sc = scale0; }
        const int col0 = colt + wc * 32 + 8 * fq, bcol0 = u.pn * BM + wc * 32 + 8 * fq;
        f32x4 bv[2][2];
#pragma unroll
        for (int bj = 0; bj < 2; ++bj)
#pragma unroll
            for (int n = 0; n < 2; ++n) bv[bj][n] = bias ? *(const f32x4*)(bias + bcol0 + bj * HALF + 4 * n) : (f32x4){0.f, 0.f, 0.f, 0.f};
#pragma unroll
        for (int ai = 0; ai < 2; ++ai)
#pragma unroll
            for (int m = 0; m < 4; ++m) { bf16_t* rowp = base + (size_t)(row0 + ai * HALF + m * 16) * ldc + col0;
#pragma unroll
                for (int bj = 0; bj < 2; ++bj) { f32x4 v0 = acc[ai][bj][m][0] + bv[bj][0], v1 = acc[ai][bj][m][1] + bv[bj][1];
                    if (ACT == 1) { f32x2 a = gelu_pk((f32x2){v0[0], v0[1]}), b = gelu_pk((f32x2){v0[2], v0[3]}), c = gelu_pk((f32x2){v1[0], v1[1]}), d = gelu_pk((f32x2){v1[2], v1[3]});
                        v0 = (f32x4){a.x, a.y, b.x, b.y}; v1 = (f32x4){c.x, c.y, d.x, d.y}; }
                    v0 = v0 * sc; v1 = v1 * sc; u32x4 w; w.x = cvt_pk_bf16(v0[0], v0[1]); w.y = cvt_pk_bf16(v0[2], v0[3]); w.z = cvt_pk_bf16(v1[0], v1[1]); w.w = cvt_pk_bf16(v1[2], v1[3]);
                    *(u32x4*)(rowp + bj * HALF) = w; } }
    }
};
template <class Epi, class Sched, bool ALIGN_EPI = false, bool SP2 = false>
__device__ __forceinline__ void gemm_phase(PG8_LAS unsigned char* lds, const Gemm g, const Sched& S, const Epi& E) {
    int tid = threadIdx.x; asm volatile("" : "+v"(tid));
    const int wid = __builtin_amdgcn_readfirstlane(tid >> 6), lane = tid & 63, wr = wid >> 2, wc = wid & 3, fr = lane & 15, fq = lane >> 4;
    int K = g.K; asm volatile("" : "+s"(K));
    const int nt = K / BK;
    unsigned voffA[2], voffB[2];
#pragma unroll
    for (int i = 0; i < 2; ++i) { int R, C; stage_rc(tid * 16 + i * 8192, R, C); const int Rb = Epi::PERM ? ((R & ~31) + perm32(R & 31)) : R;
        voffA[i] = (unsigned)(R * K + C) * 2u; voffB[i] = (unsigned)(Rb * K + C) * 2u; }
    const size_t kstep = (size_t)(BK * 2);
    const size_t hstep = (size_t)HALF * K * 2;
    const size_t tstep = 2 * hstep;
    const unsigned ldsw = (unsigned)wid * 1024u;
    const int aoff = lds_byte(wr * 64 + fr, fq * 8), boff = lds_byte(wc * 32 + fr, fq * 8);
#define PG8_SA(b, h) (((b) * 2 + (h)) * HTB)
#define PG8_SB(b, h) ((4 + (b) * 2 + (h)) * HTB)
#define PG8_STAGE(bufoff, gbase, voff) do { _Pragma("unroll") for (int _i = 0; _i < 2; ++_i) \
        __builtin_amdgcn_global_load_lds((const unsigned*)((const char*)(gbase) + (voff)[_i]), (PG8_LAS unsigned*)(lds + (bufoff) + ldsw + _i * 8192), 16, 0, 0); } while (0)
#define PG8_LDA(dst, b, h) do { _Pragma("unroll") for (int m = 0; m < 4; ++m) _Pragma("unroll") for (int k = 0; k < 2; ++k) dst[m][k] = *(const PG8_LAS bf16x8*)(lds + PG8_SA(b, h) + aoff + m * 2048 + k * 1024); } while (0)
#define PG8_LDB(dst, b, h) do { _Pragma("unroll") for (int n = 0; n < 2; ++n) _Pragma("unroll") for (int k = 0; k < 2; ++k) dst[n][k] = *(const PG8_LAS bf16x8*)(lds + PG8_SB(b, h) + boff + n * 2048 + k * 1024); } while (0)
#define PG8_MMA(ai, bj, At, Bt) do { __builtin_amdgcn_s_setprio(1); _Pragma("unroll") for (int m = 0; m < 4; ++m) _Pragma("unroll") for (int n = 0; n < 2; ++n) _Pragma("unroll") for (int k = 0; k < 2; ++k) \
        acc[ai][bj][m][n] = __builtin_amdgcn_mfma_f32_16x16x32_bf16(Bt[n][k], At[m][k], acc[ai][bj][m][n], 0, 0, 0); __builtin_amdgcn_s_setprio(0); } while (0)
#define PG8_WAIT_V(n) asm volatile("s_waitcnt vmcnt(" #n ")" ::: "memory")
#define PG8_WAIT_L(n) asm volatile("s_waitcnt lgkmcnt(" #n ")" ::: "memory")
#define PG8_BAR __builtin_amdgcn_s_barrier()
#define PG8_SCHED __builtin_amdgcn_sched_barrier(0)
    Unit cur, nxt; int ui = 0;
    if (!S.next(0, cur)) return;
    f32x4 acc[2][2][4][2];
#pragma unroll
    for (int a = 0; a < 2; ++a)
#pragma unroll
        for (int b = 0; b < 2; ++b)
#pragma unroll
            for (int m = 0; m < 4; ++m)
#pragma unroll
                for (int n = 0; n < 2; ++n) acc[a][b][m][n] = (f32x4){0.f, 0.f, 0.f, 0.f};
    bf16x8 At[4][2], B0[2][2], B1[2][2];
    const char* cA = (const char*)g.A + (size_t)cur.pm * tstep; const char* cB = (const char*)g.Bt + (size_t)cur.pn * tstep;
    S.a_ready(cur);
    if constexpr (SP2) {
        PG8_STAGE(PG8_SB(0, 0), cB, voffB); PG8_STAGE(PG8_SB(0, 1), cB + hstep, voffB); PG8_STAGE(PG8_SA(0, 0), cA, voffA); PG8_STAGE(PG8_SA(0, 1), cA + hstep, voffA);
        if (wr == 1) PG8_BAR;
        PG8_WAIT_V(2); PG8_BAR;
        PG8_STAGE(PG8_SB(1, 0), cB + kstep, voffB); PG8_STAGE(PG8_SA(1, 0), cA + kstep, voffA); PG8_STAGE(PG8_SB(1, 1), cB + hstep + kstep, voffB);
        PG8_WAIT_V(6); PG8_BAR;
    } else {
        PG8_STAGE(PG8_SB(0, 0), cB, voffB); PG8_STAGE(PG8_SA(0, 0), cA, voffA); PG8_STAGE(PG8_SB(0, 1), cB + hstep, voffB); PG8_STAGE(PG8_SA(0, 1), cA + hstep, voffA);
        if (wr == 1) PG8_BAR;
        PG8_WAIT_V(4); PG8_BAR;
        PG8_STAGE(PG8_SB(1, 0), cB + kstep, voffB); PG8_STAGE(PG8_SA(1, 0), cA + kstep, voffA); PG8_STAGE(PG8_SB(1, 1), cB + hstep + kstep, voffB);
        PG8_WAIT_V(6); PG8_BAR;
    }
    for (;;) {
        const bool has_next = S.next(ui + 1, nxt);
        const char* nA = has_next ? (const char*)g.A + (size_t)nxt.pm * tstep : cA; const char* nB = has_next ? (const char*)g.Bt + (size_t)nxt.pn * tstep : cB;
        int t = 0;
#pragma unroll 1
        do {
            const bool last = (t == nt - 2);
            const char* a1 = cA + (size_t)(t + 1) * kstep;
            const char* a2 = last ? nA : cA + (size_t)(t + 2) * kstep; const char* b2 = last ? nB : cB + (size_t)(t + 2) * kstep;
            const char* a3 = a2 + kstep; const char* b3 = b2 + kstep;
            if (last && has_next) S.a_ready(nxt);
            if constexpr (SP2) {
            PG8_LDB(B0, 0, 0); PG8_LDB(B1, 0, 1); PG8_SCHED; PG8_LDA(At, 0, 0); PG8_STAGE(PG8_SA(1, 1), a1 + hstep, voffA);
            PG8_WAIT_V(8); PG8_WAIT_L(0); PG8_BAR; PG8_MMA(0, 0, At, B0); PG8_MMA(0, 1, At, B1); PG8_BAR; PG8_SCHED;
            PG8_LDA(At, 0, 1); PG8_STAGE(PG8_SB(0, 0), b2, voffB); PG8_STAGE(PG8_SB(0, 1), b2 + hstep, voffB); PG8_STAGE(PG8_SA(0, 0), a2, voffA);
            PG8_WAIT_V(8); PG8_WAIT_L(0); PG8_BAR; PG8_MMA(1, 0, At, B0); PG8_MMA(1, 1, At, B1); PG8_BAR; PG8_SCHED;
            PG8_LDB(B0, 1, 0); PG8_LDB(B1, 1, 1); PG8_SCHED; PG8_LDA(At, 1, 0); PG8_STAGE(PG8_SA(0, 1), a2 + hstep, voffA);
            PG8_WAIT_V(8); PG8_WAIT_L(0); PG8_BAR; PG8_MMA(0, 0, At, B0); PG8_MMA(0, 1, At, B1); PG8_BAR; PG8_SCHED;
            PG8_LDA(At, 1, 1); PG8_STAGE(PG8_SB(1, 0), b3, voffB); PG8_STAGE(PG8_SB(1, 1), b3 + hstep, voffB); PG8_STAGE(PG8_SA(1, 0), a3, voffA);
            PG8_WAIT_V(8); PG8_WAIT_L(0); PG8_BAR; PG8_MMA(1, 0, At, B0); PG8_MMA(1, 1, At, B1); PG8_BAR; PG8_SCHED;
            } else {
            PG8_LDB(B0, 0, 0); PG8_SCHED; PG8_LDA(At, 0, 0); PG8_STAGE(PG8_SA(1, 1), a1 + hstep, voffA);
            PG8_WAIT_L(8); PG8_BAR; PG8_WAIT_L(0); PG8_MMA(0, 0, At, B0); PG8_BAR; PG8_SCHED;
            PG8_LDB(B1, 0, 1); PG8_STAGE(PG8_SB(0, 0), b2, voffB);
            PG8_BAR; PG8_WAIT_L(0); PG8_MMA(0, 1, At, B1); PG8_BAR;
            PG8_LDA(At, 0, 1); PG8_STAGE(PG8_SA(0, 0), a2, voffA);
            PG8_BAR; PG8_WAIT_L(0); PG8_MMA(1, 0, At, B0); PG8_BAR; PG8_SCHED;
            PG8_STAGE(PG8_SB(0, 1), b2 + hstep, voffB);
            PG8_WAIT_V(6); PG8_BAR; PG8_MMA(1, 1, At, B1); PG8_BAR;
            PG8_LDB(B0, 1, 0); PG8_SCHED; PG8_LDA(At, 1, 0); PG8_STAGE(PG8_SA(0, 1), a2 + hstep, voffA);
            PG8_WAIT_L(8); PG8_BAR; PG8_WAIT_L(0); PG8_MMA(0, 0, At, B0); PG8_BAR; PG8_SCHED;
            PG8_LDB(B1, 1, 1); PG8_STAGE(PG8_SB(1, 0), b3, voffB);
            PG8_BAR; PG8_WAIT_L(0); PG8_MMA(0, 1, At, B1); PG8_BAR;
            PG8_LDA(At, 1, 1); PG8_STAGE(PG8_SA(1, 0), a3, voffA);
            PG8_BAR; PG8_WAIT_L(0); PG8_MMA(1, 0, At, B0); PG8_BAR; PG8_SCHED;
            PG8_STAGE(PG8_SB(1, 1), b3 + hstep, voffB);
            PG8_WAIT_V(6); PG8_BAR; PG8_MMA(1, 1, At, B1); PG8_BAR;
            }
            t += 2;
        } while (t < nt);
        if constexpr (ALIGN_EPI) { if (wr == 0) PG8_BAR; }
        if constexpr (!Epi::AFTER_DRAIN) { E(acc, cur, wr, wc, fr, fq); S.done(cur); }
        if (!has_next) break;
#pragma unroll
        for (int a = 0; a < 2; ++a)
#pragma unroll
            for (int b = 0; b < 2; ++b)
#pragma unroll
                for (int m = 0; m < 4; ++m)
#pragma unroll
                    for (int n = 0; n < 2; ++n) acc[a][b][m][n] = (f32x4){0.f, 0.f, 0.f, 0.f};
        cur = nxt; cA = nA; cB = nB; ++ui;
        if constexpr (ALIGN_EPI) { if (wr == 1) PG8_BAR; }
    }
    PG8_WAIT_V(0);
    if constexpr (!ALIGN_EPI) { if (wr == 0) PG8_BAR; }
    PG8_BAR;
    if constexpr (Epi::AFTER_DRAIN) { E.fused(acc, cur, wr, wc, fr, fq, lds, wid, lane); S.done(cur); }
#undef PG8_SA
#undef PG8_SB
#undef PG8_STAGE
#undef PG8_LDA
#undef PG8_LDB
#undef PG8_MMA
#undef PG8_WAIT_V
#undef PG8_WAIT_L
#undef PG8_BAR
#undef PG8_SCHED
}
typedef int v4i_t __attribute__((ext_vector_type(4)));
typedef int v8i_t __attribute__((ext_vector_type(8)));
template <class Epi, class Sched, bool ALIGN_EPI = false, bool SP2 = false>
__device__ __forceinline__ void gemm_phase8(PG8_LAS unsigned char* lds, const Gemm g, const Sched& S, const Epi& E) {
    int tid = threadIdx.x; asm volatile("" : "+v"(tid));
    const int wid = __builtin_amdgcn_readfirstlane(tid >> 6), lane = tid & 63, wr = wid >> 2, wc = wid & 3, fr = lane & 15, fq = lane >> 4;
    int K = g.K; asm volatile("" : "+s"(K));
    const int nt = K / BK;
    unsigned voffA[2], voffB[2];
#pragma unroll
    for (int i = 0; i < 2; ++i) { int R, C; stage_rc(tid * 16 + i * 8192, R, C); const int Rb = Epi::PERM ? ((R & ~31) + perm32(R & 31)) : R;
        voffA[i] = (unsigned)(R * K + C) * 2u; voffB[i] = (unsigned)(Rb * K + C) * 2u; }
    const size_t kstep = (size_t)(BK * 2);
    const size_t hstep = (size_t)HALF * K * 2;
    const size_t tstep = 2 * hstep;
    const unsigned ldsw = (unsigned)wid * 1024u;
    const int aoff = lds_byte(wr * 64 + fr, fq * 8), boff = lds_byte(wc * 32 + fr, fq * 8);
#define PG8_SA(b, h) (((b) * 2 + (h)) * HTB)
#define PG8_SB(b, h) ((4 + (b) * 2 + (h)) * HTB)
#define PG8_STAGE(bufoff, gbase, voff) do { _Pragma("unroll") for (int _i = 0; _i < 2; ++_i) \
        __builtin_amdgcn_global_load_lds((const unsigned*)((const char*)(gbase) + (voff)[_i]), (PG8_LAS unsigned*)(lds + (bufoff) + ldsw + _i * 8192), 16, 0, 0); } while (0)
#define PG8_LDA(dst, b, h) do { _Pragma("unroll") for (int m = 0; m < 4; ++m) { const v4i_t lo_ = *(const PG8_LAS v4i_t*)(lds + PG8_SA(b, h) + aoff + m * 2048), hi_ = *(const PG8_LAS v4i_t*)(lds + PG8_SA(b, h) + aoff + m * 2048 + 1024); dst[m] = __builtin_shufflevector(lo_, hi_, 0, 1, 2, 3, 4, 5, 6, 7); } } while (0)
#define PG8_LDB(dst, b, h) do { _Pragma("unroll") for (int n = 0; n < 2; ++n) { const v4i_t lo_ = *(const PG8_LAS v4i_t*)(lds + PG8_SB(b, h) + boff + n * 2048), hi_ = *(const PG8_LAS v4i_t*)(lds + PG8_SB(b, h) + boff + n * 2048 + 1024); dst[n] = __builtin_shufflevector(lo_, hi_, 0, 1, 2, 3, 4, 5, 6, 7); } } while (0)
#define PG8_MMA(ai, bj, At, Bt) do { __builtin_amdgcn_s_setprio(1); _Pragma("unroll") for (int m = 0; m < 4; ++m) _Pragma("unroll") for (int n = 0; n < 2; ++n) \
        asm volatile("v_mfma_scale_f32_16x16x128_f8f6f4 %0, %1, %2, %0, %3, %3 op_sel_hi:[0,0,0]" : "+v"(acc[ai][bj][m][n]) : "v"(Bt[n]), "v"(At[m]), "v"(sclv)); __builtin_amdgcn_s_setprio(0); } while (0)
#define PG8_WAIT_V(n) asm volatile("s_waitcnt vmcnt(" #n ")" ::: "memory")
#define PG8_WAIT_V_RELAXED(n) asm volatile("s_waitcnt vmcnt(%0)" :: "n"((n) + PG8_NVM) : "memory")
#define PG8_MMA0(ai, bj, At, Bt) do { __builtin_amdgcn_s_setprio(1); _Pragma("unroll") for (int m = 0; m < 4; ++m) _Pragma("unroll") for (int n = 0; n < 2; ++n) \
        asm volatile("v_mfma_scale_f32_16x16x128_f8f6f4 %0, %1, %2, 0, %3, %3 op_sel_hi:[0,0,0]" : "=&v"(acc[ai][bj][m][n]) : "v"(Bt[n]), "v"(At[m]), "v"(sclv)); __builtin_amdgcn_s_setprio(0); } while (0)
#define PG8_WAIT_L(n) asm volatile("s_waitcnt lgkmcnt(" #n ")" ::: "memory")
#define PG8_BAR __builtin_amdgcn_s_barrier()
#define PG8_SCHED __builtin_amdgcn_sched_barrier(0)
    Unit cur, nxt; int ui = 0;
    if (!S.next(0, cur)) return;
    f32x4 acc[2][2][4][2];
#pragma unroll
    for (int a = 0; a < 2; ++a)
#pragma unroll
        for (int b = 0; b < 2; ++b)
#pragma unroll
            for (int m = 0; m < 4; ++m)
#pragma unroll
                for (int n = 0; n < 2; ++n) acc[a][b][m][n] = (f32x4){0.f, 0.f, 0.f, 0.f};
    v8i_t At[4], B0[2], B1[2];
    int sclv = 0x7f7f7f7f; asm volatile("" : "+v"(sclv));
    const char* cA = (const char*)g.A + (size_t)cur.pm * tstep; const char* cB = (const char*)g.Bt + (size_t)cur.pn * tstep;
    S.a_ready(cur);
    if constexpr (SP2) {
        PG8_STAGE(PG8_SB(0, 0), cB, voffB); PG8_STAGE(PG8_SB(0, 1), cB + hstep, voffB); PG8_STAGE(PG8_SA(0, 0), cA, voffA); PG8_STAGE(PG8_SA(0, 1), cA + hstep, voffA);
        if (wr == 1) PG8_BAR;
        PG8_WAIT_V(2); PG8_BAR;
        PG8_STAGE(PG8_SB(1, 0), cB + kstep, voffB); PG8_STAGE(PG8_SA(1, 0), cA + kstep, voffA); PG8_STAGE(PG8_SB(1, 1), cB + hstep + kstep, voffB);
        PG8_WAIT_V(6); PG8_BAR;
    } else {
        PG8_STAGE(PG8_SB(0, 0), cB, voffB); PG8_STAGE(PG8_SA(0, 0), cA, voffA); PG8_STAGE(PG8_SB(0, 1), cB + hstep, voffB); PG8_STAGE(PG8_SA(0, 1), cA + hstep, voffA);
        if (wr == 1) PG8_BAR;
        PG8_WAIT_V(4); PG8_BAR;
        PG8_STAGE(PG8_SB(1, 0), cB + kstep, voffB); PG8_STAGE(PG8_SA(1, 0), cA + kstep, voffA); PG8_STAGE(PG8_SB(1, 1), cB + hstep + kstep, voffB);
        PG8_WAIT_V(6); PG8_BAR;
    }
    for (;;) {
        const bool has_next = S.next(ui + 1, nxt);
        const char* nA = has_next ? (const char*)g.A + (size_t)nxt.pm * tstep : cA; const char* nB = has_next ? (const char*)g.Bt + (size_t)nxt.pn * tstep : cB;
        int t = 0;
        if (ui > 0) {
            static_assert(SP2, "peeled first K-tile pair: SP2 loop only");
            const bool last = (t == nt - 2);
            const char* a1 = cA + (size_t)(t + 1) * kstep;
            const char* a2 = last ? nA : cA + (size_t)(t + 2) * kstep; const char* b2 = last ? nB : cB + (size_t)(t + 2) * kstep;
            const char* a3 = a2 + kstep; const char* b3 = b2 + kstep;
            if (last && has_next) S.a_ready(nxt);
            if constexpr (SP2) {
            PG8_LDB(B0, 0, 0); PG8_LDB(B1, 0, 1); PG8_SCHED; PG8_LDA(At, 0, 0); PG8_STAGE(PG8_SA(1, 1), a1 + hstep, voffA);
            PG8_WAIT_V_RELAXED(8); PG8_WAIT_L(0); PG8_BAR; PG8_MMA0(0, 0, At, B0); PG8_MMA0(0, 1, At, B1); PG8_BAR; PG8_SCHED;
            PG8_LDA(At, 0, 1); PG8_STAGE(PG8_SB(0, 0), b2, voffB); PG8_STAGE(PG8_SB(0, 1), b2 + hstep, voffB); PG8_STAGE(PG8_SA(0, 0), a2, voffA);
            PG8_WAIT_V_RELAXED(8); PG8_WAIT_L(0); PG8_BAR; PG8_MMA0(1, 0, At, B0); PG8_MMA0(1, 1, At, B1); PG8_BAR; PG8_SCHED;
            PG8_LDB(B0, 1, 0); PG8_LDB(B1, 1, 1); PG8_SCHED; PG8_LDA(At, 1, 0); PG8_STAGE(PG8_SA(0, 1), a2 + hstep, voffA);
            PG8_WAIT_V(8); PG8_WAIT_L(0); PG8_BAR; PG8_MMA(0, 0, At, B0); PG8_MMA(0, 1, At, B1); PG8_BAR; PG8_SCHED;
            PG8_LDA(At, 1, 1); PG8_STAGE(PG8_SB(1, 0), b3, voffB); PG8_STAGE(PG8_SB(1, 1), b3 + hstep, voffB); PG8_STAGE(PG8_SA(1, 0), a3, voffA);
            PG8_WAIT_V(8); PG8_WAIT_L(0); PG8_BAR; PG8_MMA(1, 0, At, B0); PG8_MMA(1, 1, At, B1); PG8_BAR; PG8_SCHED;
            } else {
            PG8_LDB(B0, 0, 0); PG8_SCHED; PG8_LDA(At, 0, 0); PG8_STAGE(PG8_SA(1, 1), a1 + hstep, voffA);
            PG8_WAIT_L(8); PG8_BAR; PG8_WAIT_L(0); PG8_MMA(0, 0, At, B0); PG8_BAR; PG8_SCHED;
            PG8_LDB(B1, 0, 1); PG8_STAGE(PG8_SB(0, 0), b2, voffB);
            PG8_BAR; PG8_WAIT_L(0); PG8_MMA(0, 1, At, B1); PG8_BAR;
            PG8_LDA(At, 0, 1); PG8_STAGE(PG8_SA(0, 0), a2, voffA);
            PG8_BAR; PG8_WAIT_L(0); PG8_MMA(1, 0, At, B0); PG8_BAR; PG8_SCHED;
            PG8_STAGE(PG8_SB(0, 1), b2 + hstep, voffB);
            PG8_WAIT_V(6); PG8_BAR; PG8_MMA(1, 1, At, B1); PG8_BAR;
            PG8_LDB(B0, 1, 0); PG8_SCHED; PG8_LDA(At, 1, 0); PG8_STAGE(PG8_SA(0, 1), a2 + hstep, voffA);
            PG8_WAIT_L(8); PG8_BAR; PG8_WAIT_L(0); PG8_MMA(0, 0, At, B0); PG8_BAR; PG8_SCHED;
            PG8_LDB(B1, 1, 1); PG8_STAGE(PG8_SB(1, 0), b3, voffB);
            PG8_BAR; PG8_WAIT_L(0); PG8_MMA(0, 1, At, B1); PG8_BAR;
            PG8_LDA(At, 1, 1); PG8_STAGE(PG8_SA(1, 0), a3, voffA);
            PG8_BAR; PG8_WAIT_L(0); PG8_MMA(1, 0, At, B0); PG8_BAR; PG8_SCHED;
            PG8_STAGE(PG8_SB(1, 1), b3 + hstep, voffB);
            PG8_WAIT_V(6); PG8_BAR; PG8_MMA(1, 1, At, B1); PG8_BAR;
            }
            t = 2;
        }
#pragma unroll 1
        while (t < nt) {
            const bool last = (t == nt - 2);
            const char* a1 = cA + (size_t)(t + 1) * kstep;
            const char* a2 = last ? nA : cA + (size_t)(t + 2) * kstep; const char* b2 = last ? nB : cB + (size_t)(t + 2) * kstep;
            const char* a3 = a2 + kstep; const char* b3 = b2 + kstep;
            if (last && has_next) S.a_ready(nxt);
            if constexpr (SP2) {
            PG8_LDB(B0, 0, 0); PG8_LDB(B1, 0, 1); PG8_SCHED; PG8_LDA(At, 0, 0); PG8_STAGE(PG8_SA(1, 1), a1 + hstep, voffA);
            PG8_WAIT_V(8); PG8_WAIT_L(0); PG8_BAR; PG8_MMA(0, 0, At, B0); PG8_MMA(0, 1, At, B1); PG8_BAR; PG8_SCHED;
            PG8_LDA(At, 0, 1); PG8_STAGE(PG8_SB(0, 0), b2, voffB); PG8_STAGE(PG8_SB(0, 1), b2 + hstep, voffB); PG8_STAGE(PG8_SA(0, 0), a2, voffA);
            PG8_WAIT_V(8); PG8_WAIT_L(0); PG8_BAR; PG8_MMA(1, 0, At, B0); PG8_MMA(1, 1, At, B1); PG8_BAR; PG8_SCHED;
            PG8_LDB(B0, 1, 0); PG8_LDB(B1, 1, 1); PG8_SCHED; PG8_LDA(At, 1, 0); PG8_STAGE(PG8_SA(0, 1), a2 + hstep, voffA);
            PG8_WAIT_V(8); PG8_WAIT_L(0); PG8_BAR; PG8_MMA(0, 0, At, B0); PG8_MMA(0, 1, At, B1); PG8_BAR; PG8_SCHED;
            PG8_LDA(At, 1, 1); PG8_STAGE(PG8_SB(1, 0), b3, voffB); PG8_STAGE(PG8_SB(1, 1), b3 + hstep, voffB); PG8_STAGE(PG8_SA(1, 0), a3, voffA);
            PG8_WAIT_V(8); PG8_WAIT_L(0); PG8_BAR; PG8_MMA(1, 0, At, B0); PG8_MMA(1, 1, At, B1); PG8_BAR; PG8_SCHED;
            } else {
            PG8_LDB(B0, 0, 0); PG8_SCHED; PG8_LDA(At, 0, 0); PG8_STAGE(PG8_SA(1, 1), a1 + hstep, voffA);
            PG8_WAIT_L(8); PG8_BAR; PG8_WAIT_L(0); PG8_MMA(0, 0, At, B0); PG8_BAR; PG8_SCHED;
            PG8_LDB(B1, 0, 1); PG8_STAGE(PG8_SB(0, 0), b2, voffB);
            PG8_BAR; PG8_WAIT_L(0); PG8_MMA(0, 1, At, B1); PG8_BAR;
            PG8_LDA(At, 0, 1); PG8_STAGE(PG8_SA(0, 0), a2, voffA);
            PG8_BAR; PG8_WAIT_L(0); PG8_MMA(1, 0, At, B0); PG8_BAR; PG8_SCHED;
            PG8_STAGE(PG8_SB(0, 1), b2 + hstep, voffB);
            PG8_WAIT_V(6); PG8_BAR; PG8_MMA(1, 1, At, B1); PG8_BAR;
            PG8_LDB(B0, 1, 0); PG8_SCHED; PG8_LDA(At, 1, 0); PG8_STAGE(PG8_SA(0, 1), a2 + hstep, voffA);
            PG8_WAIT_L(8); PG8_BAR; PG8_WAIT_L(0); PG8_MMA(0, 0, At, B0); PG8_BAR; PG8_SCHED;
            PG8_LDB(B1, 1, 1); PG8_STAGE(PG8_SB(1, 0), b3, voffB);
            PG8_BAR; PG8_WAIT_L(0); PG8_MMA(0, 1, At, B1); PG8_BAR;
            PG8_LDA(At, 1, 1); PG8_STAGE(PG8_SA(1, 0), a3, voffA);
            PG8_BAR; PG8_WAIT_L(0); PG8_MMA(1, 0, At, B0); PG8_BAR; PG8_SCHED;
            PG8_STAGE(PG8_SB(1, 1), b3 + hstep, voffB);
            PG8_WAIT_V(6); PG8_BAR; PG8_MMA(1, 1, At, B1); PG8_BAR;
            }
            t += 2;
        }
        if constexpr (ALIGN_EPI) { if (wr == 0) PG8_BAR; }
        asm volatile("s_nop 15\n\ts_nop 15" ::: "memory");
        if constexpr (!Epi::AFTER_DRAIN) { E(acc, cur, wr, wc, fr, fq); S.done(cur); }
        if (!has_next) break;
        cur = nxt; cA = nA; cB = nB; ++ui;
        if constexpr (ALIGN_EPI) { if (wr == 1) PG8_BAR; }
    }
    PG8_WAIT_V(0);
    if constexpr (!ALIGN_EPI) { if (wr == 0) PG8_BAR; }
    PG8_BAR;
    if constexpr (Epi::AFTER_DRAIN) { E.fused(acc, cur, wr, wc, fr, fq, lds, wid, lane); S.done(cur); }
#undef PG8_SA
#undef PG8_SB
#undef PG8_STAGE
#undef PG8_LDA
#undef PG8_LDB
#undef PG8_MMA
#undef PG8_WAIT_V
#undef PG8_WAIT_V_RELAXED
#undef PG8_MMA0
#undef PG8_WAIT_L
#undef PG8_BAR
#undef PG8_SCHED
}
struct GemmG { const void* A; const bf16_t* Bt; const int* rowidx; int K; int rowbytes; };
template <class Epi, class Sched, bool ALIGN_EPI = false, bool SP2 = false>
__device__ __forceinline__ void gemm_phase8g(PG8_LAS unsigned char* lds, const GemmG g, const Sched& S, const Epi& E) {
    int tid = threadIdx.x; asm volatile("" : "+v"(tid));
    const int wid = __builtin_amdgcn_readfirstlane(tid >> 6), lane = tid & 63, wr = wid >> 2, wc = wid & 3, fr = lane & 15, fq = lane >> 4;
    int K = g.K; asm volatile("" : "+s"(K));
    const int nt = K / BK;
    unsigned voffA[2], voffB[2];
    int Rl[2]; unsigned Cb[2];
#pragma unroll
    for (int i = 0; i < 2; ++i) { int R, C; stage_rc(tid * 16 + i * 8192, R, C); const int Rb = Epi::PERM ? ((R & ~31) + perm32(R & 31)) : R;
        voffA[i] = (unsigned)(R * K + C) * 2u; voffB[i] = (unsigned)(Rb * K + C) * 2u; Rl[i] = R; Cb[i] = (unsigned)C * 2u; }
    (void)voffA;
    unsigned gC0[2], gC1[2], gN0[2], gN1[2];
#define PG8_GOFF(d0, d1, pm_) do { _Pragma("unroll") for (int _i = 0; _i < 2; ++_i) { const int* ri_ = g.rowidx + (size_t)(pm_) * BM + Rl[_i]; \
        d0[_i] = (unsigned)ri_[0] * (unsigned)g.rowbytes + Cb[_i]; d1[_i] = (unsigned)ri_[HALF] * (unsigned)g.rowbytes + Cb[_i]; } } while (0)
#define PG8_GRAW(raw, pm_) do { _Pragma("unroll") for (int _i = 0; _i < 2; ++_i) { const int* ri_ = g.rowidx + (size_t)(pm_) * BM + Rl[_i]; \
        asm volatile("global_load_dword %0, %1, off" : "=v"(raw[2 * _i]) : "v"(ri_) : "memory"); asm volatile("global_load_dword %0, %1, off offset:512" : "=v"(raw[2 * _i + 1]) : "v"(ri_) : "memory"); } } while (0)
#define PG8_GWAIT(raw) asm volatile("s_waitcnt vmcnt(4)" : "+v"(raw[0]), "+v"(raw[1]), "+v"(raw[2]), "+v"(raw[3]) :: "memory")
#define PG8_GCVT(d0, d1, raw) do { _Pragma("unroll") for (int _i = 0; _i < 2; ++_i) { d0[_i] = (unsigned)raw[2 * _i] * (unsigned)g.rowbytes + Cb[_i]; d1[_i] = (unsigned)raw[2 * _i + 1] * (unsigned)g.rowbytes + Cb[_i]; } } while (0)
    static_assert(HALF * 4 == 512, "row-index load offset");
    const size_t kstep = (size_t)(BK * 2);
    const size_t hstep = (size_t)HALF * K * 2;
    const size_t tstep = 2 * hstep;
    const unsigned ldsw = (unsigned)wid * 1024u;
    const int aoff = lds_byte(wr * 64 + fr, fq * 8), boff = lds_byte(wc * 32 + fr, fq * 8);
#define PG8_SA(b, h) (((b) * 2 + (h)) * HTB)
#define PG8_SB(b, h) ((4 + (b) * 2 + (h)) * HTB)
#define PG8_STAGE(bufoff, gbase, voff) do { _Pragma("unroll") for (int _i = 0; _i < 2; ++_i) \
        __builtin_amdgcn_global_load_lds((const unsigned*)((const char*)(gbase) + (voff)[_i]), (PG8_LAS unsigned*)(lds + (bufoff) + ldsw + _i * 8192), 16, 0, 0); } while (0)
#define PG8_LDA(dst, b, h) do { _Pragma("unroll") for (int m = 0; m < 4; ++m) { const v4i_t lo_ = *(const PG8_LAS v4i_t*)(lds + PG8_SA(b, h) + aoff + m * 2048), hi_ = *(const PG8_LAS v4i_t*)(lds + PG8_SA(b, h) + aoff + m * 2048 + 1024); dst[m] = __builtin_shufflevector(lo_, hi_, 0, 1, 2, 3, 4, 5, 6, 7); } } while (0)
#define PG8_LDB(dst, b, h) do { _Pragma("unroll") for (int n = 0; n < 2; ++n) { const v4i_t lo_ = *(const PG8_LAS v4i_t*)(lds + PG8_SB(b, h) + boff + n * 2048), hi_ = *(const PG8_LAS v4i_t*)(lds + PG8_SB(b, h) + boff + n * 2048 + 1024); dst[n] = __builtin_shufflevector(lo_, hi_, 0, 1, 2, 3, 4, 5, 6, 7); } } while (0)
#define PG8_MMA(ai, bj, At, Bt) do { __builtin_amdgcn_s_setprio(1); _Pragma("unroll") for (int m = 0; m < 4; ++m) _Pragma("unroll") for (int n = 0; n < 2; ++n) \
        asm volatile("v_mfma_scale_f32_16x16x128_f8f6f4 %0, %1, %2, %0, %3, %3 op_sel_hi:[0,0,0]" : "+v"(acc[ai][bj][m][n]) : "v"(Bt[n]), "v"(At[m]), "v"(sclv)); __builtin_amdgcn_s_setprio(0); } while (0)
#define PG8_WAIT_V(n) asm volatile("s_waitcnt vmcnt(" #n ")" ::: "memory")
#define PG8_WAIT_V_RELAXED(n) asm volatile("s_waitcnt vmcnt(%0)" :: "n"((n) + PG8_NVM) : "memory")
#define PG8_MMA0(ai, bj, At, Bt) do { __builtin_amdgcn_s_setprio(1); _Pragma("unroll") for (int m = 0; m < 4; ++m) _Pragma("unroll") for (int n = 0; n < 2; ++n) \
        asm volatile("v_mfma_scale_f32_16x16x128_f8f6f4 %0, %1, %2, 0, %3, %3 op_sel_hi:[0,0,0]" : "=&v"(acc[ai][bj][m][n]) : "v"(Bt[n]), "v"(At[m]), "v"(sclv)); __builtin_amdgcn_s_setprio(0); } while (0)
#define PG8_WAIT_L(n) asm volatile("s_waitcnt lgkmcnt(" #n ")" ::: "memory")
#define PG8_BAR __builtin_amdgcn_s_barrier()
#define PG8_SCHED __builtin_amdgcn_sched_barrier(0)
    Unit cur, nxt, nn; int ui = 0;
    if (!S.next(0, cur)) return;
    bool has_next = S.next(1, nxt);
    int rawN[4] = {0, 0, 0, 0};
    f32x4 acc[2][2][4][2];
#pragma unroll
    for (int a = 0; a < 2; ++a)
#pragma unroll
        for (int b = 0; b < 2; ++b)
#pragma unroll
            for (int m = 0; m < 4; ++m)
#pragma unroll
                for (int n = 0; n < 2; ++n) acc[a][b][m][n] = (f32x4){0.f, 0.f, 0.f, 0.f};
    v8i_t At[4], B0[2], B1[2];
    int sclv = 0x7f7f7f7f; asm volatile("" : "+v"(sclv));
    const char* cA = (const char*)g.A; const char* cB = (const char*)g.Bt + (size_t)cur.pn * tstep;
    PG8_GOFF(gC0, gC1, cur.pm);
    if (has_next) PG8_GOFF(gN0, gN1, nxt.pm); else { _Pragma("unroll") for (int _i = 0; _i < 2; ++_i) { gN0[_i] = gC0[_i]; gN1[_i] = gC1[_i]; } }
    S.a_ready(cur);
    if constexpr (SP2) {
        PG8_STAGE(PG8_SB(0, 0), cB, voffB); PG8_STAGE(PG8_SB(0, 1), cB + hstep, voffB); PG8_STAGE(PG8_SA(0, 0), cA, gC0); PG8_STAGE(PG8_SA(0, 1), cA, gC1);
        if (wr == 1) PG8_BAR;
        PG8_WAIT_V(2); PG8_BAR;
        PG8_STAGE(PG8_SB(1, 0), cB + kstep, voffB); PG8_STAGE(PG8_SA(1, 0), cA + kstep, gC0); PG8_STAGE(PG8_SB(1, 1), cB + hstep + kstep, voffB);
        PG8_WAIT_V(6); PG8_BAR;
    } else {
        PG8_STAGE(PG8_SB(0, 0), cB, voffB); PG8_STAGE(PG8_SA(0, 0), cA, gC0); PG8_STAGE(PG8_SB(0, 1), cB + hstep, voffB); PG8_STAGE(PG8_SA(0, 1), cA, gC1);
        if (wr == 1) PG8_BAR;
        PG8_WAIT_V(4); PG8_BAR;
        PG8_STAGE(PG8_SB(1, 0), cB + kstep, voffB); PG8_STAGE(PG8_SA(1, 0), cA + kstep, gC0); PG8_STAGE(PG8_SB(1, 1), cB + hstep + kstep, voffB);
        PG8_WAIT_V(6); PG8_BAR;
    }
    for (;;) {
        const char* nA = cA; const char* nB = has_next ? (const char*)g.Bt + (size_t)nxt.pn * tstep : cB;
        int t = 0;
        if (ui > 0) {
            static_assert(SP2, "peeled first K-tile pair: SP2 loop only");
            const bool last = (t == nt - 2);
            const char* a1 = cA + (size_t)(t + 1) * kstep;
            const char* a2 = last ? nA : cA + (size_t)(t + 2) * kstep; const char* b2 = last ? nB : cB + (size_t)(t + 2) * kstep;
            const char* a3 = a2 + kstep; const char* b3 = b2 + kstep;
            unsigned v20[2], v21[2];
            _Pragma("unroll") for (int _i = 0; _i < 2; ++_i) { v20[_i] = last ? gN0[_i] : gC0[_i]; v21[_i] = last ? gN1[_i] : gC1[_i]; }
            if (last && has_next) S.a_ready(nxt);
            if constexpr (SP2) {
            PG8_LDB(B0, 0, 0); PG8_LDB(B1, 0, 1); PG8_SCHED; PG8_LDA(At, 0, 0); PG8_STAGE(PG8_SA(1, 1), a1, gC1);
            PG8_WAIT_V_RELAXED(8); PG8_WAIT_L(0); PG8_BAR; PG8_MMA0(0, 0, At, B0); PG8_MMA0(0, 1, At, B1); PG8_BAR; PG8_SCHED;
            PG8_LDA(At, 0, 1); PG8_STAGE(PG8_SB(0, 0), b2, voffB); PG8_STAGE(PG8_SB(0, 1), b2 + hstep, voffB); PG8_STAGE(PG8_SA(0, 0), a2, v20);
            PG8_WAIT_V_RELAXED(8); PG8_WAIT_L(0); PG8_BAR; PG8_MMA0(1, 0, At, B0); PG8_MMA0(1, 1, At, B1); PG8_BAR; PG8_SCHED;
            PG8_LDB(B0, 1, 0); PG8_LDB(B1, 1, 1); PG8_SCHED; PG8_LDA(At, 1, 0); PG8_STAGE(PG8_SA(0, 1), a2, v21);
            PG8_WAIT_V(8); PG8_WAIT_L(0); PG8_BAR; PG8_MMA(0, 0, At, B0); PG8_MMA(0, 1, At, B1); PG8_BAR; PG8_SCHED;
            PG8_LDA(At, 1, 1); PG8_STAGE(PG8_SB(1, 0), b3, voffB); PG8_STAGE(PG8_SB(1, 1), b3 + hstep, voffB); PG8_STAGE(PG8_SA(1, 0), a3, v20);
            PG8_WAIT_V(8); PG8_WAIT_L(0); PG8_BAR; PG8_MMA(1, 0, At, B0); PG8_MMA(1, 1, At, B1); PG8_BAR; PG8_SCHED;
            } else {
            PG8_LDB(B0, 0, 0); PG8_SCHED; PG8_LDA(At, 0, 0); PG8_STAGE(PG8_SA(1, 1), a1, gC1);
            PG8_WAIT_L(8); PG8_BAR; PG8_WAIT_L(0); PG8_MMA(0, 0, At, B0); PG8_BAR; PG8_SCHED;
            PG8_LDB(B1, 0, 1); PG8_STAGE(PG8_SB(0, 0), b2, voffB);
            PG8_BAR; PG8_WAIT_L(0); PG8_MMA(0, 1, At, B1); PG8_BAR;
            PG8_LDA(At, 0, 1); PG8_STAGE(PG8_SA(0, 0), a2, v20);
            PG8_BAR; PG8_WAIT_L(0); PG8_MMA(1, 0, At, B0); PG8_BAR; PG8_SCHED;
            PG8_STAGE(PG8_SB(0, 1), b2 + hstep, voffB);
            PG8_WAIT_V(6); PG8_BAR; PG8_MMA(1, 1, At, B1); PG8_BAR;
            PG8_LDB(B0, 1, 0); PG8_SCHED; PG8_LDA(At, 1, 0); PG8_STAGE(PG8_SA(0, 1), a2, v21);
            PG8_WAIT_L(8); PG8_BAR; PG8_WAIT_L(0); PG8_MMA(0, 0, At, B0); PG8_BAR; PG8_SCHED;
            PG8_LDB(B1, 1, 1); PG8_STAGE(PG8_SB(1, 0), b3, voffB);
            PG8_BAR; PG8_WAIT_L(0); PG8_MMA(0, 1, At, B1); PG8_BAR;
            PG8_LDA(At, 1, 1); PG8_STAGE(PG8_SA(1, 0), a3, v20);
            PG8_BAR; PG8_WAIT_L(0); PG8_MMA(1, 0, At, B0); PG8_BAR; PG8_SCHED;
            PG8_STAGE(PG8_SB(1, 1), b3 + hstep, voffB);
            PG8_WAIT_V(6); PG8_BAR; PG8_MMA(1, 1, At, B1); PG8_BAR;
            }
            t = 2;
        }
#pragma unroll 1
        while (t < nt) {
            const bool last = (t == nt - 2);
            const char* a1 = cA + (size_t)(t + 1) * kstep;
            const char* a2 = last ? nA : cA + (size_t)(t + 2) * kstep; const char* b2 = last ? nB : cB + (size_t)(t + 2) * kstep;
            const char* a3 = a2 + kstep; const char* b3 = b2 + kstep;
            unsigned v20[2], v21[2];
            _Pragma("unroll") for (int _i = 0; _i < 2; ++_i) { v20[_i] = last ? gN0[_i] : gC0[_i]; v21[_i] = last ? gN1[_i] : gC1[_i]; }
            if (last && has_next) S.a_ready(nxt);
            if constexpr (SP2) {
            PG8_LDB(B0, 0, 0); PG8_LDB(B1, 0, 1); PG8_SCHED; PG8_LDA(At, 0, 0); PG8_STAGE(PG8_SA(1, 1), a1, gC1);
            PG8_WAIT_V(8); PG8_WAIT_L(0); PG8_BAR; PG8_MMA(0, 0, At, B0); PG8_MMA(0, 1, At, B1); PG8_BAR; PG8_SCHED;
            PG8_LDA(At, 0, 1); PG8_STAGE(PG8_SB(0, 0), b2, voffB); PG8_STAGE(PG8_SB(0, 1), b2 + hstep, voffB); PG8_STAGE(PG8_SA(0, 0), a2, v20);
            PG8_WAIT_V(8); PG8_WAIT_L(0); PG8_BAR; PG8_MMA(1, 0, At, B0); PG8_MMA(1, 1, At, B1); PG8_BAR; PG8_SCHED;
            PG8_LDB(B0, 1, 0); PG8_LDB(B1, 1, 1); PG8_SCHED; PG8_LDA(At, 1, 0); PG8_STAGE(PG8_SA(0, 1), a2, v21);
            PG8_WAIT_V(8); PG8_WAIT_L(0); PG8_BAR; PG8_MMA(0, 0, At, B0); PG8_MMA(0, 1, At, B1); PG8_BAR; PG8_SCHED;
            PG8_LDA(At, 1, 1); PG8_STAGE(PG8_SB(1, 0), b3, voffB); PG8_STAGE(PG8_SB(1, 1), b3 + hstep, voffB); PG8_STAGE(PG8_SA(1, 0), a3, v20);
            PG8_WAIT_V(8); PG8_WAIT_L(0); PG8_BAR; PG8_MMA(1, 0, At, B0); PG8_MMA(1, 1, At, B1); PG8_BAR; PG8_SCHED;
            } else {
            PG8_LDB(B0, 0, 0); PG8_SCHED; PG8_LDA(At, 0, 0); PG8_STAGE(PG8_SA(1, 1), a1, gC1);
            PG8_WAIT_L(8); PG8_BAR; PG8_WAIT_L(0); PG8_MMA(0, 0, At, B0); PG8_BAR; PG8_SCHED;
            PG8_LDB(B1, 0, 1); PG8_STAGE(PG8_SB(0, 0), b2, voffB);
            PG8_BAR; PG8_WAIT_L(0); PG8_MMA(0, 1, At, B1); PG8_BAR;
            PG8_LDA(At, 0, 1); PG8_STAGE(PG8_SA(0, 0), a2, v20);
            PG8_BAR; PG8_WAIT_L(0); PG8_MMA(1, 0, At, B0); PG8_BAR; PG8_SCHED;
            PG8_STAGE(PG8_SB(0, 1), b2 + hstep, voffB);
            PG8_WAIT_V(6); PG8_BAR; PG8_MMA(1, 1, At, B1); PG8_BAR;
            PG8_LDB(B0, 1, 0); PG8_SCHED; PG8_LDA(At, 1, 0); PG8_STAGE(PG8_SA(0, 1), a2, v21);
            PG8_WAIT_L(8); PG8_BAR; PG8_WAIT_L(0); PG8_MMA(0, 0, At, B0); PG8_BAR; PG8_SCHED;
            PG8_LDB(B1, 1, 1); PG8_STAGE(PG8_SB(1, 0), b3, voffB);
            PG8_BAR; PG8_WAIT_L(0); PG8_MMA(0, 1, At, B1); PG8_BAR;
            PG8_LDA(At, 1, 1); PG8_STAGE(PG8_SA(1, 0), a3, v20);
            PG8_BAR; PG8_WAIT_L(0); PG8_MMA(1, 0, At, B0); PG8_BAR; PG8_SCHED;
            PG8_STAGE(PG8_SB(1, 1), b3 + hstep, voffB);
            PG8_WAIT_V(6); PG8_BAR; PG8_MMA(1, 1, At, B1); PG8_BAR;
            }
            t += 2;
        }
        const bool has_nn = has_next && S.next(ui + 2, nn);
        if (has_nn) PG8_GRAW(rawN, nn.pm);
        if constexpr (ALIGN_EPI) { if (wr == 0) PG8_BAR; }
        asm volatile("s_nop 15\n\ts_nop 15" ::: "memory");
        if constexpr (!Epi::AFTER_DRAIN) { E(acc, cur, wr, wc, fr, fq); S.done(cur); }
        if (!has_next) break;
        cur = nxt; nxt = nn; has_next = has_nn; cA = nA; cB = nB; ++ui;
        _Pragma("unroll") for (int _i = 0; _i < 2; ++_i) { gC0[_i] = gN0[_i]; gC1[_i] = gN1[_i]; }
        PG8_GWAIT(rawN);
        if (has_next) PG8_GCVT(gN0, gN1, rawN);
        if constexpr (ALIGN_EPI) { if (wr == 1) PG8_BAR; }
    }
    PG8_WAIT_V(0);
    if constexpr (!ALIGN_EPI) { if (wr == 0) PG8_BAR; }
    PG8_BAR;
    if constexpr (Epi::AFTER_DRAIN) { E.fused(acc, cur, wr, wc, fr, fq, lds, wid, lane); S.done(cur); }
#undef PG8_SA
#undef PG8_SB
#undef PG8_STAGE
#undef PG8_GOFF
#undef PG8_GRAW
#undef PG8_GWAIT
#undef PG8_GCVT
#undef PG8_LDA
#undef PG8_LDB
#undef PG8_MMA
#undef PG8_WAIT_V
#undef PG8_WAIT_V_RELAXED
#undef PG8_MMA0
#undef PG8_WAIT_L
#undef PG8_BAR
#undef PG8_SCHED
}
}
namespace pg8 {
typedef int i32x4_t __attribute__((ext_vector_type(4)));
template <class Epi, class Sched, bool ALIGN_EPI = false, bool SP2 = false>
__device__ __forceinline__ void gemm_phase_i8(PG8_LAS unsigned char* lds, const Gemm g, const Sched& S, const Epi& E) {
    int tid = threadIdx.x; asm volatile("" : "+v"(tid));
    const int wid = __builtin_amdgcn_readfirstlane(tid >> 6), lane = tid & 63, wr = wid >> 2, wc = wid & 3, fr = lane & 15, fq = lane >> 4;
    int K = g.K; asm volatile("" : "+s"(K));
    const int nt = K / BK;
    unsigned voffA[2], voffB[2];
#pragma unroll
    for (int i = 0; i < 2; ++i) { int R, C; stage_rc(tid * 16 + i * 8192, R, C); const int Rb = Epi::PERM ? ((R & ~31) + perm32(R & 31)) : R;
        voffA[i] = (unsigned)(R * K + C) * 2u; voffB[i] = (unsigned)(Rb * K + C) * 2u; }
    const size_t kstep = (size_t)(BK * 2);
    const size_t hstep = (size_t)HALF * K * 2;
    const size_t tstep = 2 * hstep;
    const unsigned ldsw = (unsigned)wid * 1024u;
    const int aoff = lds_byte(wr * 64 + fr, fq * 8), boff = lds_byte(wc * 32 + fr, fq * 8);
#define PG8_SA(b, h) (((b) * 2 + (h)) * HTB)
#define PG8_SB(b, h) ((4 + (b) * 2 + (h)) * HTB)
#define PG8_STAGE(bufoff, gbase, voff) do { _Pragma("unroll") for (int _i = 0; _i < 2; ++_i) \
        __builtin_amdgcn_global_load_lds((const unsigned*)((const char*)(gbase) + (voff)[_i]), (PG8_LAS unsigned*)(lds + (bufoff) + ldsw + _i * 8192), 16, 0, 0); } while (0)
#define PG8_LDA(dst, b, h) do { _Pragma("unroll") for (int m = 0; m < 4; ++m) _Pragma("unroll") for (int k = 0; k < 2; ++k) dst[m][k] = *(const PG8_LAS bf16x8*)(lds + PG8_SA(b, h) + aoff + m * 2048 + k * 1024); } while (0)
#define PG8_LDB(dst, b, h) do { _Pragma("unroll") for (int n = 0; n < 2; ++n) _Pragma("unroll") for (int k = 0; k < 2; ++k) dst[n][k] = *(const PG8_LAS bf16x8*)(lds + PG8_SB(b, h) + boff + n * 2048 + k * 1024); } while (0)
#define PG8_MMA(ai, bj, At, Bt) do { __builtin_amdgcn_s_setprio(1); _Pragma("unroll") for (int m = 0; m < 4; ++m) _Pragma("unroll") for (int n = 0; n < 2; ++n) _Pragma("unroll") for (int k = 0; k < 2; ++k) \
        acc[ai][bj][m][n] = __builtin_amdgcn_mfma_i32_16x16x64_i8(__builtin_bit_cast(i32x4_t, Bt[n][k]), __builtin_bit_cast(i32x4_t, At[m][k]), acc[ai][bj][m][n], 0, 0, 0); __builtin_amdgcn_s_setprio(0); } while (0)
#define PG8_WAIT_V(n) asm volatile("s_waitcnt vmcnt(" #n ")" ::: "memory")
#define PG8_WAIT_L(n) asm volatile("s_waitcnt lgkmcnt(" #n ")" ::: "memory")
#define PG8_BAR __builtin_amdgcn_s_barrier()
#define PG8_SCHED __builtin_amdgcn_sched_barrier(0)
    Unit cur, nxt; int ui = 0;
    if (!S.next(0, cur)) return;
    i32x4_t acc[2][2][4][2];
#pragma unroll
    for (int a = 0; a < 2; ++a)
#pragma unroll
        for (int b = 0; b < 2; ++b)
#pragma unroll
            for (int m = 0; m < 4; ++m)
#pragma unroll
                for (int n = 0; n < 2; ++n) acc[a][b][m][n] = (i32x4_t){0, 0, 0, 0};
    bf16x8 At[4][2], B0[2][2], B1[2][2];
    const char* cA = (const char*)g.A + (size_t)cur.pm * tstep; const char* cB = (const char*)g.Bt + (size_t)cur.pn * tstep;
    S.a_ready(cur);
    if constexpr (SP2) {
        PG8_STAGE(PG8_SB(0, 0), cB, voffB); PG8_STAGE(PG8_SB(0, 1), cB + hstep, voffB); PG8_STAGE(PG8_SA(0, 0), cA, voffA); PG8_STAGE(PG8_SA(0, 1), cA + hstep, voffA);
        if (wr == 1) PG8_BAR;
        PG8_WAIT_V(2); PG8_BAR;
        PG8_STAGE(PG8_SB(1, 0), cB + kstep, voffB); PG8_STAGE(PG8_SA(1, 0), cA + kstep, voffA); PG8_STAGE(PG8_SB(1, 1), cB + hstep + kstep, voffB);
        PG8_WAIT_V(6); PG8_BAR;
    } else {
        PG8_STAGE(PG8_SB(0, 0), cB, voffB); PG8_STAGE(PG8_SA(0, 0), cA, voffA); PG8_STAGE(PG8_SB(0, 1), cB + hstep, voffB); PG8_STAGE(PG8_SA(0, 1), cA + hstep, voffA);
        if (wr == 1) PG8_BAR;
        PG8_WAIT_V(4); PG8_BAR;
        PG8_STAGE(PG8_SB(1, 0), cB + kstep, voffB); PG8_STAGE(PG8_SA(1, 0), cA + kstep, voffA); PG8_STAGE(PG8_SB(1, 1), cB + hstep + kstep, voffB);
        PG8_WAIT_V(6); PG8_BAR;
    }
    for (;;) {
        const bool has_next = S.next(ui + 1, nxt);
        const char* nA = has_next ? (const char*)g.A + (size_t)nxt.pm * tstep : cA; const char* nB = has_next ? (const char*)g.Bt + (size_t)nxt.pn * tstep : cB;
        int t = 0;
#pragma unroll 1
        do {
            const bool last = (t == nt - 2);
            const char* a1 = cA + (size_t)(t + 1) * kstep;
            const char* a2 = last ? nA : cA + (size_t)(t + 2) * kstep; const char* b2 = last ? nB : cB + (size_t)(t + 2) * kstep;
            const char* a3 = a2 + kstep; const char* b3 = b2 + kstep;
            if (last && has_next) S.a_ready(nxt);
            if constexpr (SP2) {
            PG8_LDB(B0, 0, 0); PG8_LDB(B1, 0, 1); PG8_SCHED; PG8_LDA(At, 0, 0); PG8_STAGE(PG8_SA(1, 1), a1 + hstep, voffA);
            PG8_WAIT_V(8); PG8_WAIT_L(0); PG8_BAR; PG8_MMA(0, 0, At, B0); PG8_MMA(0, 1, At, B1); PG8_BAR; PG8_SCHED;
            PG8_LDA(At, 0, 1); PG8_STAGE(PG8_SB(0, 0), b2, voffB); PG8_STAGE(PG8_SB(0, 1), b2 + hstep, voffB); PG8_STAGE(PG8_SA(0, 0), a2, voffA);
            PG8_WAIT_V(8); PG8_WAIT_L(0); PG8_BAR; PG8_MMA(1, 0, At, B0); PG8_MMA(1, 1, At, B1); PG8_BAR; PG8_SCHED;
            PG8_LDB(B0, 1, 0); PG8_LDB(B1, 1, 1); PG8_SCHED; PG8_LDA(At, 1, 0); PG8_STAGE(PG8_SA(0, 1), a2 + hstep, voffA);
            PG8_WAIT_V(8); PG8_WAIT_L(0); PG8_BAR; PG8_MMA(0, 0, At, B0); PG8_MMA(0, 1, At, B1); PG8_BAR; PG8_SCHED;
            PG8_LDA(At, 1, 1); PG8_STAGE(PG8_SB(1, 0), b3, voffB); PG8_STAGE(PG8_SB(1, 1), b3 + hstep, voffB); PG8_STAGE(PG8_SA(1, 0), a3, voffA);
            PG8_WAIT_V(8); PG8_WAIT_L(0); PG8_BAR; PG8_MMA(1, 0, At, B0); PG8_MMA(1, 1, At, B1); PG8_BAR; PG8_SCHED;
            } else {
            PG8_LDB(B0, 0, 0); PG8_SCHED; PG8_LDA(At, 0, 0); PG8_STAGE(PG8_SA(1, 1), a1 + hstep, voffA);
            PG8_WAIT_L(8); PG8_BAR; PG8_WAIT_L(0); PG8_MMA(0, 0, At, B0); PG8_BAR; PG8_SCHED;
            PG8_LDB(B1, 0, 1); PG8_STAGE(PG8_SB(0, 0), b2, voffB);
            PG8_BAR; PG8_WAIT_L(0); PG8_MMA(0, 1, At, B1); PG8_BAR;
            PG8_LDA(At, 0, 1); PG8_STAGE(PG8_SA(0, 0), a2, voffA);
            PG8_BAR; PG8_WAIT_L(0); PG8_MMA(1, 0, At, B0); PG8_BAR; PG8_SCHED;
            PG8_STAGE(PG8_SB(0, 1), b2 + hstep, voffB);
            PG8_WAIT_V(6); PG8_BAR; PG8_MMA(1, 1, At, B1); PG8_BAR;
            PG8_LDB(B0, 1, 0); PG8_SCHED; PG8_LDA(At, 1, 0); PG8_STAGE(PG8_SA(0, 1), a2 + hstep, voffA);
            PG8_WAIT_L(8); PG8_BAR; PG8_WAIT_L(0); PG8_MMA(0, 0, At, B0); PG8_BAR; PG8_SCHED;
            PG8_LDB(B1, 1, 1); PG8_STAGE(PG8_SB(1, 0), b3, voffB);
            PG8_BAR; PG8_WAIT_L(0); PG8_MMA(0, 1, At, B1); PG8_BAR;
            PG8_LDA(At, 1, 1); PG8_STAGE(PG8_SA(1, 0), a3, voffA);
            PG8_BAR; PG8_WAIT_L(0); PG8_MMA(1, 0, At, B0); PG8_BAR; PG8_SCHED;
            PG8_STAGE(PG8_SB(1, 1), b3 + hstep, voffB);
            PG8_WAIT_V(6); PG8_BAR; PG8_MMA(1, 1, At, B1); PG8_BAR;
            }
            t += 2;
        } while (t < nt);
        if constexpr (ALIGN_EPI) { if (wr == 0) PG8_BAR; }
        if constexpr (!Epi::AFTER_DRAIN) { E(acc, cur, wr, wc, fr, fq); S.done(cur); }
        if (!has_next) break;
#pragma unroll
        for (int a = 0; a < 2; ++a)
#pragma unroll
            for (int b = 0; b < 2; ++b)
#pragma unroll
                for (int m = 0; m < 4; ++m)
#pragma unroll
                    for (int n = 0; n < 2; ++n) acc[a][b][m][n] = (i32x4_t){0, 0, 0, 0};
        cur = nxt; cA = nA; cB = nB; ++ui;
        if constexpr (ALIGN_EPI) { if (wr == 1) PG8_BAR; }
    }
    PG8_WAIT_V(0);
    if constexpr (!ALIGN_EPI) { if (wr == 0) PG8_BAR; }
    PG8_BAR;
    if constexpr (Epi::AFTER_DRAIN) { E.fused(acc, cur, wr, wc, fr, fq, lds, wid, lane); S.done(cur); }
#undef PG8_SA
#undef PG8_SB
#undef PG8_STAGE
#undef PG8_LDA
#undef PG8_LDB
#undef PG8_MMA
#undef PG8_WAIT_V
#undef PG8_WAIT_L
#undef PG8_BAR
#undef PG8_SCHED
}
}
#define GAS __attribute__((address_space(1)))
#define LAS __attribute__((address_space(3)))
typedef unsigned short bf16;
typedef unsigned v4u __attribute__((ext_vector_type(4)));
typedef float f32x4 __attribute__((ext_vector_type(4)));
typedef short bf16x8 __attribute__((ext_vector_type(8)));
typedef GAS unsigned gu32;
typedef GAS unsigned long long gu64;
#define RLX_AGENT __ATOMIC_RELAXED, __HIP_MEMORY_SCOPE_AGENT
#define LDS_WAIT() asm volatile("s_waitcnt lgkmcnt(0)" ::: "memory")
#define VM_WAIT() asm volatile("s_waitcnt vmcnt(0)" ::: "memory")
__device__ __forceinline__ unsigned long long rt() { return __builtin_amdgcn_s_memrealtime(); }
__device__ __forceinline__ unsigned f2bf(float f) { unsigned u = __builtin_bit_cast(unsigned, f); return (u + 0x7fffu + ((u >> 16) & 1u)) >> 16; }
__device__ __forceinline__ unsigned pk2(float lo, float hi) { return f2bf(lo) | (f2bf(hi) << 16); }

#define XB_TMO      128
#define XB_XCNT(j)  (256  + 64 * (j))
#define XB_XSUB(j)  (1280 + 64 * (j))
#define XB_XGEN(j)  (2304 + 64 * (j))
#define XB_TOP      3328
#define XB_TOPGEN   3392
#define XCD_BAR_WORDS 3456
#define XB_SPIN_CAP (1u << 18)

__device__ __forceinline__ unsigned xb_ld(unsigned* p)              { return __hip_atomic_load(p, __ATOMIC_RELAXED, __HIP_MEMORY_SCOPE_AGENT); }
__device__ __forceinline__ unsigned xb_add(unsigned* p, unsigned v) { return __hip_atomic_fetch_add(p, v, __ATOMIC_RELAXED, __HIP_MEMORY_SCOPE_AGENT); }
__device__ __forceinline__ unsigned xb_xcc_id() { return (unsigned)__builtin_amdgcn_s_getreg((3 << 11) | 20) & 0xFu; }
#define XB_SPIN(cond, bar) do { unsigned _sp = 0; while (cond) { __builtin_amdgcn_s_sleep(1); \
    if ((++_sp & 255u) == 0u) { if (xb_ld(&(bar)[XB_TMO])) break; if (_sp > XB_SPIN_CAP) { atomicAdd(&(bar)[XB_TMO], 1u); break; } } } } while (0)

struct XcdBarrier {
    unsigned* bar; unsigned x;
    volatile LAS unsigned* st;
};

__device__ __forceinline__ XcdBarrier xcd_barrier_post(unsigned* bar, volatile LAS unsigned* st) {
    XcdBarrier b; b.bar = bar; b.x = xb_xcc_id(); b.st = st;
    if (threadIdx.x == 0) (void)xb_add(&bar[XB_XCNT(b.x)], 1u);
    return b;
}
__device__ __forceinline__ void xcd_barrier_complete(unsigned* bar, unsigned x, unsigned& nloc, unsigned& nx) {
    const unsigned G = gridDim.x * gridDim.y * gridDim.z;
    unsigned sum, cnt, mine, sp = 0u;
    for (;;) {
        sum = 0u; cnt = 0u; mine = 0u;
#pragma unroll
        for (unsigned j = 0; j < 16; ++j) { const unsigned c = xb_ld(&bar[XB_XCNT(j)]); sum += c; cnt += (c > 0u) ? 1u : 0u; mine = (j == x) ? c : mine; }
        if (sum == G) break;
        __builtin_amdgcn_s_sleep(1);
        if ((++sp & 255u) == 0u) { if (xb_ld(&bar[XB_TMO])) break; if (sp > XB_SPIN_CAP) { atomicAdd(&bar[XB_TMO], 1u); break; } }
    }
    nloc = mine > 0u ? mine : 1u; nx = cnt > 0u ? cnt : 1u;
}

__device__ __forceinline__ void xcd_barrier(const XcdBarrier& b) {
    asm volatile("s_waitcnt vmcnt(0)" ::: "memory");
    __syncthreads();
    if (threadIdx.x == 0) {
        unsigned* bar = b.bar;
        __builtin_amdgcn_s_waitcnt(0);
        unsigned nloc = b.st[0], nx = b.st[1];
        if (nloc == 0u) { xcd_barrier_complete(bar, b.x, nloc, nx); b.st[0] = nloc; b.st[1] = nx; }
        const unsigned old = xb_add(&bar[XB_XSUB(b.x)], 1u);
        const unsigned gen = old / nloc;
        if (old + 1u == (gen + 1u) * nloc) {
            __builtin_amdgcn_fence(__ATOMIC_RELEASE, "agent");
            asm volatile("s_waitcnt vmcnt(0)" ::: "memory");
            const unsigned og = xb_add(&bar[XB_TOP], 1u);
            const unsigned tg = og / nx;
            if (og + 1u == (tg + 1u) * nx) xb_add(&bar[XB_TOPGEN], 1u);
            else XB_SPIN(xb_ld(&bar[XB_TOPGEN]) == tg, bar);
            __builtin_amdgcn_fence(__ATOMIC_ACQUIRE, "agent");
            xb_add(&bar[XB_XGEN(b.x)], 1u);
            asm volatile("s_waitcnt vmcnt(0)" ::: "memory");
        } else {
            XB_SPIN(xb_ld(&bar[XB_XGEN(b.x)]) == gen, bar);
            __builtin_amdgcn_fence(__ATOMIC_ACQUIRE, "agent");
            asm volatile("s_waitcnt vmcnt(0)" ::: "memory");
        }
    }
    __syncthreads();
}
constexpr int T = 65536, SEQ = 4096, DM = 1024;
constexpr int NWAVES = 8;
constexpr float EPS = 1e-6f;
constexpr float LOG2E = 1.4426950408889634f;
constexpr float QSCALE_A = 0.10206207261596575f * LOG2E;
constexpr float QSCALE_B = 0.125f * LOG2E;
constexpr float LOG2_THETA = 13.287712379549449f;
constexpr float INV_2PI = 0.15915494309189535f;

constexpr size_t MiB = 1u << 20;
constexpr size_t WS_CTL = 0, CTL_ZERO_BYTES = 4 * MiB;
constexpr size_t WS_MOD = 2 * MiB;
constexpr size_t WS_TOPK = 4 * MiB;
constexpr size_t WS_GATES = 4 * MiB + 512 * 1024;
constexpr size_t WS_SLOTS = 5 * MiB;
constexpr size_t WS_GSLOT = 5 * MiB + 512 * 1024;
constexpr size_t WS_BLKCNT = 6 * MiB + 128 * 1024;
constexpr size_t WS_PENDS = 6 * MiB + 256 * 1024;
constexpr size_t WS_TOKSLOT = 6 * MiB + 512 * 1024;
constexpr size_t WS_ROWSC = 7 * MiB + 256 * 1024;
constexpr size_t WS_WAMAX = 64 * 1024;
constexpr size_t WS_W = 8 * MiB;
constexpr size_t W_IN = WS_W;
constexpr size_t W_UQ = W_IN + (size_t)1280 * 1024 * 2;
constexpr size_t W_UKV = W_UQ + (size_t)768 * 256 * 2;
constexpr size_t W_OUT = W_UKV + (size_t)1024 * 128 * 2;
constexpr size_t W_GU = W_OUT + (size_t)1024 * 1024 * 2;
constexpr size_t W_D = W_GU + (size_t)5632 * 1024 * 2;
constexpr size_t W_QKV = W_D + (size_t)1024 * 2816 * 2;
constexpr size_t W_DO = W_QKV + (size_t)3072 * 1024 * 2;
constexpr size_t W_MGU = W_DO + (size_t)1024 * 1024 * 2;
constexpr size_t W_MD = W_MGU + (size_t)8 * 7168 * 1024 * 2;
constexpr size_t W_END = W_MD + (size_t)8 * 1024 * 3584 * 2;
static_assert(W_END <= 208 * MiB, "weights region");
constexpr size_t A_H = 208 * MiB;
constexpr size_t A_P = 336 * MiB;
constexpr size_t A_CQ = 496 * MiB;
constexpr size_t A_CKV = 528 * MiB;
constexpr size_t A_QB = 544 * MiB;
constexpr size_t A_KB = 608 * MiB;
constexpr size_t A_QA = 624 * MiB;
constexpr size_t A_KV = 720 * MiB;
constexpr size_t A_KA = 848 * MiB;
constexpr size_t A_ATT0 = A_H;
constexpr size_t A_ACT = 336 * MiB;
constexpr size_t A_QKV = 336 * MiB;
constexpr size_t A_ATT1 = 720 * MiB;
constexpr size_t A_O2 = 848 * MiB;
constexpr size_t A_LSE1 = 976 * MiB;
constexpr size_t A_LSE2 = 980 * MiB;
constexpr size_t A_HP = 208 * MiB;
constexpr size_t A_Y = 208 * MiB;
constexpr size_t A_ACTM = 468 * MiB;
constexpr size_t WS_NEED = 984 * MiB;

constexpr int CW_BAR = 4096;
constexpr int RING_BYTES = 131072;
constexpr int LDS_BYTES = 163840;
constexpr int MISC_OFF = LDS_BYTES - 512;
constexpr int LDS_ZERO_OFF = LDS_BYTES - 1024;

constexpr int NPH = 28;
#ifndef FFN_FP8
#define FFN_FP8 3
#endif

struct Args {
    const float* in[31];
    float* out;
    unsigned char* ws;
    int ph_lo, ph_hi;
};
enum { I_X = 0, I_C, I_ADA_E_W, I_ADA_E_B, I_NORM_E_MIX, I_NORM_E_FFN, I_W_IN, I_Q_NORM, I_W_UQ, I_KV_NORM, I_W_UKV, I_MLA_QG, I_MLA_KG, I_GQA_QG, I_GQA_KG,
       I_E_W_OUT, I_FFN_G, I_FFN_U, I_FFN_D, I_ADA_O_W, I_ADA_O_B, I_NORM_O_MIX, I_NORM_O_FFN, I_DIL_QKV, I_DIL_QG, I_DIL_KG, I_DIL_OUT, I_ROUTER, I_MOE_G, I_MOE_U, I_MOE_D };

__device__ __forceinline__ float bf2f(unsigned b) { return __builtin_bit_cast(float, b << 16); }
__device__ __forceinline__ float bflo(unsigned w) { return __builtin_bit_cast(float, w << 16); }
__device__ __forceinline__ float bfhi(unsigned w) { return __builtin_bit_cast(float, w & 0xffff0000u); }
template <int CTRL> __device__ __forceinline__ float dppf(float v) { return __builtin_bit_cast(float, __builtin_amdgcn_update_dpp(0, __builtin_bit_cast(int, v), CTRL, 0xF, 0xF, false)); }
__device__ __forceinline__ float rdl(float v, int l) { return __builtin_bit_cast(float, __builtin_amdgcn_readlane(__builtin_bit_cast(int, v), l)); }
__device__ __forceinline__ float wave_sum(float v) {
    v += dppf<0xB1>(v); v += dppf<0x4E>(v); v += dppf<0x141>(v); v += dppf<0x140>(v);
    return (rdl(v, 0) + rdl(v, 16)) + (rdl(v, 32) + rdl(v, 48));
}
__device__ __forceinline__ float wave_max(float v) {
    v = fmaxf(v, dppf<0xB1>(v)); v = fmaxf(v, dppf<0x4E>(v)); v = fmaxf(v, dppf<0x141>(v)); v = fmaxf(v, dppf<0x140>(v));
    return fmaxf(fmaxf(rdl(v, 0), rdl(v, 16)), fmaxf(rdl(v, 32), rdl(v, 48)));
}
typedef __bf16 bf16n2_t __attribute__((ext_vector_type(2)));
typedef float f32n2_t __attribute__((ext_vector_type(2)));
__device__ __forceinline__ unsigned cvtpk(float lo, float hi) { const f32n2_t v = {lo, hi}; return __builtin_bit_cast(unsigned, __builtin_convertvector(v, bf16n2_t)); }

__device__ __forceinline__ void transpose_item(const float* W, int N, int k0, int n0, bf16* dst, int Kd, LAS float* scr, int lane) {
#pragma unroll 4
    for (int i = 0; i < 32; ++i) { const int kk = 2 * i + (lane >> 5); scr[kk * 33 + (lane & 31)] = W[(size_t)(k0 + kk) * N + n0 + (lane & 31)]; }
    LDS_WAIT(); asm volatile("" ::: "memory");
    const int c = lane & 7;
#pragma unroll
    for (int j = 0; j < 4; ++j) { const int n = (lane >> 3) + 8 * j; const LAS float* s = scr + (8 * c) * 33 + n;
        v4u o; o.x = pk2(s[0 * 33], s[1 * 33]); o.y = pk2(s[2 * 33], s[3 * 33]); o.z = pk2(s[4 * 33], s[5 * 33]); o.w = pk2(s[6 * 33], s[7 * 33]);
        *(GAS v4u*)(dst + (size_t)n * Kd + k0 + 8 * c) = o; }
    LDS_WAIT(); asm volatile("" ::: "memory");
}
__device__ __forceinline__ void tr_plain(const float* W, int K, int N, bf16* WT, int r, LAS float* scr, int lane) {
    const int nblk = N / 32, kb = r / nblk, nb = r % nblk;
    transpose_item(W, N, 64 * kb, 32 * nb, WT + (size_t)(32 * nb) * K, K, scr, lane);
}
__device__ __forceinline__ void tr_gu(const float* W, int K, int N, bf16* WT, int upoff, int r, LAS float* scr, int lane) {
    const int nblk = N / 32, kb = r / nblk, nb = r % nblk, n0 = 32 * nb;
    const int drow = (n0 >> 7) * 256 + (n0 & 127) + upoff;
    transpose_item(W, N, 64 * kb, n0, WT + (size_t)drow * K, K, scr, lane);
}


typedef unsigned u32x2_t __attribute__((ext_vector_type(2)));
constexpr float F8_WS = 64.f, F8_HS = 4.f, F8_AS = 4.f;
__device__ __forceinline__ float clamp448(float v) { return fminf(fmaxf(v, -448.f), 448.f); }
__device__ __forceinline__ unsigned pk4_fp8(float a, float b, float c, float d) { int w = 0; w = __builtin_amdgcn_cvt_pk_fp8_f32(a, b, w, false); w = __builtin_amdgcn_cvt_pk_fp8_f32(c, d, w, true); return (unsigned)w; }
__device__ __forceinline__ void transpose_item8(const float* W, int N, int k0, int n0, unsigned char* dst8, int Kd, float sc, LAS float* scr, int lane) {
#pragma unroll 4
    for (int i = 0; i < 32; ++i) { const int kk = 2 * i + (lane >> 5); scr[kk * 33 + (lane & 31)] = W[(size_t)(k0 + kk) * N + n0 + (lane & 31)]; }
    LDS_WAIT(); asm volatile("" ::: "memory");
    const int c = lane & 7;
#pragma unroll
    for (int j = 0; j < 4; ++j) { const int n = (lane >> 3) + 8 * j; const LAS float* s = scr + (8 * c) * 33 + n;
        u32x2_t o; o.x = pk4_fp8(s[0 * 33] * sc, s[1 * 33] * sc, s[2 * 33] * sc, s[3 * 33] * sc); o.y = pk4_fp8(s[4 * 33] * sc, s[5 * 33] * sc, s[6 * 33] * sc, s[7 * 33] * sc);
        *(GAS u32x2_t*)(dst8 + (size_t)n * Kd + k0 + 8 * c) = o; }
    LDS_WAIT(); asm volatile("" ::: "memory");
}
__device__ __forceinline__ void tr_plain8(const float* W, int K, int N, unsigned char* WT, int r, LAS float* scr, int lane) {
    const int nblk = N / 32, kb = r / nblk, nb = r % nblk;
    transpose_item8(W, N, 64 * kb, 32 * nb, WT + (size_t)(32 * nb) * K, K, F8_WS, scr, lane);
}
__device__ __forceinline__ void tr_gu8(const float* W, int K, int N, unsigned char* WT, int upoff, int r, LAS float* scr, int lane) {
    const int nblk = N / 32, kb = r / nblk, nb = r % nblk, n0 = 32 * nb;
    const int drow = (n0 >> 7) * 256 + (n0 & 127) + upoff;
    transpose_item8(W, N, 64 * kb, n0, WT + (size_t)drow * K, K, F8_WS, scr, lane);
}


__device__ __forceinline__ unsigned pk4_i8(float a, float b, float c, float d) {
    const int ia = (int)__builtin_rintf(__builtin_amdgcn_fmed3f(a, -127.f, 127.f)), ib = (int)__builtin_rintf(__builtin_amdgcn_fmed3f(b, -127.f, 127.f));
    const int ic = (int)__builtin_rintf(__builtin_amdgcn_fmed3f(c, -127.f, 127.f)), id = (int)__builtin_rintf(__builtin_amdgcn_fmed3f(d, -127.f, 127.f));
    return (unsigned)(ia & 255) | ((unsigned)(ib & 255) << 8) | ((unsigned)(ic & 255) << 16) | ((unsigned)(id & 255) << 24);
}
__device__ __forceinline__ void transpose_item_i8(const float* W, int N, int k0, int n0, unsigned char* dst8, int Kd, float sc, LAS float* scr, int lane) {
#pragma unroll 4
    for (int i = 0; i < 32; ++i) { const int kk = 2 * i + (lane >> 5); scr[kk * 33 + (lane & 31)] = W[(size_t)(k0 + kk) * N + n0 + (lane & 31)]; }
    LDS_WAIT(); asm volatile("" ::: "memory");
    const int c = lane & 7;
#pragma unroll
    for (int j = 0; j < 4; ++j) { const int n = (lane >> 3) + 8 * j; const LAS float* s = scr + (8 * c) * 33 + n;
        u32x2_t o; o.x = pk4_i8(s[0 * 33] * sc, s[1 * 33] * sc, s[2 * 33] * sc, s[3 * 33] * sc); o.y = pk4_i8(s[4 * 33] * sc, s[5 * 33] * sc, s[6 * 33] * sc, s[7 * 33] * sc);
        *(GAS u32x2_t*)(dst8 + (size_t)n * Kd + k0 + 8 * c) = o; }
    LDS_WAIT(); asm volatile("" ::: "memory");
}
__device__ __forceinline__ void tr_gu_i8(const float* W, int K, int N, unsigned char* WT, int upoff, float sc, int r, LAS float* scr, int lane) {
    const int nblk = N / 32, kb = r / nblk, nb = r % nblk, n0 = 32 * nb;
    const int drow = (n0 >> 7) * 256 + (n0 & 127) + upoff;
    transpose_item_i8(W, N, 64 * kb, n0, WT + (size_t)drow * K, K, sc, scr, lane);
}
__device__ __forceinline__ void absmax_pass(const float* w, size_t n4, unsigned* slot, int gw, int NGW, int lane) {
    float mx = 0.f;
    for (size_t i = (size_t)gw * 64 + lane; i < n4; i += (size_t)NGW * 64) { const f32x4 v = ((const f32x4*)w)[i]; mx = fmaxf(fmaxf(mx, fmaxf(fabsf(v.x), fabsf(v.y))), fmaxf(fabsf(v.z), fabsf(v.w))); }
#pragma unroll
    for (int o = 1; o < 64; o <<= 1) mx = fmaxf(mx, __shfl_xor(mx, o));
    if (lane == 0) atomicMax(slot, __builtin_bit_cast(unsigned, mx));
}
__device__ __forceinline__ void p0_prologue(const Args& a, LAS unsigned char* lds, int gw, int NGW, int wave, int lane) {
    unsigned char* ws = a.ws;
    LAS float* scr = (LAS float*)(lds + wave * 16384);
    constexpr int I0 = 16 * 37, I1 = 4 * 24, I2 = 2 * 32, I3 = 16 * 32, I4 = 16 * 88, I6 = 44 * 32, I7 = 16 * 96, I8 = 16 * 32, IM = 16 * 112, IMD = 56 * 32;
    constexpr int NITEMS = I0 + I1 + I2 + I3 + 2 * I4 + I6 + I7 + I8 + 16 * IM + 8 * IMD;
#ifndef PROBE_P0N
#define PROBE_P0N 0
#endif
    for (int rp0_ = 0; rp0_ <= PROBE_P0N; ++rp0_)
    for (int it = gw; it < NITEMS; it += NGW) {
        int r = it;
        if (r < I0) continue;
        r -= I0;
        if (r < I1) { tr_plain(a.in[I_W_UQ], 256, 768, (bf16*)(ws + W_UQ), r, scr, lane); continue; } r -= I1;
        if (r < I2) {
            const int nblk = 1024 / 32, kb = r / nblk, nb = r % nblk, n0 = 32 * nb; const int hd = n0 >> 7, w = n0 & 127; const int drow = (w < 64) ? hd * 64 + w : 512 + hd * 64 + (w - 64);
            transpose_item(a.in[I_W_UKV], 1024, 64 * kb, n0, (bf16*)(ws + W_UKV) + (size_t)drow * 128, 128, scr, lane); continue; } r -= I2;
        if (r < I3) { tr_plain(a.in[I_E_W_OUT], 1024, 1024, (bf16*)(ws + W_OUT), r, scr, lane); continue; } r -= I3;
#if FFN_FP8 == 1
        if (r < I4) { tr_gu8(a.in[I_FFN_G], 1024, 2816, ws + W_GU, 0, r, scr, lane); continue; } r -= I4;
        if (r < I4) { tr_gu8(a.in[I_FFN_U], 1024, 2816, ws + W_GU, 128, r, scr, lane); continue; } r -= I4;
        if (r < I6) { tr_plain8(a.in[I_FFN_D], 2816, 1024, ws + W_D, r, scr, lane); continue; } r -= I6;
#elif FFN_FP8 == 2
        if (r < I4) { tr_gu(a.in[I_FFN_G], 1024, 2816, (bf16*)(ws + W_GU), 0, r, scr, lane); continue; } r -= I4;
        if (r < I4) { tr_gu(a.in[I_FFN_U], 1024, 2816, (bf16*)(ws + W_GU), 128, r, scr, lane); continue; } r -= I4;
        if (r < I6) { tr_plain8(a.in[I_FFN_D], 2816, 1024, ws + W_D, r, scr, lane); continue; } r -= I6;
#elif FFN_FP8 == 3
        if (r < 2 * I4) continue;
        r -= 2 * I4;
        if (r < I6) { tr_plain8(a.in[I_FFN_D], 2816, 1024, ws + W_D, r, scr, lane); continue; } r -= I6;
#else
        if (r < 2 * I4) continue;
        r -= 2 * I4;
        if (r < I6) { tr_plain(a.in[I_FFN_D], 2816, 1024, (bf16*)(ws + W_D), r, scr, lane); continue; } r -= I6;
#endif
        if (r < I7) continue;
        r -= I7;
        if (r < I8) { tr_plain(a.in[I_DIL_OUT], 1024, 1024, (bf16*)(ws + W_DO), r, scr, lane); continue; } r -= I8;
        if (r < 8 * IM) { const int e = r / IM; tr_gu8(a.in[I_MOE_G] + (size_t)e * 1024 * 3584, 1024, 3584, ws + W_MGU + (size_t)e * 7168 * 1024, 0, r % IM, scr, lane); continue; } r -= 8 * IM;
        if (r < 8 * IM) { const int e = r / IM; tr_gu8(a.in[I_MOE_U] + (size_t)e * 1024 * 3584, 1024, 3584, ws + W_MGU + (size_t)e * 7168 * 1024, 128, r % IM, scr, lane); continue; } r -= 8 * IM;
        { const int e = r / IMD; tr_plain8(a.in[I_MOE_D] + (size_t)e * 3584 * 1024, 3584, 1024, ws + W_MD + (size_t)e * 1024 * 3584, r % IMD, scr, lane); }
    }
    { GAS v4u* z = (GAS v4u*)(ws + W_IN + (size_t)1184 * 1024);
      for (int i = gw * 64 + lane; i < 6144; i += NGW * 64) z[i] = (v4u){0u, 0u, 0u, 0u}; }
#if FFN_FP8 == 0 || FFN_FP8 == 3
    absmax_pass(a.in[I_FFN_G], (size_t)1024 * 2816 / 4, (unsigned*)(ws + WS_WAMAX), gw, NGW, lane); absmax_pass(a.in[I_FFN_U], (size_t)1024 * 2816 / 4, (unsigned*)(ws + WS_WAMAX), gw, NGW, lane);
    absmax_pass(a.in[I_DIL_QKV], (size_t)1024 * 3072 / 4, (unsigned*)(ws + WS_WAMAX) + 1, gw, NGW, lane);
    absmax_pass(a.in[I_W_IN], (size_t)1024 * 1184 / 4, (unsigned*)(ws + WS_WAMAX) + 2, gw, NGW, lane);
#endif
    for (int u = gw; u < 2 * 96 * 16; u += NGW) {
        const int layer = u / 1536, rem = u % 1536, cg = rem >> 4, kc = rem & 15;
        const float* W = a.in[layer ? I_ADA_O_W : I_ADA_E_W]; const float* bia = a.in[layer ? I_ADA_O_B : I_ADA_E_B];
        unsigned long long* mod = (unsigned long long*)(ws + WS_MOD) + layer * 16 * 6144;
        const int n = cg * 64 + lane, k0 = kc * 64;
        float s[16], acc[16];
#pragma unroll
        for (int b = 0; b < 16; ++b) { const float cv = a.in[I_C][b * 1024 + k0 + lane]; s[b] = cv / (1.f + __expf(-cv)); acc[b] = 0.f; }
#pragma unroll 4
        for (int kk = 0; kk < 64; ++kk) { const float w = W[(size_t)(k0 + kk) * 6144 + n];
#pragma unroll
            for (int b = 0; b < 16; ++b) acc[b] += __builtin_bit_cast(float, __builtin_amdgcn_readlane(__builtin_bit_cast(int, s[b]), kk)) * w; }
        const float bv = (kc == 0) ? bia[n] : 0.f;
#pragma unroll
        for (int b = 0; b < 16; ++b) atomicAdd(mod + b * 6144 + n, (unsigned long long)(long long)((acc[b] + bv) * 1099511627776.0f));
    }
}

struct ModPar { f32x4 a[4], s[4]; };
typedef long long modw_t;
__device__ __forceinline__ float modv(const modw_t* p) { return (float)(*p) * 9.094947017729282e-13f; }
__device__ __forceinline__ f32x4 modv4(const modw_t* p) { return (f32x4){modv(p), modv(p + 1), modv(p + 2), modv(p + 3)}; }
__device__ __forceinline__ void load_modpar(ModPar& mp, const float* g, const modw_t* mod_b, int jshift, int jscale, int lane) {
#pragma unroll
    for (int j = 0; j < 4; ++j) { const int col = 4 * lane + 256 * j;
        const f32x4 gv = *(const f32x4*)(g + col), sc = modv4(mod_b + jscale * 1024 + col), sh = modv4(mod_b + jshift * 1024 + col);
        mp.a[j] = gv * (sc + 1.0f); mp.s[j] = sh; }
}
constexpr int XP = 2048;
template <bool BF = false>
__device__ __forceinline__ void mod_row_f32(const void* xrow, const ModPar& mp, f32x4 (&h)[4], int lane) {
    float ss = 0.f;
#pragma unroll
    for (int j = 0; j < 4; ++j) {
        if (BF) { const uint2 r = ((const uint2*)xrow)[lane + 64 * j]; h[j] = (f32x4){bflo(r.x), bfhi(r.x), bflo(r.y), bfhi(r.y)}; }
        else h[j] = ((const f32x4*)xrow)[lane + 64 * j];
        ss += (h[j].x * h[j].x + h[j].y * h[j].y) + (h[j].z * h[j].z + h[j].w * h[j].w); }
    const float rs = 1.0f / sqrtf(wave_sum(ss) * (1.f / 1024.f) + EPS);
#pragma unroll
    for (int j = 0; j < 4; ++j) h[j] = h[j] * rs * mp.a[j] + mp.s[j];
}
__device__ __forceinline__ void store_row_bf16(bf16* orow, const f32x4 (&h)[4], int lane) {
    unsigned long long* o8 = (unsigned long long*)orow + lane;
#pragma unroll
    for (int j = 0; j < 4; ++j) o8[64 * j] = (unsigned long long)pk2(h[j].x, h[j].y) | ((unsigned long long)pk2(h[j].z, h[j].w) << 32);
}
__device__ __forceinline__ void store_row_fp8(unsigned char* orow, const f32x4 (&h)[4], int lane) {
    unsigned* o4 = (unsigned*)orow + lane;
#pragma unroll
    for (int j = 0; j < 4; ++j) o4[64 * j] = pk4_fp8(clamp448(h[j].x * F8_HS), clamp448(h[j].y * F8_HS), clamp448(h[j].z * F8_HS), clamp448(h[j].w * F8_HS));
}
__device__ __forceinline__ void store_row_i8(unsigned char* orow, float* rowscale, const f32x4 (&h)[4], int lane) {
    float mx = 0.f;
#pragma unroll
    for (int j = 0; j < 4; ++j) mx = fmaxf(fmaxf(mx, fmaxf(fabsf(h[j].x), fabsf(h[j].y))), fmaxf(fabsf(h[j].z), fabsf(h[j].w)));
    mx = wave_max(mx);
    mx = fmaxf(mx, 1e-20f); const float inv = 127.f / mx;
    unsigned* o4 = (unsigned*)orow + lane;
#pragma unroll
    for (int j = 0; j < 4; ++j) o4[64 * j] = pk4_i8(h[j].x * inv, h[j].y * inv, h[j].z * inv, h[j].w * inv);
    if (lane == 0) *rowscale = mx * (1.f / 127.f);
}
template <bool F8OUT = false, bool BFIN = false, bool I8OUT = false>
__device__ __forceinline__ void modulate_phase(const void* xin, const float* g, const modw_t* mod_layer, int jshift, int jscale, bf16* H, int gw, int NGW, int lane, float* rowsc = nullptr) {
    for (int bi = gw; bi < T / 32; bi += NGW) {
        const int b = bi >> 7; ModPar mp; load_modpar(mp, g, mod_layer + b * 6144, jshift, jscale, lane);
#pragma unroll 8
        for (int r = 0; r < 32; ++r) { const size_t row = (size_t)bi * 32 + r; f32x4 h[4]; if (BFIN) mod_row_f32<true>((const bf16*)xin + row * XP, mp, h, lane); else mod_row_f32<false>((const float*)xin + row * 1024, mp, h, lane); if (I8OUT) store_row_i8((unsigned char*)H + row * 1024, rowsc + row, h, lane); else if (F8OUT) store_row_fp8((unsigned char*)H + row * 1024, h, lane); else store_row_bf16(H + row * 1024, h, lane); }
    }
}

__device__ __forceinline__ void cs_rev(float pos, float revf, float& c, float& s) { const float fr = __builtin_amdgcn_fractf(pos * revf); c = __builtin_amdgcn_cosf(fr); s = __builtin_amdgcn_sinf(fr); }
__device__ __forceinline__ void unpack8(const v4u& r, float (&v)[8]) { v[0] = bflo(r.x); v[1] = bfhi(r.x); v[2] = bflo(r.y); v[3] = bfhi(r.y); v[4] = bflo(r.z); v[5] = bfhi(r.z); v[6] = bflo(r.w); v[7] = bfhi(r.w); }
__device__ __forceinline__ v4u pack8(const float (&v)[8]) { v4u o; o.x = pk2(v[0], v[1]); o.y = pk2(v[2], v[3]); o.z = pk2(v[4], v[5]); o.w = pk2(v[6], v[7]); return o; }

__device__ __forceinline__ void r2_phase(const Args& a, int gw, int NGW, int lane) {
    unsigned char* ws = a.ws;
    const bf16* P = (const bf16*)(ws + A_P); bf16* CQ = (bf16*)(ws + A_CQ); bf16* CKV = (bf16*)(ws + A_CKV); bf16* QB = (bf16*)(ws + A_QB); bf16* KB = (bf16*)(ws + A_KB);
    const int sub = lane & 7;
    float qn[4], kvn[2], gq[8], gk[8], revf[8];
#pragma unroll
    for (int i = 0; i < 4; ++i) qn[i] = a.in[I_Q_NORM][4 * lane + i];
    kvn[0] = a.in[I_KV_NORM][2 * lane]; kvn[1] = a.in[I_KV_NORM][2 * lane + 1];
#pragma unroll
    for (int j = 0; j < 8; ++j) { gq[j] = a.in[I_GQA_QG][8 * sub + j]; gk[j] = a.in[I_GQA_KG][8 * sub + j];
        const int i = 8 * (sub & 1) + j; revf[j] = exp2f(-(float)i * (LOG2_THETA / 16.f)) * INV_2PI; }
#pragma unroll 2
    for (int row = gw; row < T; row += NGW) {
        const bf16* pr = P + (size_t)row * 1280; const int t = row & 4095; const float pos = (float)((sub & 4) ? (t & 63) : (t >> 6));
        { const uint2 raw = *(const uint2*)(pr + 4 * lane); float v0 = bflo(raw.x), v1 = bfhi(raw.x), v2 = bflo(raw.y), v3 = bfhi(raw.y);
          const float rs = 1.0f / sqrtf(wave_sum((v0 * v0 + v1 * v1) + (v2 * v2 + v3 * v3)) * (1.f / 256.f) + EPS);
          uint2 o; o.x = pk2(v0 * rs * qn[0], v1 * rs * qn[1]); o.y = pk2(v2 * rs * qn[2], v3 * rs * qn[3]); *(uint2*)(CQ + (size_t)row * 256 + 4 * lane) = o; }
        { const unsigned raw = *(const unsigned*)(pr + 256 + 2 * lane); float v0 = bflo(raw), v1 = bfhi(raw);
          const float rs = 1.0f / sqrtf(wave_sum(v0 * v0 + v1 * v1) * (1.f / 128.f) + EPS);
          *(unsigned*)(CKV + (size_t)row * 128 + 2 * lane) = pk2(v0 * rs * kvn[0], v1 * rs * kvn[1]); }
#pragma unroll
        for (int which = 1; which < 2; ++which) {
            const int l2 = which ? (lane & 15) : lane;
            const v4u raw = *(const v4u*)(pr + (which ? 928 : 416) + 8 * l2); float v[8]; unpack8(raw, v);
            float ss = 0.f;
#pragma unroll
            for (int j = 0; j < 8; ++j) ss += v[j] * v[j];
            ss += __shfl_xor(ss, 1); ss += __shfl_xor(ss, 2); ss += __shfl_xor(ss, 4);
            const float rs = 1.0f / sqrtf(ss * (1.f / 64.f) + EPS); float o[8];
#pragma unroll
            for (int j = 0; j < 8; ++j) { const float x = v[j] * rs * (which ? gk[j] : gq[j]); const float w = __shfl_xor(x, 2); float c, s; cs_rev(pos, revf[j], c, s);
                o[j] = (sub & 2) ? (x * c + w * s) : (x * c - w * s); if (!which) o[j] *= QSCALE_B; }
            if (!which) *(v4u*)(QB + (size_t)row * 512 + 8 * lane) = pack8(o);
            else if (lane < 16) *(v4u*)(KB + (size_t)row * 128 + 8 * lane) = pack8(o);
        }
    }
}

__device__ __forceinline__ void r3_phase(const Args& a, int gw, int NGW, int lane) {
    unsigned char* ws = a.ws;
    const bf16* P = (const bf16*)(ws + A_P); bf16* QA = (bf16*)(ws + A_QA); const bf16* KV = (const bf16*)(ws + A_KV); bf16* KA = (bf16*)(ws + A_KA);
    const int head = lane >> 3, sub = lane & 7;
    float gqn[8], gqr[4], gkn[8], gkr[4], revf[4];
#pragma unroll
    for (int j = 0; j < 8; ++j) { gqn[j] = a.in[I_MLA_QG][8 * sub + j]; gkn[j] = a.in[I_MLA_KG][8 * sub + j]; }
#pragma unroll
    for (int j = 0; j < 4; ++j) { gqr[j] = a.in[I_MLA_QG][64 + 4 * sub + j]; gkr[j] = a.in[I_MLA_KG][64 + 4 * sub + j];
        const int i = 4 * (sub & 3) + j; revf[j] = exp2f(-(float)i * (LOG2_THETA / 16.f)) * INV_2PI; }
#pragma unroll 2
    for (int row = gw; row < T; row += NGW) {
        const float pos = (float)(row & 4095);
#pragma unroll
        for (int which = 1; which < 2; ++which) {
            const bf16* np = which ? (KV + (size_t)row * 512 + head * 64 + 8 * sub) : (QA + (size_t)row * 768 + head * 96 + 8 * sub);
            const bf16* rp = which ? (P + (size_t)row * 1280 + 384 + 4 * sub) : (QA + (size_t)row * 768 + head * 96 + 64 + 4 * sub);
            const v4u rn = *(const v4u*)np; const uint2 rr = *(const uint2*)rp;
            float v[8], r4[4]; unpack8(rn, v); r4[0] = bflo(rr.x); r4[1] = bfhi(rr.x); r4[2] = bflo(rr.y); r4[3] = bfhi(rr.y);
            float ss = 0.f;
#pragma unroll
            for (int j = 0; j < 8; ++j) ss += v[j] * v[j];
#pragma unroll
            for (int j = 0; j < 4; ++j) ss += r4[j] * r4[j];
            ss += __shfl_xor(ss, 1); ss += __shfl_xor(ss, 2); ss += __shfl_xor(ss, 4);
            const float rs = 1.0f / sqrtf(ss * (1.f / 96.f) + EPS); const float qs = which ? 1.0f : QSCALE_A;
            float o[8], orp[4];
#pragma unroll
            for (int j = 0; j < 8; ++j) o[j] = v[j] * rs * (which ? gkn[j] : gqn[j]) * qs;
#pragma unroll
            for (int j = 0; j < 4; ++j) { const float x = r4[j] * rs * (which ? gkr[j] : gqr[j]); const float w = __shfl_xor(x, 4); float c, s; cs_rev(pos, revf[j], c, s);
                orp[j] = ((sub & 4) ? (x * c + w * s) : (x * c - w * s)) * qs; }
            bf16* on = (which ? KA : QA) + (size_t)row * 768 + head * 96;
            *(v4u*)(on + 8 * sub) = pack8(o);
            uint2 o2; o2.x = pk2(orp[0], orp[1]); o2.y = pk2(orp[2], orp[3]); *(uint2*)(on + 64 + 4 * sub) = o2;
        }
    }
}

__device__ __forceinline__ void r6_phase(const Args& a, int gw, int NGW, int lane) {
    bf16* QKV = (bf16*)(a.ws + A_QKV);
    const int sub = lane & 3;
    float gq[16], gk[16], revf[16];
#pragma unroll
    for (int j = 0; j < 16; ++j) { gq[j] = a.in[I_DIL_QG][16 * sub + j]; gk[j] = a.in[I_DIL_KG][16 * sub + j];
        const int i = 16 * (sub & 1) + j; revf[j] = exp2f(-(float)i * (LOG2_THETA / 32.f)) * INV_2PI; }
    for (int row = gw; row < T; row += NGW) {
        const float pos = (float)(row & 4095);
#pragma unroll
        for (int which = 0; which < 2; ++which) {
            bf16* p = QKV + (size_t)row * 3072 + which * 1024 + 16 * lane;
            const v4u r0 = *(const v4u*)p, r1 = *(const v4u*)(p + 8); float v0[8], v1[8]; unpack8(r0, v0); unpack8(r1, v1);
            float ss = 0.f;
#pragma unroll
            for (int j = 0; j < 8; ++j) ss += v0[j] * v0[j] + v1[j] * v1[j];
            ss += __shfl_xor(ss, 1); ss += __shfl_xor(ss, 2);
            const float rs = 1.0f / sqrtf(ss * (1.f / 64.f) + EPS); float o0[8], o1[8];
#pragma unroll
            for (int j = 0; j < 16; ++j) { const float xin = (j < 8) ? v0[j & 7] : v1[j & 7]; const float x = xin * rs * (which ? gk[j] : gq[j]); const float w = __shfl_xor(x, 2); float c, s; cs_rev(pos, revf[j], c, s);
                float o = (sub & 2) ? (x * c + w * s) : (x * c - w * s); if (!which) o *= QSCALE_B; if (j < 8) o0[j & 7] = o; else o1[j & 7] = o; }
            *(v4u*)p = pack8(o0); *(v4u*)(p + 8) = pack8(o1);
        }
    }
}
namespace att {
using f32x16 = __attribute__((ext_vector_type(16))) float;
using s16x4 = __attribute__((ext_vector_type(4))) short;
#define SBAR() __builtin_amdgcn_sched_barrier(0)
__device__ __forceinline__ int crow(int r, int hi) { return (r & 3) + 8 * (r >> 2) + 4 * hi; }
template <int DQ> struct Lay {
    static constexpr int KROW = DQ * 2 + 16;
    static constexpr int KBUF = 64 * KROW;
    static constexpr int VBUF = 8192;
    static constexpr int K_OFF = 0, V_OFF = 2 * KBUF, WS_OFF = V_OFF + 2 * VBUF, BYTES = WS_OFF + 8 * 512;
};
__device__ __forceinline__ int v_st(int k, int c) { const int kk = k; return ((kk >> 3) * 2 + (c >> 5)) * 512 + ((kk & 7) * 32 + (c & 31)) * 2; }
__device__ __forceinline__ int v_rd_base(int lane) { return ((lane & 3) << 3) | (((lane >> 2) & 3) << 6) | (((lane >> 4) & 1) << 5) | (((lane >> 5) & 1) << 8); }
template <int OFF> __device__ __forceinline__ s16x4 tr_read(int vb) { s16x4 r; asm volatile("ds_read_b64_tr_b16 %0, %1 offset:%2" : "=&v"(r) : "v"(vb), "i"(OFF) : "memory"); return r; }
template <int D0> __device__ __forceinline__ void pv_one(f32x16& od, int vb, bf16x8 pa0, bf16x8 pa1, bf16x8 pa2, bf16x8 pa3) {
    const s16x4 l0 = tr_read<D0 * 512 + 0 * 2048>(vb), h0 = tr_read<D0 * 512 + 0 * 2048 + 1024>(vb), l1 = tr_read<D0 * 512 + 1 * 2048>(vb), h1 = tr_read<D0 * 512 + 1 * 2048 + 1024>(vb);
    const s16x4 l2 = tr_read<D0 * 512 + 2 * 2048>(vb), h2 = tr_read<D0 * 512 + 2 * 2048 + 1024>(vb), l3 = tr_read<D0 * 512 + 3 * 2048>(vb), h3 = tr_read<D0 * 512 + 3 * 2048 + 1024>(vb);
    asm volatile("s_waitcnt lgkmcnt(0)" ::: "memory"); SBAR();
#define PKV(L, H) (bf16x8){L[0], L[1], L[2], L[3], H[0], H[1], H[2], H[3]}
    od = __builtin_amdgcn_mfma_f32_32x32x16_bf16(pa0, PKV(l0, h0), od, 0, 0, 0);
    od = __builtin_amdgcn_mfma_f32_32x32x16_bf16(pa1, PKV(l1, h1), od, 0, 0, 0);
    od = __builtin_amdgcn_mfma_f32_32x32x16_bf16(pa2, PKV(l2, h2), od, 0, 0, 0);
    od = __builtin_amdgcn_mfma_f32_32x32x16_bf16(pa3, PKV(l3, h3), od, 0, 0, 0);
#undef PKV
}
__device__ __forceinline__ float rowmax32(const f32x16& p0, const f32x16& p1) {
    float a = fmaxf(fmaxf(p0[0], p0[1]), p1[0]), b = fmaxf(fmaxf(p0[2], p0[3]), p1[1]); a = fmaxf(fmaxf(a, p1[2]), p1[3]);
#pragma unroll
    for (int r = 4; r < 16; r += 4) { a = fmaxf(fmaxf(a, p0[r]), p0[r + 1]); b = fmaxf(fmaxf(b, p0[r + 2]), p0[r + 3]); a = fmaxf(fmaxf(a, p1[r]), p1[r + 1]); b = fmaxf(fmaxf(b, p1[r + 2]), p1[r + 3]); }
    float m = fmaxf(a, b);
    auto rr = __builtin_amdgcn_permlane32_swap(__float_as_uint(m), __float_as_uint(m), false, false);
    return fmaxf(__uint_as_float(rr[0]), __uint_as_float(rr[1]));
}
template <int D0, int KH> __device__ __forceinline__ void pv_half(f32x16& od, int vb, bf16x8 paA, bf16x8 paB) {
    const s16x4 l0 = tr_read<D0 * 512 + (2 * KH) * 2048>(vb), h0 = tr_read<D0 * 512 + (2 * KH) * 2048 + 1024>(vb), l1 = tr_read<D0 * 512 + (2 * KH + 1) * 2048>(vb), h1 = tr_read<D0 * 512 + (2 * KH + 1) * 2048 + 1024>(vb);
    asm volatile("s_waitcnt lgkmcnt(0)" ::: "memory"); SBAR();
#define PKV(L, H) (bf16x8){L[0], L[1], L[2], L[3], H[0], H[1], H[2], H[3]}
    od = __builtin_amdgcn_mfma_f32_32x32x16_bf16(paA, PKV(l0, h0), od, 0, 0, 0);
    od = __builtin_amdgcn_mfma_f32_32x32x16_bf16(paB, PKV(l1, h1), od, 0, 0, 0);
#undef PKV
}
struct VH { s16x4 l0, h0, l1, h1, m0, n0, m1, n1; };
__device__ __forceinline__ void vh_issue(VH& f, int vb) {
    f.l0 = tr_read<0>(vb); f.h0 = tr_read<1024>(vb); f.l1 = tr_read<2048>(vb); f.h1 = tr_read<3072>(vb);
    f.m0 = tr_read<512>(vb); f.n0 = tr_read<1536>(vb); f.m1 = tr_read<2560>(vb); f.n1 = tr_read<3584>(vb); }
__device__ __forceinline__ void vh_mm(f32x16& o0, f32x16& o1, const VH& f, bf16x8 paA, bf16x8 paB) {
#define PKV(L, H) (bf16x8){L[0], L[1], L[2], L[3], H[0], H[1], H[2], H[3]}
    o0 = __builtin_amdgcn_mfma_f32_32x32x16_bf16(paA, PKV(f.l0, f.h0), o0, 0, 0, 0); o1 = __builtin_amdgcn_mfma_f32_32x32x16_bf16(paA, PKV(f.m0, f.n0), o1, 0, 0, 0);
    o0 = __builtin_amdgcn_mfma_f32_32x32x16_bf16(paB, PKV(f.l1, f.h1), o0, 0, 0, 0); o1 = __builtin_amdgcn_mfma_f32_32x32x16_bf16(paB, PKV(f.m1, f.n1), o1, 0, 0, 0);
#undef PKV
}
struct VF { s16x4 l0, h0, l1, h1, l2, h2, l3, h3; };
template <int D0> __device__ __forceinline__ void v_issue(VF& f, int vb) {
    f.l0 = tr_read<D0 * 512 + 0 * 2048>(vb); f.h0 = tr_read<D0 * 512 + 0 * 2048 + 1024>(vb); f.l1 = tr_read<D0 * 512 + 1 * 2048>(vb); f.h1 = tr_read<D0 * 512 + 1 * 2048 + 1024>(vb);
    f.l2 = tr_read<D0 * 512 + 2 * 2048>(vb); f.h2 = tr_read<D0 * 512 + 2 * 2048 + 1024>(vb); f.l3 = tr_read<D0 * 512 + 3 * 2048>(vb); f.h3 = tr_read<D0 * 512 + 3 * 2048 + 1024>(vb); }
__device__ __forceinline__ void pv_mm(f32x16& od, const VF& f, bf16x8 pa0, bf16x8 pa1, bf16x8 pa2, bf16x8 pa3) {
#define PKV(L, H) (bf16x8){L[0], L[1], L[2], L[3], H[0], H[1], H[2], H[3]}
    od = __builtin_amdgcn_mfma_f32_32x32x16_bf16(pa0, PKV(f.l0, f.h0), od, 0, 0, 0); od = __builtin_amdgcn_mfma_f32_32x32x16_bf16(pa1, PKV(f.l1, f.h1), od, 0, 0, 0);
    od = __builtin_amdgcn_mfma_f32_32x32x16_bf16(pa2, PKV(f.l2, f.h2), od, 0, 0, 0); od = __builtin_amdgcn_mfma_f32_32x32x16_bf16(pa3, PKV(f.l3, f.h3), od, 0, 0, 0);
#undef PKV
}
__device__ __forceinline__ void pv_ones(f32x16& os, bf16x8 pa0, bf16x8 pa1, bf16x8 pa2, bf16x8 pa3) {
    const bf16x8 one = {0x3F80, 0x3F80, 0x3F80, 0x3F80, 0x3F80, 0x3F80, 0x3F80, 0x3F80};
    os = __builtin_amdgcn_mfma_f32_32x32x16_bf16(pa0, one, os, 0, 0, 0); os = __builtin_amdgcn_mfma_f32_32x32x16_bf16(pa1, one, os, 0, 0, 0);
    os = __builtin_amdgcn_mfma_f32_32x32x16_bf16(pa2, one, os, 0, 0, 0); os = __builtin_amdgcn_mfma_f32_32x32x16_bf16(pa3, one, os, 0, 0, 0); }
struct LayB { static constexpr int KROW = 144, KBUF = 64 * KROW, VBUF = 8192, NS = 6, K_OFF = 0, V_OFF = NS * KBUF, WS_OFF = V_OFF + NS * VBUF, OST_OFF = WS_OFF + 8 * 512, BYTES = OST_OFF + 8 * 4096; };
struct BU { unsigned rowq; int t0, nt, q0; };
__device__ __forceinline__ BU band_unit(int dil, int sub) { BU u; const int r = (dil == 1) ? 0 : (dil == 4 ? (sub >> 2) : sub), qb = (dil == 1) ? sub : (dil == 4 ? (sub & 3) : 0), ntt = 64 / dil;
    u.rowq = (unsigned)(r + 256 * qb * dil); const int t0 = (4 * qb - 1 < 0) ? 0 : 4 * qb - 1, t1 = (4 * qb + 5 > ntt) ? ntt : 4 * qb + 5; u.t0 = t0; u.nt = t1 - t0; u.q0 = 256 * qb; return u; }
template <bool MERGE, bool FAST>
__device__ __forceinline__ void band_phase(const bf16* Qh, const bf16* Kh, const bf16* Vh, int dil, bf16* Ob, int ldo, float* Lb, const bf16* O1b, const bf16* O2b, const float* L1b, const float* L2b, LAS char* lds) {
    using LY = LayB;
    int tid = threadIdx.x; asm volatile("" : "+v"(tid));
    const int lane = tid & 63, r32 = lane & 31, hi = lane >> 5; const int wid = __builtin_amdgcn_readfirstlane(tid >> 6);
    LAS float* wsf = (LAS float*)(lds + LY::WS_OFF) + wid * 128;
    LAS char* ost = lds + LY::OST_OFF + wid * 4096;
    const int krow = tid >> 3, kch = tid & 7;
    const int vkey = 2 * (tid >> 4) + ((tid >> 2) & 1), vcol = 32 * ((tid >> 3) & 1) + 8 * (tid & 3);
    const int kst = krow * LY::KROW + kch * 16, vst = v_st(vkey, vcol);
    const int vb0 = (int)(unsigned)(size_t)(lds + LY::V_OFF) + v_rd_base(lane);
    const LAS char* kbase = lds + LY::K_OFF + r32 * LY::KROW + hi * 16;
    bf16x8 sk[6], sv[6], qr[4];
    const int ldb = dil * 128;
    const unsigned ko_ = (unsigned)(krow * ldb + kch * 16), vo_ = (unsigned)(vkey * ldb + vcol * 2), qo_ = (unsigned)((wid * 32 + r32) * ldb + hi * 16);
    BU cur = band_unit(dil, 0);
#define B_LOADS(U) do { const size_t sb_ = (size_t)((U).rowq % (unsigned)dil) * 128; \
        _Pragma("unroll") for (int s_ = 0; s_ < 6; ++s_) if (s_ < (U).nt) { const size_t o_ = sb_ + (size_t)((U).t0 + s_) * 64 * (size_t)ldb; \
            sk[s_] = *reinterpret_cast<const bf16x8*>((const char*)Kh + o_ + ko_); sv[s_] = *reinterpret_cast<const bf16x8*>((const char*)Vh + o_ + vo_); } } while (0)
#define B_LOAD1(U, s_) do { if ((s_) < (U).nt) { const size_t o_ = (size_t)((U).rowq % (unsigned)dil) * 128 + (size_t)((U).t0 + (s_)) * 64 * (size_t)ldb; \
        sk[s_] = *reinterpret_cast<const bf16x8*>((const char*)Kh + o_ + ko_); sv[s_] = *reinterpret_cast<const bf16x8*>((const char*)Vh + o_ + vo_); } } while (0)
    B_LOADS(cur);
    for (int L = 0; L < 16; ++L) {
        { const char* qb_ = (const char*)Qh + (size_t)cur.rowq * 128;
#pragma unroll
          for (int d0 = 0; d0 < 4; ++d0) qr[d0] = *reinterpret_cast<const bf16x8*>(qb_ + d0 * 32 + qo_); }
        asm volatile("s_waitcnt lgkmcnt(0)\n\ts_barrier" ::: "memory");
#pragma unroll
        for (int s_ = 0; s_ < 6; ++s_) if (s_ < cur.nt) { *(LAS bf16x8*)(lds + LY::K_OFF + s_ * LY::KBUF + kst) = sk[s_]; *(LAS bf16x8*)(lds + LY::V_OFF + s_ * LY::VBUF + vst) = sv[s_]; }
        asm volatile("s_waitcnt lgkmcnt(0)\n\ts_barrier" ::: "memory");
        const bool has_next = (L + 1 < 16);
        BU nxt = cur; if (has_next) { nxt = band_unit(dil, L + 1); if (FAST) { B_LOAD1(nxt, 0); B_LOAD1(nxt, 1); } else B_LOADS(nxt); }
        const int lo = cur.q0 + 32 * wid; int ta = (lo - 64) >> 6, tb = (lo + 95) >> 6; if (ta < cur.t0) ta = cur.t0; if (tb > cur.t0 + cur.nt - 1) tb = cur.t0 + cur.nt - 1;
        const int qi = lo + r32;
        float m_reg = -1e30f, l_reg = 0.f; f32x16 o[2]; o[0] = f32x16{}; o[1] = f32x16{};
#define PK4(P, BASE, OUT) do { v4u w = {cvtpk(P[BASE + 0], P[BASE + 1]), cvtpk(P[BASE + 2], P[BASE + 3]), cvtpk(P[BASE + 4], P[BASE + 5]), cvtpk(P[BASE + 6], P[BASE + 7])}; OUT = *reinterpret_cast<bf16x8*>(&w); } while (0)
        if constexpr (FAST) {
            const int kbeg = lo - 64, lstream = 4096 / dil, thr_ = r32 - 4 * hi;
#define BH_ADDR(j, KB, VB, OKJ) const int kh##j = kbeg + 32 * (j); const bool OKJ = (kh##j >= 0) && (kh##j < lstream); \
            int tj##j = kh##j >> 6; tj##j = tj##j < cur.t0 ? cur.t0 : (tj##j > cur.t0 + cur.nt - 1 ? cur.t0 + cur.nt - 1 : tj##j); const int hf##j = (kh##j >> 5) & 1; \
            const LAS char* KB = kbase + (tj##j - cur.t0) * LY::KBUF + hf##j * 32 * LY::KROW; const int VB = vb0 + (tj##j - cur.t0) * LY::VBUF + hf##j * 4096;
#define BH_QK(P, KB) do { P = f32x16{}; _Pragma("unroll") for (int d0 = 0; d0 < 4; ++d0) { const bf16x8 b_ = *(const LAS bf16x8*)((KB) + d0 * 32); P = __builtin_amdgcn_mfma_f32_32x32x16_bf16(b_, qr[d0], P, 0, 0, 0); } } while (0)
#define BH_SM(P, OKJ, MODE, PA, PB) do { \
            if ((MODE) == 1) { _Pragma("unroll") for (int r = 0; r < 16; ++r) { const int c_ = (r & 3) + 8 * (r >> 2); if (c_ < thr_) P[r] = -INFINITY; } } \
            if ((MODE) == 2) { _Pragma("unroll") for (int r = 0; r < 16; ++r) { const int c_ = (r & 3) + 8 * (r >> 2); if (c_ > thr_) P[r] = -INFINITY; } } \
            float ps_ = 0.f; _Pragma("unroll") for (int r = 0; r < 16; ++r) { P[r] = __builtin_amdgcn_exp2f(P[r]); ps_ += P[r]; } l_reg += (OKJ) ? ps_ : 0.f; \
            PK4(P, 0, PA); PK4(P, 8, PB); if (!(OKJ)) { PA = bf16x8{}; PB = bf16x8{}; } } while (0)
#define BH_PV(VB, PA, PB) do { pv_half<0, 0>(o[0], VB, PA, PB); pv_half<1, 0>(o[1], VB, PA, PB); } while (0)
            BH_ADDR(0, kb0_, vbh0_, ok0_) BH_ADDR(1, kb1_, vbh1_, ok1_) BH_ADDR(2, kb2_, vbh2_, ok2_) BH_ADDR(3, kb3_, vbh3_, ok3_) BH_ADDR(4, kb4_, vbh4_, ok4_)
            f32x16 pX, pY; bf16x8 paA, paB;
#define BH_STAGE(VB, QKSTMT, PC, OKJ, MODE) do { VH vf_; vh_issue(vf_, VB); SBAR(); QKSTMT; BH_SM(PC, OKJ, MODE, paA, paB); \
            asm volatile("s_waitcnt lgkmcnt(0)" ::: "memory"); SBAR(); vh_mm(o[0], o[1], vf_, paA, paB); SBAR(); } while (0)
            BH_QK(pX, kb0_);
            BH_STAGE(vbh0_, BH_QK(pY, kb1_), pX, ok0_, 1); if (has_next) B_LOAD1(nxt, 2);
            BH_STAGE(vbh1_, BH_QK(pX, kb2_), pY, ok1_, 0); if (has_next) B_LOAD1(nxt, 3);
            BH_STAGE(vbh2_, BH_QK(pY, kb3_), pX, ok2_, 0); if (has_next) B_LOAD1(nxt, 4);
            BH_STAGE(vbh3_, BH_QK(pX, kb4_), pY, ok3_, 0); if (has_next) B_LOAD1(nxt, 5);
            BH_STAGE(vbh4_, (void)0, pX, ok4_, 2);
#undef BH_STAGE
#undef BH_ADDR
#undef BH_QK
#undef BH_SM
#undef BH_PV
            { auto rr = __builtin_amdgcn_permlane32_swap(__float_as_uint(l_reg), __float_as_uint(l_reg), false, false); l_reg = __uint_as_float(rr[0]) + __uint_as_float(rr[1]); }
            m_reg = 0.f;
        } else
        for (int t = ta; t <= tb; ++t) {
            const int slot = t - cur.t0;
            f32x16 p0 = f32x16{}, p1 = f32x16{};
            { const LAS char* kb = kbase + slot * LY::KBUF;
#pragma unroll
              for (int d0 = 0; d0 < 4; ++d0) { const bf16x8 b0 = *(const LAS bf16x8*)(kb + d0 * 32); const bf16x8 b1 = *(const LAS bf16x8*)(kb + 32 * LY::KROW + d0 * 32);
                  p0 = __builtin_amdgcn_mfma_f32_32x32x16_bf16(b0, qr[d0], p0, 0, 0, 0); p1 = __builtin_amdgcn_mfma_f32_32x32x16_bf16(b1, qr[d0], p1, 0, 0, 0); } }
            if (64 * t < lo - 33) { const int a_ = qi - 64 - 64 * t - 4 * hi;
#pragma unroll
                for (int r = 0; r < 16; ++r) { const int c_ = (r & 3) + 8 * (r >> 2); if (c_ < a_) p0[r] = -INFINITY; if (c_ + 32 < a_) p1[r] = -INFINITY; } }
            else if (64 * t + 63 > lo + 64) { const int b_ = qi + 64 - 64 * t - 4 * hi;
#pragma unroll
                for (int r = 0; r < 16; ++r) { const int c_ = (r & 3) + 8 * (r >> 2); if (c_ > b_) p0[r] = -INFINITY; if (c_ + 32 > b_) p1[r] = -INFINITY; } }
            const float pmax = rowmax32(p0, p1);
            if (t == ta) { m_reg = fmaxf(pmax, -1e30f); }
            else if (__any(pmax > m_reg)) {
                const float mn = fmaxf(m_reg, pmax); const float alpha = __builtin_amdgcn_exp2f(m_reg - mn); m_reg = mn; l_reg *= alpha;
                if (hi == 0) wsf[r32] = alpha; asm volatile("s_waitcnt lgkmcnt(0)" ::: "memory");
#pragma unroll
                for (int r = 0; r < 16; ++r) { const float al = wsf[crow(r, hi)]; o[0][r] *= al; o[1][r] *= al; }
            }
#pragma unroll
            for (int r = 0; r < 16; ++r) { p0[r] = __builtin_amdgcn_exp2f(p0[r] - m_reg); p1[r] = __builtin_amdgcn_exp2f(p1[r] - m_reg); }
            float ps = 0.f;
#pragma unroll
            for (int r = 0; r < 16; ++r) ps += p0[r] + p1[r];
            { auto rr = __builtin_amdgcn_permlane32_swap(__float_as_uint(ps), __float_as_uint(ps), false, false); ps = __uint_as_float(rr[0]) + __uint_as_float(rr[1]); }
            l_reg += ps;
            bf16x8 pa0, pa1, pa2, pa3;
            PK4(p0, 0, pa0); PK4(p0, 8, pa1); PK4(p1, 0, pa2); PK4(p1, 8, pa3);
            const int vb = vb0 + slot * LY::VBUF;
            pv_one<0>(o[0], vb, pa0, pa1, pa2, pa3); pv_one<1>(o[1], vb, pa0, pa1, pa2, pa3);
        }
#undef PK4
        const float lse = m_reg + __builtin_amdgcn_logf(l_reg);
        if (hi == 0) { wsf[r32] = __builtin_amdgcn_rcpf(l_reg); wsf[32 + r32] = lse; }
        v4u a1[4], a2[4]; float L1v[4], L2v[4];
        if constexpr (MERGE) {
#pragma unroll
            for (int i = 0; i < 4; ++i) { const size_t tr_ = (size_t)cur.rowq + (size_t)(wid * 32 + (lane >> 3) + 8 * i) * dil;
                a1[i] = *(const v4u*)(O1b + tr_ * 64 + (lane & 7) * 8); a2[i] = *(const v4u*)(O2b + tr_ * 64 + (lane & 7) * 8); L1v[i] = L1b[tr_]; L2v[i] = L2b[tr_]; }
        }
        asm volatile("s_waitcnt lgkmcnt(0)" ::: "memory");
        { const int odd = lane & 1; const unsigned sel = odd ? 0x03020706u : 0x05040100u;
          LAS char* wb = ost + (4 * hi + odd) * 128 + (r32 & ~1) * 2;
#pragma unroll
          for (int k = 0; k < 8; ++k) { const int r0 = ((2 * k) & 3) + 8 * ((2 * k) >> 2);
              const float rl0 = wsf[r0 + 4 * hi], rl1 = wsf[r0 + 1 + 4 * hi];
#pragma unroll
              for (int d0 = 0; d0 < 2; ++d0) { const unsigned pk = cvtpk(o[d0][2 * k] * rl0, o[d0][2 * k + 1] * rl1);
                  const unsigned rc = (unsigned)__builtin_amdgcn_update_dpp(0, (int)pk, 0xB1, 0xF, 0xF, false);
                  *(LAS unsigned*)(wb + r0 * 128 + d0 * 64) = __builtin_amdgcn_perm(rc, pk, sel); } } }
        asm volatile("s_waitcnt lgkmcnt(0)" ::: "memory");
        if (!MERGE) { if (hi == 0) Lb[(size_t)cur.rowq + (size_t)(wid * 32 + r32) * dil] = lse; }
        v4u vv[4]; float L3v[4];
#pragma unroll
        for (int i = 0; i < 4; ++i) { const int row = (lane >> 3) + 8 * i; vv[i] = *(const LAS v4u*)(ost + row * 128 + (lane & 7) * 16); if (MERGE) L3v[i] = wsf[32 + row]; }
#pragma unroll
        for (int i = 0; i < 4; ++i) { const int row = (lane >> 3) + 8 * i, ch = lane & 7; const size_t tr_ = (size_t)cur.rowq + (size_t)(wid * 32 + row) * dil;
            v4u v = vv[i];
            if constexpr (MERGE) {
                const float L3 = L3v[i], L1 = L1v[i], L2 = L2v[i];
                const float M = fmaxf(L3, fmaxf(L1, L2)); float w1 = __builtin_amdgcn_exp2f(L1 - M), w2 = __builtin_amdgcn_exp2f(L2 - M), w3 = __builtin_amdgcn_exp2f(L3 - M);
                const float inv = __builtin_amdgcn_rcpf(w1 + w2 + w3); w1 *= inv; w2 *= inv; w3 *= inv;
                float x3[8], x1[8], x2[8], y[8]; unpack8(v, x3); unpack8(a1[i], x1); unpack8(a2[i], x2);
#pragma unroll
                for (int e = 0; e < 8; ++e) y[e] = w1 * x1[e] + w2 * x2[e] + w3 * x3[e];
                v = pack8(y);
            }
            *(v4u*)(Ob + tr_ * (size_t)ldo + ch * 8) = v; }
        cur = nxt;
    }
    __syncthreads();
#undef B_LOADS
#undef B_LOAD1
}


template <int DQ> __device__ __forceinline__ void q_finish(bf16x8 (&qr)[DQ / 16], const float* __restrict__ gain, int t, int hi) {
    constexpr int ND = DQ / 16; float v[ND][8]; float ss = 0.f;
#pragma unroll
    for (int d0 = 0; d0 < ND; ++d0) { const v4u r = __builtin_bit_cast(v4u, qr[d0]); unpack8(r, v[d0]);
#pragma unroll
        for (int j = 0; j < 8; ++j) ss += v[d0][j] * v[d0][j]; }
    { auto rr = __builtin_amdgcn_permlane32_swap(__float_as_uint(ss), __float_as_uint(ss), false, false); ss = __uint_as_float(rr[0]) + __uint_as_float(rr[1]); }
    const float rs = (1.0f / sqrtf(ss * (1.0f / DQ) + EPS)) * (DQ == 96 ? QSCALE_A : QSCALE_B);
#pragma unroll
    for (int d0 = 0; d0 < ND; ++d0) { const f32x4 g0 = *(const f32x4*)(gain + 16 * d0 + 8 * hi), g1 = *(const f32x4*)(gain + 16 * d0 + 8 * hi + 4);
        v[d0][0] *= rs * g0[0]; v[d0][1] *= rs * g0[1]; v[d0][2] *= rs * g0[2]; v[d0][3] *= rs * g0[3]; v[d0][4] *= rs * g1[0]; v[d0][5] *= rs * g1[1]; v[d0][6] *= rs * g1[2]; v[d0][7] *= rs * g1[3]; }
#pragma unroll
    for (int j = 0; j < 8; ++j) { const float revf = exp2f(-(float)(8 * hi + j) * (LOG2_THETA / 16.f)) * INV_2PI; float c, s;
        if (DQ == 96) { cs_rev((float)t, revf, c, s); const float a = v[4][j], b = v[5][j]; v[4][j] = a * c - b * s; v[5][j] = a * s + b * c; }
        else { cs_rev((float)(t >> 6), revf, c, s); float a = v[0][j], b = v[1][j]; v[0][j] = a * c - b * s; v[1][j] = a * s + b * c;
               cs_rev((float)(t & 63), revf, c, s); a = v[2][j]; b = v[3][j]; v[2][j] = a * c - b * s; v[3][j] = a * s + b * c; } }
#pragma unroll
    for (int d0 = 0; d0 < ND; ++d0) { const v4u w = pack8(v[d0]); qr[d0] = __builtin_bit_cast(bf16x8, w); }
}
constexpr float THR_L2 = 8.0f;
template <int DQ, int NS_ = 4> struct LayD {
    static constexpr int KROW = DQ * 2 + 16, KBUF = 64 * KROW, VBUF = 8192, NS = NS_;
    static constexpr int K_OFF = 0, V_OFF = NS * KBUF, WS_OFF = V_OFF + NS * VBUF, OST_OFF = WS_OFF + 8 * 512, BYTES_D = OST_OFF + 8 * 4096;
    static_assert(BYTES_D <= 160 * 1024 - 1024, "attention LDS");
};
template <int DQ>
__device__ __forceinline__ void attn_dense(const bf16* __restrict__ Qp, long ldq, const float* __restrict__ qgain, int tq0, const bf16* __restrict__ Kp, long ldk, const bf16* __restrict__ Vp, long ldv, int NT, bf16* Op, long ldo, LAS char* lds) {
    using LY = LayD<DQ>;
    int tid = threadIdx.x; asm volatile("" : "+v"(tid));
    const int lane = tid & 63, r32 = lane & 31, hi = lane >> 5; const int wid = __builtin_amdgcn_readfirstlane(tid >> 6);
    LAS float* wsf = (LAS float*)(lds + LY::WS_OFF) + wid * 128;
    bf16x8 qr[DQ / 16];
    { const bf16* Qw = Qp + (long)(wid * 32 + r32) * ldq + hi * 8;
#pragma unroll
      for (int d0 = 0; d0 < DQ / 16; ++d0) qr[d0] = *reinterpret_cast<const bf16x8*>(Qw + d0 * 16); }
    q_finish<DQ>(qr, qgain, tq0 + wid * 32 + r32, hi);
    constexpr int CPR = DQ / 8;
    const int kc0 = tid, krow0 = kc0 / CPR, kch0 = kc0 % CPR;
    const int kc1 = tid + 512, krow1 = kc1 / CPR, kch1 = kc1 % CPR;
    const bool k2 = (DQ == 96) && (wid < 4);
    const int vkey = 2 * (tid >> 4) + ((tid >> 2) & 1), vcol = 32 * ((tid >> 3) & 1) + 8 * (tid & 3);
    const int kst0 = krow0 * LY::KROW + kch0 * 16, kst1 = krow1 * LY::KROW + kch1 * 16, vst = v_st(vkey, vcol);
    const bf16* kg0 = Kp + (long)krow0 * ldk + kch0 * 8; const bf16* kg1 = Kp + (long)krow1 * ldk + kch1 * 8; const bf16* vg = Vp + (long)vkey * ldv + vcol;
    bf16x8 skE0, skE1 = {}, svE, skO0, skO1 = {}, svO;
#define D_LOAD(SK0, SK1, SV, t) do { const long ko = (long)(t) * 64 * ldk; SK0 = *reinterpret_cast<const bf16x8*>(kg0 + ko); if (k2) SK1 = *reinterpret_cast<const bf16x8*>(kg1 + ko); SV = *reinterpret_cast<const bf16x8*>(vg + (long)(t) * 64 * ldv); } while (0)
#define D_WRITE(b, SK0, SK1, SV) do { *(LAS bf16x8*)(lds + LY::K_OFF + (b) * LY::KBUF + kst0) = SK0; if (k2) *(LAS bf16x8*)(lds + LY::K_OFF + (b) * LY::KBUF + kst1) = SK1; \
        *(LAS bf16x8*)(lds + LY::V_OFF + (b) * LY::VBUF + vst) = SV; } while (0)
    const int vb0 = (int)(unsigned)(size_t)(lds + LY::V_OFF) + v_rd_base(lane);
    const LAS char* kbase = lds + LY::K_OFF + r32 * LY::KROW + hi * 16;
    float m_ref = 0.f, l_reg = 0.f; f32x16 o[2]; o[0] = f32x16{}; o[1] = f32x16{};
    f32x16 negm = f32x16{}; asm volatile("" : "+v"(negm));
    f32x16 pA0, pA1, pB0, pB1; float alA = 1.f, alB = 1.f; bf16x8 pa0, pa1, pa2, pa3;
#define D_QKT(P0, P1, b) do { const LAS char* kb_ = kbase + (b) * LY::KBUF; P0 = negm; P1 = negm; \
        _Pragma("unroll") for (int d0 = 0; d0 < DQ / 16; ++d0) { const bf16x8 b0_ = *(const LAS bf16x8*)(kb_ + d0 * 32); const bf16x8 b1_ = *(const LAS bf16x8*)(kb_ + 32 * LY::KROW + d0 * 32); \
            P0 = __builtin_amdgcn_mfma_f32_32x32x16_bf16(b0_, qr[d0], P0, 0, 0, 0); P1 = __builtin_amdgcn_mfma_f32_32x32x16_bf16(b1_, qr[d0], P1, 0, 0, 0); } } while (0)
#define D_PART(P0, P1, AL, FIRST) do { const float rm_ = rowmax32(P0, P1); AL = 1.f; \
        if ((FIRST) || __any(rm_ > THR_L2)) { const float dl_ = (FIRST) ? rm_ : fmaxf(rm_, 0.f); m_ref += dl_; \
            _Pragma("unroll") for (int r = 0; r < 16; ++r) { P0[r] -= dl_; P1[r] -= dl_; } \
            _Pragma("unroll") for (int r = 0; r < 16; ++r) negm[r] = -m_ref; asm volatile("" : "+v"(negm)); \
            AL = __builtin_amdgcn_exp2f(-dl_); } \
        _Pragma("unroll") for (int r = 0; r < 16; ++r) P0[r] = __builtin_amdgcn_exp2f(P0[r]); } while (0)
#define D_PK4(P, BASE, OUT) do { v4u w = {cvtpk(P[BASE + 0], P[BASE + 1]), cvtpk(P[BASE + 2], P[BASE + 3]), cvtpk(P[BASE + 4], P[BASE + 5]), cvtpk(P[BASE + 6], P[BASE + 7])}; OUT = *reinterpret_cast<bf16x8*>(&w); } while (0)
#define D_FIN(P0, P1, AL) do { _Pragma("unroll") for (int r = 0; r < 16; ++r) P1[r] = __builtin_amdgcn_exp2f(P1[r]); \
        float ps_ = 0.f; _Pragma("unroll") for (int r = 0; r < 16; ++r) ps_ += P0[r]; _Pragma("unroll") for (int r = 0; r < 16; ++r) ps_ += P1[r]; \
        { auto rr = __builtin_amdgcn_permlane32_swap(__float_as_uint(ps_), __float_as_uint(ps_), false, false); ps_ = __uint_as_float(rr[0]) + __uint_as_float(rr[1]); } \
        l_reg = l_reg * (AL) + ps_; D_PK4(P0, 0, pa0); D_PK4(P0, 8, pa1); D_PK4(P1, 0, pa2); D_PK4(P1, 8, pa3); } while (0)
#define D_RESC(AL) do { if (__any((AL) < 1.f)) { if (hi == 0) wsf[r32] = (AL); asm volatile("s_waitcnt lgkmcnt(0)" ::: "memory"); \
        _Pragma("unroll") for (int r = 0; r < 16; ++r) { const float a_ = wsf[crow(r, hi)]; o[0][r] *= a_; o[1][r] *= a_; } } } while (0)
#define D_PV(b) do { const int vb_ = vb0 + (b) * LY::VBUF; pv_one<0>(o[0], vb_, pa0, pa1, pa2, pa3); pv_one<1>(o[1], vb_, pa0, pa1, pa2, pa3); } while (0)
    D_LOAD(skE0, skE1, svE, 0); D_LOAD(skO0, skO1, svO, 1);
    D_WRITE(0, skE0, skE1, svE); D_WRITE(1, skO0, skO1, svO);
    D_LOAD(skE0, skE1, svE, 2); D_LOAD(skO0, skO1, svO, 3);
    __syncthreads();
    D_QKT(pA0, pA1, 0); D_PART(pA0, pA1, alA, true); alA = 1.f;
    for (int j = 1; j + 1 < NT; j += 2) {
        SBAR(); D_QKT(pB0, pB1, j & 3);
        D_FIN(pA0, pA1, alA); SBAR();
        D_PV((j - 1) & 3); D_PART(pB0, pB1, alB, false);
        D_WRITE((j + 1) & 3, skE0, skE1, svE);
        if (j + 3 < NT) D_LOAD(skE0, skE1, svE, j + 3);
        D_RESC(alB); __syncthreads();
        SBAR(); D_QKT(pA0, pA1, (j + 1) & 3);
        D_FIN(pB0, pB1, alB); SBAR();
        D_PV(j & 3); D_PART(pA0, pA1, alA, false);
        D_WRITE((j + 2) & 3, skO0, skO1, svO);
        if (j + 4 < NT) D_LOAD(skO0, skO1, svO, j + 4);
        D_RESC(alA); __syncthreads();
    }
    SBAR(); D_QKT(pB0, pB1, (NT - 1) & 3);
    D_FIN(pA0, pA1, alA); SBAR();
    D_PV((NT - 2) & 3); D_PART(pB0, pB1, alB, false);
    D_RESC(alB);
    D_FIN(pB0, pB1, alB); SBAR();
    D_PV((NT - 1) & 3);
    if (hi == 0) wsf[r32] = __builtin_amdgcn_rcpf(l_reg);
    asm volatile("s_waitcnt lgkmcnt(0)" ::: "memory");
    LAS char* ost = lds + LY::OST_OFF + wid * 4096;
#pragma unroll
    for (int r = 0; r < 16; ++r) { const int orow = crow(r, hi); const float rl = wsf[orow];
        *(LAS unsigned short*)(ost + orow * 128 + r32 * 2) = (unsigned short)f2bf(o[0][r] * rl); *(LAS unsigned short*)(ost + orow * 128 + 64 + r32 * 2) = (unsigned short)f2bf(o[1][r] * rl); }
    asm volatile("s_waitcnt lgkmcnt(0)" ::: "memory");
    bf16* Ow = Op + (long)(wid * 32) * ldo;
#pragma unroll
    for (int i = 0; i < 4; ++i) { const int row = (lane >> 3) + 8 * i, ch = lane & 7; const v4u v = *(const LAS v4u*)(ost + row * 128 + ch * 16); *(v4u*)(Ow + (long)row * ldo + ch * 8) = v; }
    __syncthreads();
#undef D_LOAD
#undef D_WRITE
#undef D_QKT
#undef D_PART
#undef D_PK4
#undef D_FIN
#undef D_RESC
#undef D_PV
}

template <int DQ>
__device__ __forceinline__ void attn_dense_fast(const bf16* __restrict__ Qp, long ldq, const float* __restrict__ qgain, int tq0, const bf16* __restrict__ Kp, long ldk, const bf16* __restrict__ Vp, long ldv, int NT, bf16* Op, long ldo, LAS char* lds) {
    using LY = LayD<DQ, 5>;
    int tid = threadIdx.x; asm volatile("" : "+v"(tid));
    const int lane = tid & 63, r32 = lane & 31, hi = lane >> 5; const int wid = __builtin_amdgcn_readfirstlane(tid >> 6);
    LAS float* wsf = (LAS float*)(lds + LY::WS_OFF) + wid * 128;
    bf16x8 qr[DQ / 16];
    { const bf16* Qw = Qp + (long)(wid * 32 + r32) * ldq + hi * 8;
#pragma unroll
      for (int d0 = 0; d0 < DQ / 16; ++d0) qr[d0] = *reinterpret_cast<const bf16x8*>(Qw + d0 * 16); }
    q_finish<DQ>(qr, qgain, tq0 + wid * 32 + r32, hi);
    constexpr int KCH = LY::KROW / 16, KPC = LY::KBUF / 1024; static_assert(LY::KBUF % 1024 == 0 && KPC <= 16 && KPC > 8, "K tile pieces");
    unsigned kofs[2]; int kpc[2];
#pragma unroll
    for (int i = 0; i < 2; ++i) { int pc = wid + 8 * i; if (pc > KPC - 1) pc = KPC - 1; const int c = pc * 64 + lane, row = c / KCH; int cc = c - row * KCH; if (cc > DQ / 8 - 1) cc = DQ / 8 - 1;
        kpc[i] = pc; kofs[i] = (unsigned)(row * (int)ldk + cc * 8) * 2u; }
    unsigned vofs; { const int pb = (wid * 64 + lane) * 16, sub = pb >> 9, within = (pb & 511) >> 1, key = (sub >> 1) * 8 + (within >> 5), col = (sub & 1) * 32 + (within & 31); vofs = (unsigned)(key * (int)ldv + col) * 2u; }
#define D_DMA(t, b) do { const char* kb_ = (const char*)Kp + (size_t)(t) * 128 * (size_t)ldk; const char* vp_ = (const char*)Vp + (size_t)(t) * 128 * (size_t)ldv; \
        __builtin_amdgcn_global_load_lds((const unsigned*)(kb_ + kofs[0]), (LAS unsigned*)(lds + LY::K_OFF + (b) * LY::KBUF + kpc[0] * 1024), 16, 0, 0); \
        __builtin_amdgcn_global_load_lds((const unsigned*)(kb_ + kofs[1]), (LAS unsigned*)(lds + LY::K_OFF + (b) * LY::KBUF + kpc[1] * 1024), 16, 0, 0); \
        __builtin_amdgcn_global_load_lds((const unsigned*)(vp_ + vofs), (LAS unsigned*)(lds + LY::V_OFF + (b) * LY::VBUF + wid * 1024), 16, 0, 0); } while (0)
#define D_BAR(N) asm volatile("s_waitcnt vmcnt(" #N ")\n\ts_barrier" ::: "memory")
    const int vb0 = (int)(unsigned)(size_t)(lds + LY::V_OFF) + v_rd_base(lane);
    const LAS char* kbase = lds + LY::K_OFF + r32 * LY::KROW + hi * 16;
    f32x16 o[2]; o[0] = f32x16{}; o[1] = f32x16{}; float l0 = 0.f, l1 = 0.f, l2 = 0.f, l3 = 0.f;
    f32x16 pA0, pA1, pB0, pB1; bf16x8 pa0, pa1, pa2, pa3;
#define D_QKT(P0, P1, b) do { const LAS char* kb_ = kbase + (b) * LY::KBUF; P0 = f32x16{}; P1 = f32x16{}; \
        _Pragma("unroll") for (int d0 = 0; d0 < DQ / 16; ++d0) { const bf16x8 b0_ = *(const LAS bf16x8*)(kb_ + d0 * 32); const bf16x8 b1_ = *(const LAS bf16x8*)(kb_ + 32 * LY::KROW + d0 * 32); \
            P0 = __builtin_amdgcn_mfma_f32_32x32x16_bf16(b0_, qr[d0], P0, 0, 0, 0); P1 = __builtin_amdgcn_mfma_f32_32x32x16_bf16(b1_, qr[d0], P1, 0, 0, 0); } } while (0)
#define D_PK4(P, BASE, OUT) do { v4u w = {cvtpk(P[BASE + 0], P[BASE + 1]), cvtpk(P[BASE + 2], P[BASE + 3]), cvtpk(P[BASE + 4], P[BASE + 5]), cvtpk(P[BASE + 6], P[BASE + 7])}; OUT = *reinterpret_cast<bf16x8*>(&w); } while (0)
#define D_FIN(P0, P1) do { _Pragma("unroll") for (int r = 0; r < 16; ++r) { P0[r] = __builtin_amdgcn_exp2f(P0[r]); P1[r] = __builtin_amdgcn_exp2f(P1[r]); } \
        D_PK4(P0, 0, pa0); D_PK4(P0, 8, pa1); D_PK4(P1, 0, pa2); D_PK4(P1, 8, pa3); } while (0)
#define PKVF(L, H) (bf16x8){L[0], L[1], L[2], L[3], H[0], H[1], H[2], H[3]}
#define D_ADDA(ACC, X) asm("v_add_f32 %0, %0, %1" : "+v"(ACC) : "v"(X))
#define D_MMA4(OD, PA, L, H, PC, R0) do { OD = __builtin_amdgcn_mfma_f32_32x32x16_bf16(PA, PKVF(L, H), OD, 0, 0, 0); \
        D_ADDA(l0, PC[R0]); D_ADDA(l1, PC[R0 + 1]); D_ADDA(l2, PC[R0 + 2]); D_ADDA(l3, PC[R0 + 3]); SBAR(); } while (0)
#define D_STEP(HAVEN, PN0, PN1, SN, PC0, PC1, SC) do { VF fa_, fb_; const int vb_ = vb0 + (SC) * LY::VBUF; \
        v_issue<0>(fa_, vb_); SBAR(); \
        if (HAVEN) D_QKT(PN0, PN1, SN); \
        D_FIN(PC0, PC1); \
        asm volatile("s_waitcnt lgkmcnt(0)" ::: "memory"); SBAR(); \
        v_issue<1>(fb_, vb_); \
        D_MMA4(o[0], pa0, fa_.l0, fa_.h0, PC0, 0); D_MMA4(o[0], pa1, fa_.l1, fa_.h1, PC0, 4); D_MMA4(o[0], pa2, fa_.l2, fa_.h2, PC0, 8); D_MMA4(o[0], pa3, fa_.l3, fa_.h3, PC0, 12); \
        asm volatile("s_waitcnt lgkmcnt(0)" ::: "memory"); SBAR(); \
        D_MMA4(o[1], pa0, fb_.l0, fb_.h0, PC1, 0); D_MMA4(o[1], pa1, fb_.l1, fb_.h1, PC1, 4); D_MMA4(o[1], pa2, fb_.l2, fb_.h2, PC1, 8); D_MMA4(o[1], pa3, fb_.l3, fb_.h3, PC1, 12); } while (0)
#define NEXT5(x) ((x) == 4 ? 0 : (x) + 1)
    D_DMA(0, 0); D_DMA(1, 1); D_DMA(2, 2); D_DMA(3, 3);
    D_BAR(6);
    D_QKT(pA0, pA1, 0);
    int sl_pv = 0, sl_qk = 1, sl_d = 4;
    for (int j = 1; j + 1 < NT; j += 2) {
        { const int tt = (j + 3 < NT) ? j + 3 : NT - 1; D_DMA(tt, sl_d); }
        D_STEP(true, pB0, pB1, sl_qk, pA0, pA1, sl_pv);
        D_BAR(6);
        sl_pv = sl_qk; sl_qk = NEXT5(sl_qk); sl_d = NEXT5(sl_d);
        { const int tt = (j + 4 < NT) ? j + 4 : NT - 1; D_DMA(tt, sl_d); }
        D_STEP(true, pA0, pA1, sl_qk, pB0, pB1, sl_pv);
        D_BAR(6);
        sl_pv = sl_qk; sl_qk = NEXT5(sl_qk); sl_d = NEXT5(sl_d);
    }
    D_STEP(true, pB0, pB1, sl_qk, pA0, pA1, sl_pv);
    D_STEP(false, pA0, pA1, 0, pB0, pB1, sl_qk);
#undef NEXT5
    LAS char* ost = lds + LY::OST_OFF + wid * 4096;
    float l_reg = (l0 + l1) + (l2 + l3);
    { auto rr = __builtin_amdgcn_permlane32_swap(__float_as_uint(l_reg), __float_as_uint(l_reg), false, false); l_reg = __uint_as_float(rr[0]) + __uint_as_float(rr[1]); }
    if (hi == 0) wsf[r32] = __builtin_amdgcn_rcpf(l_reg);
    asm volatile("s_waitcnt lgkmcnt(0)" ::: "memory");
#pragma unroll
    for (int r = 0; r < 16; ++r) { const int orow = crow(r, hi); const float rl = wsf[orow];
        *(LAS unsigned short*)(ost + orow * 128 + r32 * 2) = (unsigned short)f2bf(o[0][r] * rl); *(LAS unsigned short*)(ost + orow * 128 + 64 + r32 * 2) = (unsigned short)f2bf(o[1][r] * rl); }
    asm volatile("s_waitcnt lgkmcnt(0)" ::: "memory");
    bf16* Ow = Op + (long)(wid * 32) * ldo;
#pragma unroll
    for (int i = 0; i < 4; ++i) { const int row = (lane >> 3) + 8 * i, ch = lane & 7; const v4u v = *(const LAS v4u*)(ost + row * 128 + ch * 16); *(v4u*)(Ow + (long)row * ldo + ch * 8) = v; }
    asm volatile("s_waitcnt vmcnt(0)" ::: "memory");
    __syncthreads();
#undef D_DMA
#undef D_BAR
#undef D_QKT
#undef D_PK4
#undef D_FIN
#undef D_STEP
#undef D_MMA4
#undef D_ADDA
#undef PKVF
}
__device__ __forceinline__ float wave_absmax(const float* g, int n) { int tid = threadIdx.x; const int lane = tid & 63; float m = 0.f; for (int i = lane; i < n; i += 64) m = fmaxf(m, fabsf(g[i]));
#pragma unroll
    for (int o = 1; o < 64; o <<= 1) m = fmaxf(m, __shfl_xor(m, o));
    return __builtin_bit_cast(float, __builtin_amdgcn_readfirstlane(__builtin_bit_cast(int, m))); }
}
namespace pg8 {
struct EpiResGate {
    static constexpr bool PERM = false, AFTER_DRAIN = false;
    const float* base; float* out; const long long* gate; float sc;
    __device__ __forceinline__ void operator()(const f32x4 (&acc)[2][2][4][2], const Unit& u, int wr, int wc, int fr, int fq) const {
        const int b = u.pm >> 4; const int col0 = u.pn * BM + wc * 32 + 4 * fq; const long long* gp = gate + b * 6144 + col0;
        f32x4 gv[2][2];
#pragma unroll
        for (int bj = 0; bj < 2; ++bj)
#pragma unroll
            for (int n = 0; n < 2; ++n) { const long long* q = gp + bj * HALF + n * 16; gv[bj][n] = (f32x4){(float)q[0], (float)q[1], (float)q[2], (float)q[3]} * (9.094947017729282e-13f * sc); }
#pragma unroll
        for (int ai = 0; ai < 2; ++ai)
#pragma unroll
            for (int m = 0; m < 4; ++m) { const size_t off = (size_t)(u.pm * BM + ai * HALF + wr * 64 + m * 16 + fr) * 1024 + col0;
#pragma unroll
                for (int bj = 0; bj < 2; ++bj)
#pragma unroll
                    for (int n = 0; n < 2; ++n) { const f32x4 bs = *(const f32x4*)(base + off + bj * HALF + n * 16); *(f32x4*)(out + off + bj * HALF + n * 16) = bs + gv[bj][n] * acc[ai][bj][m][n]; }
                if (m & 1) asm volatile("" ::: "memory"); }
    }
};

template <bool BASEF32> struct EpiResB {
    static constexpr bool PERM = true, AFTER_DRAIN = false;
    const void* base; bf16_t* out; const long long* gate; float sc;
    __device__ __forceinline__ void operator()(const f32x4 (&acc)[2][2][4][2], const Unit& u, int wr, int wc, int fr, int fq) const {
        const int b = u.pm >> 4; const int col0 = u.pn * BM + wc * 32 + 8 * fq; const long long* gp = gate + b * 6144 + col0;
        float gv[2][8];
#pragma unroll
        for (int bj = 0; bj < 2; ++bj)
#pragma unroll
            for (int e = 0; e < 8; ++e) gv[bj][e] = (float)gp[bj * HALF + e] * (9.094947017729282e-13f * sc);
#pragma unroll
        for (int ai = 0; ai < 2; ++ai)
#pragma unroll
            for (int m = 0; m < 4; ++m) { const size_t row = (size_t)(u.pm * BM + ai * HALF + wr * 64 + m * 16 + fr);
#pragma unroll
                for (int bj = 0; bj < 2; ++bj) { float bs[8];
                    if (BASEF32) { const f32x4 b0 = *(const f32x4*)((const float*)base + row * 1024 + col0 + bj * HALF), b1 = *(const f32x4*)((const float*)base + row * 1024 + col0 + bj * HALF + 4);
                        bs[0] = b0[0]; bs[1] = b0[1]; bs[2] = b0[2]; bs[3] = b0[3]; bs[4] = b1[0]; bs[5] = b1[1]; bs[6] = b1[2]; bs[7] = b1[3]; }
                    else { const u32x4 r = *(const u32x4*)((const bf16_t*)base + row * 2048 + col0 + bj * HALF);
                        bs[0] = __builtin_bit_cast(float, r.x << 16); bs[1] = __builtin_bit_cast(float, r.x & 0xffff0000u); bs[2] = __builtin_bit_cast(float, r.y << 16); bs[3] = __builtin_bit_cast(float, r.y & 0xffff0000u);
                        bs[4] = __builtin_bit_cast(float, r.z << 16); bs[5] = __builtin_bit_cast(float, r.z & 0xffff0000u); bs[6] = __builtin_bit_cast(float, r.w << 16); bs[7] = __builtin_bit_cast(float, r.w & 0xffff0000u); }
                    const f32x4 a0 = acc[ai][bj][m][0], a1 = acc[ai][bj][m][1];
                    u32x4 w; w.x = cvt_pk_bf16(bs[0] + gv[bj][0] * a0[0], bs[1] + gv[bj][1] * a0[1]); w.y = cvt_pk_bf16(bs[2] + gv[bj][2] * a0[2], bs[3] + gv[bj][3] * a0[3]);
                    w.z = cvt_pk_bf16(bs[4] + gv[bj][4] * a1[0], bs[5] + gv[bj][5] * a1[1]); w.w = cvt_pk_bf16(bs[6] + gv[bj][6] * a1[2], bs[7] + gv[bj][7] * a1[3]);
                    *(u32x4*)(out + row * 2048 + col0 + bj * HALF) = w; }
                if (m & 1) asm volatile("" ::: "memory"); }
    }
};
__device__ __forceinline__ f32x2 silu2(f32x2 ag, f32x2 au, float c1, float k) {
    const f32x2 t = ag * c1; f32x2 e; e.x = __builtin_amdgcn_exp2f(t.x); e.y = __builtin_amdgcn_exp2f(t.y);
    const f32x2 d = e * k + k; f32x2 r; r.x = __builtin_amdgcn_rcpf(d.x); r.y = __builtin_amdgcn_rcpf(d.y);
    return (ag * au) * r;
}
__device__ __forceinline__ float silu_mul(float g, float u) { return g * __builtin_amdgcn_rcpf(1.0f + __builtin_amdgcn_exp2f(-1.4426950408889634f * g)) * u; }
struct EpiSwiGLU {
    static constexpr bool PERM = true, AFTER_DRAIN = false;
    bf16_t* O; int ldo; int nNe; int pm0;
    __device__ __forceinline__ void operator()(const f32x4 (&acc)[2][2][4][2], const Unit& u, int wr, int wc, int fr, int fq) const {
        const int pnl = u.pn % nNe; const int col0 = pnl * HALF + wc * 32 + 8 * fq; const int row0 = (u.pm - pm0) * BM + wr * 64 + fr;
#pragma unroll
        for (int ai = 0; ai < 2; ++ai)
#pragma unroll
            for (int m = 0; m < 4; ++m) { bf16_t* rowp = O + (size_t)(row0 + ai * HALF + m * 16) * ldo + col0;
                const f32x4 g0 = acc[ai][0][m][0], g1 = acc[ai][0][m][1], u0 = acc[ai][1][m][0], u1 = acc[ai][1][m][1];
                const f32x2 y0 = silu2((f32x2){g0[0], g0[1]}, (f32x2){u0[0], u0[1]}, -1.4426950408889634f, 1.0f), y1 = silu2((f32x2){g0[2], g0[3]}, (f32x2){u0[2], u0[3]}, -1.4426950408889634f, 1.0f);
                const f32x2 y2 = silu2((f32x2){g1[0], g1[1]}, (f32x2){u1[0], u1[1]}, -1.4426950408889634f, 1.0f), y3 = silu2((f32x2){g1[2], g1[3]}, (f32x2){u1[2], u1[3]}, -1.4426950408889634f, 1.0f);
                u32x4 w; w.x = cvt_pk_bf16(y0.x, y0.y); w.y = cvt_pk_bf16(y1.x, y1.y); w.z = cvt_pk_bf16(y2.x, y2.y); w.w = cvt_pk_bf16(y3.x, y3.y);
                *(u32x4*)rowp = w; }
    }
};

struct EpiSwiGLU8 {
    static constexpr bool PERM = true, AFTER_DRAIN = false;
    unsigned char* O; int ldo; int nNe; int pm0; float SI;
    __device__ __forceinline__ void operator()(const f32x4 (&acc)[2][2][4][2], const Unit& u, int wr, int wc, int fr, int fq) const {
        const int pnl = u.pn % nNe; const int col0 = pnl * HALF + wc * 32 + 8 * fq; const int row0 = (u.pm - pm0) * BM + wr * 64 + fr;
#pragma unroll
        for (int ai = 0; ai < 2; ++ai)
#pragma unroll
            for (int m = 0; m < 4; ++m) { unsigned char* rowp = O + (size_t)(row0 + ai * HALF + m * 16) * ldo + col0;
                const float C1 = -1.4426950408889634f * SI, KK = 1.0f / (SI * SI * F8_AS);
                const f32x4 g0 = acc[ai][0][m][0], g1 = acc[ai][0][m][1], u0 = acc[ai][1][m][0], u1 = acc[ai][1][m][1];
                const f32x2 y0 = silu2((f32x2){g0[0], g0[1]}, (f32x2){u0[0], u0[1]}, C1, KK), y1 = silu2((f32x2){g0[2], g0[3]}, (f32x2){u0[2], u0[3]}, C1, KK);
                const f32x2 y2 = silu2((f32x2){g1[0], g1[1]}, (f32x2){u1[0], u1[1]}, C1, KK), y3 = silu2((f32x2){g1[2], g1[3]}, (f32x2){u1[2], u1[3]}, C1, KK);
#define M448(v) __builtin_amdgcn_fmed3f((v), -448.f, 448.f)
                u32x2_t w; w.x = pk4_fp8(M448(y0.x), M448(y0.y), M448(y1.x), M448(y1.y)); w.y = pk4_fp8(M448(y2.x), M448(y2.y), M448(y3.x), M448(y3.y));
#undef M448
                *(u32x2_t*)rowp = w; }
    }
};
struct EpiMoeDown {
    static constexpr bool PERM = true, AFTER_DRAIN = false;
    bf16_t* Y; const float* gs; int pm0; float sc;
    __device__ __forceinline__ void operator()(const f32x4 (&acc)[2][2][4][2], const Unit& u, int wr, int wc, int fr, int fq) const {
        const int pnl = u.pn & 3; const int col0 = pnl * BM + wc * 32 + 8 * fq; const int row0 = (u.pm + pm0) * BM + wr * 64 + fr;
#pragma unroll
        for (int ai = 0; ai < 2; ++ai)
#pragma unroll
            for (int m = 0; m < 4; ++m) { const int row = row0 + ai * HALF + m * 16; const float g = gs[row] * sc; bf16_t* rowp = Y + (size_t)row * 1024 + col0;
#pragma unroll
                for (int bj = 0; bj < 2; ++bj) { const f32x4 v0 = acc[ai][bj][m][0] * g, v1 = acc[ai][bj][m][1] * g;
                    u32x4 w; w.x = cvt_pk_bf16(v0[0], v0[1]); w.y = cvt_pk_bf16(v0[2], v0[3]); w.z = cvt_pk_bf16(v1[0], v1[1]); w.w = cvt_pk_bf16(v1[2], v1[3]);
                    *(u32x4*)(rowp + bj * HALF) = w; } }
    }
};

struct EpiQKRope {
    static constexpr bool PERM = true, AFTER_DRAIN = false;
    bf16_t* O; const float* gq; const float* gk;
    static constexpr size_t HM = (size_t)65536 * 1024;
    __device__ __forceinline__ void operator()(const f32x4 (&acc)[2][2][4][2], const Unit& u, int wr, int wc, int fr, int fq) const {
        const int row0 = u.pm * BM + wr * 64 + fr;
        if (u.pn >= 8) {
#pragma unroll
            for (int ai = 0; ai < 2; ++ai)
#pragma unroll
                for (int m = 0; m < 4; ++m) { const int row = row0 + ai * HALF + m * 16; const size_t bt = (size_t)(row >> 12) * 16 * 4096 + (row & 4095);
#pragma unroll
                    for (int bj = 0; bj < 2; ++bj) { const f32x4 v0 = acc[ai][bj][m][0], v1 = acc[ai][bj][m][1]; const int head = (u.pn - 8) * 4 + 2 * bj + (wc >> 1);
                        u32x4 w; w.x = cvt_pk_bf16(v0[0], v0[1]); w.y = cvt_pk_bf16(v0[2], v0[3]); w.z = cvt_pk_bf16(v1[0], v1[1]); w.w = cvt_pk_bf16(v1[2], v1[3]);
                        *(u32x4*)(O + (size_t)2 * HM + (bt + (size_t)head * 4096) * 64 + 32 * (wc & 1) + 8 * fq) = w; } }
            return;
        }
        const bool isk = u.pn >= 4; const float* gp = isk ? gk : gq; const float qs = isk ? 1.0f : (0.125f * 1.4426950408889634f);
        const int head = 4 * (u.pn & 3) + wc; bf16_t* Ob = O + (isk ? HM : (size_t)0) + (size_t)head * 4096 * 64 + 8 * fq;
        float g1[8], g2[8], rv[8];
#pragma unroll
        for (int e = 0; e < 8; ++e) { g1[e] = gp[8 * fq + e] * qs; g2[e] = gp[32 + 8 * fq + e] * qs; rv[e] = __builtin_amdgcn_exp2f(-(float)(8 * fq + e) * (13.287712379549449f / 32.f)) * 0.15915494309189535f; }
#pragma unroll
        for (int ai = 0; ai < 2; ++ai)
#pragma unroll
            for (int m = 0; m < 4; ++m) { const int row = row0 + ai * HALF + m * 16; const float pos = (float)(row & 4095);
                float x1[8], x2[8]; float ss = 0.f;
#pragma unroll
                for (int n = 0; n < 2; ++n)
#pragma unroll
                    for (int i = 0; i < 4; ++i) { x1[4 * n + i] = acc[ai][0][m][n][i]; x2[4 * n + i] = acc[ai][1][m][n][i]; ss += x1[4 * n + i] * x1[4 * n + i] + x2[4 * n + i] * x2[4 * n + i]; }
                ss += __shfl_xor(ss, 16); ss += __shfl_xor(ss, 32);
                const float rs = __builtin_amdgcn_rsqf(ss * (1.f / 64.f) + 1e-6f);
                float o1[8], o2[8];
#pragma unroll
                for (int e = 0; e < 8; ++e) { const float fr_ = __builtin_amdgcn_fractf(pos * rv[e]); const float c = __builtin_amdgcn_cosf(fr_), s = __builtin_amdgcn_sinf(fr_);
                    const float a = x1[e] * rs * g1[e], b = x2[e] * rs * g2[e]; o1[e] = a * c - b * s; o2[e] = a * s + b * c; }
                bf16_t* rowp = Ob + ((size_t)(row >> 12) * 16 * 4096 + (row & 4095)) * 64;
                u32x4 w; w.x = cvt_pk_bf16(o1[0], o1[1]); w.y = cvt_pk_bf16(o1[2], o1[3]); w.z = cvt_pk_bf16(o1[4], o1[5]); w.w = cvt_pk_bf16(o1[6], o1[7]); *(u32x4*)rowp = w;
                w.x = cvt_pk_bf16(o2[0], o2[1]); w.y = cvt_pk_bf16(o2[2], o2[3]); w.z = cvt_pk_bf16(o2[4], o2[5]); w.w = cvt_pk_bf16(o2[6], o2[7]); *(u32x4*)(rowp + 32) = w; }
    }
};
struct EpiQKRopeI8 {
    static constexpr bool PERM = true, AFTER_DRAIN = false;
    bf16_t* O; const float* gq; const float* gk; const float* rowscale; const unsigned* wamax;
    static constexpr size_t HM = (size_t)65536 * 1024;
    __device__ __forceinline__ void operator()(const i32x4_t (&acc)[2][2][4][2], const Unit& u, int wr, int wc, int fr, int fq) const {
        const int row0 = u.pm * BM + wr * 64 + fr; const float ws_ = __builtin_bit_cast(float, *wamax) * (1.f / 127.f);
        if (u.pn >= 8) {
#pragma unroll
            for (int ai = 0; ai < 2; ++ai)
#pragma unroll
                for (int m = 0; m < 4; ++m) { const int row = row0 + ai * HALF + m * 16; const size_t bt = (size_t)(row >> 12) * 16 * 4096 + (row & 4095);
#pragma unroll
                    for (int bj = 0; bj < 2; ++bj) { const float s_ = rowscale[row] * ws_; const i32x4_t a0 = acc[ai][bj][m][0], a1 = acc[ai][bj][m][1]; const f32x4 v0 = (f32x4){(float)a0[0], (float)a0[1], (float)a0[2], (float)a0[3]} * s_, v1 = (f32x4){(float)a1[0], (float)a1[1], (float)a1[2], (float)a1[3]} * s_; const int head = (u.pn - 8) * 4 + 2 * bj + (wc >> 1);
                        u32x4 w; w.x = cvt_pk_bf16(v0[0], v0[1]); w.y = cvt_pk_bf16(v0[2], v0[3]); w.z = cvt_pk_bf16(v1[0], v1[1]); w.w = cvt_pk_bf16(v1[2], v1[3]);
                        *(u32x4*)(O + (size_t)2 * HM + (bt + (size_t)head * 4096) * 64 + 32 * (wc & 1) + 8 * fq) = w; } }
            return;
        }
        const bool isk = u.pn >= 4; const float* gp = isk ? gk : gq; const float qs = isk ? 1.0f : (0.125f * 1.4426950408889634f);
        const int head = 4 * (u.pn & 3) + wc; bf16_t* Ob = O + (isk ? HM : (size_t)0) + (size_t)head * 4096 * 64 + 8 * fq;
        float g1[8], g2[8], rv[8];
#pragma unroll
        for (int e = 0; e < 8; ++e) { g1[e] = gp[8 * fq + e] * qs; g2[e] = gp[32 + 8 * fq + e] * qs; rv[e] = __builtin_amdgcn_exp2f(-(float)(8 * fq + e) * (13.287712379549449f / 32.f)) * 0.15915494309189535f; }
#pragma unroll
        for (int ai = 0; ai < 2; ++ai)
#pragma unroll
            for (int m = 0; m < 4; ++m) { const int row = row0 + ai * HALF + m * 16; const float pos = (float)(row & 4095); const float s_ = rowscale[row] * ws_;
                float x1[8], x2[8]; float ss = 0.f;
#pragma unroll
                for (int n = 0; n < 2; ++n)
#pragma unroll
                    for (int i = 0; i < 4; ++i) { x1[4 * n + i] = (float)acc[ai][0][m][n][i] * s_; x2[4 * n + i] = (float)acc[ai][1][m][n][i] * s_; ss += x1[4 * n + i] * x1[4 * n + i] + x2[4 * n + i] * x2[4 * n + i]; }
                ss += __shfl_xor(ss, 16); ss += __shfl_xor(ss, 32);
                const float rs = __builtin_amdgcn_rsqf(ss * (1.f / 64.f) + 1e-6f);
                float o1[8], o2[8];
#pragma unroll
                for (int e = 0; e < 8; ++e) { const float fr_ = __builtin_amdgcn_fractf(pos * rv[e]); const float c = __builtin_amdgcn_cosf(fr_), s = __builtin_amdgcn_sinf(fr_);
                    const float a = x1[e] * rs * g1[e], b = x2[e] * rs * g2[e]; o1[e] = a * c - b * s; o2[e] = a * s + b * c; }
                bf16_t* rowp = Ob + ((size_t)(row >> 12) * 16 * 4096 + (row & 4095)) * 64;
                u32x4 w; w.x = cvt_pk_bf16(o1[0], o1[1]); w.y = cvt_pk_bf16(o1[2], o1[3]); w.z = cvt_pk_bf16(o1[4], o1[5]); w.w = cvt_pk_bf16(o1[6], o1[7]); *(u32x4*)rowp = w;
                w.x = cvt_pk_bf16(o2[0], o2[1]); w.y = cvt_pk_bf16(o2[2], o2[3]); w.z = cvt_pk_bf16(o2[4], o2[5]); w.w = cvt_pk_bf16(o2[6], o2[7]); *(u32x4*)(rowp + 32) = w; }
    }
};

struct EpiSwiGLUi8 {
    static constexpr bool PERM = true, AFTER_DRAIN = false;
    bf16_t* O; int ldo; const float* rowscale; const unsigned* wamax;
    __device__ __forceinline__ void operator()(const i32x4_t (&acc)[2][2][4][2], const Unit& u, int wr, int wc, int fr, int fq) const {
        const int col0 = u.pn * HALF + wc * 32 + 8 * fq; const int row0 = u.pm * BM + wr * 64 + fr;
        const float ws_ = __builtin_bit_cast(float, *wamax) * (1.f / 127.f);
#pragma unroll
        for (int ai = 0; ai < 2; ++ai)
#pragma unroll
            for (int m = 0; m < 4; ++m) { const int row = row0 + ai * HALF + m * 16; bf16_t* rowp = O + (size_t)row * ldo + col0;
                const float s = rowscale[row] * ws_; const float C1 = -1.4426950408889634f * s, KK = 1.0f / (s * s);
                const i32x4_t g0 = acc[ai][0][m][0], g1 = acc[ai][0][m][1], u0 = acc[ai][1][m][0], u1 = acc[ai][1][m][1];
                const f32x2 y0 = silu2((f32x2){(float)g0[0], (float)g0[1]}, (f32x2){(float)u0[0], (float)u0[1]}, C1, KK), y1 = silu2((f32x2){(float)g0[2], (float)g0[3]}, (f32x2){(float)u0[2], (float)u0[3]}, C1, KK);
                const f32x2 y2 = silu2((f32x2){(float)g1[0], (float)g1[1]}, (f32x2){(float)u1[0], (float)u1[1]}, C1, KK), y3 = silu2((f32x2){(float)g1[2], (float)g1[3]}, (f32x2){(float)u1[2], (float)u1[3]}, C1, KK);
                u32x4 w; w.x = cvt_pk_bf16(y0.x, y0.y); w.y = cvt_pk_bf16(y1.x, y1.y); w.z = cvt_pk_bf16(y2.x, y2.y); w.w = cvt_pk_bf16(y3.x, y3.y);
                *(u32x4*)rowp = w; }
    }
};

struct EpiSwiGLUi8f8 {
    static constexpr bool PERM = true, AFTER_DRAIN = false;
    unsigned char* O; int ldo; const float* rowscale; const unsigned* wamax;
    __device__ __forceinline__ void operator()(const i32x4_t (&acc)[2][2][4][2], const Unit& u, int wr, int wc, int fr, int fq) const {
        const int col0 = u.pn * HALF + wc * 32 + 8 * fq; const int row0 = u.pm * BM + wr * 64 + fr;
        const float ws_ = __builtin_bit_cast(float, *wamax) * (1.f / 127.f);
#pragma unroll
        for (int ai = 0; ai < 2; ++ai)
#pragma unroll
            for (int m = 0; m < 4; ++m) { const int row = row0 + ai * HALF + m * 16; unsigned char* rowp = O + (size_t)row * ldo + col0;
                const float s = rowscale[row] * ws_; const float C1 = -1.4426950408889634f * s, KK = 1.0f / (s * s * F8_AS);
                const i32x4_t g0 = acc[ai][0][m][0], g1 = acc[ai][0][m][1], u0 = acc[ai][1][m][0], u1 = acc[ai][1][m][1];
                const f32x2 y0 = silu2((f32x2){(float)g0[0], (float)g0[1]}, (f32x2){(float)u0[0], (float)u0[1]}, C1, KK), y1 = silu2((f32x2){(float)g0[2], (float)g0[3]}, (f32x2){(float)u0[2], (float)u0[3]}, C1, KK);
                const f32x2 y2 = silu2((f32x2){(float)g1[0], (float)g1[1]}, (f32x2){(float)u1[0], (float)u1[1]}, C1, KK), y3 = silu2((f32x2){(float)g1[2], (float)g1[3]}, (f32x2){(float)u1[2], (float)u1[3]}, C1, KK);
#define M448(v) __builtin_amdgcn_fmed3f((v), -448.f, 448.f)
                u32x2_t w; w.x = pk4_fp8(M448(y0.x), M448(y0.y), M448(y1.x), M448(y1.y)); w.y = pk4_fp8(M448(y2.x), M448(y2.y), M448(y3.x), M448(y3.y));
#undef M448
                *(u32x2_t*)rowp = w; }
    }
};

struct EpiBf16I8 {
    static constexpr bool PERM = true, AFTER_DRAIN = false;
    bf16_t* O; int ldc; const float* rowscale; const unsigned* wamax;
    __device__ __forceinline__ void operator()(const i32x4_t (&acc)[2][2][4][2], const Unit& u, int wr, int wc, int fr, int fq) const {
        const int row0 = u.pm * BM + wr * 64 + fr; const int col0 = u.pn * BM + wc * 32 + 8 * fq; const float ws_ = __builtin_bit_cast(float, *wamax) * (1.f / 127.f);
#pragma unroll
        for (int ai = 0; ai < 2; ++ai)
#pragma unroll
            for (int m = 0; m < 4; ++m) { const int row = row0 + ai * HALF + m * 16; const float s_ = rowscale[row] * ws_; bf16_t* rowp = O + (size_t)row * ldc + col0;
#pragma unroll
                for (int bj = 0; bj < 2; ++bj) { const i32x4_t a0 = acc[ai][bj][m][0], a1 = acc[ai][bj][m][1];
                    u32x4 w; w.x = cvt_pk_bf16((float)a0[0] * s_, (float)a0[1] * s_); w.y = cvt_pk_bf16((float)a0[2] * s_, (float)a0[3] * s_); w.z = cvt_pk_bf16((float)a1[0] * s_, (float)a1[1] * s_); w.w = cvt_pk_bf16((float)a1[2] * s_, (float)a1[3] * s_);
                    *(u32x4*)(rowp + bj * HALF) = w; } }
    }
};
struct MoeOrder {
    StaticOrder so; int nN, pmA, tile0; int pends[8];
    __device__ void init(int nM_, int nN_, int G_, int c_, int pmA_, int tile0_, const int* pe) { so.nM = nM_; so.nN = nN_; so.nwg = nM_ * nN_; so.G = G_; so.c = c_; nN = nN_; pmA = pmA_; tile0 = tile0_;
#pragma unroll
        for (int j = 0; j < 8; ++j) pends[j] = __builtin_amdgcn_readfirstlane(pe[j]); }
    __device__ bool next(int i, Unit& u) const {
        Unit v; if (!so.next(i, v)) return false;
        const int r0 = (tile0 + v.pm) * BM; int e = 0;
#pragma unroll
        for (int j = 0; j < 7; ++j) e += (r0 >= pends[j]) ? 1 : 0;
        u.pm = v.pm + pmA; u.pn = e * nN + v.pn; return true;
    }
    __device__ __forceinline__ void a_ready(const Unit&) const {}
    __device__ __forceinline__ void done(const Unit&) const {}
};
}

__device__ __forceinline__ void r7_phase(const Args& a, unsigned char* lds_g, int vcu, int G, int tid, int wave, int lane) {
    unsigned char* ws = a.ws; const bf16* x = (const bf16*)a.out; const float* router = a.in[I_ROUTER];
    int* topk = (int*)(ws + WS_TOPK); float* gates = (float*)(ws + WS_GATES); int* blkcnt = (int*)(ws + WS_BLKCNT);
    int* hist = (int*)lds_g;
    float rw[4][4][8];
#pragma unroll
    for (int j = 0; j < 4; ++j)
#pragma unroll
        for (int i = 0; i < 4; ++i) { const int col = 4 * lane + 256 * j + i; const f32x4 r0 = *(const f32x4*)(router + col * 8), r1 = *(const f32x4*)(router + col * 8 + 4);
            rw[j][i][0] = r0.x; rw[j][i][1] = r0.y; rw[j][i][2] = r0.z; rw[j][i][3] = r0.w; rw[j][i][4] = r1.x; rw[j][i][5] = r1.y; rw[j][i][6] = r1.z; rw[j][i][7] = r1.w; }
    const modw_t* mod = (const modw_t*)(ws + WS_MOD) + 16 * 6144;
    for (int blk = vcu; blk < 256; blk += G) {
        if (tid < 8) hist[tid] = 0;
        __syncthreads();
        const int b = blk >> 4; ModPar mp; load_modpar(mp, a.in[I_NORM_O_FFN], mod + b * 6144, 3, 4, lane);
        unsigned long long cnt = 0ull;
#pragma unroll 2
        for (int r = 0; r < 32; ++r) { const int row = blk * 256 + wave * 32 + r; f32x4 h[4]; mod_row_f32<true>(x + (size_t)row * XP, mp, h, lane);
            store_row_fp8(ws + A_HP + (size_t)row * 1024, h, lane);
            float lg[8];
#pragma unroll
            for (int e = 0; e < 8; ++e) { float s = 0.f;
#pragma unroll
                for (int j = 0; j < 4; ++j) s += (h[j].x * rw[j][0][e] + h[j].y * rw[j][1][e]) + (h[j].z * rw[j][2][e] + h[j].w * rw[j][3][e]);
                lg[e] = wave_sum(s); }
            int e1 = 0; float v1 = lg[0];
#pragma unroll
            for (int e = 1; e < 8; ++e) if (lg[e] > v1) { v1 = lg[e]; e1 = e; }
            int e2 = -1; float v2 = -INFINITY;
#pragma unroll
            for (int e = 0; e < 8; ++e) if (e != e1 && lg[e] > v2) { v2 = lg[e]; e2 = e; }
            e1 = __builtin_amdgcn_readfirstlane(e1); e2 = __builtin_amdgcn_readfirstlane(e2);
            const float g1 = 1.0f / (1.0f + __expf(v2 - v1)), g2 = 1.0f - g1;
            if (lane == 0) { topk[row] = e1 | (e2 << 8); gates[2 * row] = g1; gates[2 * row + 1] = g2; }
            cnt += (1ull << (8 * e1)) + (1ull << (8 * e2));
        }
        if (lane < 8) atomicAdd(&hist[lane], (int)((cnt >> (8 * lane)) & 255ull));
        __syncthreads();
        if (tid < 8) blkcnt[blk * 8 + tid] = hist[tid];
        __syncthreads();
    }
}

__device__ __forceinline__ void r8_phase(const Args& a, unsigned char* lds_g, int vcu, int G, int tid, int wave, int lane) {
    unsigned char* ws = a.ws;
    const int* topk = (const int*)(ws + WS_TOPK); const float* gates = (const float*)(ws + WS_GATES); const int* blkcnt = (const int*)(ws + WS_BLKCNT);
    int* slots = (int*)(ws + WS_SLOTS); float* gslot = (float*)(ws + WS_GSLOT); int* pends_g = (int*)(ws + WS_PENDS); int* tokslot = (int*)(ws + WS_TOKSLOT);
    int* tot = (int*)lds_g; int* base = tot + 8; int* pst = tot + 16; int* wcnt = tot + 32;
    if (tid < 8) tot[tid] = 0;
    __syncthreads();
    for (int idx = tid; idx < 2048; idx += 512) atomicAdd(&tot[idx & 7], blkcnt[idx]);
    __syncthreads();
    if (tid == 0) { int p = 0; for (int e = 0; e < 8; ++e) { pst[e] = p; p += (tot[e] + 255) & ~255; if (vcu == 0) pends_g[e] = p; } }
    __syncthreads();
    if (vcu < 8) { const int e = vcu, lo = pst[e] + tot[e], hi = pst[e] + ((tot[e] + 255) & ~255);
        for (int s = lo + tid; s < hi; s += NWAVES * 64) { tokslot[s] = 0; gslot[s] = 0.f; } }
    for (int blk = vcu; blk < 256; blk += G) {
        if (tid < 8) base[tid] = 0;
        __syncthreads();
        for (int idx = tid; idx < 2048; idx += 512) if ((idx >> 3) < blk) atomicAdd(&base[idx & 7], blkcnt[idx]);
        const int token = blk * 256 + (tid >> 1), k = tid & 1; const int pk = topk[token]; const int ea = k ? ((pk >> 8) & 255) : (pk & 255);
        int rank = 0;
#pragma unroll
        for (int e = 0; e < 8; ++e) { const unsigned long long mask = __ballot(ea == e); if (ea == e) rank = __popcll(mask & ((1ull << lane) - 1ull)); if (lane == 0) wcnt[wave * 8 + e] = __popcll(mask); }
        __syncthreads();
        int s = pst[ea] + base[ea] + rank;
        for (int w = 0; w < wave; ++w) s += wcnt[w * 8 + ea];
        slots[token * 2 + k] = s; gslot[s] = gates[token * 2 + k]; tokslot[s] = token;
        __syncthreads();
    }
}

__device__ __forceinline__ void r9_phase(const Args& a, int gw, int NGW, int lane) {
    unsigned char* ws = a.ws; float* out = a.out; const int* slots = (const int*)(ws + WS_SLOTS); const bf16* Y = (const bf16*)(ws + A_Y);
    const modw_t* mod = (const modw_t*)(ws + WS_MOD) + 16 * 6144;
    for (int bi = gw; bi < T / 32; bi += NGW) {
        const int b = bi >> 7; f32x4 gt[4];
#pragma unroll
        for (int j = 0; j < 4; ++j) gt[j] = modv4(mod + b * 6144 + 5 * 1024 + 4 * lane + 256 * j);
        for (int r = 0; r < 32; ++r) { const int row = bi * 32 + r; const int s1 = slots[2 * row], s2 = slots[2 * row + 1];
            const uint2* y1 = (const uint2*)(Y + (size_t)s1 * 1024) + lane; const uint2* y2 = (const uint2*)(Y + (size_t)s2 * 1024) + lane;
            const uint2* xb = (const uint2*)((const bf16*)out + (size_t)row * XP) + lane; f32x4* o = (f32x4*)(out + (size_t)row * 1024) + lane;
            f32x4 v[4];
#pragma unroll
            for (int j = 0; j < 4; ++j) { const uint2 p = y1[64 * j], q = y2[64 * j], x3 = xb[64 * j];
                v[j].x = bflo(x3.x) + gt[j].x * (bflo(p.x) + bflo(q.x)); v[j].y = bfhi(x3.x) + gt[j].y * (bfhi(p.x) + bfhi(q.x)); v[j].z = bflo(x3.y) + gt[j].z * (bflo(p.y) + bflo(q.y)); v[j].w = bfhi(x3.y) + gt[j].w * (bfhi(p.y) + bfhi(q.y)); }
            asm volatile("s_waitcnt vmcnt(0)" ::: "memory");
#pragma unroll
            for (int j = 0; j < 4; ++j) o[64 * j] = v[j];
            asm volatile("" ::: "memory"); }
    }
}

#ifndef MK_PER_PHASE
#define MK_PER_PHASE 0
#endif
__global__ void __launch_bounds__(NWAVES * 64, 2) mega_fwd(Args args) {
    extern __shared__ __attribute__((aligned(16))) unsigned char lds_raw[];
    LAS unsigned char* lds = (LAS unsigned char*)lds_raw;
    volatile LAS unsigned* MISC = (volatile LAS unsigned*)(lds + MISC_OFF);
    const int G = gridDim.x, bx = blockIdx.x; const int vcu = (G % 8 == 0) ? (bx % 8) * (G / 8) + bx / 8 : bx;
    const int NGW = G * NWAVES;
    unsigned char* ws = args.ws;
    for (int u = threadIdx.x; u < (LDS_BYTES - LDS_ZERO_OFF) / 4; u += NWAVES * 64) ((LAS unsigned*)(lds + LDS_ZERO_OFF))[u] = 0u;
#define IDS() int tid = threadIdx.x; asm volatile("" : "+v"(tid)); const int lane = tid & 63, wave = __builtin_amdgcn_readfirstlane(tid >> 6); const int gw = vcu * NWAVES + wave; (void)lane; (void)gw
    __syncthreads();
    XcdBarrier bar; bar.bar = (unsigned*)(ws + WS_CTL) + CW_BAR; bar.x = 0; bar.st = nullptr;
    if (!MK_PER_PHASE) bar = xcd_barrier_post((unsigned*)(ws + WS_CTL) + CW_BAR, MISC + 8);
    const int lo = args.ph_lo, hi = args.ph_hi;
#define IN(k) (lo <= (k) && (k) < hi)
#ifndef PROBE_REP
#define PROBE_REP 0u
#endif
#ifndef PROBE_REPN
#define PROBE_REPN 1
#endif
#define PREP(k) for (int rp_ = 0; rp_ < 1 + PROBE_REPN * (int)((PROBE_REP >> (k)) & 1u); ++rp_)
#define SEAM(k) do { if (!MK_PER_PHASE) { if (IN(k) && IN((k) + 1)) xcd_barrier(bar); } } while (0)
    const bool ROWLOCAL = false && (G * 256 == T);
#define LOCAL_SEAM() do { __builtin_amdgcn_fence(__ATOMIC_RELEASE, "agent"); asm volatile("s_waitcnt vmcnt(0)" ::: "memory"); __syncthreads(); __builtin_amdgcn_fence(__ATOMIC_ACQUIRE, "agent"); } while (0)
    const modw_t* mod_e = (const modw_t*)(ws + WS_MOD); const modw_t* mod_o = mod_e + 16 * 6144;
    bf16* H = (bf16*)(ws + A_H);
    bf16* XB = (bf16*)args.out;

    if (IN(0)) { IDS(); p0_prologue(args, lds, gw, NGW, wave, lane); } SEAM(0);
    if (IN(1)) PREP(1) { IDS(); modulate_phase<false, false, true>(args.in[I_X], args.in[I_NORM_E_MIX], mod_e, 0, 1, H, gw, NGW, lane, (float*)(ws + WS_ROWSC));
#if FFN_FP8 == 0 || FFN_FP8 == 3
        {
            LAS float* scr = (LAS float*)(lds + wave * 16384); const float wsc = 127.f / fmaxf(__builtin_bit_cast(float, *(const unsigned*)(ws + WS_WAMAX)), 1e-30f);
            for (int it = gw; it < 2 * 1408; it += NGW) { const bool up = it >= 1408; tr_gu_i8(args.in[up ? I_FFN_U : I_FFN_G], 1024, 2816, ws + W_GU, up ? 128 : 0, wsc, up ? it - 1408 : it, scr, lane); }
            const float wsi = 127.f / fmaxf(__builtin_bit_cast(float, *((const unsigned*)(ws + WS_WAMAX) + 2)), 1e-30f);
            for (int it = gw; it < 16 * 37; it += NGW) { const int kb = it / 37, nb = it % 37; transpose_item_i8(args.in[I_W_IN], 1184, 64 * kb, 32 * nb, ws + W_IN + (size_t)(32 * nb) * 1024, 1024, wsi, scr, lane); }
            const float wsq = 127.f / fmaxf(__builtin_bit_cast(float, *((const unsigned*)(ws + WS_WAMAX) + 1)), 1e-30f);
            for (int it = gw; it < 16 * 96; it += NGW) { const int kb = it / 96, nb = it % 96, n0 = 32 * nb; int drow = n0;
                if (n0 < 2048) { const int tt = n0 >> 8, wc_ = (n0 & 255) >> 6, bj = (n0 & 63) >> 5; drow = tt * 256 + bj * 128 + wc_ * 32; }
                transpose_item_i8(args.in[I_DIL_QKV], 3072, 64 * kb, n0, ws + W_QKV + (size_t)drow * 1024, 1024, wsq, scr, lane); }
        }
#endif
    } SEAM(1);
    if (IN(2)) { pg8::Gemm g{H, (const bf16*)(ws + W_IN), T, 1280, 512}; pg8::StaticOrder S; S.init(T, 1280, G, bx);
        pg8::EpiBf16I8 E{(bf16*)(ws + A_P), 1280, (const float*)(ws + WS_ROWSC), (const unsigned*)(ws + WS_WAMAX) + 2};
        pg8::gemm_phase_i8<pg8::EpiBf16I8, pg8::StaticOrder, true, true>(lds, g, S, E); } SEAM(2);
    if (IN(3)) PREP(3) { IDS(); r2_phase(args, gw, NGW, lane); } SEAM(3);
    if (IN(4)) {
        { pg8::Gemm g{(const bf16*)(ws + A_CQ), (const bf16*)(ws + W_UQ), T, 768, 256}; pg8::StaticOrder S; S.init(T, 768, G, bx);
          pg8::EpiBf16<0> E{(bf16*)(ws + A_QA), 768, nullptr, 0, 0, 1.f};
          pg8::gemm_phase<pg8::EpiBf16<0>, pg8::StaticOrder, true, true>(lds, g, S, E); }
        __syncthreads();
        { pg8::Gemm g{(const bf16*)(ws + A_CKV), (const bf16*)(ws + W_UKV), T, 1024, 128}; pg8::StaticOrder S; S.init(T, 1024, G, bx);
          pg8::EpiBf16<0> E{(bf16*)(ws + A_KV), 512, nullptr, 512, (size_t)T * 512, 1.f};
          pg8::gemm_phase<pg8::EpiBf16<0>, pg8::StaticOrder, true, true>(lds, g, S, E); }
    } SEAM(4);
    if (IN(5)) PREP(5) { IDS(); r3_phase(args, gw, NGW, lane); } SEAM(5);
    if (IN(6)) PREP(6) {
        bf16* ATT = (bf16*)(ws + A_ATT0);
        const float bndA = 96.f * att::wave_absmax(args.in[I_MLA_QG], 96) * att::wave_absmax(args.in[I_MLA_KG], 96) * QSCALE_A;
        const float bndB = 64.f * att::wave_absmax(args.in[I_GQA_QG], 64) * att::wave_absmax(args.in[I_GQA_KG], 64) * QSCALE_B;
        for (int L = vcu; L < 2048; L += G) {
            const int u = L & 2047, b = u >> 7, h = (u >> 4) & 7, qb = u & 15; const size_t r0 = (size_t)b * SEQ, rq = r0 + 256 * qb;
            if (bndA < 64.f) att::attn_dense_fast<96>((const bf16*)(ws + A_QA) + rq * 768 + h * 96, 768, args.in[I_MLA_QG], 256 * qb, (const bf16*)(ws + A_KA) + r0 * 768 + h * 96, 768, (const bf16*)(ws + A_KV) + (size_t)T * 512 + r0 * 512 + h * 64, 512,
                                              64, ATT + rq * 1024 + h * 64, 1024, (LAS char*)lds);
            else att::attn_dense<96>((const bf16*)(ws + A_QA) + rq * 768 + h * 96, 768, args.in[I_MLA_QG], 256 * qb, (const bf16*)(ws + A_KA) + r0 * 768 + h * 96, 768, (const bf16*)(ws + A_KV) + (size_t)T * 512 + r0 * 512 + h * 64, 512,
                                              64, ATT + rq * 1024 + h * 64, 1024, (LAS char*)lds);
        }
        for (int L = vcu; L < 2048; L += G) {
            const int u = L & 2047, b = u >> 7, h = (u >> 4) & 7, qb = u & 15; const size_t r0 = (size_t)b * SEQ, rq = r0 + 256 * qb;
            if (bndB < 64.f) att::attn_dense_fast<64>((const bf16*)(ws + A_P) + rq * 1280 + 416 + h * 64, 1280, args.in[I_GQA_QG], 256 * qb, (const bf16*)(ws + A_KB) + r0 * 128 + (h >> 2) * 64, 128, (const bf16*)(ws + A_P) + r0 * 1280 + 1056 + (h >> 2) * 64, 1280,
                                     64, ATT + rq * 1024 + 512 + h * 64, 1024, (LAS char*)lds);
            else att::attn_dense<64>((const bf16*)(ws + A_P) + rq * 1280 + 416 + h * 64, 1280, args.in[I_GQA_QG], 256 * qb, (const bf16*)(ws + A_KB) + r0 * 128 + (h >> 2) * 64, 128, (const bf16*)(ws + A_P) + r0 * 1280 + 1056 + (h >> 2) * 64, 1280,
                                     64, ATT + rq * 1024 + 512 + h * 64, 1024, (LAS char*)lds);
        }
    } SEAM(6);
    if (IN(7)) { pg8::Gemm g{(const bf16*)(ws + A_ATT0), (const bf16*)(ws + W_OUT), T, 1024, 1024}; pg8::StaticOrder S; S.init(T, 1024, G, bx);
        pg8::EpiResB<true> E{args.in[I_X], XB, mod_e + 2 * 1024, 1.f};
        pg8::gemm_phase<pg8::EpiResB<true>, pg8::StaticOrder, true, true>(lds, g, S, E); } SEAM(7);
#if FFN_FP8 == 1
    if (IN(8)) { IDS(); modulate_phase<true, true>(XB, args.in[I_NORM_E_FFN], mod_e, 3, 4, H, gw, NGW, lane); } SEAM(8);
    if (IN(9)) { pg8::Gemm g{H, (const bf16*)(ws + W_GU), T, 5632, 512}; pg8::StaticOrder S; S.init(T, 5632, G, bx);
        pg8::EpiSwiGLU8 E{ws + A_ACT, 2816, 1 << 30, 0, 1.0f / (F8_HS * F8_WS)};
        pg8::gemm_phase8<pg8::EpiSwiGLU8, pg8::StaticOrder, true, true>(lds, g, S, E); } SEAM(9);
    if (IN(10)) { pg8::Gemm g{(const bf16*)(ws + A_ACT), (const bf16*)(ws + W_D), T, 1024, 1408}; pg8::StaticOrder S; S.init(T, 1024, G, bx);
        pg8::EpiResB<false> E{XB, XB, mod_e + 5 * 1024, 1.0f / (F8_AS * F8_WS)};
        pg8::gemm_phase8<pg8::EpiResB<false>, pg8::StaticOrder, true, true>(lds, g, S, E); } SEAM(10);
#elif FFN_FP8 == 2
    if (IN(8)) { IDS(); modulate_phase<false, true>(XB, args.in[I_NORM_E_FFN], mod_e, 3, 4, H, gw, NGW, lane); } SEAM(8);
    if (IN(9)) { pg8::Gemm g{H, (const bf16*)(ws + W_GU), T, 5632, 1024}; pg8::StaticOrder S; S.init(T, 5632, G, bx);
        pg8::EpiSwiGLU8 E{ws + A_ACT, 2816, 1 << 30, 0, 1.0f};
        pg8::gemm_phase<pg8::EpiSwiGLU8, pg8::StaticOrder, true, true>(lds, g, S, E); } SEAM(9);
    if (IN(10)) { pg8::Gemm g{(const bf16*)(ws + A_ACT), (const bf16*)(ws + W_D), T, 1024, 1408}; pg8::StaticOrder S; S.init(T, 1024, G, bx);
        pg8::EpiResB<false> E{XB, XB, mod_e + 5 * 1024, 1.0f / (F8_AS * F8_WS)};
        pg8::gemm_phase8<pg8::EpiResB<false>, pg8::StaticOrder, true, true>(lds, g, S, E); } SEAM(10);
#elif FFN_FP8 == 3
    if (IN(8)) PREP(8) { IDS(); modulate_phase<false, true, true>(XB, args.in[I_NORM_E_FFN], mod_e, 3, 4, H, gw, NGW, lane, (float*)(ws + WS_ROWSC)); }
    if (ROWLOCAL) { if (!MK_PER_PHASE && IN(8) && IN(9)) LOCAL_SEAM(); } else SEAM(8);
    if (IN(9)) { pg8::Gemm g{H, (const bf16*)(ws + W_GU), T, 5632, 512};
        pg8::EpiSwiGLUi8f8 E{ws + A_ACT, 2816, (const float*)(ws + WS_ROWSC), (const unsigned*)(ws + WS_WAMAX)};
        if (ROWLOCAL) { pg8::RowLocalOrder S; S.init(T, 5632, G, vcu); pg8::gemm_phase_i8<pg8::EpiSwiGLUi8f8, pg8::RowLocalOrder, true, true>(lds, g, S, E); }
        else { pg8::StaticOrder S; S.init(T, 5632, G, bx); pg8::gemm_phase_i8<pg8::EpiSwiGLUi8f8, pg8::StaticOrder, true, true>(lds, g, S, E); } } SEAM(9);
    if (IN(10)) { pg8::Gemm g{(const bf16*)(ws + A_ACT), (const bf16*)(ws + W_D), T, 1024, 1408}; pg8::StaticOrder S; S.init(T, 1024, G, bx);
        pg8::EpiResB<false> E{XB, XB, mod_e + 5 * 1024, 1.0f / (F8_AS * F8_WS)};
        pg8::gemm_phase8<pg8::EpiResB<false>, pg8::StaticOrder, true, true>(lds, g, S, E); } SEAM(10);
#else
    if (IN(8)) { IDS(); modulate_phase<false, true, true>(XB, args.in[I_NORM_E_FFN], mod_e, 3, 4, H, gw, NGW, lane, (float*)(ws + WS_ROWSC)); } SEAM(8);
    if (IN(9)) { pg8::Gemm g{H, (const bf16*)(ws + W_GU), T, 5632, 512}; pg8::StaticOrder S; S.init(T, 5632, G, bx);
        pg8::EpiSwiGLUi8 E{(bf16*)(ws + A_ACT), 2816, (const float*)(ws + WS_ROWSC), (const unsigned*)(ws + WS_WAMAX)};
        pg8::gemm_phase_i8<pg8::EpiSwiGLUi8, pg8::StaticOrder, true, true>(lds, g, S, E); } SEAM(9);
    if (IN(10)) { pg8::Gemm g{(const bf16*)(ws + A_ACT), (const bf16*)(ws + W_D), T, 1024, 2816}; pg8::StaticOrder S; S.init(T, 1024, G, bx);
        pg8::EpiResB<false> E{XB, XB, mod_e + 5 * 1024, 1.f};
        pg8::gemm_phase<pg8::EpiResB<false>, pg8::StaticOrder, true, true>(lds, g, S, E); } SEAM(10);
#endif
    if (IN(11)) PREP(11) { IDS(); modulate_phase<false, true, true>(XB, args.in[I_NORM_O_MIX], mod_o, 0, 1, H, gw, NGW, lane, (float*)(ws + WS_ROWSC)); }
    if (ROWLOCAL) { if (!MK_PER_PHASE && IN(11) && IN(12)) LOCAL_SEAM(); } else SEAM(11);
    if (IN(12)) { pg8::Gemm g{H, (const bf16*)(ws + W_QKV), T, 3072, 512};
        pg8::EpiQKRopeI8 E{(bf16*)(ws + A_QKV), args.in[I_DIL_QG], args.in[I_DIL_KG], (const float*)(ws + WS_ROWSC), (const unsigned*)(ws + WS_WAMAX) + 1};
        if (ROWLOCAL) { pg8::RowLocalOrder S; S.init(T, 3072, G, vcu); pg8::gemm_phase_i8<pg8::EpiQKRopeI8, pg8::RowLocalOrder, true, true>(lds, g, S, E); }
        else { pg8::StaticOrder S; S.init(T, 3072, G, bx); pg8::gemm_phase_i8<pg8::EpiQKRopeI8, pg8::StaticOrder, true, true>(lds, g, S, E); } }
      SEAM(13);
    if (IN(14)) PREP(14) {
        constexpr size_t HM = (size_t)T * 1024;
        const bf16* QH = (const bf16*)(ws + A_QKV); bf16* O1H = (bf16*)(ws + A_H); bf16* O2H = (bf16*)(ws + A_O2); float* L1 = (float*)(ws + A_LSE1); float* L2 = (float*)(ws + A_LSE2); bf16* ATT = (bf16*)(ws + A_ATT1);
        const float bndC = 64.f * att::wave_absmax(args.in[I_DIL_QG], 64) * att::wave_absmax(args.in[I_DIL_KG], 64) * QSCALE_B;
        for (int bh = vcu; bh < 256; bh += G) {
            const int b = bh >> 4, h = bh & 15; const size_t hb = (size_t)bh * 4096 * 64;
            const bf16* Qb_ = QH + hb; const bf16* Kb_ = QH + HM + hb; const bf16* Vb_ = QH + 2 * HM + hb;
            if (bndC < 100.f) {
            att::band_phase<false, true>(Qb_, Kb_, Vb_, 1, O1H + hb, 64, L1 + (size_t)bh * 4096, nullptr, nullptr, nullptr, nullptr, (LAS char*)lds);
            att::band_phase<false, true>(Qb_, Kb_, Vb_, 4, O2H + hb, 64, L2 + (size_t)bh * 4096, nullptr, nullptr, nullptr, nullptr, (LAS char*)lds);
            asm volatile("s_waitcnt vmcnt(0)" ::: "memory"); __syncthreads();
            att::band_phase<true, true>(Qb_, Kb_, Vb_, 16, ATT + (size_t)b * SEQ * 1024 + h * 64, 1024, nullptr, O1H + hb, O2H + hb, L1 + (size_t)bh * 4096, L2 + (size_t)bh * 4096, (LAS char*)lds);
            } else {
            att::band_phase<false, false>(Qb_, Kb_, Vb_, 1, O1H + hb, 64, L1 + (size_t)bh * 4096, nullptr, nullptr, nullptr, nullptr, (LAS char*)lds);
            att::band_phase<false, false>(Qb_, Kb_, Vb_, 4, O2H + hb, 64, L2 + (size_t)bh * 4096, nullptr, nullptr, nullptr, nullptr, (LAS char*)lds);
            asm volatile("s_waitcnt vmcnt(0)" ::: "memory"); __syncthreads();
            att::band_phase<true, false>(Qb_, Kb_, Vb_, 16, ATT + (size_t)b * SEQ * 1024 + h * 64, 1024, nullptr, O1H + hb, O2H + hb, L1 + (size_t)bh * 4096, L2 + (size_t)bh * 4096, (LAS char*)lds);
            }
        }
    }
      SEAM(15);
    if (IN(16)) { pg8::Gemm g{(const bf16*)(ws + A_ATT1), (const bf16*)(ws + W_DO), T, 1024, 1024}; pg8::StaticOrder S; S.init(T, 1024, G, bx);
        pg8::EpiResB<false> E{XB, XB, mod_o + 2 * 1024, 1.f};
        pg8::gemm_phase<pg8::EpiResB<false>, pg8::StaticOrder, true, true>(lds, g, S, E); } SEAM(16);
    if (IN(17)) PREP(17) { IDS(); r7_phase(args, lds_raw, vcu, G, tid, wave, lane); } SEAM(17);
    if (IN(18)) { IDS(); r8_phase(args, lds_raw, vcu, G, tid, wave, lane); } SEAM(18);
    {
        const int* pe = (const int*)(ws + WS_PENDS);
        if (IN(19)) { const int ntot = __builtin_amdgcn_readfirstlane(pe[7]) >> 8;
            pg8::GemmG g{ws + A_HP, (const bf16*)(ws + W_MGU), (const int*)(ws + WS_TOKSLOT), 512, 1024}; pg8::MoeOrder S; S.init(ntot, 28, G, bx, 0, 0, pe);
            pg8::EpiSwiGLU8 E{ws + A_ACTM, 3584, 28, 0, 1.0f / (F8_HS * F8_WS)};
            pg8::gemm_phase8g<pg8::EpiSwiGLU8, pg8::MoeOrder, true, true>(lds, g, S, E); }
        SEAM(19);
        if (IN(20)) { const int ntot = __builtin_amdgcn_readfirstlane(pe[7]) >> 8;
            pg8::Gemm g{(const bf16*)(ws + A_ACTM), (const bf16*)(ws + W_MD), 0, 0, 1792}; pg8::MoeOrder S; S.init(ntot, 4, G, bx, 0, 0, pe);
            pg8::EpiMoeDown E{(bf16*)(ws + A_Y), (const float*)(ws + WS_GSLOT), 0, 1.0f / (F8_AS * F8_WS)};
            pg8::gemm_phase8<pg8::EpiMoeDown, pg8::MoeOrder, true, true>(lds, g, S, E); }
        if (!MK_PER_PHASE) { if (IN(20) && IN(27)) xcd_barrier(bar); }
    }
    if (IN(27)) { IDS(); r9_phase(args, gw, NGW, lane); }
#undef IN
#undef SEAM
}

extern "C" void kernel_launch(void* const* d_in, const int* in_sizes, int n_in, void* d_out, int out_size, void* d_ws, size_t ws_size, hipStream_t stream) {
    static int grid = 0;
    if (grid == 0) {
        if (n_in != 31 || in_sizes[0] != T * DM || out_size != T * DM || ws_size < WS_NEED) {
            fprintf(stderr, "kernel_launch: expected 31 inputs, x/out of %d floats, >= %zu bytes of workspace; got n_in %d in0 %d out %d ws %zu\n", T * DM, (size_t)WS_NEED, n_in, n_in > 0 ? in_sizes[0] : -1, out_size, ws_size);
            grid = -1; return; }
        int dev = 0, cus = 0, per_cu = 0;
        if (hipGetDevice(&dev) != hipSuccess || hipDeviceGetAttribute(&cus, hipDeviceAttributeMultiprocessorCount, dev) != hipSuccess) { grid = -1; return; }
        if (hipFuncSetAttribute((const void*)mega_fwd, hipFuncAttributeMaxDynamicSharedMemorySize, LDS_BYTES) != hipSuccess) { fprintf(stderr, "kernel_launch: hipFuncSetAttribute failed\n"); grid = -1; return; }
        if (hipOccupancyMaxActiveBlocksPerMultiprocessor(&per_cu, (const void*)mega_fwd, NWAVES * 64, LDS_BYTES) != hipSuccess || per_cu < 1)
            fprintf(stderr, "kernel_launch: note: occupancy query reports %d workgroups per CU\n", per_cu);
        (void)hipGetLastError();
        grid = cus;
    }
    if (grid < 0) return;
    if (hipMemsetAsync((char*)d_ws + WS_CTL, 0, CTL_ZERO_BYTES, stream) != hipSuccess) { fprintf(stderr, "kernel_launch: memset failed\n"); return; }
    Args a{};
    for (int i = 0; i < 31; ++i) a.in[i] = (const float*)d_in[i];
    a.out = (float*)d_out; a.ws = (unsigned char*)d_ws;
#if MK_PER_PHASE
#ifndef REPMASK
#define REPMASK 0u
#endif
    for (int p = 0; p < NPH; ++p) { a.ph_lo = p; a.ph_hi = p + 1; hipLaunchKernelGGL(mega_fwd, dim3(grid), dim3(NWAVES * 64), LDS_BYTES, stream, a);
        if ((REPMASK >> p) & 1u) hipLaunchKernelGGL(mega_fwd, dim3(grid), dim3(NWAVES * 64), LDS_BYTES, stream, a); }
#else
    a.ph_lo = 0; a.ph_hi = NPH;
    hipLaunchKernelGGL(mega_fwd, dim3(grid), dim3(NWAVES * 64), LDS_BYTES, stream, a);
#endif
    const hipError_t le = hipPeekAtLastError();
    if (le != hipSuccess) fprintf(stderr, "kernel_launch: launch failed: %s\n", hipGetErrorName(le));
}
```

```cpp
#define MK_PER_PHASE 0
#define REPMASK 0u
#define BAND_REP 1
#define PROBE_REP 0u
#define PROBE_REPN 1
#define PROBE_P0N 0
#define PROBE_R9N 0
#define PROBE_BARN 0
#define PROBE_NOBAR 0
#define PROBE_BANDV 0
#define PROBE_G8V 0
#define PROBE_ATTV 0
#include <hip/hip_runtime.h>
#include <cstdio>
#include <cstdint>
namespace pg8 {
#define PG8_LAS __attribute__((address_space(3)))
typedef unsigned short bf16_t;
typedef short bf16x8 __attribute__((ext_vector_type(8)));
typedef float f32x4 __attribute__((ext_vector_type(4)));
typedef unsigned u32x4 __attribute__((ext_vector_type(4)));
constexpr int BM = 256, BK = 64, HALF = 128, HTB = HALF * BK * 2  , STAGE_BYTES = 8 * HTB, NXCD = 8, WGM = 8;

__host__ __device__ __forceinline__ int lds_byte(int r, int c) { const int st = (r >> 4) * 2 + (c >> 5), rr = r & 15, cc = c & 31, ob = rr * 64 + cc * 2; return st * 1024 + (ob ^ (((ob >> 9) & 1) << 5)); }
__host__ __device__ __forceinline__ void stage_rc(int b, int& R, int& C) { const int st = b / 1024, sb = b % 1024, swz = sb ^ (((sb >> 9) & 1) << 5); R = (st >> 1) * 16 + swz / 64; C = (st & 1) * 32 + (swz % 64) / 2; }
__host__ __device__ __forceinline__ int perm32(int rho) { const int n = rho >> 4, i = rho & 15; return 8 * (i >> 2) + 4 * n + (i & 3); }

struct Unit { int pm, pn; };
struct Gemm { const bf16_t* A; const bf16_t* Bt; int M, N, K; };

constexpr int PG8_NVM = 8;

struct StaticOrder {
    int nM, nN, nwg, G, c;
    __host__ __device__ void init(int M, int N, int G_, int c_) { nM = M / BM; nN = N / BM; nwg = nM * nN; G = G_; c = c_; }
    __host__ __device__ bool next(int i, Unit& u) const {
        const long L = (long)i * G + c; if (L >= nwg) return false;
        int wgid = (int)L; { const int q = nwg / NXCD, r = nwg % NXCD, xcd = wgid % NXCD, off = wgid / NXCD; wgid = (xcd < r ? xcd * (q + 1) : r * (q + 1) + (xcd - r) * q) + off; }
        const int nig = WGM * nN, gid = wgid / nig, fm = gid * WGM, gsz = (nM - fm) < WGM ? (nM - fm) : WGM;
        u.pm = fm + ((wgid % nig) % gsz); u.pn = (wgid % nig) / gsz; return true;
    }
    __device__ __forceinline__ void a_ready(const Unit&) const {}
    __device__ __forceinline__ void done(const Unit&) const {}
};

struct RowLocalOrder {
    int nM, nN, G, c;
    __host__ __device__ void init(int M, int N, int G_, int c_) { nM = M / BM; nN = N / BM; G = G_; c = c_; }
    __host__ __device__ bool next(int i, Unit& u) const { const int t = i / nN; const int pm = c + t * G; if (pm >= nM) return false; u.pm = pm; u.pn = i - t * nN; return true; }
    __device__ __forceinline__ void a_ready(const Unit&) const {}
    __device__ __forceinline__ void done(const Unit&) const {}
};

__device__ __forceinline__ unsigned cvt_pk_bf16(float lo, float hi) { unsigned r; asm volatile("v_cvt_pk_bf16_f32 %0, %1, %2" : "=v"(r) : "v"(lo), "v"(hi)); return r; }
typedef float f32x2 __attribute__((ext_vector_type(2)));
__device__ __forceinline__ f32x2 gelu_pk(f32x2 v) {
    const f32x2 av = __builtin_elementwise_abs(v), d = av * 0.2316418882f + 1.0f;
    f32x2 t; t.x = __builtin_amdgcn_rcpf(d.x); t.y = __builtin_amdgcn_rcpf(d.y);
    f32x2 q = t * 0.5307027145f + (-0.7265760135f); q = q * t + 0.7107068705f; q = q * t + (-0.142248368f); q = q * t + 0.127414796f; q = q * t;
    const f32x2 s = (v * v) * (-0.72134752044f);
    f32x2 e; e.x = __builtin_amdgcn_exp2f(s.x); e.y = __builtin_amdgcn_exp2f(s.y);
    const f32x2 m = v * (q * e), r = v - m;
    f32x2 o; o.x = v.x < 0.f ? m.x : r.x; o.y = v.y < 0.f ? m.y : r.y; return o;
}

template <int ACT  > struct EpiBf16 {
    static constexpr bool PERM = true, AFTER_DRAIN = false; static_assert(ACT == 0 || ACT == 1, "EpiBf16: ACT is 0 (none) or 1 (gelu_pk)");
    bf16_t* O; int ldc; const float* bias; int split_cols; size_t split_stride; float scale0;
    __device__ __forceinline__ void operator()(const f32x4 (&acc)[2][2][4][2], const Unit& u, int wr, int wc, int fr, int fq) const {
        const int row0 = u.pm * BM + wr * 64 + fr; int colt = u.pn * BM; bf16_t* base = O;
        float sc = 1.f; if (split_cols) { const int t = colt / split_cols; base += (size_t)t * split_stride; colt -= t * split_cols; if (t == 0) sc = scale0; }
        const int col0 = colt + wc * 32 + 8 * fq, bcol0 = u.pn * BM + wc * 32 + 8 * fq;
        f32x4 bv[2][2];
#pragma unroll
        for (int bj = 0; bj < 2; ++bj)
#pragma unroll
            for (int n = 0; n < 2; ++n) bv[bj][n] = bias ? *(const f32x4*)(bias + bcol0 + bj * HALF + 4 * n) : (f32x4){0.f, 0.f, 0.f, 0.f};
#pragma unroll
        for (int ai = 0; ai < 2; ++ai)
#pragma unroll
            for (int m = 0; m < 4; ++m) { bf16_t* rowp = base + (size_t)(row0 + ai * HALF + m * 16) * ldc + col0;
#pragma unroll
                for (int bj = 0; bj < 2; ++bj) { f32x4 v0 = acc[ai][bj][m][0] + bv[bj][0], v1 = acc[ai][bj][m][1] + bv[bj][1];
                    if (ACT == 1) { f32x2 a = gelu_pk((f32x2){v0[0], v0[1]}), b = gelu_pk((f32x2){v0[2], v0[3]}), c = gelu_pk((f32x2){v1[0], v1[1]}), d = gelu_pk((f32x2){v1[2], v1[3]});
                        v0 = (f32x4){a.x, a.y, b.x, b.y}; v1 = (f32x4){c.x, c.y, d.x, d.y}; }
                    v0 = v0 * sc; v1 = v1 * sc; u32x4 w; w.x = cvt_pk_bf16(v0[0], v0[1]); w.y = cvt_pk_bf16(v0[2], v0[3]); w.z = cvt_pk_bf16(v1[0], v1[1]); w.w = cvt_pk_bf16(v1[2], v1[3]);
                    *(u32x4*)(rowp + bj * HALF) = w; } }
    }
};
template <class Epi, class Sched, bool ALIGN_EPI = false, bool SP2 = false>
__device__ __forceinline__ void gemm_phase(PG8_LAS unsigned char* lds, const Gemm g, const Sched& S, const Epi& E) {
    int tid = threadIdx.x; asm volatile("" : "+v"(tid));
    const int wid = __builtin_amdgcn_readfirstlane(tid >> 6), lane = tid & 63, wr = wid >> 2, wc = wid & 3, fr = lane & 15, fq = lane >> 4;
    int K = g.K; asm volatile("" : "+s"(K));
    const int nt = K / BK;
    unsigned voffA[2], voffB[2];
#pragma unroll
    for (int i = 0; i < 2; ++i) { int R, C; stage_rc(tid * 16 + i * 8192, R, C); const int Rb = Epi::PERM ? ((R & ~31) + perm32(R & 31)) : R;
        voffA[i] = (unsigned)(R * K + C) * 2u; voffB[i] = (unsigned)(Rb * K + C) * 2u; }
    const size_t kstep = (size_t)(BK * 2);
    const size_t hstep = (size_t)HALF * K * 2;
    const size_t tstep = 2 * hstep;
    const unsigned ldsw = (unsigned)wid * 1024u;
    const int aoff = lds_byte(wr * 64 + fr, fq * 8), boff = lds_byte(wc * 32 + fr, fq * 8);
#define PG8_SA(b, h) (((b) * 2 + (h)) * HTB)
#define PG8_SB(b, h) ((4 + (b) * 2 + (h)) * HTB)
#define PG8_STAGE(bufoff, gbase, voff) do { _Pragma("unroll") for (int _i = 0; _i < 2; ++_i) \
        __builtin_amdgcn_global_load_lds((const unsigned*)((const char*)(gbase) + (voff)[_i]), (PG8_LAS unsigned*)(lds + (bufoff) + ldsw + _i * 8192), 16, 0, 0); } while (0)
#define PG8_LDA(dst, b, h) do { _Pragma("unroll") for (int m = 0; m < 4; ++m) _Pragma("unroll") for (int k = 0; k < 2; ++k) dst[m][k] = *(const PG8_LAS bf16x8*)(lds + PG8_SA(b, h) + aoff + m * 2048 + k * 1024); } while (0)
#define PG8_LDB(dst, b, h) do { _Pragma("unroll") for (int n = 0; n < 2; ++n) _Pragma("unroll") for (int k = 0; k < 2; ++k) dst[n][k] = *(const PG8_LAS bf16x8*)(lds + PG8_SB(b, h) + boff + n * 2048 + k * 1024); } while (0)
#define PG8_MMA(ai, bj, At, Bt) do { __builtin_amdgcn_s_setprio(1); _Pragma("unroll") for (int m = 0; m < 4; ++m) _Pragma("unroll") for (int n = 0; n < 2; ++n) _Pragma("unroll") for (int k = 0; k < 2; ++k) \
        acc[ai][bj][m][n] = __builtin_amdgcn_mfma_f32_16x16x32_bf16(Bt[n][k], At[m][k], acc[ai][bj][m][n], 0, 0, 0); __builtin_amdgcn_s_setprio(0); } while (0)
#define PG8_WAIT_V(n) asm volatile("s_waitcnt vmcnt(" #n ")" ::: "memory")
#define PG8_WAIT_L(n) asm volatile("s_waitcnt lgkmcnt(" #n ")" ::: "memory")
#define PG8_BAR __builtin_amdgcn_s_barrier()
#define PG8_SCHED __builtin_amdgcn_sched_barrier(0)
    Unit cur, nxt; int ui = 0;
    if (!S.next(0, cur)) return;
    f32x4 acc[2][2][4][2];
#pragma unroll
    for (int a = 0; a < 2; ++a)
#pragma unroll
        for (int b = 0; b < 2; ++b)
#pragma unroll
            for (int m = 0; m < 4; ++m)
#pragma unroll
                for (int n = 0; n < 2; ++n) acc[a][b][m][n] = (f32x4){0.f, 0.f, 0.f, 0.f};
    bf16x8 At[4][2], B0[2][2], B1[2][2];
    const char* cA = (const char*)g.A + (size_t)cur.pm * tstep; const char* cB = (const char*)g.Bt + (size_t)cur.pn * tstep;
    S.a_ready(cur);
    if constexpr (SP2) {
        PG8_STAGE(PG8_SB(0, 0), cB, voffB); PG8_STAGE(PG8_SB(0, 1), cB + hstep, voffB); PG8_STAGE(PG8_SA(0, 0), cA, voffA); PG8_STAGE(PG8_SA(0, 1), cA + hstep, voffA);
        if (wr == 1) PG8_BAR;
        PG8_WAIT_V(2); PG8_BAR;
        PG8_STAGE(PG8_SB(1, 0), cB + kstep, voffB); PG8_STAGE(PG8_SA(1, 0), cA + kstep, voffA); PG8_STAGE(PG8_SB(1, 1), cB + hstep + kstep, voffB);
        PG8_WAIT_V(6); PG8_BAR;
    } else {
        PG8_STAGE(PG8_SB(0, 0), cB, voffB); PG8_STAGE(PG8_SA(0, 0), cA, voffA); PG8_STAGE(PG8_SB(0, 1), cB + hstep, voffB); PG8_STAGE(PG8_SA(0, 1), cA + hstep, voffA);
        if (wr == 1) PG8_BAR;
        PG8_WAIT_V(4); PG8_BAR;
        PG8_STAGE(PG8_SB(1, 0), cB + kstep, voffB); PG8_STAGE(PG8_SA(1, 0), cA + kstep, voffA); PG8_STAGE(PG8_SB(1, 1), cB + hstep + kstep, voffB);
        PG8_WAIT_V(6); PG8_BAR;
    }
    for (;;) {
        const bool has_next = S.next(ui + 1, nxt);
        const char* nA = has_next ? (const char*)g.A + (size_t)nxt.pm * tstep : cA; const char* nB = has_next ? (const char*)g.Bt + (size_t)nxt.pn * tstep : cB;
        int t = 0;
#pragma unroll 1
        do {
            const bool last = (t == nt - 2);
            const char* a1 = cA + (size_t)(t + 1) * kstep;
            const char* a2 = last ? nA : cA + (size_t)(t + 2) * kstep; const char* b2 = last ? nB : cB + (size_t)(t + 2) * kstep;
            const char* a3 = a2 + kstep; const char* b3 = b2 + kstep;
            if (last && has_next) S.a_ready(nxt);
            if constexpr (SP2) {
            PG8_LDB(B0, 0, 0); PG8_LDB(B1, 0, 1); PG8_SCHED; PG8_LDA(At, 0, 0); PG8_STAGE(PG8_SA(1, 1), a1 + hstep, voffA);
            PG8_WAIT_V(8); PG8_WAIT_L(0); PG8_BAR; PG8_MMA(0, 0, At, B0); PG8_MMA(0, 1, At, B1); PG8_BAR; PG8_SCHED;
            PG8_LDA(At, 0, 1); PG8_STAGE(PG8_SB(0, 0), b2, voffB); PG8_STAGE(PG8_SB(0, 1), b2 + hstep, voffB); PG8_STAGE(PG8_SA(0, 0), a2, voffA);
            PG8_WAIT_V(8); PG8_WAIT_L(0); PG8_BAR; PG8_MMA(1, 0, At, B0); PG8_MMA(1, 1, At, B1); PG8_BAR; PG8_SCHED;
            PG8_LDB(B0, 1, 0); PG8_LDB(B1, 1, 1); PG8_SCHED; PG8_LDA(At, 1, 0); PG8_STAGE(PG8_SA(0, 1), a2 + hstep, voffA);
            PG8_WAIT_V(8); PG8_WAIT_L(0); PG8_BAR; PG8_MMA(0, 0, At, B0); PG8_MMA(0, 1, At, B1); PG8_BAR; PG8_SCHED;
            PG8_LDA(At, 1, 1); PG8_STAGE(PG8_SB(1, 0), b3, voffB); PG8_STAGE(PG8_SB(1, 1), b3 + hstep, voffB); PG8_STAGE(PG8_SA(1, 0), a3, voffA);
            PG8_WAIT_V(8); PG8_WAIT_L(0); PG8_BAR; PG8_MMA(1, 0, At, B0); PG8_MMA(1, 1, At, B1); PG8_BAR; PG8_SCHED;
            } else {
            PG8_LDB(B0, 0, 0); PG8_SCHED; PG8_LDA(At, 0, 0); PG8_STAGE(PG8_SA(1, 1), a1 + hstep, voffA);
            PG8_WAIT_L(8); PG8_BAR; PG8_WAIT_L(0); PG8_MMA(0, 0, At, B0); PG8_BAR; PG8_SCHED;
            PG8_LDB(B1, 0, 1); PG8_STAGE(PG8_SB(0, 0), b2, voffB);
            PG8_BAR; PG8_WAIT_L(0); PG8_MMA(0, 1, At, B1); PG8_BAR;
            PG8_LDA(At, 0, 1); PG8_STAGE(PG8_SA(0, 0), a2, voffA);
            PG8_BAR; PG8_WAIT_L(0); PG8_MMA(1, 0, At, B0); PG8_BAR; PG8_SCHED;
            PG8_STAGE(PG8_SB(0, 1), b2 + hstep, voffB);
            PG8_WAIT_V(6); PG8_BAR; PG8_MMA(1, 1, At, B1); PG8_BAR;
            PG8_LDB(B0, 1, 0); PG8_SCHED; PG8_LDA(At, 1, 0); PG8_STAGE(PG8_SA(0, 1), a2 + hstep, voffA);
            PG8_WAIT_L(8); PG8_BAR; PG8_WAIT_L(0); PG8_MMA(0, 0, At, B0); PG8_BAR; PG8_SCHED;
            PG8_LDB(B1, 1, 1); PG8_STAGE(PG8_SB(1, 0), b3, voffB);
            PG8_BAR; PG8_WAIT_L(0); PG8_MMA(0, 1, At, B1); PG8_BAR;
            PG8_LDA(At, 1, 1); PG8_STAGE(PG8_SA(1, 0), a3, voffA);
            PG8_BAR; PG8_WAIT_L(0); PG8_MMA(1, 0, At, B0); PG8_BAR; PG8_SCHED;
            PG8_STAGE(PG8_SB(1, 1), b3 + hstep, voffB);
            PG8_WAIT_V(6); PG8_BAR; PG8_MMA(1, 1, At, B1); PG8_BAR;
            }
            t += 2;
        } while (t < nt);
        if constexpr (ALIGN_EPI) { if (wr == 0) PG8_BAR; }
        if constexpr (!Epi::AFTER_DRAIN) { E(acc, cur, wr, wc, fr, fq); S.done(cur); }
        if (!has_next) break;
#pragma unroll
        for (int a = 0; a < 2; ++a)
#pragma unroll
            for (int b = 0; b < 2; ++b)
#pragma unroll
                for (int m = 0; m < 4; ++m)
#pragma unroll
                    for (int n = 0; n < 2; ++n) acc[a][b][m][n] = (f32x4){0.f, 0.f, 0.f, 0.f};
        cur = nxt; cA = nA; cB = nB; ++ui;
        if constexpr (ALIGN_EPI) { if (wr == 1) PG8_BAR; }
    }
    PG8_WAIT_V(0);
    if constexpr (!ALIGN_EPI) { if (wr == 0) PG8_BAR; }
    PG8_BAR;
    if constexpr (Epi::AFTER_DRAIN) { E.fused(acc, cur, wr, wc, fr, fq, lds, wid, lane); S.done(cur); }
#undef PG8_SA
#undef PG8_SB
#undef PG8_STAGE
#undef PG8_LDA
#undef PG8_LDB
#undef PG8_MMA
#undef PG8_WAIT_V
#undef PG8_WAIT_L
#undef PG8_BAR
#undef PG8_SCHED
}
typedef int v4i_t __attribute__((ext_vector_type(4)));
typedef int v8i_t __attribute__((ext_vector_type(8)));
template <class Epi, class Sched, bool ALIGN_EPI = false, bool SP2 = false>
__device__ __forceinline__ void gemm_phase8(PG8_LAS unsigned char* lds, const Gemm g, const Sched& S, const Epi& E) {
    int tid = threadIdx.x; asm volatile("" : "+v"(tid));
    const int wid = __builtin_amdgcn_readfirstlane(tid >> 6), lane = tid & 63, wr = wid >> 2, wc = wid & 3, fr = lane & 15, fq = lane >> 4;
    int K = g.K; asm volatile("" : "+s"(K));
    const int nt = K / BK;
    unsigned voffA[2], voffB[2];
#pragma unroll
    for (int i = 0; i < 2; ++i) { int R, C; stage_rc(tid * 16 + i * 8192, R, C); const int Rb = Epi::PERM ? ((R & ~31) + perm32(R & 31)) : R;
        voffA[i] = (unsigned)(R * K + C) * 2u; voffB[i] = (unsigned)(Rb * K + C) * 2u; }
    const size_t kstep = (size_t)(BK * 2);
    const size_t hstep = (size_t)HALF * K * 2;
    const size_t tstep = 2 * hstep;
    const unsigned ldsw = (unsigned)wid * 1024u;
    const int aoff = lds_byte(wr * 64 + fr, fq * 8), boff = lds_byte(wc * 32 + fr, fq * 8);
#define PG8_SA(b, h) (((b) * 2 + (h)) * HTB)
#define PG8_SB(b, h) ((4 + (b) * 2 + (h)) * HTB)
#define PG8_STAGE(bufoff, gbase, voff) do { _Pragma("unroll") for (int _i = 0; _i < 2; ++_i) \
        __builtin_amdgcn_global_load_lds((const unsigned*)((const char*)(gbase) + (voff)[_i]), (PG8_LAS unsigned*)(lds + (bufoff) + ldsw + _i * 8192), 16, 0, 0); } while (0)
#define PG8_LDA(dst, b, h) do { _Pragma("unroll") for (int m = 0; m < 4; ++m) { const v4i_t lo_ = *(const PG8_LAS v4i_t*)(lds + PG8_SA(b, h) + aoff + m * 2048), hi_ = *(const PG8_LAS v4i_t*)(lds + PG8_SA(b, h) + aoff + m * 2048 + 1024); dst[m] = __builtin_shufflevector(lo_, hi_, 0, 1, 2, 3, 4, 5, 6, 7); } } while (0)
#define PG8_LDB(dst, b, h) do { _Pragma("unroll") for (int n = 0; n < 2; ++n) { const v4i_t lo_ = *(const PG8_LAS v4i_t*)(lds + PG8_SB(b, h) + boff + n * 2048), hi_ = *(const PG8_LAS v4i_t*)(lds + PG8_SB(b, h) + boff + n * 2048 + 1024); dst[n] = __builtin_shufflevector(lo_, hi_, 0, 1, 2, 3, 4, 5, 6, 7); } } while (0)
#define PG8_MMA(ai, bj, At, Bt) do { __builtin_amdgcn_s_setprio(1); _Pragma("unroll") for (int m = 0; m < 4; ++m) _Pragma("unroll") for (int n = 0; n < 2; ++n) \
        asm volatile("v_mfma_scale_f32_16x16x128_f8f6f4 %0, %1, %2, %0, %3, %3 op_sel_hi:[0,0,0]" : "+v"(acc[ai][bj][m][n]) : "v"(Bt[n]), "v"(At[m]), "v"(sclv)); __builtin_amdgcn_s_setprio(0); } while (0)
#define PG8_WAIT_V(n) asm volatile("s_waitcnt vmcnt(" #n ")" ::: "memory")
#define PG8_WAIT_V_RELAXED(n) asm volatile("s_waitcnt vmcnt(%0)" :: "n"((n) + PG8_NVM) : "memory")
#define PG8_MMA0(ai, bj, At, Bt) do { __builtin_amdgcn_s_setprio(1); _Pragma("unroll") for (int m = 0; m < 4; ++m) _Pragma("unroll") for (int n = 0; n < 2; ++n) \
        asm volatile("v_mfma_scale_f32_16x16x128_f8f6f4 %0, %1, %2, 0, %3, %3 op_sel_hi:[0,0,0]" : "=&v"(acc[ai][bj][m][n]) : "v"(Bt[n]), "v"(At[m]), "v"(sclv)); __builtin_amdgcn_s_setprio(0); } while (0)
#define PG8_WAIT_L(n) asm volatile("s_waitcnt lgkmcnt(" #n ")" ::: "memory")
#define PG8_BAR __builtin_amdgcn_s_barrier()
#define PG8_SCHED __builtin_amdgcn_sched_barrier(0)
    Unit cur, nxt; int ui = 0;
    if (!S.next(0, cur)) return;
    f32x4 acc[2][2][4][2];
#pragma unroll
    for (int a = 0; a < 2; ++a)
#pragma unroll
        for (int b = 0; b < 2; ++b)
#pragma unroll
            for (int m = 0; m < 4; ++m)
#pragma unroll
                for (int n = 0; n < 2; ++n) acc[a][b][m][n] = (f32x4){0.f, 0.f, 0.f, 0.f};
    v8i_t At[4], B0[2], B1[2];
    int sclv = 0x7f7f7f7f; asm volatile("" : "+v"(sclv));
    const char* cA = (const char*)g.A + (size_t)cur.pm * tstep; const char* cB = (const char*)g.Bt + (size_t)cur.pn * tstep;
    S.a_ready(cur);
    if constexpr (SP2) {
        PG8_STAGE(PG8_SB(0, 0), cB, voffB); PG8_STAGE(PG8_SB(0, 1), cB + hstep, voffB); PG8_STAGE(PG8_SA(0, 0), cA, voffA); PG8_STAGE(PG8_SA(0, 1), cA + hstep, voffA);
        if (wr == 1) PG8_BAR;
        PG8_WAIT_V(2); PG8_BAR;
        PG8_STAGE(PG8_SB(1, 0), cB + kstep, voffB); PG8_STAGE(PG8_SA(1, 0), cA + kstep, voffA); PG8_STAGE(PG8_SB(1, 1), cB + hstep + kstep, voffB);
        PG8_WAIT_V(6); PG8_BAR;
    } else {
        PG8_STAGE(PG8_SB(0, 0), cB, voffB); PG8_STAGE(PG8_SA(0, 0), cA, voffA); PG8_STAGE(PG8_SB(0, 1), cB + hstep, voffB); PG8_STAGE(PG8_SA(0, 1), cA + hstep, voffA);
        if (wr == 1) PG8_BAR;
        PG8_WAIT_V(4); PG8_BAR;
        PG8_STAGE(PG8_SB(1, 0), cB + kstep, voffB); PG8_STAGE(PG8_SA(1, 0), cA + kstep, voffA); PG8_STAGE(PG8_SB(1, 1), cB + hstep + kstep, voffB);
        PG8_WAIT_V(6); PG8_BAR;
    }
    for (;;) {
        const bool has_next = S.next(ui + 1, nxt);
        const char* nA = has_next ? (const char*)g.A + (size_t)nxt.pm * tstep : cA; const char* nB = has_next ? (const char*)g.Bt + (size_t)nxt.pn * tstep : cB;
        int t = 0;
        if (ui > 0) {
            static_assert(SP2, "peeled first K-tile pair: SP2 loop only");
            const bool last = (t == nt - 2);
            const char* a1 = cA + (size_t)(t + 1) * kstep;
            const char* a2 = last ? nA : cA + (size_t)(t + 2) * kstep; const char* b2 = last ? nB : cB + (size_t)(t + 2) * kstep;
            const char* a3 = a2 + kstep; const char* b3 = b2 + kstep;
            if (last && has_next) S.a_ready(nxt);
            if constexpr (SP2) {
            PG8_LDB(B0, 0, 0); PG8_LDB(B1, 0, 1); PG8_SCHED; PG8_LDA(At, 0, 0); PG8_STAGE(PG8_SA(1, 1), a1 + hstep, voffA);
            PG8_WAIT_V_RELAXED(8); PG8_WAIT_L(0); PG8_BAR; PG8_MMA0(0, 0, At, B0); PG8_MMA0(0, 1, At, B1); PG8_BAR; PG8_SCHED;
            PG8_LDA(At, 0, 1); PG8_STAGE(PG8_SB(0, 0), b2, voffB); PG8_STAGE(PG8_SB(0, 1), b2 + hstep, voffB); PG8_STAGE(PG8_SA(0, 0), a2, voffA);
            PG8_WAIT_V_RELAXED(8); PG8_WAIT_L(0); PG8_BAR; PG8_MMA0(1, 0, At, B0); PG8_MMA0(1, 1, At, B1); PG8_BAR; PG8_SCHED;
            PG8_LDB(B0, 1, 0); PG8_LDB(B1, 1, 1); PG8_SCHED; PG8_LDA(At, 1, 0); PG8_STAGE(PG8_SA(0, 1), a2 + hstep, voffA);
            PG8_WAIT_V(8); PG8_WAIT_L(0); PG8_BAR; PG8_MMA(0, 0, At, B0); PG8_MMA(0, 1, At, B1); PG8_BAR; PG8_SCHED;
            PG8_LDA(At, 1, 1); PG8_STAGE(PG8_SB(1, 0), b3, voffB); PG8_STAGE(PG8_SB(1, 1), b3 + hstep, voffB); PG8_STAGE(PG8_SA(1, 0), a3, voffA);
            PG8_WAIT_V(8); PG8_WAIT_L(0); PG8_BAR; PG8_MMA(1, 0, At, B0); PG8_MMA(1, 1, At, B1); PG8_BAR; PG8_SCHED;
            } else {
            PG8_LDB(B0, 0, 0); PG8_SCHED; PG8_LDA(At, 0, 0); PG8_STAGE(PG8_SA(1, 1), a1 + hstep, voffA);
            PG8_WAIT_L(8); PG8_BAR; PG8_WAIT_L(0); PG8_MMA(0, 0, At, B0); PG8_BAR; PG8_SCHED;
            PG8_LDB(B1, 0, 1); PG8_STAGE(PG8_SB(0, 0), b2, voffB);
            PG8_BAR; PG8_WAIT_L(0); PG8_MMA(0, 1, At, B1); PG8_BAR;
            PG8_LDA(At, 0, 1); PG8_STAGE(PG8_SA(0, 0), a2, voffA);
            PG8_BAR; PG8_WAIT_L(0); PG8_MMA(1, 0, At, B0); PG8_BAR; PG8_SCHED;
            PG8_STAGE(PG8_SB(0, 1), b2 + hstep, voffB);
            PG8_WAIT_V(6); PG8_BAR; PG8_MMA(1, 1, At, B1); PG8_BAR;
            PG8_LDB(B0, 1, 0); PG8_SCHED; PG8_LDA(At, 1, 0); PG8_STAGE(PG8_SA(0, 1), a2 + hstep, voffA);
            PG8_WAIT_L(8); PG8_BAR; PG8_WAIT_L(0); PG8_MMA(0, 0, At, B0); PG8_BAR; PG8_SCHED;
            PG8_LDB(B1, 1, 1); PG8_STAGE(PG8_SB(1, 0), b3, voffB);
            PG8_BAR; PG8_WAIT_L(0); PG8_MMA(0, 1, At, B1); PG8_BAR;
            PG8_LDA(At, 1, 1); PG8_STAGE(PG8_SA(1, 0), a3, voffA);
            PG8_BAR; PG8_WAIT_L(0); PG8_MMA(1, 0, At, B0); PG8_BAR; PG8_SCHED;
            PG8_STAGE(PG8_SB(1, 1), b3 + hstep, voffB);
            PG8_WAIT_V(6); PG8_BAR; PG8_MMA(1, 1, At, B1); PG8_BAR;
            }
            t = 2;
        }
#pragma unroll 1
        while (t < nt) {
            const bool last = (t == nt - 2);
            const char* a1 = cA + (size_t)(t + 1) * kstep;
            const char* a2 = last ? nA : cA + (size_t)(t + 2) * kstep; const char* b2 = last ? nB : cB + (size_t)(t + 2) * kstep;
            const char* a3 = a2 + kstep; const char* b3 = b2 + kstep;
            if (last && has_next) S.a_ready(nxt);
            if constexpr (SP2) {
            PG8_LDB(B0, 0, 0); PG8_LDB(B1, 0, 1); PG8_SCHED; PG8_LDA(At, 0, 0); PG8_STAGE(PG8_SA(1, 1), a1 + hstep, voffA);
            PG8_WAIT_V(8); PG8_WAIT_L(0); PG8_BAR; PG8_MMA(0, 0, At, B0); PG8_MMA(0, 1, At, B1); PG8_BAR; PG8_SCHED;
            PG8_LDA(At, 0, 1); PG8_STAGE(PG8_SB(0, 0), b2, voffB); PG8_STAGE(PG8_SB(0, 1), b2 + hstep, voffB); PG8_STAGE(PG8_SA(0, 0), a2, voffA);
            PG8_WAIT_V(8); PG8_WAIT_L(0); PG8_BAR; PG8_MMA(1, 0, At, B0); PG8_MMA(1, 1, At, B1); PG8_BAR; PG8_SCHED;
            PG8_LDB(B0, 1, 0); PG8_LDB(B1, 1, 1); PG8_SCHED; PG8_LDA(At, 1, 0); PG8_STAGE(PG8_SA(0, 1), a2 + hstep, voffA);
            PG8_WAIT_V(8); PG8_WAIT_L(0); PG8_BAR; PG8_MMA(0, 0, At, B0); PG8_MMA(0, 1, At, B1); PG8_BAR; PG8_SCHED;
            PG8_LDA(At, 1, 1); PG8_STAGE(PG8_SB(1, 0), b3, voffB); PG8_STAGE(PG8_SB(1, 1), b3 + hstep, voffB); PG8_STAGE(PG8_SA(1, 0), a3, voffA);
            PG8_WAIT_V(8); PG8_WAIT_L(0); PG8_BAR; PG8_MMA(1, 0, At, B0); PG8_MMA(1, 1, At, B1); PG8_BAR; PG8_SCHED;
            } else {
            PG8_LDB(B0, 0, 0); PG8_SCHED; PG8_LDA(At, 0, 0); PG8_STAGE(PG8_SA(1, 1), a1 + hstep, voffA);
            PG8_WAIT_L(8); PG8_BAR; PG8_WAIT_L(0); PG8_MMA(0, 0, At, B0); PG8_BAR; PG8_SCHED;
            PG8_LDB(B1, 0, 1); PG8_STAGE(PG8_SB(0, 0), b2, voffB);
            PG8_BAR; PG8_WAIT_L(0); PG8_MMA(0, 1, At, B1); PG8_BAR;
            PG8_LDA(At, 0, 1); PG8_STAGE(PG8_SA(0, 0), a2, voffA);
            PG8_BAR; PG8_WAIT_L(0); PG8_MMA(1, 0, At, B0); PG8_BAR; PG8_SCHED;
            PG8_STAGE(PG8_SB(0, 1), b2 + hstep, voffB);
            PG8_WAIT_V(6); PG8_BAR; PG8_MMA(1, 1, At, B1); PG8_BAR;
            PG8_LDB(B0, 1, 0); PG8_SCHED; PG8_LDA(At, 1, 0); PG8_STAGE(PG8_SA(0, 1), a2 + hstep, voffA);
            PG8_WAIT_L(8); PG8_BAR; PG8_WAIT_L(0); PG8_MMA(0, 0, At, B0); PG8_BAR; PG8_SCHED;
            PG8_LDB(B1, 1, 1); PG8_STAGE(PG8_SB(1, 0), b3, voffB);
            PG8_BAR; PG8_WAIT_L(0); PG8_MMA(0, 1, At, B1); PG8_BAR;
            PG8_LDA(At, 1, 1); PG8_STAGE(PG8_SA(1, 0), a3, voffA);
            PG8_BAR; PG8_WAIT_L(0); PG8_MMA(1, 0, At, B0); PG8_BAR; PG8_SCHED;
            PG8_STAGE(PG8_SB(1, 1), b3 + hstep, voffB);
            PG8_WAIT_V(6); PG8_BAR; PG8_MMA(1, 1, At, B1); PG8_BAR;
            }
            t += 2;
        }
        if constexpr (ALIGN_EPI) { if (wr == 0) PG8_BAR; }
        asm volatile("s_nop 15\n\ts_nop 15" ::: "memory");
        if constexpr (!Epi::AFTER_DRAIN) { E(acc, cur, wr, wc, fr, fq); S.done(cur); }
        if (!has_next) break;
        cur = nxt; cA = nA; cB = nB; ++ui;
        if constexpr (ALIGN_EPI) { if (wr == 1) PG8_BAR; }
    }
    PG8_WAIT_V(0);
    if constexpr (!ALIGN_EPI) { if (wr == 0) PG8_BAR; }
    PG8_BAR;
    if constexpr (Epi::AFTER_DRAIN) { E.fused(acc, cur, wr, wc, fr, fq, lds, wid, lane); S.done(cur); }
#undef PG8_SA
#undef PG8_SB
#undef PG8_STAGE
#undef PG8_LDA
#undef PG8_LDB
#undef PG8_MMA
#undef PG8_WAIT_V
#undef PG8_WAIT_V_RELAXED
#undef PG8_MMA0
#undef PG8_WAIT_L
#undef PG8_BAR
#undef PG8_SCHED
}
struct GemmG { const void* A; const bf16_t* Bt; const int* rowidx; int K; int rowbytes; };
template <class Epi, class Sched, bool ALIGN_EPI = false, bool SP2 = false>
__device__ __forceinline__ void gemm_phase8g(PG8_LAS unsigned char* lds, const GemmG g, const Sched& S, const Epi& E) {
    int tid = threadIdx.x; asm volatile("" : "+v"(tid));
    const int wid = __builtin_amdgcn_readfirstlane(tid >> 6), lane = tid & 63, wr = wid >> 2, wc = wid & 3, fr = lane & 15, fq = lane >> 4;
    int K = g.K; asm volatile("" : "+s"(K));
    const int nt = K / BK;
    unsigned voffA[2], voffB[2];
    int Rl[2]; unsigned Cb[2];
#pragma unroll
    for (int i = 0; i < 2; ++i) { int R, C; stage_rc(tid * 16 + i * 8192, R, C); const int Rb = Epi::PERM ? ((R & ~31) + perm32(R & 31)) : R;
        voffA[i] = (unsigned)(R * K + C) * 2u; voffB[i] = (unsigned)(Rb * K + C) * 2u; Rl[i] = R; Cb[i] = (unsigned)C * 2u; }
    (void)voffA;
    unsigned gC0[2], gC1[2], gN0[2], gN1[2];
#define PG8_GOFF(d0, d1, pm_) do { _Pragma("unroll") for (int _i = 0; _i < 2; ++_i) { const int* ri_ = g.rowidx + (size_t)(pm_) * BM + Rl[_i]; \
        d0[_i] = (unsigned)ri_[0] * (unsigned)g.rowbytes + Cb[_i]; d1[_i] = (unsigned)ri_[HALF] * (unsigned)g.rowbytes + Cb[_i]; } } while (0)
#define PG8_GRAW(raw, pm_) do { _Pragma("unroll") for (int _i = 0; _i < 2; ++_i) { const int* ri_ = g.rowidx + (size_t)(pm_) * BM + Rl[_i]; \
        asm volatile("global_load_dword %0, %1, off" : "=v"(raw[2 * _i]) : "v"(ri_) : "memory"); asm volatile("global_load_dword %0, %1, off offset:512" : "=v"(raw[2 * _i + 1]) : "v"(ri_) : "memory"); } } while (0)
#define PG8_GWAIT(raw) asm volatile("s_waitcnt vmcnt(4)" : "+v"(raw[0]), "+v"(raw[1]), "+v"(raw[2]), "+v"(raw[3]) :: "memory")
#define PG8_GCVT(d0, d1, raw) do { _Pragma("unroll") for (int _i = 0; _i < 2; ++_i) { d0[_i] = (unsigned)raw[2 * _i] * (unsigned)g.rowbytes + Cb[_i]; d1[_i] = (unsigned)raw[2 * _i + 1] * (unsigned)g.rowbytes + Cb[_i]; } } while (0)
    static_assert(HALF * 4 == 512, "row-index load offset");
    const size_t kstep = (size_t)(BK * 2);
    const size_t hstep = (size_t)HALF * K * 2;
    const size_t tstep = 2 * hstep;
    const unsigned ldsw = (unsigned)wid * 1024u;
    const int aoff = lds_byte(wr * 64 + fr, fq * 8), boff = lds_byte(wc * 32 + fr, fq * 8);
#define PG8_SA(b, h) (((b) * 2 + (h)) * HTB)
#define PG8_SB(b, h) ((4 + (b) * 2 + (h)) * HTB)
#define PG8_STAGE(bufoff, gbase, voff) do { _Pragma("unroll") for (int _i = 0; _i < 2; ++_i) \
        __builtin_amdgcn_global_load_lds((const unsigned*)((const char*)(gbase) + (voff)[_i]), (PG8_LAS unsigned*)(lds + (bufoff) + ldsw + _i * 8192), 16, 0, 0); } while (0)
#define PG8_LDA(dst, b, h) do { _Pragma("unroll") for (int m = 0; m < 4; ++m) { const v4i_t lo_ = *(const PG8_LAS v4i_t*)(lds + PG8_SA(b, h) + aoff + m * 2048), hi_ = *(const PG8_LAS v4i_t*)(lds + PG8_SA(b, h) + aoff + m * 2048 + 1024); dst[m] = __builtin_shufflevector(lo_, hi_, 0, 1, 2, 3, 4, 5, 6, 7); } } while (0)
#define PG8_LDB(dst, b, h) do { _Pragma("unroll") for (int n = 0; n < 2; ++n) { const v4i_t lo_ = *(const PG8_LAS v4i_t*)(lds + PG8_SB(b, h) + boff + n * 2048), hi_ = *(const PG8_LAS v4i_t*)(lds + PG8_SB(b, h) + boff + n * 2048 + 1024); dst[n] = __builtin_shufflevector(lo_, hi_, 0, 1, 2, 3, 4, 5, 6, 7); } } while (0)
#define PG8_MMA(ai, bj, At, Bt) do { __builtin_amdgcn_s_setprio(1); _Pragma("unroll") for (int m = 0; m < 4; ++m) _Pragma("unroll") for (int n = 0; n < 2; ++n) \
        asm volatile("v_mfma_scale_f32_16x16x128_f8f6f4 %0, %1, %2, %0, %3, %3 op_sel_hi:[0,0,0]" : "+v"(acc[ai][bj][m][n]) : "v"(Bt[n]), "v"(At[m]), "v"(sclv)); __builtin_amdgcn_s_setprio(0); } while (0)
#define PG8_WAIT_V(n) asm volatile("s_waitcnt vmcnt(" #n ")" ::: "memory")
#define PG8_WAIT_V_RELAXED(n) asm volatile("s_waitcnt vmcnt(%0)" :: "n"((n) + PG8_NVM) : "memory")
#define PG8_MMA0(ai, bj, At, Bt) do { __builtin_amdgcn_s_setprio(1); _Pragma("unroll") for (int m = 0; m < 4; ++m) _Pragma("unroll") for (int n = 0; n < 2; ++n) \
        asm volatile("v_mfma_scale_f32_16x16x128_f8f6f4 %0, %1, %2, 0, %3, %3 op_sel_hi:[0,0,0]" : "=&v"(acc[ai][bj][m][n]) : "v"(Bt[n]), "v"(At[m]), "v"(sclv)); __builtin_amdgcn_s_setprio(0); } while (0)
#define PG8_WAIT_L(n) asm volatile("s_waitcnt lgkmcnt(" #n ")" ::: "memory")
#define PG8_BAR __builtin_amdgcn_s_barrier()
#define PG8_SCHED __builtin_amdgcn_sched_barrier(0)
    Unit cur, nxt, nn; int ui = 0;
    if (!S.next(0, cur)) return;
    bool has_next = S.next(1, nxt);
    int rawN[4] = {0, 0, 0, 0};
    f32x4 acc[2][2][4][2];
#pragma unroll
    for (int a = 0; a < 2; ++a)
#pragma unroll
        for (int b = 0; b < 2; ++b)
#pragma unroll
            for (int m = 0; m < 4; ++m)
#pragma unroll
                for (int n = 0; n < 2; ++n) acc[a][b][m][n] = (f32x4){0.f, 0.f, 0.f, 0.f};
    v8i_t At[4], B0[2], B1[2];
    int sclv = 0x7f7f7f7f; asm volatile("" : "+v"(sclv));
    const char* cA = (const char*)g.A; const char* cB = (const char*)g.Bt + (size_t)cur.pn * tstep;
    PG8_GOFF(gC0, gC1, cur.pm);
    if (has_next) PG8_GOFF(gN0, gN1, nxt.pm); else { _Pragma("unroll") for (int _i = 0; _i < 2; ++_i) { gN0[_i] = gC0[_i]; gN1[_i] = gC1[_i]; } }
    S.a_ready(cur);
    if constexpr (SP2) {
        PG8_STAGE(PG8_SB(0, 0), cB, voffB); PG8_STAGE(PG8_SB(0, 1), cB + hstep, voffB); PG8_STAGE(PG8_SA(0, 0), cA, gC0); PG8_STAGE(PG8_SA(0, 1), cA, gC1);
        if (wr == 1) PG8_BAR;
        PG8_WAIT_V(2); PG8_BAR;
        PG8_STAGE(PG8_SB(1, 0), cB + kstep, voffB); PG8_STAGE(PG8_SA(1, 0), cA + kstep, gC0); PG8_STAGE(PG8_SB(1, 1), cB + hstep + kstep, voffB);
        PG8_WAIT_V(6); PG8_BAR;
    } else {
        PG8_STAGE(PG8_SB(0, 0), cB, voffB); PG8_STAGE(PG8_SA(0, 0), cA, gC0); PG8_STAGE(PG8_SB(0, 1), cB + hstep, voffB); PG8_STAGE(PG8_SA(0, 1), cA, gC1);
        if (wr == 1) PG8_BAR;
        PG8_WAIT_V(4); PG8_BAR;
        PG8_STAGE(PG8_SB(1, 0), cB + kstep, voffB); PG8_STAGE(PG8_SA(1, 0), cA + kstep, gC0); PG8_STAGE(PG8_SB(1, 1), cB + hstep + kstep, voffB);
        PG8_WAIT_V(6); PG8_BAR;
    }
    for (;;) {
        const char* nA = cA; const char* nB = has_next ? (const char*)g.Bt + (size_t)nxt.pn * tstep : cB;
        int t = 0;
        if (ui > 0) {
            static_assert(SP2, "peeled first K-tile pair: SP2 loop only");
            const bool last = (t == nt - 2);
            const char* a1 = cA + (size_t)(t + 1) * kstep;
            const char* a2 = last ? nA : cA + (size_t)(t + 2) * kstep; const char* b2 = last ? nB : cB + (size_t)(t + 2) * kstep;
            const char* a3 = a2 + kstep; const char* b3 = b2 + kstep;
            unsigned v20[2], v21[2];
            _Pragma("unroll") for (int _i = 0; _i < 2; ++_i) { v20[_i] = last ? gN0[_i] : gC0[_i]; v21[_i] = last ? gN1[_i] : gC1[_i]; }
            if (last && has_next) S.a_ready(nxt);
            if constexpr (SP2) {
            PG8_LDB(B0, 0, 0); PG8_LDB(B1, 0, 1); PG8_SCHED; PG8_LDA(At, 0, 0); PG8_STAGE(PG8_SA(1, 1), a1, gC1);
            PG8_WAIT_V_RELAXED(8); PG8_WAIT_L(0); PG8_BAR; PG8_MMA0(0, 0, At, B0); PG8_MMA0(0, 1, At, B1); PG8_BAR; PG8_SCHED;
            PG8_LDA(At, 0, 1); PG8_STAGE(PG8_SB(0, 0), b2, voffB); PG8_STAGE(PG8_SB(0, 1), b2 + hstep, voffB); PG8_STAGE(PG8_SA(0, 0), a2, v20);
            PG8_WAIT_V_RELAXED(8); PG8_WAIT_L(0); PG8_BAR; PG8_MMA0(1, 0, At, B0); PG8_MMA0(1, 1, At, B1); PG8_BAR; PG8_SCHED;
            PG8_LDB(B0, 1, 0); PG8_LDB(B1, 1, 1); PG8_SCHED; PG8_LDA(At, 1, 0); PG8_STAGE(PG8_SA(0, 1), a2, v21);
            PG8_WAIT_V(8); PG8_WAIT_L(0); PG8_BAR; PG8_MMA(0, 0, At, B0); PG8_MMA(0, 1, At, B1); PG8_BAR; PG8_SCHED;
            PG8_LDA(At, 1, 1); PG8_STAGE(PG8_SB(1, 0), b3, voffB); PG8_STAGE(PG8_SB(1, 1), b3 + hstep, voffB); PG8_STAGE(PG8_SA(1, 0), a3, v20);
            PG8_WAIT_V(8); PG8_WAIT_L(0); PG8_BAR; PG8_MMA(1, 0, At, B0); PG8_MMA(1, 1, At, B1); PG8_BAR; PG8_SCHED;
            } else {
            PG8_LDB(B0, 0, 0); PG8_SCHED; PG8_LDA(At, 0, 0); PG8_STAGE(PG8_SA(1, 1), a1, gC1);
            PG8_WAIT_L(8); PG8_BAR; PG8_WAIT_L(0); PG8_MMA(0, 0, At, B0); PG8_BAR; PG8_SCHED;
            PG8_LDB(B1, 0, 1); PG8_STAGE(PG8_SB(0, 0), b2, voffB);
            PG8_BAR; PG8_WAIT_L(0); PG8_MMA(0, 1, At, B1); PG8_BAR;
            PG8_LDA(At, 0, 1); PG8_STAGE(PG8_SA(0, 0), a2, v20);
            PG8_BAR; PG8_WAIT_L(0); PG8_MMA(1, 0, At, B0); PG8_BAR; PG8_SCHED;
            PG8_STAGE(PG8_SB(0, 1), b2 + hstep, voffB);
            PG8_WAIT_V(6); PG8_BAR; PG8_MMA(1, 1, At, B1); PG8_BAR;
            PG8_LDB(B0, 1, 0); PG8_SCHED; PG8_LDA(At, 1, 0); PG8_STAGE(PG8_SA(0, 1), a2, v21);
            PG8_WAIT_L(8); PG8_BAR; PG8_WAIT_L(0); PG8_MMA(0, 0, At, B0); PG8_BAR; PG8_SCHED;
            PG8_LDB(B1, 1, 1); PG8_STAGE(PG8_SB(1, 0), b3, voffB);
            PG8_BAR; PG8_WAIT_L(0); PG8_MMA(0, 1, At, B1); PG8_BAR;
            PG8_LDA(At, 1, 1); PG8_STAGE(PG8_SA(1, 0), a3, v20);
            PG8_BAR; PG8_WAIT_L(0); PG8_MMA(1, 0, At, B0); PG8_BAR; PG8_SCHED;
            PG8_STAGE(PG8_SB(1, 1), b3 + hstep, voffB);
            PG8_WAIT_V(6); PG8_BAR; PG8_MMA(1, 1, At, B1); PG8_BAR;
            }
            t = 2;
        }
#pragma unroll 1
        while (t < nt) {
            const bool last = (t == nt - 2);
            const char* a1 = cA + (size_t)(t + 1) * kstep;
            const char* a2 = last ? nA : cA + (size_t)(t + 2) * kstep; const char* b2 = last ? nB : cB + (size_t)(t + 2) * kstep;
            const char* a3 = a2 + kstep; const char* b3 = b2 + kstep;
            unsigned v20[2], v21[2];
            _Pragma("unroll") for (int _i = 0; _i < 2; ++_i) { v20[_i] = last ? gN0[_i] : gC0[_i]; v21[_i] = last ? gN1[_i] : gC1[_i]; }
            if (last && has_next) S.a_ready(nxt);
            if constexpr (SP2) {
            PG8_LDB(B0, 0, 0); PG8_LDB(B1, 0, 1); PG8_SCHED; PG8_LDA(At, 0, 0); PG8_STAGE(PG8_SA(1, 1), a1, gC1);
            PG8_WAIT_V(8); PG8_WAIT_L(0); PG8_BAR; PG8_MMA(0, 0, At, B0); PG8_MMA(0, 1, At, B1); PG8_BAR; PG8_SCHED;
            PG8_LDA(At, 0, 1); PG8_STAGE(PG8_SB(0, 0), b2, voffB); PG8_STAGE(PG8_SB(0, 1), b2 + hstep, voffB); PG8_STAGE(PG8_SA(0, 0), a2, v20);
            PG8_WAIT_V(8); PG8_WAIT_L(0); PG8_BAR; PG8_MMA(1, 0, At, B0); PG8_MMA(1, 1, At, B1); PG8_BAR; PG8_SCHED;
            PG8_LDB(B0, 1, 0); PG8_LDB(B1, 1, 1); PG8_SCHED; PG8_LDA(At, 1, 0); PG8_STAGE(PG8_SA(0, 1), a2, v21);
            PG8_WAIT_V(8); PG8_WAIT_L(0); PG8_BAR; PG8_MMA(0, 0, At, B0); PG8_MMA(0, 1, At, B1); PG8_BAR; PG8_SCHED;
            PG8_LDA(At, 1, 1); PG8_STAGE(PG8_SB(1, 0), b3, voffB); PG8_STAGE(PG8_SB(1, 1), b3 + hstep, voffB); PG8_STAGE(PG8_SA(1, 0), a3, v20);
            PG8_WAIT_V(8); PG8_WAIT_L(0); PG8_BAR; PG8_MMA(1, 0, At, B0); PG8_MMA(1, 1, At, B1); PG8_BAR; PG8_SCHED;
            } else {
            PG8_LDB(B0, 0, 0); PG8_SCHED; PG8_LDA(At, 0, 0); PG8_STAGE(PG8_SA(1, 1), a1, gC1);
            PG8_WAIT_L(8); PG8_BAR; PG8_WAIT_L(0); PG8_MMA(0, 0, At, B0); PG8_BAR; PG8_SCHED;
            PG8_LDB(B1, 0, 1); PG8_STAGE(PG8_SB(0, 0), b2, voffB);
            PG8_BAR; PG8_WAIT_L(0); PG8_MMA(0, 1, At, B1); PG8_BAR;
            PG8_LDA(At, 0, 1); PG8_STAGE(PG8_SA(0, 0), a2, v20);
            PG8_BAR; PG8_WAIT_L(0); PG8_MMA(1, 0, At, B0); PG8_BAR; PG8_SCHED;
            PG8_STAGE(PG8_SB(0, 1), b2 + hstep, voffB);
            PG8_WAIT_V(6); PG8_BAR; PG8_MMA(1, 1, At, B1); PG8_BAR;
            PG8_LDB(B0, 1, 0); PG8_SCHED; PG8_LDA(At, 1, 0); PG8_STAGE(PG8_SA(0, 1), a2, v21);
            PG8_WAIT_L(8); PG8_BAR; PG8_WAIT_L(0); PG8_MMA(0, 0, At, B0); PG8_BAR; PG8_SCHED;
            PG8_LDB(B1, 1, 1); PG8_STAGE(PG8_SB(1, 0), b3, voffB);
            PG8_BAR; PG8_WAIT_L(0); PG8_MMA(0, 1, At, B1); PG8_BAR;
            PG8_LDA(At, 1, 1); PG8_STAGE(PG8_SA(1, 0), a3, v20);
            PG8_BAR; PG8_WAIT_L(0); PG8_MMA(1, 0, At, B0); PG8_BAR; PG8_SCHED;
            PG8_STAGE(PG8_SB(1, 1), b3 + hstep, voffB);
            PG8_WAIT_V(6); PG8_BAR; PG8_MMA(1, 1, At, B1); PG8_BAR;
            }
            t += 2;
        }
        const bool has_nn = has_next && S.next(ui + 2, nn);
        if (has_nn) PG8_GRAW(rawN, nn.pm);
        if constexpr (ALIGN_EPI) { if (wr == 0) PG8_BAR; }
        asm volatile("s_nop 15\n\ts_nop 15" ::: "memory");
        if constexpr (!Epi::AFTER_DRAIN) { E(acc, cur, wr, wc, fr, fq); S.done(cur); }
        if (!has_next) break;
        cur = nxt; nxt = nn; has_next = has_nn; cA = nA; cB = nB; ++ui;
        _Pragma("unroll") for (int _i = 0; _i < 2; ++_i) { gC0[_i] = gN0[_i]; gC1[_i] = gN1[_i]; }
        PG8_GWAIT(rawN);
        if (has_next) PG8_GCVT(gN0, gN1, rawN);
        if constexpr (ALIGN_EPI) { if (wr == 1) PG8_BAR; }
    }
    PG8_WAIT_V(0);
    if constexpr (!ALIGN_EPI) { if (wr == 0) PG8_BAR; }
    PG8_BAR;
    if constexpr (Epi::AFTER_DRAIN) { E.fused(acc, cur, wr, wc, fr, fq, lds, wid, lane); S.done(cur); }
#undef PG8_SA
#undef PG8_SB
#undef PG8_STAGE
#undef PG8_GOFF
#undef PG8_GRAW
#undef PG8_GWAIT
#undef PG8_GCVT
#undef PG8_LDA
#undef PG8_LDB
#undef PG8_MMA
#undef PG8_WAIT_V
#undef PG8_WAIT_V_RELAXED
#undef PG8_MMA0
#undef PG8_WAIT_L
#undef PG8_BAR
#undef PG8_SCHED
}
}
namespace pg8 {
typedef int i32x4_t __attribute__((ext_vector_type(4)));
template <class Epi, class Sched, bool ALIGN_EPI = false, bool SP2 = false>
__device__ __forceinline__ void gemm_phase_i8(PG8_LAS unsigned char* lds, const Gemm g, const Sched& S, const Epi& E) {
    int tid = threadIdx.x; asm volatile("" : "+v"(tid));
    const int wid = __builtin_amdgcn_readfirstlane(tid >> 6), lane = tid & 63, wr = wid >> 2, wc = wid & 3, fr = lane & 15, fq = lane >> 4;
    int K = g.K; asm volatile("" : "+s"(K));
    const int nt = K / BK;
    unsigned voffA[2], voffB[2];
#pragma unroll
    for (int i = 0; i < 2; ++i) { int R, C; stage_rc(tid * 16 + i * 8192, R, C); const int Rb = Epi::PERM ? ((R & ~31) + perm32(R & 31)) : R;
        voffA[i] = (unsigned)(R * K + C) * 2u; voffB[i] = (unsigned)(Rb * K + C) * 2u; }
    const size_t kstep = (size_t)(BK * 2);
    const size_t hstep = (size_t)HALF * K * 2;
    const size_t tstep = 2 * hstep;
    const unsigned ldsw = (unsigned)wid * 1024u;
    const int aoff = lds_byte(wr * 64 + fr, fq * 8), boff = lds_byte(wc * 32 + fr, fq * 8);
#define PG8_SA(b, h) (((b) * 2 + (h)) * HTB)
#define PG8_SB(b, h) ((4 + (b) * 2 + (h)) * HTB)
#define PG8_STAGE(bufoff, gbase, voff) do { _Pragma("unroll") for (int _i = 0; _i < 2; ++_i) \
        __builtin_amdgcn_global_load_lds((const unsigned*)((const char*)(gbase) + (voff)[_i]), (PG8_LAS unsigned*)(lds + (bufoff) + ldsw + _i * 8192), 16, 0, 0); } while (0)
#define PG8_LDA(dst, b, h) do { _Pragma("unroll") for (int m = 0; m < 4; ++m) _Pragma("unroll") for (int k = 0; k < 2; ++k) dst[m][k] = *(const PG8_LAS bf16x8*)(lds + PG8_SA(b, h) + aoff + m * 2048 + k * 1024); } while (0)
#define PG8_LDB(dst, b, h) do { _Pragma("unroll") for (int n = 0; n < 2; ++n) _Pragma("unroll") for (int k = 0; k < 2; ++k) dst[n][k] = *(const PG8_LAS bf16x8*)(lds + PG8_SB(b, h) + boff + n * 2048 + k * 1024); } while (0)
#define PG8_MMA(ai, bj, At, Bt) do { __builtin_amdgcn_s_setprio(1); _Pragma("unroll") for (int m = 0; m < 4; ++m) _Pragma("unroll") for (int n = 0; n < 2; ++n) _Pragma("unroll") for (int k = 0; k < 2; ++k) \
        acc[ai][bj][m][n] = __builtin_amdgcn_mfma_i32_16x16x64_i8(__builtin_bit_cast(i32x4_t, Bt[n][k]), __builtin_bit_cast(i32x4_t, At[m][k]), acc[ai][bj][m][n], 0, 0, 0); __builtin_amdgcn_s_setprio(0); } while (0)
#define PG8_WAIT_V(n) asm volatile("s_waitcnt vmcnt(" #n ")" ::: "memory")
#define PG8_WAIT_L(n) asm volatile("s_waitcnt lgkmcnt(" #n ")" ::: "memory")
#define PG8_BAR __builtin_amdgcn_s_barrier()
#define PG8_SCHED __builtin_amdgcn_sched_barrier(0)
    Unit cur, nxt; int ui = 0;
    if (!S.next(0, cur)) return;
    i32x4_t acc[2][2][4][2];
#pragma unroll
    for (int a = 0; a < 2; ++a)
#pragma unroll
        for (int b = 0; b < 2; ++b)
#pragma unroll
            for (int m = 0; m < 4; ++m)
#pragma unroll
                for (int n = 0; n < 2; ++n) acc[a][b][m][n] = (i32x4_t){0, 0, 0, 0};
    bf16x8 At[4][2], B0[2][2], B1[2][2];
    const char* cA = (const char*)g.A + (size_t)cur.pm * tstep; const char* cB = (const char*)g.Bt + (size_t)cur.pn * tstep;
    S.a_ready(cur);
    if constexpr (SP2) {
        PG8_STAGE(PG8_SB(0, 0), cB, voffB); PG8_STAGE(PG8_SB(0, 1), cB + hstep, voffB); PG8_STAGE(PG8_SA(0, 0), cA, voffA); PG8_STAGE(PG8_SA(0, 1), cA + hstep, voffA);
        if (wr == 1) PG8_BAR;
        PG8_WAIT_V(2); PG8_BAR;
        PG8_STAGE(PG8_SB(1, 0), cB + kstep, voffB); PG8_STAGE(PG8_SA(1, 0), cA + kstep, voffA); PG8_STAGE(PG8_SB(1, 1), cB + hstep + kstep, voffB);
        PG8_WAIT_V(6); PG8_BAR;
    } else {
        PG8_STAGE(PG8_SB(0, 0), cB, voffB); PG8_STAGE(PG8_SA(0, 0), cA, voffA); PG8_STAGE(PG8_SB(0, 1), cB + hstep, voffB); PG8_STAGE(PG8_SA(0, 1), cA + hstep, voffA);
        if (wr == 1) PG8_BAR;
        PG8_WAIT_V(4); PG8_BAR;
        PG8_STAGE(PG8_SB(1, 0), cB + kstep, voffB); PG8_STAGE(PG8_SA(1, 0), cA + kstep, voffA); PG8_STAGE(PG8_SB(1, 1), cB + hstep + kstep, voffB);
        PG8_WAIT_V(6); PG8_BAR;
    }
    for (;;) {
        const bool has_next = S.next(ui + 1, nxt);
        const char* nA = has_next ? (const char*)g.A + (size_t)nxt.pm * tstep : cA; const char* nB = has_next ? (const char*)g.Bt + (size_t)nxt.pn * tstep : cB;
        int t = 0;
#pragma unroll 1
        do {
            const bool last = (t == nt - 2);
            const char* a1 = cA + (size_t)(t + 1) * kstep;
            const char* a2 = last ? nA : cA + (size_t)(t + 2) * kstep; const char* b2 = last ? nB : cB + (size_t)(t + 2) * kstep;
            const char* a3 = a2 + kstep; const char* b3 = b2 + kstep;
            if (last && has_next) S.a_ready(nxt);
            if constexpr (SP2) {
            PG8_LDB(B0, 0, 0); PG8_LDB(B1, 0, 1); PG8_SCHED; PG8_LDA(At, 0, 0); PG8_STAGE(PG8_SA(1, 1), a1 + hstep, voffA);
            PG8_WAIT_V(8); PG8_WAIT_L(0); PG8_BAR; PG8_MMA(0, 0, At, B0); PG8_MMA(0, 1, At, B1); PG8_BAR; PG8_SCHED;
            PG8_LDA(At, 0, 1); PG8_STAGE(PG8_SB(0, 0), b2, voffB); PG8_STAGE(PG8_SB(0, 1), b2 + hstep, voffB); PG8_STAGE(PG8_SA(0, 0), a2, voffA);
            PG8_WAIT_V(8); PG8_WAIT_L(0); PG8_BAR; PG8_MMA(1, 0, At, B0); PG8_MMA(1, 1, At, B1); PG8_BAR; PG8_SCHED;
            PG8_LDB(B0, 1, 0); PG8_LDB(B1, 1, 1); PG8_SCHED; PG8_LDA(At, 1, 0); PG8_STAGE(PG8_SA(0, 1), a2 + hstep, voffA);
            PG8_WAIT_V(8); PG8_WAIT_L(0); PG8_BAR; PG8_MMA(0, 0, At, B0); PG8_MMA(0, 1, At, B1); PG8_BAR; PG8_SCHED;
            PG8_LDA(At, 1, 1); PG8_STAGE(PG8_SB(1, 0), b3, voffB); PG8_STAGE(PG8_SB(1, 1), b3 + hstep, voffB); PG8_STAGE(PG8_SA(1, 0), a3, voffA);
            PG8_WAIT_V(8); PG8_WAIT_L(0); PG8_BAR; PG8_MMA(1, 0, At, B0); PG8_MMA(1, 1, At, B1); PG8_BAR; PG8_SCHED;
            } else {
            PG8_LDB(B0, 0, 0); PG8_SCHED; PG8_LDA(At, 0, 0); PG8_STAGE(PG8_SA(1, 1), a1 + hstep, voffA);
            PG8_WAIT_L(8); PG8_BAR; PG8_WAIT_L(0); PG8_MMA(0, 0, At, B0); PG8_BAR; PG8_SCHED;
            PG8_LDB(B1, 0, 1); PG8_STAGE(PG8_SB(0, 0), b2, voffB);
            PG8_BAR; PG8_WAIT_L(0); PG8_MMA(0, 1, At, B1); PG8_BAR;
            PG8_LDA(At, 0, 1); PG8_STAGE(PG8_SA(0, 0), a2, voffA);
            PG8_BAR; PG8_WAIT_L(0); PG8_MMA(1, 0, At, B0); PG8_BAR; PG8_SCHED;
            PG8_STAGE(PG8_SB(0, 1), b2 + hstep, voffB);
            PG8_WAIT_V(6); PG8_BAR; PG8_MMA(1, 1, At, B1); PG8_BAR;
            PG8_LDB(B0, 1, 0); PG8_SCHED; PG8_LDA(At, 1, 0); PG8_STAGE(PG8_SA(0, 1), a2 + hstep, voffA);
            PG8_WAIT_L(8); PG8_BAR; PG8_WAIT_L(0); PG8_MMA(0, 0, At, B0); PG8_BAR; PG8_SCHED;
            PG8_LDB(B1, 1, 1); PG8_STAGE(PG8_SB(1, 0), b3, voffB);
            PG8_BAR; PG8_WAIT_L(0); PG8_MMA(0, 1, At, B1); PG8_BAR;
            PG8_LDA(At, 1, 1); PG8_STAGE(PG8_SA(1, 0), a3, voffA);
            PG8_BAR; PG8_WAIT_L(0); PG8_MMA(1, 0, At, B0); PG8_BAR; PG8_SCHED;
            PG8_STAGE(PG8_SB(1, 1), b3 + hstep, voffB);
            PG8_WAIT_V(6); PG8_BAR; PG8_MMA(1, 1, At, B1); PG8_BAR;
            }
            t += 2;
        } while (t < nt);
        if constexpr (ALIGN_EPI) { if (wr == 0) PG8_BAR; }
        if constexpr (!Epi::AFTER_DRAIN) { E(acc, cur, wr, wc, fr, fq); S.done(cur); }
        if (!has_next) break;
#pragma unroll
        for (int a = 0; a < 2; ++a)
#pragma unroll
            for (int b = 0; b < 2; ++b)
#pragma unroll
                for (int m = 0; m < 4; ++m)
#pragma unroll
                    for (int n = 0; n < 2; ++n) acc[a][b][m][n] = (i32x4_t){0, 0, 0, 0};
        cur = nxt; cA = nA; cB = nB; ++ui;
        if constexpr (ALIGN_EPI) { if (wr == 1) PG8_BAR; }
    }
    PG8_WAIT_V(0);
    if constexpr (!ALIGN_EPI) { if (wr == 0) PG8_BAR; }
    PG8_BAR;
    if constexpr (Epi::AFTER_DRAIN) { E.fused(acc, cur, wr, wc, fr, fq, lds, wid, lane); S.done(cur); }
#undef PG8_SA
#undef PG8_SB
#undef PG8_STAGE
#undef PG8_LDA
#undef PG8_LDB
#undef PG8_MMA
#undef PG8_WAIT_V
#undef PG8_WAIT_L
#undef PG8_BAR
#undef PG8_SCHED
}
}
#define GAS __attribute__((address_space(1)))
#define LAS __attribute__((address_space(3)))
typedef unsigned short bf16;
typedef unsigned v4u __attribute__((ext_vector_type(4)));
typedef float f32x4 __attribute__((ext_vector_type(4)));
typedef short bf16x8 __attribute__((ext_vector_type(8)));
typedef GAS unsigned gu32;
typedef GAS unsigned long long gu64;
#define RLX_AGENT __ATOMIC_RELAXED, __HIP_MEMORY_SCOPE_AGENT
#define LDS_WAIT() asm volatile("s_waitcnt lgkmcnt(0)" ::: "memory")
#define VM_WAIT() asm volatile("s_waitcnt vmcnt(0)" ::: "memory")
__device__ __forceinline__ unsigned long long rt() { return __builtin_amdgcn_s_memrealtime(); }
__device__ __forceinline__ unsigned f2bf(float f) { unsigned u = __builtin_bit_cast(unsigned, f); return (u + 0x7fffu + ((u >> 16) & 1u)) >> 16; }
__device__ __forceinline__ unsigned pk2(float lo, float hi) { return f2bf(lo) | (f2bf(hi) << 16); }

#define XB_TMO      128
#define XB_XCNT(j)  (256  + 64 * (j))
#define XB_XSUB(j)  (1280 + 64 * (j))
#define XB_XGEN(j)  (2304 + 64 * (j))
#define XB_TOP      3328
#define XB_TOPGEN   3392
#define XCD_BAR_WORDS 3456
#define XB_SPIN_CAP (1u << 18)

__device__ __forceinline__ unsigned xb_ld(unsigned* p)              { return __hip_atomic_load(p, __ATOMIC_RELAXED, __HIP_MEMORY_SCOPE_AGENT); }
__device__ __forceinline__ unsigned xb_add(unsigned* p, unsigned v) { return __hip_atomic_fetch_add(p, v, __ATOMIC_RELAXED, __HIP_MEMORY_SCOPE_AGENT); }
__device__ __forceinline__ unsigned xb_xcc_id() { return (unsigned)__builtin_amdgcn_s_getreg((3 << 11) | 20) & 0xFu; }
#define XB_SPIN(cond, bar) do { unsigned _sp = 0; while (cond) { __builtin_amdgcn_s_sleep(1); \
    if ((++_sp & 255u) == 0u) { if (xb_ld(&(bar)[XB_TMO])) break; if (_sp > XB_SPIN_CAP) { atomicAdd(&(bar)[XB_TMO], 1u); break; } } } } while (0)

struct XcdBarrier {
    unsigned* bar; unsigned x;
    volatile LAS unsigned* st;
};

__device__ __forceinline__ XcdBarrier xcd_barrier_post(unsigned* bar, volatile LAS unsigned* st) {
    XcdBarrier b; b.bar = bar; b.x = xb_xcc_id(); b.st = st;
    if (threadIdx.x == 0) (void)xb_add(&bar[XB_XCNT(b.x)], 1u);
    return b;
}
__device__ __forceinline__ void xcd_barrier_complete(unsigned* bar, unsigned x, unsigned& nloc, unsigned& nx) {
    const unsigned G = gridDim.x * gridDim.y * gridDim.z;
    unsigned sum, cnt, mine, sp = 0u;
    for (;;) {
        sum = 0u; cnt = 0u; mine = 0u;
#pragma unroll
        for (unsigned j = 0; j < 16; ++j) { const unsigned c = xb_ld(&bar[XB_XCNT(j)]); sum += c; cnt += (c > 0u) ? 1u : 0u; mine = (j == x) ? c : mine; }
        if (sum == G) break;
        __builtin_amdgcn_s_sleep(1);
        if ((++sp & 255u) == 0u) { if (xb_ld(&bar[XB_TMO])) break; if (sp > XB_SPIN_CAP) { atomicAdd(&bar[XB_TMO], 1u); break; } }
    }
    nloc = mine > 0u ? mine : 1u; nx = cnt > 0u ? cnt : 1u;
}

__device__ __forceinline__ void xcd_barrier(const XcdBarrier& b) {
    asm volatile("s_waitcnt vmcnt(0)" ::: "memory");
    __syncthreads();
    if (threadIdx.x == 0) {
        unsigned* bar = b.bar;
        __builtin_amdgcn_s_waitcnt(0);
        unsigned nloc = b.st[0], nx = b.st[1];
        if (nloc == 0u) { xcd_barrier_complete(bar, b.x, nloc, nx); b.st[0] = nloc; b.st[1] = nx; }
        const unsigned old = xb_add(&bar[XB_XSUB(b.x)], 1u);
        const unsigned gen = old / nloc;
        if (old + 1u == (gen + 1u) * nloc) {
            __builtin_amdgcn_fence(__ATOMIC_RELEASE, "agent");
            asm volatile("s_waitcnt vmcnt(0)" ::: "memory");
            const unsigned og = xb_add(&bar[XB_TOP], 1u);
            const unsigned tg = og / nx;
            if (og + 1u == (tg + 1u) * nx) xb_add(&bar[XB_TOPGEN], 1u);
            else XB_SPIN(xb_ld(&bar[XB_TOPGEN]) == tg, bar);
            __builtin_amdgcn_fence(__ATOMIC_ACQUIRE, "agent");
            xb_add(&bar[XB_XGEN(b.x)], 1u);
            asm volatile("s_waitcnt vmcnt(0)" ::: "memory");
        } else {
            XB_SPIN(xb_ld(&bar[XB_XGEN(b.x)]) == gen, bar);
            __builtin_amdgcn_fence(__ATOMIC_ACQUIRE, "agent");
            asm volatile("s_waitcnt vmcnt(0)" ::: "memory");
        }
    }
    __syncthreads();
}
constexpr int T = 65536, SEQ = 4096, DM = 1024;
constexpr int NWAVES = 8;
constexpr float EPS = 1e-6f;
constexpr float LOG2E = 1.4426950408889634f;
constexpr float QSCALE_A = 0.10206207261596575f * LOG2E;
constexpr float QSCALE_B = 0.125f * LOG2E;
constexpr float LOG2_THETA = 13.287712379549449f;
constexpr float INV_2PI = 0.15915494309189535f;

constexpr size_t MiB = 1u << 20;
constexpr size_t WS_CTL = 0, CTL_ZERO_BYTES = 4 * MiB;
constexpr size_t WS_MOD = 2 * MiB;
constexpr size_t WS_TOPK = 4 * MiB;
constexpr size_t WS_GATES = 4 * MiB + 512 * 1024;
constexpr size_t WS_SLOTS = 5 * MiB;
constexpr size_t WS_GSLOT = 5 * MiB + 512 * 1024;
constexpr size_t WS_BLKCNT = 6 * MiB + 128 * 1024;
constexpr size_t WS_PENDS = 6 * MiB + 256 * 1024;
constexpr size_t WS_TOKSLOT = 6 * MiB + 512 * 1024;
constexpr size_t WS_ROWSC = 7 * MiB + 256 * 1024;
constexpr size_t WS_WAMAX = 64 * 1024;
constexpr size_t WS_W = 8 * MiB;
constexpr size_t W_IN = WS_W;
constexpr size_t W_UQ = W_IN + (size_t)1280 * 1024 * 2;
constexpr size_t W_UKV = W_UQ + (size_t)768 * 256 * 2;
constexpr size_t W_OUT = W_UKV + (size_t)1024 * 128 * 2;
constexpr size_t W_GU = W_OUT + (size_t)1024 * 1024 * 2;
constexpr size_t W_D = W_GU + (size_t)5632 * 1024 * 2;
constexpr size_t W_QKV = W_D + (size_t)1024 * 2816 * 2;
constexpr size_t W_DO = W_QKV + (size_t)3072 * 1024 * 2;
constexpr size_t W_MGU = W_DO + (size_t)1024 * 1024 * 2;
constexpr size_t W_MD = W_MGU + (size_t)8 * 7168 * 1024 * 2;
constexpr size_t W_END = W_MD + (size_t)8 * 1024 * 3584 * 2;
static_assert(W_END <= 208 * MiB, "weights region");
constexpr size_t A_H = 208 * MiB;
constexpr size_t A_P = 336 * MiB;
constexpr size_t A_CQ = 496 * MiB;
constexpr size_t A_CKV = 528 * MiB;
constexpr size_t A_QB = 544 * MiB;
constexpr size_t A_KB = 608 * MiB;
constexpr size_t A_QA = 624 * MiB;
constexpr size_t A_KV = 720 * MiB;
constexpr size_t A_KA = 848 * MiB;
constexpr size_t A_ATT0 = A_H;
constexpr size_t A_ACT = 336 * MiB;
constexpr size_t A_QKV = 336 * MiB;
constexpr size_t A_ATT1 = 720 * MiB;
constexpr size_t A_O2 = 848 * MiB;
constexpr size_t A_LSE1 = 976 * MiB;
constexpr size_t A_LSE2 = 980 * MiB;
constexpr size_t A_HP = 208 * MiB;
constexpr size_t A_Y = 208 * MiB;
constexpr size_t A_ACTM = 468 * MiB;
constexpr size_t WS_NEED = 984 * MiB;

constexpr int CW_BAR = 4096;
constexpr int RING_BYTES = 131072;
constexpr int LDS_BYTES = 163840;
constexpr int MISC_OFF = LDS_BYTES - 512;
constexpr int LDS_ZERO_OFF = LDS_BYTES - 1024;

constexpr int NPH = 28;
#ifndef FFN_FP8
#define FFN_FP8 3
#endif

struct Args {
    const float* in[31];
    float* out;
    unsigned char* ws;
    int ph_lo, ph_hi;
};
enum { I_X = 0, I_C, I_ADA_E_W, I_ADA_E_B, I_NORM_E_MIX, I_NORM_E_FFN, I_W_IN, I_Q_NORM, I_W_UQ, I_KV_NORM, I_W_UKV, I_MLA_QG, I_MLA_KG, I_GQA_QG, I_GQA_KG,
       I_E_W_OUT, I_FFN_G, I_FFN_U, I_FFN_D, I_ADA_O_W, I_ADA_O_B, I_NORM_O_MIX, I_NORM_O_FFN, I_DIL_QKV, I_DIL_QG, I_DIL_KG, I_DIL_OUT, I_ROUTER, I_MOE_G, I_MOE_U, I_MOE_D };

__device__ __forceinline__ float bf2f(unsigned b) { return __builtin_bit_cast(float, b << 16); }
__device__ __forceinline__ float bflo(unsigned w) { return __builtin_bit_cast(float, w << 16); }
__device__ __forceinline__ float bfhi(unsigned w) { return __builtin_bit_cast(float, w & 0xffff0000u); }
template <int CTRL> __device__ __forceinline__ float dppf(float v) { return __builtin_bit_cast(float, __builtin_amdgcn_update_dpp(0, __builtin_bit_cast(int, v), CTRL, 0xF, 0xF, false)); }
__device__ __forceinline__ float rdl(float v, int l) { return __builtin_bit_cast(float, __builtin_amdgcn_readlane(__builtin_bit_cast(int, v), l)); }
__device__ __forceinline__ float wave_sum(float v) {
    v += dppf<0xB1>(v); v += dppf<0x4E>(v); v += dppf<0x141>(v); v += dppf<0x140>(v);
    return (rdl(v, 0) + rdl(v, 16)) + (rdl(v, 32) + rdl(v, 48));
}
__device__ __forceinline__ float wave_max(float v) {
    v = fmaxf(v, dppf<0xB1>(v)); v = fmaxf(v, dppf<0x4E>(v)); v = fmaxf(v, dppf<0x141>(v)); v = fmaxf(v, dppf<0x140>(v));
    return fmaxf(fmaxf(rdl(v, 0), rdl(v, 16)), fmaxf(rdl(v, 32), rdl(v, 48)));
}
typedef __bf16 bf16n2_t __attribute__((ext_vector_type(2)));
typedef float f32n2_t __attribute__((ext_vector_type(2)));
__device__ __forceinline__ unsigned cvtpk(float lo, float hi) { const f32n2_t v = {lo, hi}; return __builtin_bit_cast(unsigned, __builtin_convertvector(v, bf16n2_t)); }

__device__ __forceinline__ void transpose_item(const float* W, int N, int k0, int n0, bf16* dst, int Kd, LAS float* scr, int lane) {
#pragma unroll 4
    for (int i = 0; i < 32; ++i) { const int kk = 2 * i + (lane >> 5); scr[kk * 33 + (lane & 31)] = W[(size_t)(k0 + kk) * N + n0 + (lane & 31)]; }
    LDS_WAIT(); asm volatile("" ::: "memory");
    const int c = lane & 7;
#pragma unroll
    for (int j = 0; j < 4; ++j) { const int n = (lane >> 3) + 8 * j; const LAS float* s = scr + (8 * c) * 33 + n;
        v4u o; o.x = pk2(s[0 * 33], s[1 * 33]); o.y = pk2(s[2 * 33], s[3 * 33]); o.z = pk2(s[4 * 33], s[5 * 33]); o.w = pk2(s[6 * 33], s[7 * 33]);
        *(GAS v4u*)(dst + (size_t)n * Kd + k0 + 8 * c) = o; }
    LDS_WAIT(); asm volatile("" ::: "memory");
}
__device__ __forceinline__ void tr_plain(const float* W, int K, int N, bf16* WT, int r, LAS float* scr, int lane) {
    const int nblk = N / 32, kb = r / nblk, nb = r % nblk;
    transpose_item(W, N, 64 * kb, 32 * nb, WT + (size_t)(32 * nb) * K, K, scr, lane);
}
__device__ __forceinline__ void tr_gu(const float* W, int K, int N, bf16* WT, int upoff, int r, LAS float* scr, int lane) {
    const int nblk = N / 32, kb = r / nblk, nb = r % nblk, n0 = 32 * nb;
    const int drow = (n0 >> 7) * 256 + (n0 & 127) + upoff;
    transpose_item(W, N, 64 * kb, n0, WT + (size_t)drow * K, K, scr, lane);
}


typedef unsigned u32x2_t __attribute__((ext_vector_type(2)));
constexpr float F8_WS = 64.f, F8_HS = 4.f, F8_AS = 4.f;
__device__ __forceinline__ float clamp448(float v) { return fminf(fmaxf(v, -448.f), 448.f); }
__device__ __forceinline__ unsigned pk4_fp8(float a, float b, float c, float d) { int w = 0; w = __builtin_amdgcn_cvt_pk_fp8_f32(a, b, w, false); w = __builtin_amdgcn_cvt_pk_fp8_f32(c, d, w, true); return (unsigned)w; }
__device__ __forceinline__ void transpose_item8(const float* W, int N, int k0, int n0, unsigned char* dst8, int Kd, float sc, LAS float* scr, int lane) {
#pragma unroll 4
    for (int i = 0; i < 32; ++i) { const int kk = 2 * i + (lane >> 5); scr[kk * 33 + (lane & 31)] = W[(size_t)(k0 + kk) * N + n0 + (lane & 31)]; }
    LDS_WAIT(); asm volatile("" ::: "memory");
    const int c = lane & 7;
#pragma unroll
    for (int j = 0; j < 4; ++j) { const int n = (lane >> 3) + 8 * j; const LAS float* s = scr + (8 * c) * 33 + n;
        u32x2_t o; o.x = pk4_fp8(s[0 * 33] * sc, s[1 * 33] * sc, s[2 * 33] * sc, s[3 * 33] * sc); o.y = pk4_fp8(s[4 * 33] * sc, s[5 * 33] * sc, s[6 * 33] * sc, s[7 * 33] * sc);
        *(GAS u32x2_t*)(dst8 + (size_t)n * Kd + k0 + 8 * c) = o; }
    LDS_WAIT(); asm volatile("" ::: "memory");
}
__device__ __forceinline__ void tr_plain8(const float* W, int K, int N, unsigned char* WT, int r, LAS float* scr, int lane) {
    const int nblk = N / 32, kb = r / nblk, nb = r % nblk;
    transpose_item8(W, N, 64 * kb, 32 * nb, WT + (size_t)(32 * nb) * K, K, F8_WS, scr, lane);
}
__device__ __forceinline__ void tr_gu8(const float* W, int K, int N, unsigned char* WT, int upoff, int r, LAS float* scr, int lane) {
    const int nblk = N / 32, kb = r / nblk, nb = r % nblk, n0 = 32 * nb;
    const int drow = (n0 >> 7) * 256 + (n0 & 127) + upoff;
    transpose_item8(W, N, 64 * kb, n0, WT + (size_t)drow * K, K, F8_WS, scr, lane);
}


__device__ __forceinline__ unsigned pk4_i8(float a, float b, float c, float d) {
    const int ia = (int)__builtin_rintf(__builtin_amdgcn_fmed3f(a, -127.f, 127.f)), ib = (int)__builtin_rintf(__builtin_amdgcn_fmed3f(b, -127.f, 127.f));
    const int ic = (int)__builtin_rintf(__builtin_amdgcn_fmed3f(c, -127.f, 127.f)), id = (int)__builtin_rintf(__builtin_amdgcn_fmed3f(d, -127.f, 127.f));
    return (unsigned)(ia & 255) | ((unsigned)(ib & 255) << 8) | ((unsigned)(ic & 255) << 16) | ((unsigned)(id & 255) << 24);
}
__device__ __forceinline__ void transpose_item_i8(const float* W, int N, int k0, int n0, unsigned char* dst8, int Kd, float sc, LAS float* scr, int lane) {
#pragma unroll 4
    for (int i = 0; i < 32; ++i) { const int kk = 2 * i + (lane >> 5); scr[kk * 33 + (lane & 31)] = W[(size_t)(k0 + kk) * N + n0 + (lane & 31)]; }
    LDS_WAIT(); asm volatile("" ::: "memory");
    const int c = lane & 7;
#pragma unroll
    for (int j = 0; j < 4; ++j) { const int n = (lane >> 3) + 8 * j; const LAS float* s = scr + (8 * c) * 33 + n;
        u32x2_t o; o.x = pk4_i8(s[0 * 33] * sc, s[1 * 33] * sc, s[2 * 33] * sc, s[3 * 33] * sc); o.y = pk4_i8(s[4 * 33] * sc, s[5 * 33] * sc, s[6 * 33] * sc, s[7 * 33] * sc);
        *(GAS u32x2_t*)(dst8 + (size_t)n * Kd + k0 + 8 * c) = o; }
    LDS_WAIT(); asm volatile("" ::: "memory");
}
__device__ __forceinline__ void tr_gu_i8(const float* W, int K, int N, unsigned char* WT, int upoff, float sc, int r, LAS float* scr, int lane) {
    const int nblk = N / 32, kb = r / nblk, nb = r % nblk, n0 = 32 * nb;
    const int drow = (n0 >> 7) * 256 + (n0 & 127) + upoff;
    transpose_item_i8(W, N, 64 * kb, n0, WT + (size_t)drow * K, K, sc, scr, lane);
}
__device__ __forceinline__ void absmax_pass(const float* w, size_t n4, unsigned* slot, int gw, int NGW, int lane) {
    float mx = 0.f;
    for (size_t i = (size_t)gw * 64 + lane; i < n4; i += (size_t)NGW * 64) { const f32x4 v = ((const f32x4*)w)[i]; mx = fmaxf(fmaxf(mx, fmaxf(fabsf(v.x), fabsf(v.y))), fmaxf(fabsf(v.z), fabsf(v.w))); }
#pragma unroll
    for (int o = 1; o < 64; o <<= 1) mx = fmaxf(mx, __shfl_xor(mx, o));
    if (lane == 0) atomicMax(slot, __builtin_bit_cast(unsigned, mx));
}
__device__ __forceinline__ void p0_prologue(const Args& a, LAS unsigned char* lds, int gw, int NGW, int wave, int lane) {
    unsigned char* ws = a.ws;
    LAS float* scr = (LAS float*)(lds + wave * 16384);
    constexpr int I0 = 16 * 37, I1 = 4 * 24, I2 = 2 * 32, I3 = 16 * 32, I4 = 16 * 88, I6 = 44 * 32, I7 = 16 * 96, I8 = 16 * 32, IM = 16 * 112, IMD = 56 * 32;
    constexpr int NITEMS = I0 + I1 + I2 + I3 + 2 * I4 + I6 + I7 + I8 + 16 * IM + 8 * IMD;
#ifndef PROBE_P0N
#define PROBE_P0N 0
#endif
    for (int rp0_ = 0; rp0_ <= PROBE_P0N; ++rp0_)
    for (int it = gw; it < NITEMS; it += NGW) {
        int r = it;
        if (r < I0) continue;
        r -= I0;
        if (r < I1) { tr_plain(a.in[I_W_UQ], 256, 768, (bf16*)(ws + W_UQ), r, scr, lane); continue; } r -= I1;
        if (r < I2) {
            const int nblk = 1024 / 32, kb = r / nblk, nb = r % nblk, n0 = 32 * nb; const int hd = n0 >> 7, w = n0 & 127; const int drow = (w < 64) ? hd * 64 + w : 512 + hd * 64 + (w - 64);
            transpose_item(a.in[I_W_UKV], 1024, 64 * kb, n0, (bf16*)(ws + W_UKV) + (size_t)drow * 128, 128, scr, lane); continue; } r -= I2;
        if (r < I3) { tr_plain(a.in[I_E_W_OUT], 1024, 1024, (bf16*)(ws + W_OUT), r, scr, lane); continue; } r -= I3;
#if FFN_FP8 == 1
        if (r < I4) { tr_gu8(a.in[I_FFN_G], 1024, 2816, ws + W_GU, 0, r, scr, lane); continue; } r -= I4;
        if (r < I4) { tr_gu8(a.in[I_FFN_U], 1024, 2816, ws + W_GU, 128, r, scr, lane); continue; } r -= I4;
        if (r < I6) { tr_plain8(a.in[I_FFN_D], 2816, 1024, ws + W_D, r, scr, lane); continue; } r -= I6;
#elif FFN_FP8 == 2
        if (r < I4) { tr_gu(a.in[I_FFN_G], 1024, 2816, (bf16*)(ws + W_GU), 0, r, scr, lane); continue; } r -= I4;
        if (r < I4) { tr_gu(a.in[I_FFN_U], 1024, 2816, (bf16*)(ws + W_GU), 128, r, scr, lane); continue; } r -= I4;
        if (r < I6) { tr_plain8(a.in[I_FFN_D], 2816, 1024, ws + W_D, r, scr, lane); continue; } r -= I6;
#elif FFN_FP8 == 3
        if (r < 2 * I4) continue;
        r -= 2 * I4;
        if (r < I6) { tr_plain8(a.in[I_FFN_D], 2816, 1024, ws + W_D, r, scr, lane); continue; } r -= I6;
#else
        if (r < 2 * I4) continue;
        r -= 2 * I4;
        if (r < I6) { tr_plain(a.in[I_FFN_D], 2816, 1024, (bf16*)(ws + W_D), r, scr, lane); continue; } r -= I6;
#endif
        if (r < I7) continue;
        r -= I7;
        if (r < I8) { tr_plain(a.in[I_DIL_OUT], 1024, 1024, (bf16*)(ws + W_DO), r, scr, lane); continue; } r -= I8;
        if (r < 8 * IM) { const int e = r / IM; tr_gu8(a.in[I_MOE_G] + (size_t)e * 1024 * 3584, 1024, 3584, ws + W_MGU + (size_t)e * 7168 * 1024, 0, r % IM, scr, lane); continue; } r -= 8 * IM;
        if (r < 8 * IM) { const int e = r / IM; tr_gu8(a.in[I_MOE_U] + (size_t)e * 1024 * 3584, 1024, 3584, ws + W_MGU + (size_t)e * 7168 * 1024, 128, r % IM, scr, lane); continue; } r -= 8 * IM;
        { const int e = r / IMD; tr_plain8(a.in[I_MOE_D] + (size_t)e * 3584 * 1024, 3584, 1024, ws + W_MD + (size_t)e * 1024 * 3584, r % IMD, scr, lane); }
    }
    { GAS v4u* z = (GAS v4u*)(ws + W_IN + (size_t)1184 * 1024);
      for (int i = gw * 64 + lane; i < 6144; i += NGW * 64) z[i] = (v4u){0u, 0u, 0u, 0u}; }
#if FFN_FP8 == 0 || FFN_FP8 == 3
    absmax_pass(a.in[I_FFN_G], (size_t)1024 * 2816 / 4, (unsigned*)(ws + WS_WAMAX), gw, NGW, lane); absmax_pass(a.in[I_FFN_U], (size_t)1024 * 2816 / 4, (unsigned*)(ws + WS_WAMAX), gw, NGW, lane);
    absmax_pass(a.in[I_DIL_QKV], (size_t)1024 * 3072 / 4, (unsigned*)(ws + WS_WAMAX) + 1, gw, NGW, lane);
    absmax_pass(a.in[I_W_IN], (size_t)1024 * 1184 / 4, (unsigned*)(ws + WS_WAMAX) + 2, gw, NGW, lane);
#endif
    for (int u = gw; u < 2 * 96 * 16; u += NGW) {
        const int layer = u / 1536, rem = u % 1536, cg = rem >> 4, kc = rem & 15;
        const float* W = a.in[layer ? I_ADA_O_W : I_ADA_E_W]; const float* bia = a.in[layer ? I_ADA_O_B : I_ADA_E_B];
        unsigned long long* mod = (unsigned long long*)(ws + WS_MOD) + layer * 16 * 6144;
        const int n = cg * 64 + lane, k0 = kc * 64;
        float s[16], acc[16];
#pragma unroll
        for (int b = 0; b < 16; ++b) { const float cv = a.in[I_C][b * 1024 + k0 + lane]; s[b] = cv / (1.f + __expf(-cv)); acc[b] = 0.f; }
#pragma unroll 4
        for (int kk = 0; kk < 64; ++kk) { const float w = W[(size_t)(k0 + kk) * 6144 + n];
#pragma unroll
            for (int b = 0; b < 16; ++b) acc[b] += __builtin_bit_cast(float, __builtin_amdgcn_readlane(__builtin_bit_cast(int, s[b]), kk)) * w; }
        const float bv = (kc == 0) ? bia[n] : 0.f;
#pragma unroll
        for (int b = 0; b < 16; ++b) atomicAdd(mod + b * 6144 + n, (unsigned long long)(long long)((acc[b] + bv) * 1099511627776.0f));
    }
}

struct ModPar { f32x4 a[4], s[4]; };
typedef long long modw_t;
__device__ __forceinline__ float modv(const modw_t* p) { return (float)(*p) * 9.094947017729282e-13f; }
__device__ __forceinline__ f32x4 modv4(const modw_t* p) { return (f32x4){modv(p), modv(p + 1), modv(p + 2), modv(p + 3)}; }
__device__ __forceinline__ void load_modpar(ModPar& mp, const float* g, const modw_t* mod_b, int jshift, int jscale, int lane) {
#pragma unroll
    for (int j = 0; j < 4; ++j) { const int col = 4 * lane + 256 * j;
        const f32x4 gv = *(const f32x4*)(g + col), sc = modv4(mod_b + jscale * 1024 + col), sh = modv4(mod_b + jshift * 1024 + col);
        mp.a[j] = gv * (sc + 1.0f); mp.s[j] = sh; }
}
constexpr int XP = 2048;
template <bool BF = false>
__device__ __forceinline__ void mod_row_f32(const void* xrow, const ModPar& mp, f32x4 (&h)[4], int lane) {
    float ss = 0.f;
#pragma unroll
    for (int j = 0; j < 4; ++j) {
        if (BF) { const uint2 r = ((const uint2*)xrow)[lane + 64 * j]; h[j] = (f32x4){bflo(r.x), bfhi(r.x), bflo(r.y), bfhi(r.y)}; }
        else h[j] = ((const f32x4*)xrow)[lane + 64 * j];
        ss += (h[j].x * h[j].x + h[j].y * h[j].y) + (h[j].z * h[j].z + h[j].w * h[j].w); }
    const float rs = 1.0f / sqrtf(wave_sum(ss) * (1.f / 1024.f) + EPS);
#pragma unroll
    for (int j = 0; j < 4; ++j) h[j] = h[j] * rs * mp.a[j] + mp.s[j];
}
__device__ __forceinline__ void store_row_bf16(bf16* orow, const f32x4 (&h)[4], int lane) {
    unsigned long long* o8 = (unsigned long long*)orow + lane;
#pragma unroll
    for (int j = 0; j < 4; ++j) o8[64 * j] = (unsigned long long)pk2(h[j].x, h[j].y) | ((unsigned long long)pk2(h[j].z, h[j].w) << 32);
}
__device__ __forceinline__ void store_row_fp8(unsigned char* orow, const f32x4 (&h)[4], int lane) {
    unsigned* o4 = (unsigned*)orow + lane;
#pragma unroll
    for (int j = 0; j < 4; ++j) o4[64 * j] = pk4_fp8(clamp448(h[j].x * F8_HS), clamp448(h[j].y * F8_HS), clamp448(h[j].z * F8_HS), clamp448(h[j].w * F8_HS));
}
__device__ __forceinline__ void store_row_i8(unsigned char* orow, float* rowscale, const f32x4 (&h)[4], int lane) {
    float mx = 0.f;
#pragma unroll
    for (int j = 0; j < 4; ++j) mx = fmaxf(fmaxf(mx, fmaxf(fabsf(h[j].x), fabsf(h[j].y))), fmaxf(fabsf(h[j].z), fabsf(h[j].w)));
    mx = wave_max(mx);
    mx = fmaxf(mx, 1e-20f); const float inv = 127.f / mx;
    unsigned* o4 = (unsigned*)orow + lane;
#pragma unroll
    for (int j = 0; j < 4; ++j) o4[64 * j] = pk4_i8(h[j].x * inv, h[j].y * inv, h[j].z * inv, h[j].w * inv);
    if (lane == 0) *rowscale = mx * (1.f / 127.f);
}
template <bool F8OUT = false, bool BFIN = false, bool I8OUT = false>
__device__ __forceinline__ void modulate_phase(const void* xin, const float* g, const modw_t* mod_layer, int jshift, int jscale, bf16* H, int gw, int NGW, int lane, float* rowsc = nullptr) {
    for (int bi = gw; bi < T / 32; bi += NGW) {
        const int b = bi >> 7; ModPar mp; load_modpar(mp, g, mod_layer + b * 6144, jshift, jscale, lane);
#pragma unroll 8
        for (int r = 0; r < 32; ++r) { const size_t row = (size_t)bi * 32 + r; f32x4 h[4]; if (BFIN) mod_row_f32<true>((const bf16*)xin + row * XP, mp, h, lane); else mod_row_f32<false>((const float*)xin + row * 1024, mp, h, lane); if (I8OUT) store_row_i8((unsigned char*)H + row * 1024, rowsc + row, h, lane); else if (F8OUT) store_row_fp8((unsigned char*)H + row * 1024, h, lane); else store_row_bf16(H + row * 1024, h, lane); }
    }
}

__device__ __forceinline__ void cs_rev(float pos, float revf, float& c, float& s) { const float fr = __builtin_amdgcn_fractf(pos * revf); c = __builtin_amdgcn_cosf(fr); s = __builtin_amdgcn_sinf(fr); }
__device__ __forceinline__ void unpack8(const v4u& r, float (&v)[8]) { v[0] = bflo(r.x); v[1] = bfhi(r.x); v[2] = bflo(r.y); v[3] = bfhi(r.y); v[4] = bflo(r.z); v[5] = bfhi(r.z); v[6] = bflo(r.w); v[7] = bfhi(r.w); }
__device__ __forceinline__ v4u pack8(const float (&v)[8]) { v4u o; o.x = pk2(v[0], v[1]); o.y = pk2(v[2], v[3]); o.z = pk2(v[4], v[5]); o.w = pk2(v[6], v[7]); return o; }

__device__ __forceinline__ void r2_phase(const Args& a, int gw, int NGW, int lane) {
    unsigned char* ws = a.ws;
    const bf16* P = (const bf16*)(ws + A_P); bf16* CQ = (bf16*)(ws + A_CQ); bf16* CKV = (bf16*)(ws + A_CKV); bf16* QB = (bf16*)(ws + A_QB); bf16* KB = (bf16*)(ws + A_KB);
    const int sub = lane & 7;
    float qn[4], kvn[2], gq[8], gk[8], revf[8];
#pragma unroll
    for (int i = 0; i < 4; ++i) qn[i] = a.in[I_Q_NORM][4 * lane + i];
    kvn[0] = a.in[I_KV_NORM][2 * lane]; kvn[1] = a.in[I_KV_NORM][2 * lane + 1];
#pragma unroll
    for (int j = 0; j < 8; ++j) { gq[j] = a.in[I_GQA_QG][8 * sub + j]; gk[j] = a.in[I_GQA_KG][8 * sub + j];
        const int i = 8 * (sub & 1) + j; revf[j] = exp2f(-(float)i * (LOG2_THETA / 16.f)) * INV_2PI; }
#pragma unroll 2
    for (int row = gw; row < T; row += NGW) {
        const bf16* pr = P + (size_t)row * 1280; const int t = row & 4095; const float pos = (float)((sub & 4) ? (t & 63) : (t >> 6));
        { const uint2 raw = *(const uint2*)(pr + 4 * lane); float v0 = bflo(raw.x), v1 = bfhi(raw.x), v2 = bflo(raw.y), v3 = bfhi(raw.y);
          const float rs = 1.0f / sqrtf(wave_sum((v0 * v0 + v1 * v1) + (v2 * v2 + v3 * v3)) * (1.f / 256.f) + EPS);
          uint2 o; o.x = pk2(v0 * rs * qn[0], v1 * rs * qn[1]); o.y = pk2(v2 * rs * qn[2], v3 * rs * qn[3]); *(uint2*)(CQ + (size_t)row * 256 + 4 * lane) = o; }
        { const unsigned raw = *(const unsigned*)(pr + 256 + 2 * lane); float v0 = bflo(raw), v1 = bfhi(raw);
          const float rs = 1.0f / sqrtf(wave_sum(v0 * v0 + v1 * v1) * (1.f / 128.f) + EPS);
          *(unsigned*)(CKV + (size_t)row * 128 + 2 * lane) = pk2(v0 * rs * kvn[0], v1 * rs * kvn[1]); }
#pragma unroll
        for (int which = 1; which < 2; ++which) {
            const int l2 = which ? (lane & 15) : lane;
            const v4u raw = *(const v4u*)(pr + (which ? 928 : 416) + 8 * l2); float v[8]; unpack8(raw, v);
            float ss = 0.f;
#pragma unroll
            for (int j = 0; j < 8; ++j) ss += v[j] * v[j];
            ss += __shfl_xor(ss, 1); ss += __shfl_xor(ss, 2); ss += __shfl_xor(ss, 4);
            const float rs = 1.0f / sqrtf(ss * (1.f / 64.f) + EPS); float o[8];
#pragma unroll
            for (int j = 0; j < 8; ++j) { const float x = v[j] * rs * (which ? gk[j] : gq[j]); const float w = __shfl_xor(x, 2); float c, s; cs_rev(pos, revf[j], c, s);
                o[j] = (sub & 2) ? (x * c + w * s) : (x * c - w * s); if (!which) o[j] *= QSCALE_B; }
            if (!which) *(v4u*)(QB + (size_t)row * 512 + 8 * lane) = pack8(o);
            else if (lane < 16) *(v4u*)(KB + (size_t)row * 128 + 8 * lane) = pack8(o);
        }
    }
}

__device__ __forceinline__ void r3_phase(const Args& a, int gw, int NGW, int lane) {
    unsigned char* ws = a.ws;
    const bf16* P = (const bf16*)(ws + A_P); bf16* QA = (bf16*)(ws + A_QA); const bf16* KV = (const bf16*)(ws + A_KV); bf16* KA = (bf16*)(ws + A_KA);
    const int head = lane >> 3, sub = lane & 7;
    float gqn[8], gqr[4], gkn[8], gkr[4], revf[4];
#pragma unroll
    for (int j = 0; j < 8; ++j) { gqn[j] = a.in[I_MLA_QG][8 * sub + j]; gkn[j] = a.in[I_MLA_KG][8 * sub + j]; }
#pragma unroll
    for (int j = 0; j < 4; ++j) { gqr[j] = a.in[I_MLA_QG][64 + 4 * sub + j]; gkr[j] = a.in[I_MLA_KG][64 + 4 * sub + j];
        const int i = 4 * (sub & 3) + j; revf[j] = exp2f(-(float)i * (LOG2_THETA / 16.f)) * INV_2PI; }
#pragma unroll 2
    for (int row = gw; row < T; row += NGW) {
        const float pos = (float)(row & 4095);
#pragma unroll
        for (int which = 1; which < 2; ++which) {
            const bf16* np = which ? (KV + (size_t)row * 512 + head * 64 + 8 * sub) : (QA + (size_t)row * 768 + head * 96 + 8 * sub);
            const bf16* rp = which ? (P + (size_t)row * 1280 + 384 + 4 * sub) : (QA + (size_t)row * 768 + head * 96 + 64 + 4 * sub);
            const v4u rn = *(const v4u*)np; const uint2 rr = *(const uint2*)rp;
            float v[8], r4[4]; unpack8(rn, v); r4[0] = bflo(rr.x); r4[1] = bfhi(rr.x); r4[2] = bflo(rr.y); r4[3] = bfhi(rr.y);
            float ss = 0.f;
#pragma unroll
            for (int j = 0; j < 8; ++j) ss += v[j] * v[j];
#pragma unroll
            for (int j = 0; j < 4; ++j) ss += r4[j] * r4[j];
            ss += __shfl_xor(ss, 1); ss += __shfl_xor(ss, 2); ss += __shfl_xor(ss, 4);
            const float rs = 1.0f / sqrtf(ss * (1.f / 96.f) + EPS); const float qs = which ? 1.0f : QSCALE_A;
            float o[8], orp[4];
#pragma unroll
            for (int j = 0; j < 8; ++j) o[j] = v[j] * rs * (which ? gkn[j] : gqn[j]) * qs;
#pragma unroll
            for (int j = 0; j < 4; ++j) { const float x = r4[j] * rs * (which ? gkr[j] : gqr[j]); const float w = __shfl_xor(x, 4); float c, s; cs_rev(pos, revf[j], c, s);
                orp[j] = ((sub & 4) ? (x * c + w * s) : (x * c - w * s)) * qs; }
            bf16* on = (which ? KA : QA) + (size_t)row * 768 + head * 96;
            *(v4u*)(on + 8 * sub) = pack8(o);
            uint2 o2; o2.x = pk2(orp[0], orp[1]); o2.y = pk2(orp[2], orp[3]); *(uint2*)(on + 64 + 4 * sub) = o2;
        }
    }
}

__device__ __forceinline__ void r6_phase(const Args& a, int gw, int NGW, int lane) {
    bf16* QKV = (bf16*)(a.ws + A_QKV);
    const int sub = lane & 3;
    float gq[16], gk[16], revf[16];
#pragma unroll
    for (int j = 0; j < 16; ++j) { gq[j] = a.in[I_DIL_QG][16 * sub + j]; gk[j] = a.in[I_DIL_KG][16 * sub + j];
        const int i = 16 * (sub & 1) + j; revf[j] = exp2f(-(float)i * (LOG2_THETA / 32.f)) * INV_2PI; }
    for (int row = gw; row < T; row += NGW) {
        const float pos = (float)(row & 4095);
#pragma unroll
        for (int which = 0; which < 2; ++which) {
            bf16* p = QKV + (size_t)row * 3072 + which * 1024 + 16 * lane;
            const v4u r0 = *(const v4u*)p, r1 = *(const v4u*)(p + 8); float v0[8], v1[8]; unpack8(r0, v0); unpack8(r1, v1);
            float ss = 0.f;
#pragma unroll
            for (int j = 0; j < 8; ++j) ss += v0[j] * v0[j] + v1[j] * v1[j];
            ss += __shfl_xor(ss, 1); ss += __shfl_xor(ss, 2);
            const float rs = 1.0f / sqrtf(ss * (1.f / 64.f) + EPS); float o0[8], o1[8];
#pragma unroll
            for (int j = 0; j < 16; ++j) { const float xin = (j < 8) ? v0[j & 7] : v1[j & 7]; const float x = xin * rs * (which ? gk[j] : gq[j]); const float w = __shfl_xor(x, 2); float c, s; cs_rev(pos, revf[j], c, s);
                float o = (sub & 2) ? (x * c + w * s) : (x * c - w * s); if (!which) o *= QSCALE_B; if (j < 8) o0[j & 7] = o; else o1[j & 7] = o; }
            *(v4u*)p = pack8(o0); *(v4u*)(p + 8) = pack8(o1);
        }
    }
}
namespace att {
using f32x16 = __attribute__((ext_vector_type(16))) float;
using s16x4 = __attribute__((ext_vector_type(4))) short;
#define SBAR() __builtin_amdgcn_sched_barrier(0)
__device__ __forceinline__ int crow(int r, int hi) { return (r & 3) + 8 * (r >> 2) + 4 * hi; }
template <int DQ> struct Lay {
    static constexpr int KROW = DQ * 2 + 16;
    static constexpr int KBUF = 64 * KROW;
    static constexpr int VBUF = 8192;
    static constexpr int K_OFF = 0, V_OFF = 2 * KBUF, WS_OFF = V_OFF + 2 * VBUF, BYTES = WS_OFF + 8 * 512;
};
__device__ __forceinline__ int v_st(int k, int c) { const int kk = k; return ((kk >> 3) * 2 + (c >> 5)) * 512 + ((kk & 7) * 32 + (c & 31)) * 2; }
__device__ __forceinline__ int v_rd_base(int lane) { return ((lane & 3) << 3) | (((lane >> 2) & 3) << 6) | (((lane >> 4) & 1) << 5) | (((lane >> 5) & 1) << 8); }
template <int OFF> __device__ __forceinline__ s16x4 tr_read(int vb) { s16x4 r; asm volatile("ds_read_b64_tr_b16 %0, %1 offset:%2" : "=&v"(r) : "v"(vb), "i"(OFF) : "memory"); return r; }
template <int D0> __device__ __forceinline__ void pv_one(f32x16& od, int vb, bf16x8 pa0, bf16x8 pa1, bf16x8 pa2, bf16x8 pa3) {
    const s16x4 l0 = tr_read<D0 * 512 + 0 * 2048>(vb), h0 = tr_read<D0 * 512 + 0 * 2048 + 1024>(vb), l1 = tr_read<D0 * 512 + 1 * 2048>(vb), h1 = tr_read<D0 * 512 + 1 * 2048 + 1024>(vb);
    const s16x4 l2 = tr_read<D0 * 512 + 2 * 2048>(vb), h2 = tr_read<D0 * 512 + 2 * 2048 + 1024>(vb), l3 = tr_read<D0 * 512 + 3 * 2048>(vb), h3 = tr_read<D0 * 512 + 3 * 2048 + 1024>(vb);
    asm volatile("s_waitcnt lgkmcnt(0)" ::: "memory"); SBAR();
#define PKV(L, H) (bf16x8){L[0], L[1], L[2], L[3], H[0], H[1], H[2], H[3]}
    od = __builtin_amdgcn_mfma_f32_32x32x16_bf16(pa0, PKV(l0, h0), od, 0, 0, 0);
    od = __builtin_amdgcn_mfma_f32_32x32x16_bf16(pa1, PKV(l1, h1), od, 0, 0, 0);
    od = __builtin_amdgcn_mfma_f32_32x32x16_bf16(pa2, PKV(l2, h2), od, 0, 0, 0);
    od = __builtin_amdgcn_mfma_f32_32x32x16_bf16(pa3, PKV(l3, h3), od, 0, 0, 0);
#undef PKV
}
__device__ __forceinline__ float rowmax32(const f32x16& p0, const f32x16& p1) {
    float a = fmaxf(fmaxf(p0[0], p0[1]), p1[0]), b = fmaxf(fmaxf(p0[2], p0[3]), p1[1]); a = fmaxf(fmaxf(a, p1[2]), p1[3]);
#pragma unroll
    for (int r = 4; r < 16; r += 4) { a = fmaxf(fmaxf(a, p0[r]), p0[r + 1]); b = fmaxf(fmaxf(b, p0[r + 2]), p0[r + 3]); a = fmaxf(fmaxf(a, p1[r]), p1[r + 1]); b = fmaxf(fmaxf(b, p1[r + 2]), p1[r + 3]); }
    float m = fmaxf(a, b);
    auto rr = __builtin_amdgcn_permlane32_swap(__float_as_uint(m), __float_as_uint(m), false, false);
    return fmaxf(__uint_as_float(rr[0]), __uint_as_float(rr[1]));
}
template <int D0, int KH> __device__ __forceinline__ void pv_half(f32x16& od, int vb, bf16x8 paA, bf16x8 paB) {
    const s16x4 l0 = tr_read<D0 * 512 + (2 * KH) * 2048>(vb), h0 = tr_read<D0 * 512 + (2 * KH) * 2048 + 1024>(vb), l1 = tr_read<D0 * 512 + (2 * KH + 1) * 2048>(vb), h1 = tr_read<D0 * 512 + (2 * KH + 1) * 2048 + 1024>(vb);
    asm volatile("s_waitcnt lgkmcnt(0)" ::: "memory"); SBAR();
#define PKV(L, H) (bf16x8){L[0], L[1], L[2], L[3], H[0], H[1], H[2], H[3]}
    od = __builtin_amdgcn_mfma_f32_32x32x16_bf16(paA, PKV(l0, h0), od, 0, 0, 0);
    od = __builtin_amdgcn_mfma_f32_32x32x16_bf16(paB, PKV(l1, h1), od, 0, 0, 0);
#undef PKV
}
struct VH { s16x4 l0, h0, l1, h1, m0, n0, m1, n1; };
__device__ __forceinline__ void vh_issue(VH& f, int vb) {
    f.l0 = tr_read<0>(vb); f.h0 = tr_read<1024>(vb); f.l1 = tr_read<2048>(vb); f.h1 = tr_read<3072>(vb);
    f.m0 = tr_read<512>(vb); f.n0 = tr_read<1536>(vb); f.m1 = tr_read<2560>(vb); f.n1 = tr_read<3584>(vb); }
__device__ __forceinline__ void vh_mm(f32x16& o0, f32x16& o1, const VH& f, bf16x8 paA, bf16x8 paB) {
#define PKV(L, H) (bf16x8){L[0], L[1], L[2], L[3], H[0], H[1], H[2], H[3]}
    o0 = __builtin_amdgcn_mfma_f32_32x32x16_bf16(paA, PKV(f.l0, f.h0), o0, 0, 0, 0); o1 = __builtin_amdgcn_mfma_f32_32x32x16_bf16(paA, PKV(f.m0, f.n0), o1, 0, 0, 0);
    o0 = __builtin_amdgcn_mfma_f32_32x32x16_bf16(paB, PKV(f.l1, f.h1), o0, 0, 0, 0); o1 = __builtin_amdgcn_mfma_f32_32x32x16_bf16(paB, PKV(f.m1, f.n1), o1, 0, 0, 0);
#undef PKV
}
struct VF { s16x4 l0, h0, l1, h1, l2, h2, l3, h3; };
template <int D0> __device__ __forceinline__ void v_issue(VF& f, int vb) {
    f.l0 = tr_read<D0 * 512 + 0 * 2048>(vb); f.h0 = tr_read<D0 * 512 + 0 * 2048 + 1024>(vb); f.l1 = tr_read<D0 * 512 + 1 * 2048>(vb); f.h1 = tr_read<D0 * 512 + 1 * 2048 + 1024>(vb);
    f.l2 = tr_read<D0 * 512 + 2 * 2048>(vb); f.h2 = tr_read<D0 * 512 + 2 * 2048 + 1024>(vb); f.l3 = tr_read<D0 * 512 + 3 * 2048>(vb); f.h3 = tr_read<D0 * 512 + 3 * 2048 + 1024>(vb); }
__device__ __forceinline__ void pv_mm(f32x16& od, const VF& f, bf16x8 pa0, bf16x8 pa1, bf16x8 pa2, bf16x8 pa3) {
#define PKV(L, H) (bf16x8){L[0], L[1], L[2], L[3], H[0], H[1], H[2], H[3]}
    od = __builtin_amdgcn_mfma_f32_32x32x16_bf16(pa0, PKV(f.l0, f.h0), od, 0, 0, 0); od = __builtin_amdgcn_mfma_f32_32x32x16_bf16(pa1, PKV(f.l1, f.h1), od, 0, 0, 0);
    od = __builtin_amdgcn_mfma_f32_32x32x16_bf16(pa2, PKV(f.l2, f.h2), od, 0, 0, 0); od = __builtin_amdgcn_mfma_f32_32x32x16_bf16(pa3, PKV(f.l3, f.h3), od, 0, 0, 0);
#undef PKV
}
__device__ __forceinline__ void pv_ones(f32x16& os, bf16x8 pa0, bf16x8 pa1, bf16x8 pa2, bf16x8 pa3) {
    const bf16x8 one = {0x3F80, 0x3F80, 0x3F80, 0x3F80, 0x3F80, 0x3F80, 0x3F80, 0x3F80};
    os = __builtin_amdgcn_mfma_f32_32x32x16_bf16(pa0, one, os, 0, 0, 0); os = __builtin_amdgcn_mfma_f32_32x32x16_bf16(pa1, one, os, 0, 0, 0);
    os = __builtin_amdgcn_mfma_f32_32x32x16_bf16(pa2, one, os, 0, 0, 0); os = __builtin_amdgcn_mfma_f32_32x32x16_bf16(pa3, one, os, 0, 0, 0); }
struct LayB { static constexpr int KROW = 144, KBUF = 64 * KROW, VBUF = 8192, NS = 6, K_OFF = 0, V_OFF = NS * KBUF, WS_OFF = V_OFF + NS * VBUF, OST_OFF = WS_OFF + 8 * 512, BYTES = OST_OFF + 8 * 4096; };
struct BU { unsigned rowq; int t0, nt, q0; };
__device__ __forceinline__ BU band_unit(int dil, int sub) { BU u; const int r = (dil == 1) ? 0 : (dil == 4 ? (sub >> 2) : sub), qb = (dil == 1) ? sub : (dil == 4 ? (sub & 3) : 0), ntt = 64 / dil;
    u.rowq = (unsigned)(r + 256 * qb * dil); const int t0 = (4 * qb - 1 < 0) ? 0 : 4 * qb - 1, t1 = (4 * qb + 5 > ntt) ? ntt : 4 * qb + 5; u.t0 = t0; u.nt = t1 - t0; u.q0 = 256 * qb; return u; }
__device__ __forceinline__ bf16x8 f8x8_to_bf16x8(u32x2_t v) {
    const auto a = __builtin_amdgcn_cvt_pk_f32_fp8((int)v.x, false), b = __builtin_amdgcn_cvt_pk_f32_fp8((int)v.x, true), c = __builtin_amdgcn_cvt_pk_f32_fp8((int)v.y, false), d = __builtin_amdgcn_cvt_pk_f32_fp8((int)v.y, true);
    v4u w = {cvtpk(a[0], a[1]), cvtpk(b[0], b[1]), cvtpk(c[0], c[1]), cvtpk(d[0], d[1])}; return *reinterpret_cast<bf16x8*>(&w); }
__device__ __forceinline__ void unpack8_f8(u32x2_t v, float (&x)[8]) {
    const auto a = __builtin_amdgcn_cvt_pk_f32_fp8((int)v.x, false), b = __builtin_amdgcn_cvt_pk_f32_fp8((int)v.x, true), c = __builtin_amdgcn_cvt_pk_f32_fp8((int)v.y, false), d = __builtin_amdgcn_cvt_pk_f32_fp8((int)v.y, true);
    x[0] = a[0]; x[1] = a[1]; x[2] = b[0]; x[3] = b[1]; x[4] = c[0]; x[5] = c[1]; x[6] = d[0]; x[7] = d[1]; }
__device__ __forceinline__ bf16x8 f8x8_to_bf16x8_s(u32x2_t v, float sc) {
    const auto a = __builtin_amdgcn_cvt_pk_f32_fp8((int)v.x, false), b = __builtin_amdgcn_cvt_pk_f32_fp8((int)v.x, true), c = __builtin_amdgcn_cvt_pk_f32_fp8((int)v.y, false), d = __builtin_amdgcn_cvt_pk_f32_fp8((int)v.y, true);
    v4u w = {cvtpk(a[0] * sc, a[1] * sc), cvtpk(b[0] * sc, b[1] * sc), cvtpk(c[0] * sc, c[1] * sc), cvtpk(d[0] * sc, d[1] * sc)}; return *reinterpret_cast<bf16x8*>(&w); }
template <bool MERGE, bool FAST>
__device__ __forceinline__ void band_phase(const bf16* Qh, const bf16* Kh, const bf16* Vh, int dil, bf16* Ob, int ldo, float* Lb, const bf16* O1b, const bf16* O2b, const float* L1b, const float* L2b, LAS char* lds, int dv = 0) {
    using LY = LayB;
    int tid = threadIdx.x; asm volatile("" : "+v"(tid));
    const int lane = tid & 63, r32 = lane & 31, hi = lane >> 5; const int wid = __builtin_amdgcn_readfirstlane(tid >> 6);
    LAS float* wsf = (LAS float*)(lds + LY::WS_OFF) + wid * 128;
    LAS char* ost = lds + LY::OST_OFF + wid * 4096;
    const int krow = tid >> 3, kch = tid & 7;
    const int vkey = 2 * (tid >> 4) + ((tid >> 2) & 1), vcol = 32 * ((tid >> 3) & 1) + 8 * (tid & 3);
    const int kst = krow * LY::KROW + kch * 16, vst = v_st(vkey, vcol);
    const int vb0 = (int)(unsigned)(size_t)(lds + LY::V_OFF) + v_rd_base(lane);
    const LAS char* kbase = lds + LY::K_OFF + r32 * LY::KROW + hi * 16;
    u32x2_t sk[6], sv[6], qraw[4]; bf16x8 qr[4];
    const int ldb = dil * 128, ldb8 = dil * 64;
    const unsigned ko_ = (unsigned)(krow * ldb8 + kch * 8), vo_ = (unsigned)(vkey * ldb8 + vcol), qo_ = (unsigned)((wid * 32 + r32) * ldb8 + hi * 8);
    BU cur = band_unit(dil, 0);
#define B_LOADS(U) do { const size_t sb_ = (size_t)((U).rowq % (unsigned)dil) * 64; \
        _Pragma("unroll") for (int s_ = 0; s_ < 6; ++s_) if (s_ < (U).nt) { const size_t o_ = sb_ + (size_t)((U).t0 + s_) * 64 * (size_t)ldb8; \
            sk[s_] = *reinterpret_cast<const u32x2_t*>((const char*)Kh + o_ + ko_); sv[s_] = *reinterpret_cast<const u32x2_t*>((const char*)Vh + o_ + vo_); } } while (0)
#define B_LOAD1(U, s_) do { if ((s_) < (U).nt) { const size_t o_ = (size_t)((U).rowq % (unsigned)dil) * 64 + (size_t)((U).t0 + (s_)) * 64 * (size_t)ldb8; \
        sk[s_] = *reinterpret_cast<const u32x2_t*>((const char*)Kh + o_ + ko_); sv[s_] = *reinterpret_cast<const u32x2_t*>((const char*)Vh + o_ + vo_); } } while (0)
    B_LOADS(cur);
    for (int L = 0; L < 16; ++L) {
        if (!(dv & 4) || L == 0) { const char* qb_ = (const char*)Qh + (size_t)cur.rowq * 64;
#pragma unroll
          for (int d0 = 0; d0 < 4; ++d0) qraw[d0] = *reinterpret_cast<const u32x2_t*>(qb_ + d0 * 16 + qo_); }
        asm volatile("s_waitcnt lgkmcnt(0)" ::: "memory"); if (!(dv & 1)) asm volatile("s_barrier" ::: "memory");
#pragma unroll
        for (int s_ = 0; s_ < 6; ++s_) if (s_ < cur.nt && !(dv & 2)) { *(LAS bf16x8*)(lds + LY::K_OFF + s_ * LY::KBUF + kst) = f8x8_to_bf16x8(sk[s_]); *(LAS bf16x8*)(lds + LY::V_OFF + s_ * LY::VBUF + vst) = f8x8_to_bf16x8(sv[s_]); }
        asm volatile("s_waitcnt lgkmcnt(0)" ::: "memory"); if (!(dv & 1)) asm volatile("s_barrier" ::: "memory");
        const bool has_next = (L + 1 < 16) && !(dv & 4);
        BU nxt = cur; if (has_next) { nxt = band_unit(dil, L + 1); if (FAST) { B_LOAD1(nxt, 0); B_LOAD1(nxt, 1); } else B_LOADS(nxt); }
#pragma unroll
        for (int d0 = 0; d0 < 4; ++d0) qr[d0] = f8x8_to_bf16x8_s(qraw[d0], 0.125f);
        const int lo = cur.q0 + 32 * wid; int ta = (lo - 64) >> 6, tb = (lo + 95) >> 6; if (ta < cur.t0) ta = cur.t0; if (tb > cur.t0 + cur.nt - 1) tb = cur.t0 + cur.nt - 1;
        const int qi = lo + r32;
        float m_reg = -1e30f, l_reg = 0.f; f32x16 o[2]; o[0] = f32x16{}; o[1] = f32x16{};
#define PK4(P, BASE, OUT) do { v4u w = {cvtpk(P[BASE + 0], P[BASE + 1]), cvtpk(P[BASE + 2], P[BASE + 3]), cvtpk(P[BASE + 4], P[BASE + 5]), cvtpk(P[BASE + 6], P[BASE + 7])}; OUT = *reinterpret_cast<bf16x8*>(&w); } while (0)
        if constexpr (FAST) {
            const int kbeg = lo - 64, lstream = 4096 / dil, thr_ = r32 - 4 * hi;
#define BH_ADDR(j, KB, VB, OKJ) const int kh##j = kbeg + 32 * (j); const bool OKJ = (kh##j >= 0) && (kh##j < lstream); \
            int tj##j = kh##j >> 6; tj##j = tj##j < cur.t0 ? cur.t0 : (tj##j > cur.t0 + cur.nt - 1 ? cur.t0 + cur.nt - 1 : tj##j); const int hf##j = (kh##j >> 5) & 1; \
            const LAS char* KB = kbase + (tj##j - cur.t0) * LY::KBUF + hf##j * 32 * LY::KROW; const int VB = vb0 + (tj##j - cur.t0) * LY::VBUF + hf##j * 4096;
#define BH_QK(P, KB) do { P = f32x16{}; _Pragma("unroll") for (int d0 = 0; d0 < 4; ++d0) { const bf16x8 b_ = *(const LAS bf16x8*)((KB) + d0 * 32); P = __builtin_amdgcn_mfma_f32_32x32x16_bf16(b_, qr[d0], P, 0, 0, 0); } } while (0)
#define BH_SM(P, OKJ, MODE, PA, PB) do { \
            if ((MODE) == 1) { _Pragma("unroll") for (int r = 0; r < 16; ++r) { const int c_ = (r & 3) + 8 * (r >> 2); if (c_ < thr_) P[r] = -INFINITY; } } \
            if ((MODE) == 2) { _Pragma("unroll") for (int r = 0; r < 16; ++r) { const int c_ = (r & 3) + 8 * (r >> 2); if (c_ > thr_) P[r] = -INFINITY; } } \
            float ps_ = 0.f; _Pragma("unroll") for (int r = 0; r < 16; ++r) { P[r] = __builtin_amdgcn_exp2f(P[r]); ps_ += P[r]; } l_reg += (OKJ) ? ps_ : 0.f; \
            PK4(P, 0, PA); PK4(P, 8, PB); if (!(OKJ)) { PA = bf16x8{}; PB = bf16x8{}; } } while (0)
#define BH_PV(VB, PA, PB) do { pv_half<0, 0>(o[0], VB, PA, PB); pv_half<1, 0>(o[1], VB, PA, PB); } while (0)
            BH_ADDR(0, kb0_, vbh0_, ok0_) BH_ADDR(1, kb1_, vbh1_, ok1_) BH_ADDR(2, kb2_, vbh2_, ok2_) BH_ADDR(3, kb3_, vbh3_, ok3_) BH_ADDR(4, kb4_, vbh4_, ok4_)
            f32x16 pX, pY; bf16x8 paA, paB;
#define BH_STAGE(VB, QKSTMT, PC, OKJ, MODE) do { VH vf_; vh_issue(vf_, VB); SBAR(); QKSTMT; BH_SM(PC, OKJ, MODE, paA, paB); \
            asm volatile("s_waitcnt lgkmcnt(0)" ::: "memory"); SBAR(); vh_mm(o[0], o[1], vf_, paA, paB); SBAR(); } while (0)
            BH_QK(pX, kb0_);
            BH_STAGE(vbh0_, BH_QK(pY, kb1_), pX, ok0_, 1); if (has_next) B_LOAD1(nxt, 2);
            BH_STAGE(vbh1_, BH_QK(pX, kb2_), pY, ok1_, 0); if (has_next) B_LOAD1(nxt, 3);
            BH_STAGE(vbh2_, BH_QK(pY, kb3_), pX, ok2_, 0); if (has_next) B_LOAD1(nxt, 4);
            BH_STAGE(vbh3_, BH_QK(pX, kb4_), pY, ok3_, 0); if (has_next) B_LOAD1(nxt, 5);
            BH_STAGE(vbh4_, (void)0, pX, ok4_, 2);
#undef BH_STAGE
#undef BH_ADDR
#undef BH_QK
#undef BH_SM
#undef BH_PV
            { auto rr = __builtin_amdgcn_permlane32_swap(__float_as_uint(l_reg), __float_as_uint(l_reg), false, false); l_reg = __uint_as_float(rr[0]) + __uint_as_float(rr[1]); }
            m_reg = 0.f;
        } else
        for (int t = ta; t <= tb; ++t) {
            const int slot = t - cur.t0;
            f32x16 p0 = f32x16{}, p1 = f32x16{};
            { const LAS char* kb = kbase + slot * LY::KBUF;
#pragma unroll
              for (int d0 = 0; d0 < 4; ++d0) { const bf16x8 b0 = *(const LAS bf16x8*)(kb + d0 * 32); const bf16x8 b1 = *(const LAS bf16x8*)(kb + 32 * LY::KROW + d0 * 32);
                  p0 = __builtin_amdgcn_mfma_f32_32x32x16_bf16(b0, qr[d0], p0, 0, 0, 0); p1 = __builtin_amdgcn_mfma_f32_32x32x16_bf16(b1, qr[d0], p1, 0, 0, 0); } }
            if (64 * t < lo - 33) { const int a_ = qi - 64 - 64 * t - 4 * hi;
#pragma unroll
                for (int r = 0; r < 16; ++r) { const int c_ = (r & 3) + 8 * (r >> 2); if (c_ < a_) p0[r] = -INFINITY; if (c_ + 32 < a_) p1[r] = -INFINITY; } }
            else if (64 * t + 63 > lo + 64) { const int b_ = qi + 64 - 64 * t - 4 * hi;
#pragma unroll
                for (int r = 0; r < 16; ++r) { const int c_ = (r & 3) + 8 * (r >> 2); if (c_ > b_) p0[r] = -INFINITY; if (c_ + 32 > b_) p1[r] = -INFINITY; } }
            const float pmax = rowmax32(p0, p1);
            if (t == ta) { m_reg = fmaxf(pmax, -1e30f); }
            else if (__any(pmax > m_reg)) {
                const float mn = fmaxf(m_reg, pmax); const float alpha = __builtin_amdgcn_exp2f(m_reg - mn); m_reg = mn; l_reg *= alpha;
                if (hi == 0) wsf[r32] = alpha; asm volatile("s_waitcnt lgkmcnt(0)" ::: "memory");
#pragma unroll
                for (int r = 0; r < 16; ++r) { const float al = wsf[crow(r, hi)]; o[0][r] *= al; o[1][r] *= al; }
            }
#pragma unroll
            for (int r = 0; r < 16; ++r) { p0[r] = __builtin_amdgcn_exp2f(p0[r] - m_reg); p1[r] = __builtin_amdgcn_exp2f(p1[r] - m_reg); }
            float ps = 0.f;
#pragma unroll
            for (int r = 0; r < 16; ++r) ps += p0[r] + p1[r];
            { auto rr = __builtin_amdgcn_permlane32_swap(__float_as_uint(ps), __float_as_uint(ps), false, false); ps = __uint_as_float(rr[0]) + __uint_as_float(rr[1]); }
            l_reg += ps;
            bf16x8 pa0, pa1, pa2, pa3;
            PK4(p0, 0, pa0); PK4(p0, 8, pa1); PK4(p1, 0, pa2); PK4(p1, 8, pa3);
            const int vb = vb0 + slot * LY::VBUF;
            pv_one<0>(o[0], vb, pa0, pa1, pa2, pa3); pv_one<1>(o[1], vb, pa0, pa1, pa2, pa3);
        }
#undef PK4
        const float lse = m_reg + __builtin_amdgcn_logf(l_reg);
        if (hi == 0) { wsf[r32] = __builtin_amdgcn_rcpf(l_reg); wsf[32 + r32] = lse; }
        u32x2_t a1[4], a2[4]; float L1v[4], L2v[4];
        if constexpr (MERGE) {
#pragma unroll
            for (int i = 0; i < 4; ++i) { const size_t tr_ = (size_t)cur.rowq + (size_t)(wid * 32 + (lane >> 3) + 8 * i) * dil;
                a1[i] = *(const u32x2_t*)((const unsigned char*)O1b + tr_ * 64 + (lane & 7) * 8); a2[i] = *(const u32x2_t*)((const unsigned char*)O2b + tr_ * 64 + (lane & 7) * 8); L1v[i] = L1b[tr_]; L2v[i] = L2b[tr_]; }
        }
        asm volatile("s_waitcnt lgkmcnt(0)" ::: "memory");
        { const int odd = lane & 1; const unsigned sel = odd ? 0x03020706u : 0x05040100u;
          LAS char* wb = ost + (4 * hi + odd) * 128 + (r32 & ~1) * 2;
#pragma unroll
          for (int k = 0; k < 8; ++k) { const int r0 = ((2 * k) & 3) + 8 * ((2 * k) >> 2);
              const float rl0 = wsf[r0 + 4 * hi], rl1 = wsf[r0 + 1 + 4 * hi];
#pragma unroll
              for (int d0 = 0; d0 < 2; ++d0) { const unsigned pk = cvtpk(o[d0][2 * k] * rl0, o[d0][2 * k + 1] * rl1);
                  const unsigned rc = (unsigned)__builtin_amdgcn_update_dpp(0, (int)pk, 0xB1, 0xF, 0xF, false);
                  *(LAS unsigned*)(wb + r0 * 128 + d0 * 64) = __builtin_amdgcn_perm(rc, pk, sel); } } }
        asm volatile("s_waitcnt lgkmcnt(0)" ::: "memory");
        if (!MERGE) { if (hi == 0) Lb[(size_t)cur.rowq + (size_t)(wid * 32 + r32) * dil] = lse; }
        v4u vv[4]; float L3v[4];
#pragma unroll
        for (int i = 0; i < 4; ++i) { const int row = (lane >> 3) + 8 * i; vv[i] = *(const LAS v4u*)(ost + row * 128 + (lane & 7) * 16); if (MERGE) L3v[i] = wsf[32 + row]; }
#pragma unroll
        for (int i = 0; i < 4; ++i) { const int row = (lane >> 3) + 8 * i, ch = lane & 7; const size_t tr_ = (size_t)cur.rowq + (size_t)(wid * 32 + row) * dil;
            v4u v = vv[i];
            if constexpr (MERGE) {
                const float L3 = L3v[i], L1 = L1v[i], L2 = L2v[i];
                const float M = fmaxf(L3, fmaxf(L1, L2)); float w1 = __builtin_amdgcn_exp2f(L1 - M), w2 = __builtin_amdgcn_exp2f(L2 - M), w3 = __builtin_amdgcn_exp2f(L3 - M);
                const float inv = __builtin_amdgcn_rcpf(w1 + w2 + w3); w1 *= inv; w2 *= inv; w3 *= inv;
                float x3[8], x1[8], x2[8], y[8]; unpack8(v, x3); unpack8_f8(a1[i], x1); unpack8_f8(a2[i], x2);
#pragma unroll
                for (int e = 0; e < 8; ++e) y[e] = w1 * x1[e] + w2 * x2[e] + w3 * x3[e];
                v = pack8(y);
            }
            if (!(dv & 8)) { if constexpr (MERGE) *(v4u*)(Ob + tr_ * (size_t)ldo + ch * 8) = v;
                else { float y8[8]; unpack8(v, y8); u32x2_t w8; w8.x = pk4_fp8(y8[0], y8[1], y8[2], y8[3]); w8.y = pk4_fp8(y8[4], y8[5], y8[6], y8[7]); *(u32x2_t*)((unsigned char*)Ob + tr_ * 64 + ch * 8) = w8; } } }
        cur = nxt;
    }
    __syncthreads();
#undef B_LOADS
#undef B_LOAD1
}


template <int DQ> __device__ __forceinline__ void q_finish(bf16x8 (&qr)[DQ / 16], const float* __restrict__ gain, int t, int hi) {
    constexpr int ND = DQ / 16; float v[ND][8]; float ss = 0.f;
#pragma unroll
    for (int d0 = 0; d0 < ND; ++d0) { const v4u r = __builtin_bit_cast(v4u, qr[d0]); unpack8(r, v[d0]);
#pragma unroll
        for (int j = 0; j < 8; ++j) ss += v[d0][j] * v[d0][j]; }
    { auto rr = __builtin_amdgcn_permlane32_swap(__float_as_uint(ss), __float_as_uint(ss), false, false); ss = __uint_as_float(rr[0]) + __uint_as_float(rr[1]); }
    const float rs = (1.0f / sqrtf(ss * (1.0f / DQ) + EPS)) * (DQ == 96 ? QSCALE_A : QSCALE_B);
#pragma unroll
    for (int d0 = 0; d0 < ND; ++d0) { const f32x4 g0 = *(const f32x4*)(gain + 16 * d0 + 8 * hi), g1 = *(const f32x4*)(gain + 16 * d0 + 8 * hi + 4);
        v[d0][0] *= rs * g0[0]; v[d0][1] *= rs * g0[1]; v[d0][2] *= rs * g0[2]; v[d0][3] *= rs * g0[3]; v[d0][4] *= rs * g1[0]; v[d0][5] *= rs * g1[1]; v[d0][6] *= rs * g1[2]; v[d0][7] *= rs * g1[3]; }
#pragma unroll
    for (int j = 0; j < 8; ++j) { const float revf = exp2f(-(float)(8 * hi + j) * (LOG2_THETA / 16.f)) * INV_2PI; float c, s;
        if (DQ == 96) { cs_rev((float)t, revf, c, s); const float a = v[4][j], b = v[5][j]; v[4][j] = a * c - b * s; v[5][j] = a * s + b * c; }
        else { cs_rev((float)(t >> 6), revf, c, s); float a = v[0][j], b = v[1][j]; v[0][j] = a * c - b * s; v[1][j] = a * s + b * c;
               cs_rev((float)(t & 63), revf, c, s); a = v[2][j]; b = v[3][j]; v[2][j] = a * c - b * s; v[3][j] = a * s + b * c; } }
#pragma unroll
    for (int d0 = 0; d0 < ND; ++d0) { const v4u w = pack8(v[d0]); qr[d0] = __builtin_bit_cast(bf16x8, w); }
}
constexpr float THR_L2 = 8.0f;
template <int DQ, int NS_ = 4> struct LayD {
    static constexpr int KROW = DQ * 2 + 16, KBUF = 64 * KROW, VBUF = 8192, NS = NS_;
    static constexpr int K_OFF = 0, V_OFF = NS * KBUF, WS_OFF = V_OFF + NS * VBUF, OST_OFF = WS_OFF + 8 * 512, BYTES_D = OST_OFF + 8 * 4096;
    static_assert(BYTES_D <= 160 * 1024 - 1024, "attention LDS");
};
template <int DQ>
__device__ __forceinline__ void attn_dense(const bf16* __restrict__ Qp, long ldq, const float* __restrict__ qgain, int tq0, const bf16* __restrict__ Kp, long ldk, const bf16* __restrict__ Vp, long ldv, int NT, bf16* Op, long ldo, LAS char* lds) {
    using LY = LayD<DQ>;
    int tid = threadIdx.x; asm volatile("" : "+v"(tid));
    const int lane = tid & 63, r32 = lane & 31, hi = lane >> 5; const int wid = __builtin_amdgcn_readfirstlane(tid >> 6);
    LAS float* wsf = (LAS float*)(lds + LY::WS_OFF) + wid * 128;
    bf16x8 qr[DQ / 16];
    { const bf16* Qw = Qp + (long)(wid * 32 + r32) * ldq + hi * 8;
#pragma unroll
      for (int d0 = 0; d0 < DQ / 16; ++d0) qr[d0] = *reinterpret_cast<const bf16x8*>(Qw + d0 * 16); }
    q_finish<DQ>(qr, qgain, tq0 + wid * 32 + r32, hi);
    constexpr int CPR = DQ / 8;
    const int kc0 = tid, krow0 = kc0 / CPR, kch0 = kc0 % CPR;
    const int kc1 = tid + 512, krow1 = kc1 / CPR, kch1 = kc1 % CPR;
    const bool k2 = (DQ == 96) && (wid < 4);
    const int vkey = 2 * (tid >> 4) + ((tid >> 2) & 1), vcol = 32 * ((tid >> 3) & 1) + 8 * (tid & 3);
    const int kst0 = krow0 * LY::KROW + kch0 * 16, kst1 = krow1 * LY::KROW + kch1 * 16, vst = v_st(vkey, vcol);
    const bf16* kg0 = Kp + (long)krow0 * ldk + kch0 * 8; const bf16* kg1 = Kp + (long)krow1 * ldk + kch1 * 8; const bf16* vg = Vp + (long)vkey * ldv + vcol;
    bf16x8 skE0, skE1 = {}, svE, skO0, skO1 = {}, svO;
#define D_LOAD(SK0, SK1, SV, t) do { const long ko = (long)(t) * 64 * ldk; SK0 = *reinterpret_cast<const bf16x8*>(kg0 + ko); if (k2) SK1 = *reinterpret_cast<const bf16x8*>(kg1 + ko); SV = *reinterpret_cast<const bf16x8*>(vg + (long)(t) * 64 * ldv); } while (0)
#define D_WRITE(b, SK0, SK1, SV) do { *(LAS bf16x8*)(lds + LY::K_OFF + (b) * LY::KBUF + kst0) = SK0; if (k2) *(LAS bf16x8*)(lds + LY::K_OFF + (b) * LY::KBUF + kst1) = SK1; \
        *(LAS bf16x8*)(lds + LY::V_OFF + (b) * LY::VBUF + vst) = SV; } while (0)
    const int vb0 = (int)(unsigned)(size_t)(lds + LY::V_OFF) + v_rd_base(lane);
    const LAS char* kbase = lds + LY::K_OFF + r32 * LY::KROW + hi * 16;
    float m_ref = 0.f, l_reg = 0.f; f32x16 o[2]; o[0] = f32x16{}; o[1] = f32x16{};
    f32x16 negm = f32x16{}; asm volatile("" : "+v"(negm));
    f32x16 pA0, pA1, pB0, pB1; float alA = 1.f, alB = 1.f; bf16x8 pa0, pa1, pa2, pa3;
#define D_QKT(P0, P1, b) do { const LAS char* kb_ = kbase + (b) * LY::KBUF; P0 = negm; P1 = negm; \
        _Pragma("unroll") for (int d0 = 0; d0 < DQ / 16; ++d0) { const bf16x8 b0_ = *(const LAS bf16x8*)(kb_ + d0 * 32); const bf16x8 b1_ = *(const LAS bf16x8*)(kb_ + 32 * LY::KROW + d0 * 32); \
            P0 = __builtin_amdgcn_mfma_f32_32x32x16_bf16(b0_, qr[d0], P0, 0, 0, 0); P1 = __builtin_amdgcn_mfma_f32_32x32x16_bf16(b1_, qr[d0], P1, 0, 0, 0); } } while (0)
#define D_PART(P0, P1, AL, FIRST) do { const float rm_ = rowmax32(P0, P1); AL = 1.f; \
        if ((FIRST) || __any(rm_ > THR_L2)) { const float dl_ = (FIRST) ? rm_ : fmaxf(rm_, 0.f); m_ref += dl_; \
            _Pragma("unroll") for (int r = 0; r < 16; ++r) { P0[r] -= dl_; P1[r] -= dl_; } \
            _Pragma("unroll") for (int r = 0; r < 16; ++r) negm[r] = -m_ref; asm volatile("" : "+v"(negm)); \
            AL = __builtin_amdgcn_exp2f(-dl_); } \
        _Pragma("unroll") for (int r = 0; r < 16; ++r) P0[r] = __builtin_amdgcn_exp2f(P0[r]); } while (0)
#define D_PK4(P, BASE, OUT) do { v4u w = {cvtpk(P[BASE + 0], P[BASE + 1]), cvtpk(P[BASE + 2], P[BASE + 3]), cvtpk(P[BASE + 4], P[BASE + 5]), cvtpk(P[BASE + 6], P[BASE + 7])}; OUT = *reinterpret_cast<bf16x8*>(&w); } while (0)
#define D_FIN(P0, P1, AL) do { _Pragma("unroll") for (int r = 0; r < 16; ++r) P1[r] = __builtin_amdgcn_exp2f(P1[r]); \
        float ps_ = 0.f; _Pragma("unroll") for (int r = 0; r < 16; ++r) ps_ += P0[r]; _Pragma("unroll") for (int r = 0; r < 16; ++r) ps_ += P1[r]; \
        { auto rr = __builtin_amdgcn_permlane32_swap(__float_as_uint(ps_), __float_as_uint(ps_), false, false); ps_ = __uint_as_float(rr[0]) + __uint_as_float(rr[1]); } \
        l_reg = l_reg * (AL) + ps_; D_PK4(P0, 0, pa0); D_PK4(P0, 8, pa1); D_PK4(P1, 0, pa2); D_PK4(P1, 8, pa3); } while (0)
#define D_RESC(AL) do { if (__any((AL) < 1.f)) { if (hi == 0) wsf[r32] = (AL); asm volatile("s_waitcnt lgkmcnt(0)" ::: "memory"); \
        _Pragma("unroll") for (int r = 0; r < 16; ++r) { const float a_ = wsf[crow(r, hi)]; o[0][r] *= a_; o[1][r] *= a_; } } } while (0)
#define D_PV(b) do { const int vb_ = vb0 + (b) * LY::VBUF; pv_one<0>(o[0], vb_, pa0, pa1, pa2, pa3); pv_one<1>(o[1], vb_, pa0, pa1, pa2, pa3); } while (0)
    D_LOAD(skE0, skE1, svE, 0); D_LOAD(skO0, skO1, svO, 1);
    D_WRITE(0, skE0, skE1, svE); D_WRITE(1, skO0, skO1, svO);
    D_LOAD(skE0, skE1, svE, 2); D_LOAD(skO0, skO1, svO, 3);
    __syncthreads();
    D_QKT(pA0, pA1, 0); D_PART(pA0, pA1, alA, true); alA = 1.f;
    for (int j = 1; j + 1 < NT; j += 2) {
        SBAR(); D_QKT(pB0, pB1, j & 3);
        D_FIN(pA0, pA1, alA); SBAR();
        D_PV((j - 1) & 3); D_PART(pB0, pB1, alB, false);
        D_WRITE((j + 1) & 3, skE0, skE1, svE);
        if (j + 3 < NT) D_LOAD(skE0, skE1, svE, j + 3);
        D_RESC(alB); __syncthreads();
        SBAR(); D_QKT(pA0, pA1, (j + 1) & 3);
        D_FIN(pB0, pB1, alB); SBAR();
        D_PV(j & 3); D_PART(pA0, pA1, alA, false);
        D_WRITE((j + 2) & 3, skO0, skO1, svO);
        if (j + 4 < NT) D_LOAD(skO0, skO1, svO, j + 4);
        D_RESC(alA); __syncthreads();
    }
    SBAR(); D_QKT(pB0, pB1, (NT - 1) & 3);
    D_FIN(pA0, pA1, alA); SBAR();
    D_PV((NT - 2) & 3); D_PART(pB0, pB1, alB, false);
    D_RESC(alB);
    D_FIN(pB0, pB1, alB); SBAR();
    D_PV((NT - 1) & 3);
    if (hi == 0) wsf[r32] = __builtin_amdgcn_rcpf(l_reg);
    asm volatile("s_waitcnt lgkmcnt(0)" ::: "memory");
    LAS char* ost = lds + LY::OST_OFF + wid * 4096;
#pragma unroll
    for (int r = 0; r < 16; ++r) { const int orow = crow(r, hi); const float rl = wsf[orow];
        *(LAS unsigned short*)(ost + orow * 128 + r32 * 2) = (unsigned short)f2bf(o[0][r] * rl); *(LAS unsigned short*)(ost + orow * 128 + 64 + r32 * 2) = (unsigned short)f2bf(o[1][r] * rl); }
    asm volatile("s_waitcnt lgkmcnt(0)" ::: "memory");
    bf16* Ow = Op + (long)(wid * 32) * ldo;
#pragma unroll
    for (int i = 0; i < 4; ++i) { const int row = (lane >> 3) + 8 * i, ch = lane & 7; const v4u v = *(const LAS v4u*)(ost + row * 128 + ch * 16); *(v4u*)(Ow + (long)row * ldo + ch * 8) = v; }
    __syncthreads();
#undef D_LOAD
#undef D_WRITE
#undef D_QKT
#undef D_PART
#undef D_PK4
#undef D_FIN
#undef D_RESC
#undef D_PV
}

template <int DQ>
__device__ __forceinline__ void attn_dense_fast(const bf16* __restrict__ Qp, long ldq, const float* __restrict__ qgain, int tq0, const bf16* __restrict__ Kp, long ldk, const bf16* __restrict__ Vp, long ldv, int NT, bf16* Op, long ldo, LAS char* lds) {
    using LY = LayD<DQ, 5>;
    int tid = threadIdx.x; asm volatile("" : "+v"(tid));
    const int lane = tid & 63, r32 = lane & 31, hi = lane >> 5; const int wid = __builtin_amdgcn_readfirstlane(tid >> 6);
    LAS float* wsf = (LAS float*)(lds + LY::WS_OFF) + wid * 128;
    bf16x8 qr[DQ / 16];
    { const bf16* Qw = Qp + (long)(wid * 32 + r32) * ldq + hi * 8;
#pragma unroll
      for (int d0 = 0; d0 < DQ / 16; ++d0) qr[d0] = *reinterpret_cast<const bf16x8*>(Qw + d0 * 16); }
    q_finish<DQ>(qr, qgain, tq0 + wid * 32 + r32, hi);
    constexpr int KCH = LY::KROW / 16, KPC = LY::KBUF / 1024; static_assert(LY::KBUF % 1024 == 0 && KPC <= 16 && KPC > 8, "K tile pieces");
    unsigned kofs[2]; int kpc[2];
#pragma unroll
    for (int i = 0; i < 2; ++i) { int pc = wid + 8 * i; if (pc > KPC - 1) pc = KPC - 1; const int c = pc * 64 + lane, row = c / KCH; int cc = c - row * KCH; if (cc > DQ / 8 - 1) cc = DQ / 8 - 1;
        kpc[i] = pc; kofs[i] = (unsigned)(row * (int)ldk + cc * 8) * 2u; }
    unsigned vofs; { const int pb = (wid * 64 + lane) * 16, sub = pb >> 9, within = (pb & 511) >> 1, key = (sub >> 1) * 8 + (within >> 5), col = (sub & 1) * 32 + (within & 31); vofs = (unsigned)(key * (int)ldv + col) * 2u; }
#define D_DMA(t, b) do { const char* kb_ = (const char*)Kp + (size_t)(t) * 128 * (size_t)ldk; const char* vp_ = (const char*)Vp + (size_t)(t) * 128 * (size_t)ldv; \
        __builtin_amdgcn_global_load_lds((const unsigned*)(kb_ + kofs[0]), (LAS unsigned*)(lds + LY::K_OFF + (b) * LY::KBUF + kpc[0] * 1024), 16, 0, 0); \
        __builtin_amdgcn_global_load_lds((const unsigned*)(kb_ + kofs[1]), (LAS unsigned*)(lds + LY::K_OFF + (b) * LY::KBUF + kpc[1] * 1024), 16, 0, 0); \
        __builtin_amdgcn_global_load_lds((const unsigned*)(vp_ + vofs), (LAS unsigned*)(lds + LY::V_OFF + (b) * LY::VBUF + wid * 1024), 16, 0, 0); } while (0)
#define D_BAR(N) asm volatile("s_waitcnt vmcnt(" #N ")\n\ts_barrier" ::: "memory")
    const int vb0 = (int)(unsigned)(size_t)(lds + LY::V_OFF) + v_rd_base(lane);
    const LAS char* kbase = lds + LY::K_OFF + r32 * LY::KROW + hi * 16;
    f32x16 o[2]; o[0] = f32x16{}; o[1] = f32x16{}; float l0 = 0.f, l1 = 0.f, l2 = 0.f, l3 = 0.f;
    f32x16 pA0, pA1, pB0, pB1; bf16x8 pa0, pa1, pa2, pa3;
#define D_QKT(P0, P1, b) do { const LAS char* kb_ = kbase + (b) * LY::KBUF; P0 = f32x16{}; P1 = f32x16{}; \
        _Pragma("unroll") for (int d0 = 0; d0 < DQ / 16; ++d0) { const bf16x8 b0_ = *(const LAS bf16x8*)(kb_ + d0 * 32); const bf16x8 b1_ = *(const LAS bf16x8*)(kb_ + 32 * LY::KROW + d0 * 32); \
            P0 = __builtin_amdgcn_mfma_f32_32x32x16_bf16(b0_, qr[d0], P0, 0, 0, 0); P1 = __builtin_amdgcn_mfma_f32_32x32x16_bf16(b1_, qr[d0], P1, 0, 0, 0); } } while (0)
#define D_PK4(P, BASE, OUT) do { v4u w = {cvtpk(P[BASE + 0], P[BASE + 1]), cvtpk(P[BASE + 2], P[BASE + 3]), cvtpk(P[BASE + 4], P[BASE + 5]), cvtpk(P[BASE + 6], P[BASE + 7])}; OUT = *reinterpret_cast<bf16x8*>(&w); } while (0)
#define D_FIN(P0, P1) do { _Pragma("unroll") for (int r = 0; r < 16; ++r) { P0[r] = __builtin_amdgcn_exp2f(P0[r]); if (r < 12) P1[r] = __builtin_amdgcn_exp2f(P1[r]); }     \
        D_PK4(P0, 0, pa0); D_PK4(P0, 8, pa1); D_PK4(P1, 0, pa2); D_PK4(P1, 8, pa3); } while (0)
#define PKVF(L, H) (bf16x8){L[0], L[1], L[2], L[3], H[0], H[1], H[2], H[3]}
#define D_ADDA(ACC, X) asm("v_add_f32 %0, %0, %1" : "+v"(ACC) : "v"(X))
#define D_MMA4(OD, PA, L, H, PC, R0) do { OD = __builtin_amdgcn_mfma_f32_32x32x16_bf16(PA, PKVF(L, H), OD, 0, 0, 0); \
        D_ADDA(l0, PC[R0]); D_ADDA(l1, PC[R0 + 1]); D_ADDA(l2, PC[R0 + 2]); D_ADDA(l3, PC[R0 + 3]); SBAR(); } while (0)
#define D_MMA4X(OD, PA, L, H, PC, R0, HAVEN, PN, RX) do { OD = __builtin_amdgcn_mfma_f32_32x32x16_bf16(PA, PKVF(L, H), OD, 0, 0, 0); \
        D_ADDA(l0, PC[R0]); D_ADDA(l1, PC[R0 + 1]); D_ADDA(l2, PC[R0 + 2]); D_ADDA(l3, PC[R0 + 3]); if (HAVEN) PN[RX] = __builtin_amdgcn_exp2f(PN[RX]); SBAR(); } while (0)
#define D_STEP(HAVEN, PN0, PN1, SN, PC0, PC1, SC) do { VF fa_, fb_; const int vb_ = vb0 + (SC) * LY::VBUF; \
        v_issue<0>(fa_, vb_); SBAR(); \
        if (HAVEN) D_QKT(PN0, PN1, SN); \
        D_FIN(PC0, PC1); \
        asm volatile("s_waitcnt lgkmcnt(0)" ::: "memory"); SBAR(); \
        v_issue<1>(fb_, vb_); \
        D_MMA4(o[0], pa0, fa_.l0, fa_.h0, PC0, 0); D_MMA4(o[0], pa1, fa_.l1, fa_.h1, PC0, 4); D_MMA4(o[0], pa2, fa_.l2, fa_.h2, PC0, 8); D_MMA4(o[0], pa3, fa_.l3, fa_.h3, PC0, 12); \
        asm volatile("s_waitcnt lgkmcnt(0)" ::: "memory"); SBAR(); \
        D_MMA4X(o[1], pa0, fb_.l0, fb_.h0, PC1, 0, HAVEN, PN1, 12); D_MMA4X(o[1], pa1, fb_.l1, fb_.h1, PC1, 4, HAVEN, PN1, 13); D_MMA4X(o[1], pa2, fb_.l2, fb_.h2, PC1, 8, HAVEN, PN1, 14); D_MMA4X(o[1], pa3, fb_.l3, fb_.h3, PC1, 12, HAVEN, PN1, 15); } while (0)
#define NEXT5(x) ((x) == 4 ? 0 : (x) + 1)
    if (wid >= 4) __builtin_amdgcn_s_setprio(1);
    D_DMA(0, 0); D_DMA(1, 1); D_DMA(2, 2); D_DMA(3, 3);
    D_BAR(6);
    D_QKT(pA0, pA1, 0);
    _Pragma("unroll") for (int r = 12; r < 16; ++r) pA1[r] = __builtin_amdgcn_exp2f(pA1[r]);
    int sl_pv = 0, sl_qk = 1, sl_d = 4;
    for (int j = 1; j + 1 < NT; j += 2) {
        { const int tt = (j + 3 < NT) ? j + 3 : NT - 1; D_DMA(tt, sl_d); }
        D_STEP(true, pB0, pB1, sl_qk, pA0, pA1, sl_pv);
        D_BAR(6);
        sl_pv = sl_qk; sl_qk = NEXT5(sl_qk); sl_d = NEXT5(sl_d);
        { const int tt = (j + 4 < NT) ? j + 4 : NT - 1; D_DMA(tt, sl_d); }
        D_STEP(true, pA0, pA1, sl_qk, pB0, pB1, sl_pv);
        D_BAR(6);
        sl_pv = sl_qk; sl_qk = NEXT5(sl_qk); sl_d = NEXT5(sl_d);
    }
    D_STEP(true, pB0, pB1, sl_qk, pA0, pA1, sl_pv);
    D_STEP(false, pA0, pA1, 0, pB0, pB1, sl_qk);
#undef NEXT5
    LAS char* ost = lds + LY::OST_OFF + wid * 4096;
    float l_reg = (l0 + l1) + (l2 + l3);
    { auto rr = __builtin_amdgcn_permlane32_swap(__float_as_uint(l_reg), __float_as_uint(l_reg), false, false); l_reg = __uint_as_float(rr[0]) + __uint_as_float(rr[1]); }
    if (hi == 0) wsf[r32] = __builtin_amdgcn_rcpf(l_reg);
    asm volatile("s_waitcnt lgkmcnt(0)" ::: "memory");
#pragma unroll
    for (int r = 0; r < 16; ++r) { const int orow = crow(r, hi); const float rl = wsf[orow];
        *(LAS unsigned short*)(ost + orow * 128 + r32 * 2) = (unsigned short)f2bf(o[0][r] * rl); *(LAS unsigned short*)(ost + orow * 128 + 64 + r32 * 2) = (unsigned short)f2bf(o[1][r] * rl); }
    asm volatile("s_waitcnt lgkmcnt(0)" ::: "memory");
    bf16* Ow = Op + (long)(wid * 32) * ldo;
#pragma unroll
    for (int i = 0; i < 4; ++i) { const int row = (lane >> 3) + 8 * i, ch = lane & 7; const v4u v = *(const LAS v4u*)(ost + row * 128 + ch * 16); *(v4u*)(Ow + (long)row * ldo + ch * 8) = v; }
    __builtin_amdgcn_s_setprio(0);
    asm volatile("s_waitcnt vmcnt(0)" ::: "memory");
    __syncthreads();
#undef D_DMA
#undef D_BAR
#undef D_QKT
#undef D_PK4
#undef D_FIN
#undef D_STEP
#undef D_MMA4
#undef D_MMA4X
#undef D_ADDA
#undef PKVF
}
__device__ __forceinline__ float wave_absmax(const float* g, int n) { int tid = threadIdx.x; const int lane = tid & 63; float m = 0.f; for (int i = lane; i < n; i += 64) m = fmaxf(m, fabsf(g[i]));
#pragma unroll
    for (int o = 1; o < 64; o <<= 1) m = fmaxf(m, __shfl_xor(m, o));
    return __builtin_bit_cast(float, __builtin_amdgcn_readfirstlane(__builtin_bit_cast(int, m))); }
}
namespace pg8 {
struct EpiResGate {
    static constexpr bool PERM = false, AFTER_DRAIN = false;
    const float* base; float* out; const long long* gate; float sc;
    __device__ __forceinline__ void operator()(const f32x4 (&acc)[2][2][4][2], const Unit& u, int wr, int wc, int fr, int fq) const {
        const int b = u.pm >> 4; const int col0 = u.pn * BM + wc * 32 + 4 * fq; const long long* gp = gate + b * 6144 + col0;
        f32x4 gv[2][2];
#pragma unroll
        for (int bj = 0; bj < 2; ++bj)
#pragma unroll
            for (int n = 0; n < 2; ++n) { const long long* q = gp + bj * HALF + n * 16; gv[bj][n] = (f32x4){(float)q[0], (float)q[1], (float)q[2], (float)q[3]} * (9.094947017729282e-13f * sc); }
#pragma unroll
        for (int ai = 0; ai < 2; ++ai)
#pragma unroll
            for (int m = 0; m < 4; ++m) { const size_t off = (size_t)(u.pm * BM + ai * HALF + wr * 64 + m * 16 + fr) * 1024 + col0;
#pragma unroll
                for (int bj = 0; bj < 2; ++bj)
#pragma unroll
                    for (int n = 0; n < 2; ++n) { const f32x4 bs = *(const f32x4*)(base + off + bj * HALF + n * 16); *(f32x4*)(out + off + bj * HALF + n * 16) = bs + gv[bj][n] * acc[ai][bj][m][n]; }
                if (m & 1) asm volatile("" ::: "memory"); }
    }
};

template <bool BASEF32> struct EpiResB {
    static constexpr bool PERM = true, AFTER_DRAIN = false;
    const void* base; bf16_t* out; const long long* gate; float sc;
    __device__ __forceinline__ void operator()(const f32x4 (&acc)[2][2][4][2], const Unit& u, int wr, int wc, int fr, int fq) const {
        const int b = u.pm >> 4; const int col0 = u.pn * BM + wc * 32 + 8 * fq; const long long* gp = gate + b * 6144 + col0;
        float gv[2][8];
#pragma unroll
        for (int bj = 0; bj < 2; ++bj)
#pragma unroll
            for (int e = 0; e < 8; ++e) gv[bj][e] = (float)gp[bj * HALF + e] * (9.094947017729282e-13f * sc);
        constexpr int GM = BASEF32 ? 2 : 4;
#pragma unroll
        for (int ai = 0; ai < 2; ++ai)
#pragma unroll
            for (int mg = 0; mg < 4; mg += GM) {
                f32x4 rf[GM][2][2]; u32x4 rh[GM][2];
#pragma unroll
                for (int mi = 0; mi < GM; ++mi) { const size_t row = (size_t)(u.pm * BM + ai * HALF + wr * 64 + (mg + mi) * 16 + fr);
#pragma unroll
                    for (int bj = 0; bj < 2; ++bj) {
                        if (BASEF32) { rf[mi][bj][0] = *(const f32x4*)((const float*)base + row * 1024 + col0 + bj * HALF); rf[mi][bj][1] = *(const f32x4*)((const float*)base + row * 1024 + col0 + bj * HALF + 4); }
                        else rh[mi][bj] = *(const u32x4*)((const bf16_t*)base + row * 2048 + col0 + bj * HALF); } }
#pragma unroll
                for (int mi = 0; mi < GM; ++mi) { const int m = mg + mi; const size_t row = (size_t)(u.pm * BM + ai * HALF + wr * 64 + m * 16 + fr);
#pragma unroll
                    for (int bj = 0; bj < 2; ++bj) { float bs[8];
                        if (BASEF32) { const f32x4 b0 = rf[mi][bj][0], b1 = rf[mi][bj][1];
                            bs[0] = b0[0]; bs[1] = b0[1]; bs[2] = b0[2]; bs[3] = b0[3]; bs[4] = b1[0]; bs[5] = b1[1]; bs[6] = b1[2]; bs[7] = b1[3]; }
                        else { const u32x4 r = rh[mi][bj];
                            bs[0] = __builtin_bit_cast(float, r.x << 16); bs[1] = __builtin_bit_cast(float, r.x & 0xffff0000u); bs[2] = __builtin_bit_cast(float, r.y << 16); bs[3] = __builtin_bit_cast(float, r.y & 0xffff0000u);
                            bs[4] = __builtin_bit_cast(float, r.z << 16); bs[5] = __builtin_bit_cast(float, r.z & 0xffff0000u); bs[6] = __builtin_bit_cast(float, r.w << 16); bs[7] = __builtin_bit_cast(float, r.w & 0xffff0000u); }
                        const f32x4 a0 = acc[ai][bj][m][0], a1 = acc[ai][bj][m][1];
                        u32x4 w; w.x = cvt_pk_bf16(bs[0] + gv[bj][0] * a0[0], bs[1] + gv[bj][1] * a0[1]); w.y = cvt_pk_bf16(bs[2] + gv[bj][2] * a0[2], bs[3] + gv[bj][3] * a0[3]);
                        w.z = cvt_pk_bf16(bs[4] + gv[bj][4] * a1[0], bs[5] + gv[bj][5] * a1[1]); w.w = cvt_pk_bf16(bs[6] + gv[bj][6] * a1[2], bs[7] + gv[bj][7] * a1[3]);
                        *(u32x4*)(out + row * 2048 + col0 + bj * HALF) = w; } }
                asm volatile("" ::: "memory"); }
    }
};
__device__ __forceinline__ f32x2 silu2(f32x2 ag, f32x2 au, float c1, float k) {
    const f32x2 t = ag * c1; f32x2 e; e.x = __builtin_amdgcn_exp2f(t.x); e.y = __builtin_amdgcn_exp2f(t.y);
    const f32x2 d = e * k + k; f32x2 r; r.x = __builtin_amdgcn_rcpf(d.x); r.y = __builtin_amdgcn_rcpf(d.y);
    return (ag * au) * r;
}
__device__ __forceinline__ float silu_mul(float g, float u) { return g * __builtin_amdgcn_rcpf(1.0f + __builtin_amdgcn_exp2f(-1.4426950408889634f * g)) * u; }
struct EpiSwiGLU {
    static constexpr bool PERM = true, AFTER_DRAIN = false;
    bf16_t* O; int ldo; int nNe; int pm0;
    __device__ __forceinline__ void operator()(const f32x4 (&acc)[2][2][4][2], const Unit& u, int wr, int wc, int fr, int fq) const {
        const int pnl = u.pn % nNe; const int col0 = pnl * HALF + wc * 32 + 8 * fq; const int row0 = (u.pm - pm0) * BM + wr * 64 + fr;
#pragma unroll
        for (int ai = 0; ai < 2; ++ai)
#pragma unroll
            for (int m = 0; m < 4; ++m) { bf16_t* rowp = O + (size_t)(row0 + ai * HALF + m * 16) * ldo + col0;
                const f32x4 g0 = acc[ai][0][m][0], g1 = acc[ai][0][m][1], u0 = acc[ai][1][m][0], u1 = acc[ai][1][m][1];
                const f32x2 y0 = silu2((f32x2){g0[0], g0[1]}, (f32x2){u0[0], u0[1]}, -1.4426950408889634f, 1.0f), y1 = silu2((f32x2){g0[2], g0[3]}, (f32x2){u0[2], u0[3]}, -1.4426950408889634f, 1.0f);
                const f32x2 y2 = silu2((f32x2){g1[0], g1[1]}, (f32x2){u1[0], u1[1]}, -1.4426950408889634f, 1.0f), y3 = silu2((f32x2){g1[2], g1[3]}, (f32x2){u1[2], u1[3]}, -1.4426950408889634f, 1.0f);
                u32x4 w; w.x = cvt_pk_bf16(y0.x, y0.y); w.y = cvt_pk_bf16(y1.x, y1.y); w.z = cvt_pk_bf16(y2.x, y2.y); w.w = cvt_pk_bf16(y3.x, y3.y);
                *(u32x4*)rowp = w; }
    }
};

struct EpiSwiGLU8 {
    static constexpr bool PERM = true, AFTER_DRAIN = false;
    unsigned char* O; int ldo; int nNe; int pm0; float SI;
    __device__ __forceinline__ void operator()(const f32x4 (&acc)[2][2][4][2], const Unit& u, int wr, int wc, int fr, int fq) const {
        const int pnl = u.pn % nNe; const int col0 = pnl * HALF + wc * 32 + 8 * fq; const int row0 = (u.pm - pm0) * BM + wr * 64 + fr;
#pragma unroll
        for (int ai = 0; ai < 2; ++ai)
#pragma unroll
            for (int m = 0; m < 4; ++m) { unsigned char* rowp = O + (size_t)(row0 + ai * HALF + m * 16) * ldo + col0;
                const float C1 = -1.4426950408889634f * SI, KK = 1.0f / (SI * SI * F8_AS);
                const f32x4 g0 = acc[ai][0][m][0], g1 = acc[ai][0][m][1], u0 = acc[ai][1][m][0], u1 = acc[ai][1][m][1];
                const f32x2 y0 = silu2((f32x2){g0[0], g0[1]}, (f32x2){u0[0], u0[1]}, C1, KK), y1 = silu2((f32x2){g0[2], g0[3]}, (f32x2){u0[2], u0[3]}, C1, KK);
                const f32x2 y2 = silu2((f32x2){g1[0], g1[1]}, (f32x2){u1[0], u1[1]}, C1, KK), y3 = silu2((f32x2){g1[2], g1[3]}, (f32x2){u1[2], u1[3]}, C1, KK);
#define M448(v) __builtin_amdgcn_fmed3f((v), -448.f, 448.f)
                u32x2_t w; w.x = pk4_fp8(M448(y0.x), M448(y0.y), M448(y1.x), M448(y1.y)); w.y = pk4_fp8(M448(y2.x), M448(y2.y), M448(y3.x), M448(y3.y));
#undef M448
                *(u32x2_t*)rowp = w; }
    }
};
struct EpiMoeDown {
    static constexpr bool PERM = true, AFTER_DRAIN = false;
    bf16_t* Y; const float* gs; int pm0; float sc;
    __device__ __forceinline__ void operator()(const f32x4 (&acc)[2][2][4][2], const Unit& u, int wr, int wc, int fr, int fq) const {
        const int pnl = u.pn & 3; const int col0 = pnl * BM + wc * 32 + 8 * fq; const int row0 = (u.pm + pm0) * BM + wr * 64 + fr;
        float gsv[8];
#pragma unroll
        for (int i = 0; i < 8; ++i) gsv[i] = gs[row0 + (i >> 2) * HALF + (i & 3) * 16];
#pragma unroll
        for (int ai = 0; ai < 2; ++ai)
#pragma unroll
            for (int m = 0; m < 4; ++m) { const int row = row0 + ai * HALF + m * 16; const float g = gsv[ai * 4 + m] * sc; bf16_t* rowp = Y + (size_t)row * 1024 + col0;
#pragma unroll
                for (int bj = 0; bj < 2; ++bj) { const f32x4 v0 = acc[ai][bj][m][0] * g, v1 = acc[ai][bj][m][1] * g;
                    u32x4 w; w.x = cvt_pk_bf16(v0[0], v0[1]); w.y = cvt_pk_bf16(v0[2], v0[3]); w.z = cvt_pk_bf16(v1[0], v1[1]); w.w = cvt_pk_bf16(v1[2], v1[3]);
                    *(u32x4*)(rowp + bj * HALF) = w; } }
    }
};

struct EpiQKRope {
    static constexpr bool PERM = true, AFTER_DRAIN = false;
    bf16_t* O; const float* gq; const float* gk;
    static constexpr size_t HM = (size_t)65536 * 1024;
    __device__ __forceinline__ void operator()(const f32x4 (&acc)[2][2][4][2], const Unit& u, int wr, int wc, int fr, int fq) const {
        const int row0 = u.pm * BM + wr * 64 + fr;
        if (u.pn >= 8) {
#pragma unroll
            for (int ai = 0; ai < 2; ++ai)
#pragma unroll
                for (int m = 0; m < 4; ++m) { const int row = row0 + ai * HALF + m * 16; const size_t bt = (size_t)(row >> 12) * 16 * 4096 + (row & 4095);
#pragma unroll
                    for (int bj = 0; bj < 2; ++bj) { const f32x4 v0 = acc[ai][bj][m][0], v1 = acc[ai][bj][m][1]; const int head = (u.pn - 8) * 4 + 2 * bj + (wc >> 1);
                        u32x4 w; w.x = cvt_pk_bf16(v0[0], v0[1]); w.y = cvt_pk_bf16(v0[2], v0[3]); w.z = cvt_pk_bf16(v1[0], v1[1]); w.w = cvt_pk_bf16(v1[2], v1[3]);
                        *(u32x4*)(O + (size_t)2 * HM + (bt + (size_t)head * 4096) * 64 + 32 * (wc & 1) + 8 * fq) = w; } }
            return;
        }
        const bool isk = u.pn >= 4; const float* gp = isk ? gk : gq; const float qs = isk ? 1.0f : (0.125f * 1.4426950408889634f);
        const int head = 4 * (u.pn & 3) + wc; bf16_t* Ob = O + (isk ? HM : (size_t)0) + (size_t)head * 4096 * 64 + 8 * fq;
        float g1[8], g2[8], rv[8];
#pragma unroll
        for (int e = 0; e < 8; ++e) { g1[e] = gp[8 * fq + e] * qs; g2[e] = gp[32 + 8 * fq + e] * qs; rv[e] = __builtin_amdgcn_exp2f(-(float)(8 * fq + e) * (13.287712379549449f / 32.f)) * 0.15915494309189535f; }
#pragma unroll
        for (int ai = 0; ai < 2; ++ai)
#pragma unroll
            for (int m = 0; m < 4; ++m) { const int row = row0 + ai * HALF + m * 16; const float pos = (float)(row & 4095);
                float x1[8], x2[8]; float ss = 0.f;
#pragma unroll
                for (int n = 0; n < 2; ++n)
#pragma unroll
                    for (int i = 0; i < 4; ++i) { x1[4 * n + i] = acc[ai][0][m][n][i]; x2[4 * n + i] = acc[ai][1][m][n][i]; ss += x1[4 * n + i] * x1[4 * n + i] + x2[4 * n + i] * x2[4 * n + i]; }
                ss += __shfl_xor(ss, 16); ss += __shfl_xor(ss, 32);
                const float rs = __builtin_amdgcn_rsqf(ss * (1.f / 64.f) + 1e-6f);
                float o1[8], o2[8];
#pragma unroll
                for (int e = 0; e < 8; ++e) { const float fr_ = __builtin_amdgcn_fractf(pos * rv[e]); const float c = __builtin_amdgcn_cosf(fr_), s = __builtin_amdgcn_sinf(fr_);
                    const float a = x1[e] * rs * g1[e], b = x2[e] * rs * g2[e]; o1[e] = a * c - b * s; o2[e] = a * s + b * c; }
                bf16_t* rowp = Ob + ((size_t)(row >> 12) * 16 * 4096 + (row & 4095)) * 64;
                u32x4 w; w.x = cvt_pk_bf16(o1[0], o1[1]); w.y = cvt_pk_bf16(o1[2], o1[3]); w.z = cvt_pk_bf16(o1[4], o1[5]); w.w = cvt_pk_bf16(o1[6], o1[7]); *(u32x4*)rowp = w;
                w.x = cvt_pk_bf16(o2[0], o2[1]); w.y = cvt_pk_bf16(o2[2], o2[3]); w.z = cvt_pk_bf16(o2[4], o2[5]); w.w = cvt_pk_bf16(o2[6], o2[7]); *(u32x4*)(rowp + 32) = w; }
    }
};
struct EpiQKRopeI8 {
    static constexpr bool PERM = true, AFTER_DRAIN = false;
    bf16_t* O; const float* gq; const float* gk; const float* rowscale; const unsigned* wamax;
    static constexpr size_t HM = (size_t)65536 * 1024;
    __device__ __forceinline__ void operator()(const i32x4_t (&acc)[2][2][4][2], const Unit& u, int wr, int wc, int fr, int fq) const {
        const int row0 = u.pm * BM + wr * 64 + fr; const float ws_ = __builtin_bit_cast(float, *wamax) * (1.f / 127.f);
        float rsv[8];
#pragma unroll
        for (int i = 0; i < 8; ++i) rsv[i] = rowscale[row0 + (i >> 2) * HALF + (i & 3) * 16];
        if (u.pn >= 8) {
#pragma unroll
            for (int ai = 0; ai < 2; ++ai)
#pragma unroll
                for (int m = 0; m < 4; ++m) { const int row = row0 + ai * HALF + m * 16; const size_t bt = (size_t)(row >> 12) * 16 * 4096 + (row & 4095);
#pragma unroll
                    for (int bj = 0; bj < 2; ++bj) { const float s_ = rsv[ai * 4 + m] * ws_; const i32x4_t a0 = acc[ai][bj][m][0], a1 = acc[ai][bj][m][1]; const f32x4 v0 = (f32x4){(float)a0[0], (float)a0[1], (float)a0[2], (float)a0[3]} * s_, v1 = (f32x4){(float)a1[0], (float)a1[1], (float)a1[2], (float)a1[3]} * s_; const int head = (u.pn - 8) * 4 + 2 * bj + (wc >> 1);
                        u32x2_t w; w.x = pk4_fp8(v0[0], v0[1], v0[2], v0[3]); w.y = pk4_fp8(v1[0], v1[1], v1[2], v1[3]);
                        *(u32x2_t*)((unsigned char*)(O + (size_t)2 * HM) + (bt + (size_t)head * 4096) * 64 + 32 * (wc & 1) + 8 * fq) = w; } }
            return;
        }
        const bool isk = u.pn >= 4; const float* gp = isk ? gk : gq; const float qs = isk ? 1.0f : (0.125f * 1.4426950408889634f);
        const int head = 4 * (u.pn & 3) + wc; bf16_t* Ob = O + (isk ? HM : (size_t)0) + (size_t)head * 4096 * 64 + 8 * fq;
        float g1[8], g2[8], rv[8];
#pragma unroll
        for (int e = 0; e < 8; ++e) { g1[e] = gp[8 * fq + e] * qs; g2[e] = gp[32 + 8 * fq + e] * qs; rv[e] = __builtin_amdgcn_exp2f(-(float)(8 * fq + e) * (13.287712379549449f / 32.f)) * 0.15915494309189535f; }
#pragma unroll
        for (int ai = 0; ai < 2; ++ai)
#pragma unroll
            for (int m = 0; m < 4; ++m) { const int row = row0 + ai * HALF + m * 16; const float pos = (float)(row & 4095); const float s_ = rsv[ai * 4 + m] * ws_;
                float x1[8], x2[8]; float ss = 0.f;
#pragma unroll
                for (int n = 0; n < 2; ++n)
#pragma unroll
                    for (int i = 0; i < 4; ++i) { x1[4 * n + i] = (float)acc[ai][0][m][n][i] * s_; x2[4 * n + i] = (float)acc[ai][1][m][n][i] * s_; ss += x1[4 * n + i] * x1[4 * n + i] + x2[4 * n + i] * x2[4 * n + i]; }
                ss += __shfl_xor(ss, 16); ss += __shfl_xor(ss, 32);
                const float rs = __builtin_amdgcn_rsqf(ss * (1.f / 64.f) + 1e-6f);
                float o1[8], o2[8];
#pragma unroll
                for (int e = 0; e < 8; ++e) { const float fr_ = __builtin_amdgcn_fractf(pos * rv[e]); const float c = __builtin_amdgcn_cosf(fr_), s = __builtin_amdgcn_sinf(fr_);
                    const float a = x1[e] * rs * g1[e], b = x2[e] * rs * g2[e]; o1[e] = a * c - b * s; o2[e] = a * s + b * c; }
                const size_t ro_ = ((size_t)(row >> 12) * 16 * 4096 + (row & 4095)) * 64;
                if (isk) { unsigned char* r8 = (unsigned char*)(O + HM) + (size_t)head * 4096 * 64 + 8 * fq + ro_;
                    u32x2_t w8; w8.x = pk4_fp8(o1[0], o1[1], o1[2], o1[3]); w8.y = pk4_fp8(o1[4], o1[5], o1[6], o1[7]); *(u32x2_t*)r8 = w8;
                    w8.x = pk4_fp8(o2[0], o2[1], o2[2], o2[3]); w8.y = pk4_fp8(o2[4], o2[5], o2[6], o2[7]); *(u32x2_t*)(r8 + 32) = w8; }
                else { unsigned char* r8 = (unsigned char*)O + (size_t)head * 4096 * 64 + 8 * fq + ro_;
                    u32x2_t w8; w8.x = pk4_fp8(o1[0] * 8.f, o1[1] * 8.f, o1[2] * 8.f, o1[3] * 8.f); w8.y = pk4_fp8(o1[4] * 8.f, o1[5] * 8.f, o1[6] * 8.f, o1[7] * 8.f); *(u32x2_t*)r8 = w8;
                    w8.x = pk4_fp8(o2[0] * 8.f, o2[1] * 8.f, o2[2] * 8.f, o2[3] * 8.f); w8.y = pk4_fp8(o2[4] * 8.f, o2[5] * 8.f, o2[6] * 8.f, o2[7] * 8.f); *(u32x2_t*)(r8 + 32) = w8; } }
    }
};

struct EpiSwiGLUi8 {
    static constexpr bool PERM = true, AFTER_DRAIN = false;
    bf16_t* O; int ldo; const float* rowscale; const unsigned* wamax;
    __device__ __forceinline__ void operator()(const i32x4_t (&acc)[2][2][4][2], const Unit& u, int wr, int wc, int fr, int fq) const {
        const int col0 = u.pn * HALF + wc * 32 + 8 * fq; const int row0 = u.pm * BM + wr * 64 + fr;
        const float ws_ = __builtin_bit_cast(float, *wamax) * (1.f / 127.f);
#pragma unroll
        for (int ai = 0; ai < 2; ++ai)
#pragma unroll
            for (int m = 0; m < 4; ++m) { const int row = row0 + ai * HALF + m * 16; bf16_t* rowp = O + (size_t)row * ldo + col0;
                const float s = rowscale[row] * ws_; const float C1 = -1.4426950408889634f * s, KK = 1.0f / (s * s);
                const i32x4_t g0 = acc[ai][0][m][0], g1 = acc[ai][0][m][1], u0 = acc[ai][1][m][0], u1 = acc[ai][1][m][1];
                const f32x2 y0 = silu2((f32x2){(float)g0[0], (float)g0[1]}, (f32x2){(float)u0[0], (float)u0[1]}, C1, KK), y1 = silu2((f32x2){(float)g0[2], (float)g0[3]}, (f32x2){(float)u0[2], (float)u0[3]}, C1, KK);
                const f32x2 y2 = silu2((f32x2){(float)g1[0], (float)g1[1]}, (f32x2){(float)u1[0], (float)u1[1]}, C1, KK), y3 = silu2((f32x2){(float)g1[2], (float)g1[3]}, (f32x2){(float)u1[2], (float)u1[3]}, C1, KK);
                u32x4 w; w.x = cvt_pk_bf16(y0.x, y0.y); w.y = cvt_pk_bf16(y1.x, y1.y); w.z = cvt_pk_bf16(y2.x, y2.y); w.w = cvt_pk_bf16(y3.x, y3.y);
                *(u32x4*)rowp = w; }
    }
};

struct EpiSwiGLUi8f8 {
    static constexpr bool PERM = true, AFTER_DRAIN = false;
    unsigned char* O; int ldo; const float* rowscale; const unsigned* wamax;
    __device__ __forceinline__ void operator()(const i32x4_t (&acc)[2][2][4][2], const Unit& u, int wr, int wc, int fr, int fq) const {
        const int col0 = u.pn * HALF + wc * 32 + 8 * fq; const int row0 = u.pm * BM + wr * 64 + fr;
        const float ws_ = __builtin_bit_cast(float, *wamax) * (1.f / 127.f);
        float rsv[8];
#pragma unroll
        for (int i = 0; i < 8; ++i) rsv[i] = rowscale[row0 + (i >> 2) * HALF + (i & 3) * 16];
#pragma unroll
        for (int ai = 0; ai < 2; ++ai)
#pragma unroll
            for (int m = 0; m < 4; ++m) { const int row = row0 + ai * HALF + m * 16; unsigned char* rowp = O + (size_t)row * ldo + col0;
                const float s = rsv[ai * 4 + m] * ws_; const float C1 = -1.4426950408889634f * s, KK = 1.0f / (s * s * F8_AS);
                const i32x4_t g0 = acc[ai][0][m][0], g1 = acc[ai][0][m][1], u0 = acc[ai][1][m][0], u1 = acc[ai][1][m][1];
                const f32x2 y0 = silu2((f32x2){(float)g0[0], (float)g0[1]}, (f32x2){(float)u0[0], (float)u0[1]}, C1, KK), y1 = silu2((f32x2){(float)g0[2], (float)g0[3]}, (f32x2){(float)u0[2], (float)u0[3]}, C1, KK);
                const f32x2 y2 = silu2((f32x2){(float)g1[0], (float)g1[1]}, (f32x2){(float)u1[0], (float)u1[1]}, C1, KK), y3 = silu2((f32x2){(float)g1[2], (float)g1[3]}, (f32x2){(float)u1[2], (float)u1[3]}, C1, KK);
#define M448(v) __builtin_amdgcn_fmed3f((v), -448.f, 448.f)
                u32x2_t w; w.x = pk4_fp8(M448(y0.x), M448(y0.y), M448(y1.x), M448(y1.y)); w.y = pk4_fp8(M448(y2.x), M448(y2.y), M448(y3.x), M448(y3.y));
#undef M448
                *(u32x2_t*)rowp = w; }
    }
};

struct EpiBf16I8 {
    static constexpr bool PERM = true, AFTER_DRAIN = false;
    bf16_t* O; int ldc; const float* rowscale; const unsigned* wamax;
    __device__ __forceinline__ void operator()(const i32x4_t (&acc)[2][2][4][2], const Unit& u, int wr, int wc, int fr, int fq) const {
        const int row0 = u.pm * BM + wr * 64 + fr; const int col0 = u.pn * BM + wc * 32 + 8 * fq; const float ws_ = __builtin_bit_cast(float, *wamax) * (1.f / 127.f);
        float rsv[8];
#pragma unroll
        for (int i = 0; i < 8; ++i) rsv[i] = rowscale[row0 + (i >> 2) * HALF + (i & 3) * 16];
#pragma unroll
        for (int ai = 0; ai < 2; ++ai)
#pragma unroll
            for (int m = 0; m < 4; ++m) { const int row = row0 + ai * HALF + m * 16; const float s_ = rsv[ai * 4 + m] * ws_; bf16_t* rowp = O + (size_t)row * ldc + col0;
#pragma unroll
                for (int bj = 0; bj < 2; ++bj) { const i32x4_t a0 = acc[ai][bj][m][0], a1 = acc[ai][bj][m][1];
                    u32x4 w; w.x = cvt_pk_bf16((float)a0[0] * s_, (float)a0[1] * s_); w.y = cvt_pk_bf16((float)a0[2] * s_, (float)a0[3] * s_); w.z = cvt_pk_bf16((float)a1[0] * s_, (float)a1[1] * s_); w.w = cvt_pk_bf16((float)a1[2] * s_, (float)a1[3] * s_);
                    *(u32x4*)(rowp + bj * HALF) = w; } }
    }
};
struct MoeOrder {
    StaticOrder so; int nN, pmA, tile0; int pends[8];
    __device__ void init(int nM_, int nN_, int G_, int c_, int pmA_, int tile0_, const int* pe) { so.nM = nM_; so.nN = nN_; so.nwg = nM_ * nN_; so.G = G_; so.c = c_; nN = nN_; pmA = pmA_; tile0 = tile0_;
#pragma unroll
        for (int j = 0; j < 8; ++j) pends[j] = __builtin_amdgcn_readfirstlane(pe[j]); }
    __device__ bool next(int i, Unit& u) const {
        Unit v; if (!so.next(i, v)) return false;
        const int r0 = (tile0 + v.pm) * BM; int e = 0;
#pragma unroll
        for (int j = 0; j < 7; ++j) e += (r0 >= pends[j]) ? 1 : 0;
        u.pm = v.pm + pmA; u.pn = e * nN + v.pn; return true;
    }
    __device__ __forceinline__ void a_ready(const Unit&) const {}
    __device__ __forceinline__ void done(const Unit&) const {}
};
}

__device__ __forceinline__ void r7_phase(const Args& a, unsigned char* lds_g, int vcu, int G, int tid, int wave, int lane) {
    unsigned char* ws = a.ws; const bf16* x = (const bf16*)a.out; const float* router = a.in[I_ROUTER];
    int* topk = (int*)(ws + WS_TOPK); float* gates = (float*)(ws + WS_GATES); int* blkcnt = (int*)(ws + WS_BLKCNT);
    int* hist = (int*)lds_g;
    float rw[4][4][8];
#pragma unroll
    for (int j = 0; j < 4; ++j)
#pragma unroll
        for (int i = 0; i < 4; ++i) { const int col = 4 * lane + 256 * j + i; const f32x4 r0 = *(const f32x4*)(router + col * 8), r1 = *(const f32x4*)(router + col * 8 + 4);
            rw[j][i][0] = r0.x; rw[j][i][1] = r0.y; rw[j][i][2] = r0.z; rw[j][i][3] = r0.w; rw[j][i][4] = r1.x; rw[j][i][5] = r1.y; rw[j][i][6] = r1.z; rw[j][i][7] = r1.w; }
    const modw_t* mod = (const modw_t*)(ws + WS_MOD) + 16 * 6144;
    for (int blk = vcu; blk < 256; blk += G) {
        if (tid < 8) hist[tid] = 0;
        __syncthreads();
        const int b = blk >> 4; ModPar mp; load_modpar(mp, a.in[I_NORM_O_FFN], mod + b * 6144, 3, 4, lane);
        unsigned long long cnt = 0ull;
#pragma unroll 2
        for (int r = 0; r < 32; ++r) { const int row = blk * 256 + wave * 32 + r; f32x4 h[4]; mod_row_f32<true>(x + (size_t)row * XP, mp, h, lane);
            store_row_fp8(ws + A_HP + (size_t)row * 1024, h, lane);
            float lg[8];
#pragma unroll
            for (int e = 0; e < 8; ++e) { float s = 0.f;
#pragma unroll
                for (int j = 0; j < 4; ++j) s += (h[j].x * rw[j][0][e] + h[j].y * rw[j][1][e]) + (h[j].z * rw[j][2][e] + h[j].w * rw[j][3][e]);
                lg[e] = wave_sum(s); }
            int e1 = 0; float v1 = lg[0];
#pragma unroll
            for (int e = 1; e < 8; ++e) if (lg[e] > v1) { v1 = lg[e]; e1 = e; }
            int e2 = -1; float v2 = -INFINITY;
#pragma unroll
            for (int e = 0; e < 8; ++e) if (e != e1 && lg[e] > v2) { v2 = lg[e]; e2 = e; }
            e1 = __builtin_amdgcn_readfirstlane(e1); e2 = __builtin_amdgcn_readfirstlane(e2);
            const float g1 = 1.0f / (1.0f + __expf(v2 - v1)), g2 = 1.0f - g1;
            if (lane == 0) { topk[row] = e1 | (e2 << 8); gates[2 * row] = g1; gates[2 * row + 1] = g2; }
            cnt += (1ull << (8 * e1)) + (1ull << (8 * e2));
        }
        if (lane < 8) atomicAdd(&hist[lane], (int)((cnt >> (8 * lane)) & 255ull));
        __syncthreads();
        if (tid < 8) blkcnt[blk * 8 + tid] = hist[tid];
        __syncthreads();
    }
}

__device__ __forceinline__ void r8_phase(const Args& a, unsigned char* lds_g, int vcu, int G, int tid, int wave, int lane) {
    unsigned char* ws = a.ws;
    const int* topk = (const int*)(ws + WS_TOPK); const float* gates = (const float*)(ws + WS_GATES); const int* blkcnt = (const int*)(ws + WS_BLKCNT);
    int* slots = (int*)(ws + WS_SLOTS); float* gslot = (float*)(ws + WS_GSLOT); int* pends_g = (int*)(ws + WS_PENDS); int* tokslot = (int*)(ws + WS_TOKSLOT);
    int* tot = (int*)lds_g; int* base = tot + 8; int* pst = tot + 16; int* wcnt = tot + 32;
    if (tid < 8) tot[tid] = 0;
    __syncthreads();
    for (int idx = tid; idx < 2048; idx += 512) atomicAdd(&tot[idx & 7], blkcnt[idx]);
    __syncthreads();
    if (tid == 0) { int p = 0; for (int e = 0; e < 8; ++e) { pst[e] = p; p += (tot[e] + 255) & ~255; if (vcu == 0) pends_g[e] = p; } }
    __syncthreads();
    if (vcu < 8) { const int e = vcu, lo = pst[e] + tot[e], hi = pst[e] + ((tot[e] + 255) & ~255);
        for (int s = lo + tid; s < hi; s += NWAVES * 64) { tokslot[s] = 0; gslot[s] = 0.f; } }
    for (int blk = vcu; blk < 256; blk += G) {
        if (tid < 8) base[tid] = 0;
        __syncthreads();
        for (int idx = tid; idx < 2048; idx += 512) if ((idx >> 3) < blk) atomicAdd(&base[idx & 7], blkcnt[idx]);
        const int token = blk * 256 + (tid >> 1), k = tid & 1; const int pk = topk[token]; const int ea = k ? ((pk >> 8) & 255) : (pk & 255);
        int rank = 0;
#pragma unroll
        for (int e = 0; e < 8; ++e) { const unsigned long long mask = __ballot(ea == e); if (ea == e) rank = __popcll(mask & ((1ull << lane) - 1ull)); if (lane == 0) wcnt[wave * 8 + e] = __popcll(mask); }
        __syncthreads();
        int s = pst[ea] + base[ea] + rank;
        for (int w = 0; w < wave; ++w) s += wcnt[w * 8 + ea];
        slots[token * 2 + k] = s; gslot[s] = gates[token * 2 + k]; tokslot[s] = token;
        __syncthreads();
    }
}

__device__ __forceinline__ void r9_phase(const Args& a, int gw, int NGW, int lane, float* dst) {
    unsigned char* ws = a.ws; float* out = a.out; const int* slots = (const int*)(ws + WS_SLOTS); const bf16* Y = (const bf16*)(ws + A_Y);
    const modw_t* mod = (const modw_t*)(ws + WS_MOD) + 16 * 6144;
    for (int bi = gw; bi < T / 32; bi += NGW) {
        const int b = bi >> 7; f32x4 gt[4];
#pragma unroll
        for (int j = 0; j < 4; ++j) gt[j] = modv4(mod + b * 6144 + 5 * 1024 + 4 * lane + 256 * j);
        for (int r = 0; r < 32; ++r) { const int row = bi * 32 + r; const int s1 = slots[2 * row], s2 = slots[2 * row + 1];
            const uint2* y1 = (const uint2*)(Y + (size_t)s1 * 1024) + lane; const uint2* y2 = (const uint2*)(Y + (size_t)s2 * 1024) + lane;
            const uint2* xb = (const uint2*)((const bf16*)out + (size_t)row * XP) + lane; f32x4* o = (f32x4*)(dst + (size_t)row * 1024) + lane;
            f32x4 v[4];
#pragma unroll
            for (int j = 0; j < 4; ++j) { const uint2 p = y1[64 * j], q = y2[64 * j], x3 = xb[64 * j];
                v[j].x = bflo(x3.x) + gt[j].x * (bflo(p.x) + bflo(q.x)); v[j].y = bfhi(x3.x) + gt[j].y * (bfhi(p.x) + bfhi(q.x)); v[j].z = bflo(x3.y) + gt[j].z * (bflo(p.y) + bflo(q.y)); v[j].w = bfhi(x3.y) + gt[j].w * (bfhi(p.y) + bfhi(q.y)); }
            asm volatile("s_waitcnt vmcnt(0)" ::: "memory");
#pragma unroll
            for (int j = 0; j < 4; ++j) o[64 * j] = v[j];
            asm volatile("" ::: "memory"); }
    }
}

#ifndef MK_PER_PHASE
#define MK_PER_PHASE 0
#endif
__global__ void __launch_bounds__(NWAVES * 64, 2) mega_fwd(Args args) {
    extern __shared__ __attribute__((aligned(16))) unsigned char lds_raw[];
    LAS unsigned char* lds = (LAS unsigned char*)lds_raw;
    volatile LAS unsigned* MISC = (volatile LAS unsigned*)(lds + MISC_OFF);
    const int G = gridDim.x, bx = blockIdx.x; const int vcu = (G % 8 == 0) ? (bx % 8) * (G / 8) + bx / 8 : bx;
    const int NGW = G * NWAVES;
    unsigned char* ws = args.ws;
    for (int u = threadIdx.x; u < (LDS_BYTES - LDS_ZERO_OFF) / 4; u += NWAVES * 64) ((LAS unsigned*)(lds + LDS_ZERO_OFF))[u] = 0u;
#define IDS() int tid = threadIdx.x; asm volatile("" : "+v"(tid)); const int lane = tid & 63, wave = __builtin_amdgcn_readfirstlane(tid >> 6); const int gw = vcu * NWAVES + wave; (void)lane; (void)gw
    __syncthreads();
    XcdBarrier bar; bar.bar = (unsigned*)(ws + WS_CTL) + CW_BAR; bar.x = 0; bar.st = nullptr;
    if (!MK_PER_PHASE) bar = xcd_barrier_post((unsigned*)(ws + WS_CTL) + CW_BAR, MISC + 8);
    const int lo = args.ph_lo, hi = args.ph_hi;
#define IN(k) (lo <= (k) && (k) < hi)
#ifndef PROBE_REP
#define PROBE_REP 0u
#endif
#ifndef PROBE_REPN
#define PROBE_REPN 1
#endif
#define PREP(k) for (int rp_ = 0; rp_ < 1 + PROBE_REPN * (int)((PROBE_REP >> (k)) & 1u); ++rp_)
#ifndef PROBE_BARN
#define PROBE_BARN 0
#endif
#define SEAM(k) do { if (!MK_PER_PHASE) { if (IN(k) && IN((k) + 1)) { xcd_barrier(bar); for (int pb_ = 0; pb_ < PROBE_BARN; ++pb_) xcd_barrier(bar); } } } while (0)
    const bool ROWLOCAL = false && (G * 256 == T);
#define LOCAL_SEAM() do { __builtin_amdgcn_fence(__ATOMIC_RELEASE, "agent"); asm volatile("s_waitcnt vmcnt(0)" ::: "memory"); __syncthreads(); __builtin_amdgcn_fence(__ATOMIC_ACQUIRE, "agent"); } while (0)
    const modw_t* mod_e = (const modw_t*)(ws + WS_MOD); const modw_t* mod_o = mod_e + 16 * 6144;
    bf16* H = (bf16*)(ws + A_H);
    bf16* XB = (bf16*)args.out;

    if (IN(0)) { IDS(); p0_prologue(args, lds, gw, NGW, wave, lane); } SEAM(0);
    if (IN(1)) PREP(1) { IDS(); modulate_phase<false, false, true>(args.in[I_X], args.in[I_NORM_E_MIX], mod_e, 0, 1, H, gw, NGW, lane, (float*)(ws + WS_ROWSC));
#if FFN_FP8 == 0 || FFN_FP8 == 3
        {
            LAS float* scr = (LAS float*)(lds + wave * 16384); const float wsc = 127.f / fmaxf(__builtin_bit_cast(float, *(const unsigned*)(ws + WS_WAMAX)), 1e-30f);
            for (int it = gw; it < 2 * 1408; it += NGW) { const bool up = it >= 1408; tr_gu_i8(args.in[up ? I_FFN_U : I_FFN_G], 1024, 2816, ws + W_GU, up ? 128 : 0, wsc, up ? it - 1408 : it, scr, lane); }
            const float wsi = 127.f / fmaxf(__builtin_bit_cast(float, *((const unsigned*)(ws + WS_WAMAX) + 2)), 1e-30f);
            for (int it = gw; it < 16 * 37; it += NGW) { const int kb = it / 37, nb = it % 37; transpose_item_i8(args.in[I_W_IN], 1184, 64 * kb, 32 * nb, ws + W_IN + (size_t)(32 * nb) * 1024, 1024, wsi, scr, lane); }
            const float wsq = 127.f / fmaxf(__builtin_bit_cast(float, *((const unsigned*)(ws + WS_WAMAX) + 1)), 1e-30f);
            for (int it = gw; it < 16 * 96; it += NGW) { const int kb = it / 96, nb = it % 96, n0 = 32 * nb; int drow = n0;
                if (n0 < 2048) { const int tt = n0 >> 8, wc_ = (n0 & 255) >> 6, bj = (n0 & 63) >> 5; drow = tt * 256 + bj * 128 + wc_ * 32; }
                transpose_item_i8(args.in[I_DIL_QKV], 3072, 64 * kb, n0, ws + W_QKV + (size_t)drow * 1024, 1024, wsq, scr, lane); }
        }
#endif
    } SEAM(1);
    if (IN(2)) { pg8::Gemm g{H, (const bf16*)(ws + W_IN), T, 1280, 512}; pg8::StaticOrder S; S.init(T, 1280, G, bx);
        pg8::EpiBf16I8 E{(bf16*)(ws + A_P), 1280, (const float*)(ws + WS_ROWSC), (const unsigned*)(ws + WS_WAMAX) + 2};
        pg8::gemm_phase_i8<pg8::EpiBf16I8, pg8::StaticOrder, true, true>(lds, g, S, E); } SEAM(2);
    if (IN(3)) PREP(3) { IDS(); r2_phase(args, gw, NGW, lane); } SEAM(3);
    if (IN(4)) {
        { pg8::Gemm g{(const bf16*)(ws + A_CQ), (const bf16*)(ws + W_UQ), T, 768, 256}; pg8::StaticOrder S; S.init(T, 768, G, bx);
          pg8::EpiBf16<0> E{(bf16*)(ws + A_QA), 768, nullptr, 0, 0, 1.f};
          pg8::gemm_phase<pg8::EpiBf16<0>, pg8::StaticOrder, true, true>(lds, g, S, E); }
        __syncthreads();
        { pg8::Gemm g{(const bf16*)(ws + A_CKV), (const bf16*)(ws + W_UKV), T, 1024, 128}; pg8::StaticOrder S; S.init(T, 1024, G, bx);
          pg8::EpiBf16<0> E{(bf16*)(ws + A_KV), 512, nullptr, 512, (size_t)T * 512, 1.f};
          pg8::gemm_phase<pg8::EpiBf16<0>, pg8::StaticOrder, true, true>(lds, g, S, E); }
    } SEAM(4);
    if (IN(5)) PREP(5) { IDS(); r3_phase(args, gw, NGW, lane); } SEAM(5);
    if (IN(6)) PREP(6) {
        bf16* ATT = (bf16*)(ws + A_ATT0);
        const float bndA = 96.f * att::wave_absmax(args.in[I_MLA_QG], 96) * att::wave_absmax(args.in[I_MLA_KG], 96) * QSCALE_A;
        const float bndB = 64.f * att::wave_absmax(args.in[I_GQA_QG], 64) * att::wave_absmax(args.in[I_GQA_KG], 64) * QSCALE_B;
        for (int L = vcu; L < 2048; L += G) {
            const int u = L & 2047, b = u >> 7, h = (u >> 4) & 7, qb = u & 15; const size_t r0 = (size_t)b * SEQ, rq = r0 + 256 * qb;
            if (bndA < 64.f) att::attn_dense_fast<96>((const bf16*)(ws + A_QA) + rq * 768 + h * 96, 768, args.in[I_MLA_QG], 256 * qb, (const bf16*)(ws + A_KA) + r0 * 768 + h * 96, 768, (const bf16*)(ws + A_KV) + (size_t)T * 512 + r0 * 512 + h * 64, 512,
                                              64, ATT + rq * 1024 + h * 64, 1024, (LAS char*)lds);
            else att::attn_dense<96>((const bf16*)(ws + A_QA) + rq * 768 + h * 96, 768, args.in[I_MLA_QG], 256 * qb, (const bf16*)(ws + A_KA) + r0 * 768 + h * 96, 768, (const bf16*)(ws + A_KV) + (size_t)T * 512 + r0 * 512 + h * 64, 512,
                                              64, ATT + rq * 1024 + h * 64, 1024, (LAS char*)lds);
        }
        for (int L = vcu; L < 2048; L += G) {
            const int u = L & 2047, b = u >> 7, h = (u >> 4) & 7, qb = u & 15; const size_t r0 = (size_t)b * SEQ, rq = r0 + 256 * qb;
            if (bndB < 64.f) att::attn_dense_fast<64>((const bf16*)(ws + A_P) + rq * 1280 + 416 + h * 64, 1280, args.in[I_GQA_QG], 256 * qb, (const bf16*)(ws + A_KB) + r0 * 128 + (h >> 2) * 64, 128, (const bf16*)(ws + A_P) + r0 * 1280 + 1056 + (h >> 2) * 64, 1280,
                                     64, ATT + rq * 1024 + 512 + h * 64, 1024, (LAS char*)lds);
            else att::attn_dense<64>((const bf16*)(ws + A_P) + rq * 1280 + 416 + h * 64, 1280, args.in[I_GQA_QG], 256 * qb, (const bf16*)(ws + A_KB) + r0 * 128 + (h >> 2) * 64, 128, (const bf16*)(ws + A_P) + r0 * 1280 + 1056 + (h >> 2) * 64, 1280,
                                     64, ATT + rq * 1024 + 512 + h * 64, 1024, (LAS char*)lds);
        }
    } SEAM(6);
    if (IN(7)) { pg8::Gemm g{(const bf16*)(ws + A_ATT0), (const bf16*)(ws + W_OUT), T, 1024, 1024}; pg8::StaticOrder S; S.init(T, 1024, G, bx);
        pg8::EpiResB<true> E{args.in[I_X], XB, mod_e + 2 * 1024, 1.f};
        pg8::gemm_phase<pg8::EpiResB<true>, pg8::StaticOrder, true, true>(lds, g, S, E); } SEAM(7);
#if FFN_FP8 == 1
    if (IN(8)) { IDS(); modulate_phase<true, true>(XB, args.in[I_NORM_E_FFN], mod_e, 3, 4, H, gw, NGW, lane); } SEAM(8);
    if (IN(9)) { pg8::Gemm g{H, (const bf16*)(ws + W_GU), T, 5632, 512}; pg8::StaticOrder S; S.init(T, 5632, G, bx);
        pg8::EpiSwiGLU8 E{ws + A_ACT, 2816, 1 << 30, 0, 1.0f / (F8_HS * F8_WS)};
        pg8::gemm_phase8<pg8::EpiSwiGLU8, pg8::StaticOrder, true, true>(lds, g, S, E); } SEAM(9);
    if (IN(10)) { pg8::Gemm g{(const bf16*)(ws + A_ACT), (const bf16*)(ws + W_D), T, 1024, 1408}; pg8::StaticOrder S; S.init(T, 1024, G, bx);
        pg8::EpiResB<false> E{XB, XB, mod_e + 5 * 1024, 1.0f / (F8_AS * F8_WS)};
        pg8::gemm_phase8<pg8::EpiResB<false>, pg8::StaticOrder, true, true>(lds, g, S, E); } SEAM(10);
#elif FFN_FP8 == 2
    if (IN(8)) { IDS(); modulate_phase<false, true>(XB, args.in[I_NORM_E_FFN], mod_e, 3, 4, H, gw, NGW, lane); } SEAM(8);
    if (IN(9)) { pg8::Gemm g{H, (const bf16*)(ws + W_GU), T, 5632, 1024}; pg8::StaticOrder S; S.init(T, 5632, G, bx);
        pg8::EpiSwiGLU8 E{ws + A_ACT, 2816, 1 << 30, 0, 1.0f};
        pg8::gemm_phase<pg8::EpiSwiGLU8, pg8::StaticOrder, true, true>(lds, g, S, E); } SEAM(9);
    if (IN(10)) { pg8::Gemm g{(const bf16*)(ws + A_ACT), (const bf16*)(ws + W_D), T, 1024, 1408}; pg8::StaticOrder S; S.init(T, 1024, G, bx);
        pg8::EpiResB<false> E{XB, XB, mod_e + 5 * 1024, 1.0f / (F8_AS * F8_WS)};
        pg8::gemm_phase8<pg8::EpiResB<false>, pg8::StaticOrder, true, true>(lds, g, S, E); } SEAM(10);
#elif FFN_FP8 == 3
    if (IN(8)) PREP(8) { IDS(); modulate_phase<false, true, true>(XB, args.in[I_NORM_E_FFN], mod_e, 3, 4, H, gw, NGW, lane, (float*)(ws + WS_ROWSC)); }
    if (ROWLOCAL) { if (!MK_PER_PHASE && IN(8) && IN(9)) LOCAL_SEAM(); } else SEAM(8);
    if (IN(9)) { pg8::Gemm g{H, (const bf16*)(ws + W_GU), T, 5632, 512};
        pg8::EpiSwiGLUi8f8 E{ws + A_ACT, 2816, (const float*)(ws + WS_ROWSC), (const unsigned*)(ws + WS_WAMAX)};
        if (ROWLOCAL) { pg8::RowLocalOrder S; S.init(T, 5632, G, vcu); pg8::gemm_phase_i8<pg8::EpiSwiGLUi8f8, pg8::RowLocalOrder, true, true>(lds, g, S, E); }
        else { pg8::StaticOrder S; S.init(T, 5632, G, bx); pg8::gemm_phase_i8<pg8::EpiSwiGLUi8f8, pg8::StaticOrder, true, true>(lds, g, S, E); } } SEAM(9);
    if (IN(10)) { pg8::Gemm g{(const bf16*)(ws + A_ACT), (const bf16*)(ws + W_D), T, 1024, 1408}; pg8::StaticOrder S; S.init(T, 1024, G, bx);
        pg8::EpiResB<false> E{XB, XB, mod_e + 5 * 1024, 1.0f / (F8_AS * F8_WS)};
        pg8::gemm_phase8<pg8::EpiResB<false>, pg8::StaticOrder, true, true>(lds, g, S, E); } SEAM(10);
#else
    if (IN(8)) { IDS(); modulate_phase<false, true, true>(XB, args.in[I_NORM_E_FFN], mod_e, 3, 4, H, gw, NGW, lane, (float*)(ws + WS_ROWSC)); } SEAM(8);
    if (IN(9)) { pg8::Gemm g{H, (const bf16*)(ws + W_GU), T, 5632, 512}; pg8::StaticOrder S; S.init(T, 5632, G, bx);
        pg8::EpiSwiGLUi8 E{(bf16*)(ws + A_ACT), 2816, (const float*)(ws + WS_ROWSC), (const unsigned*)(ws + WS_WAMAX)};
        pg8::gemm_phase_i8<pg8::EpiSwiGLUi8, pg8::StaticOrder, true, true>(lds, g, S, E); } SEAM(9);
    if (IN(10)) { pg8::Gemm g{(const bf16*)(ws + A_ACT), (const bf16*)(ws + W_D), T, 1024, 2816}; pg8::StaticOrder S; S.init(T, 1024, G, bx);
        pg8::EpiResB<false> E{XB, XB, mod_e + 5 * 1024, 1.f};
        pg8::gemm_phase<pg8::EpiResB<false>, pg8::StaticOrder, true, true>(lds, g, S, E); } SEAM(10);
#endif
    if (IN(11)) PREP(11) { IDS(); modulate_phase<false, true, true>(XB, args.in[I_NORM_O_MIX], mod_o, 0, 1, H, gw, NGW, lane, (float*)(ws + WS_ROWSC)); }
    if (ROWLOCAL) { if (!MK_PER_PHASE && IN(11) && IN(12)) LOCAL_SEAM(); } else SEAM(11);
    if (IN(12)) { pg8::Gemm g{H, (const bf16*)(ws + W_QKV), T, 3072, 512};
        pg8::EpiQKRopeI8 E{(bf16*)(ws + A_QKV), args.in[I_DIL_QG], args.in[I_DIL_KG], (const float*)(ws + WS_ROWSC), (const unsigned*)(ws + WS_WAMAX) + 1};
        if (ROWLOCAL) { pg8::RowLocalOrder S; S.init(T, 3072, G, vcu); pg8::gemm_phase_i8<pg8::EpiQKRopeI8, pg8::RowLocalOrder, true, true>(lds, g, S, E); }
        else { pg8::StaticOrder S; S.init(T, 3072, G, bx); pg8::gemm_phase_i8<pg8::EpiQKRopeI8, pg8::StaticOrder, true, true>(lds, g, S, E); } }
      SEAM(13);
#ifndef PROBE_BANDV
#define PROBE_BANDV 0
#endif
#define DVARG ((rp_ + 1 < 1 + PROBE_REPN * (int)((PROBE_REP >> 14) & 1u)) ? PROBE_BANDV : 0)
    if (IN(14)) PREP(14) {
        constexpr size_t HM = (size_t)T * 1024;
        const bf16* QH = (const bf16*)(ws + A_QKV); bf16* O1H = (bf16*)(ws + A_H); bf16* O2H = (bf16*)(ws + A_O2); float* L1 = (float*)(ws + A_LSE1); float* L2 = (float*)(ws + A_LSE2); bf16* ATT = (bf16*)(ws + A_ATT1);
        const float bndC = 64.f * att::wave_absmax(args.in[I_DIL_QG], 64) * att::wave_absmax(args.in[I_DIL_KG], 64) * QSCALE_B;
        for (int bh = vcu; bh < 256; bh += G) {
            const int b = bh >> 4, h = bh & 15; const size_t hb = (size_t)bh * 4096 * 64;
            const bf16* Qb_ = (const bf16*)((const unsigned char*)QH + hb); const bf16* Kb_ = (const bf16*)((const unsigned char*)(QH + HM) + hb); const bf16* Vb_ = (const bf16*)((const unsigned char*)(QH + 2 * HM) + hb);
            if (bndC < 100.f) {
            att::band_phase<false, true>(Qb_, Kb_, Vb_, 1, (bf16*)((unsigned char*)O1H + hb), 64, L1 + (size_t)bh * 4096, nullptr, nullptr, nullptr, nullptr, (LAS char*)lds, DVARG);
            att::band_phase<false, true>(Qb_, Kb_, Vb_, 4, (bf16*)((unsigned char*)O2H + hb), 64, L2 + (size_t)bh * 4096, nullptr, nullptr, nullptr, nullptr, (LAS char*)lds, DVARG);
            asm volatile("s_waitcnt vmcnt(0)" ::: "memory"); __syncthreads();
            att::band_phase<true, true>(Qb_, Kb_, Vb_, 16, ATT + (size_t)b * SEQ * 1024 + h * 64, 1024, nullptr, (bf16*)((unsigned char*)O1H + hb), (bf16*)((unsigned char*)O2H + hb), L1 + (size_t)bh * 4096, L2 + (size_t)bh * 4096, (LAS char*)lds, DVARG);
            } else {
            att::band_phase<false, false>(Qb_, Kb_, Vb_, 1, (bf16*)((unsigned char*)O1H + hb), 64, L1 + (size_t)bh * 4096, nullptr, nullptr, nullptr, nullptr, (LAS char*)lds);
            att::band_phase<false, false>(Qb_, Kb_, Vb_, 4, (bf16*)((unsigned char*)O2H + hb), 64, L2 + (size_t)bh * 4096, nullptr, nullptr, nullptr, nullptr, (LAS char*)lds);
            asm volatile("s_waitcnt vmcnt(0)" ::: "memory"); __syncthreads();
            att::band_phase<true, false>(Qb_, Kb_, Vb_, 16, ATT + (size_t)b * SEQ * 1024 + h * 64, 1024, nullptr, (bf16*)((unsigned char*)O1H + hb), (bf16*)((unsigned char*)O2H + hb), L1 + (size_t)bh * 4096, L2 + (size_t)bh * 4096, (LAS char*)lds);
            }
        }
    }
      SEAM(15);
    if (IN(16)) { pg8::Gemm g{(const bf16*)(ws + A_ATT1), (const bf16*)(ws + W_DO), T, 1024, 1024}; pg8::StaticOrder S; S.init(T, 1024, G, bx);
        pg8::EpiResB<false> E{XB, XB, mod_o + 2 * 1024, 1.f};
        pg8::gemm_phase<pg8::EpiResB<false>, pg8::StaticOrder, true, true>(lds, g, S, E); } SEAM(16);
    if (IN(17)) PREP(17) { IDS(); r7_phase(args, lds_raw, vcu, G, tid, wave, lane); } SEAM(17);
    if (IN(18)) PREP(18) { IDS(); r8_phase(args, lds_raw, vcu, G, tid, wave, lane); } SEAM(18);
    {
        const int* pe = (const int*)(ws + WS_PENDS);
        if (IN(19)) PREP(19) { const int ntot = __builtin_amdgcn_readfirstlane(pe[7]) >> 8;
            pg8::GemmG g{ws + A_HP, (const bf16*)(ws + W_MGU), (const int*)(ws + WS_TOKSLOT), 512, 1024}; pg8::MoeOrder S; S.init(ntot, 28, G, bx, 0, 0, pe);
            pg8::EpiSwiGLU8 E{ws + A_ACTM, 3584, 28, 0, 1.0f / (F8_HS * F8_WS)};
            pg8::gemm_phase8g<pg8::EpiSwiGLU8, pg8::MoeOrder, true, true>(lds, g, S, E); }
        SEAM(19);
        if (IN(20)) { const int ntot = __builtin_amdgcn_readfirstlane(pe[7]) >> 8;
            pg8::Gemm g{(const bf16*)(ws + A_ACTM), (const bf16*)(ws + W_MD), 0, 0, 1792}; pg8::MoeOrder S; S.init(ntot, 4, G, bx, 0, 0, pe);
            pg8::EpiMoeDown E{(bf16*)(ws + A_Y), (const float*)(ws + WS_GSLOT), 0, 1.0f / (F8_AS * F8_WS)};
            pg8::gemm_phase8<pg8::EpiMoeDown, pg8::MoeOrder, true, true>(lds, g, S, E); }
        if (!MK_PER_PHASE) { if (IN(20) && IN(27)) xcd_barrier(bar); }
    }
#ifndef PROBE_R9N
#define PROBE_R9N 0
#endif
    if (IN(27)) { IDS(); for (int rp_ = 0; rp_ < PROBE_R9N; ++rp_) r9_phase(args, gw, NGW, lane, (float*)(ws + A_ATT1)); r9_phase(args, gw, NGW, lane, args.out); }
#undef IN
#undef SEAM
}

extern "C" void kernel_launch(void* const* d_in, const int* in_sizes, int n_in, void* d_out, int out_size, void* d_ws, size_t ws_size, hipStream_t stream) {
    static int grid = 0;
    if (grid == 0) {
        if (n_in != 31 || in_sizes[0] != T * DM || out_size != T * DM || ws_size < WS_NEED) {
            fprintf(stderr, "kernel_launch: expected 31 inputs, x/out of %d floats, >= %zu bytes of workspace; got n_in %d in0 %d out %d ws %zu\n", T * DM, (size_t)WS_NEED, n_in, n_in > 0 ? in_sizes[0] : -1, out_size, ws_size);
            grid = -1; return; }
        int dev = 0, cus = 0, per_cu = 0;
        if (hipGetDevice(&dev) != hipSuccess || hipDeviceGetAttribute(&cus, hipDeviceAttributeMultiprocessorCount, dev) != hipSuccess) { grid = -1; return; }
        if (hipFuncSetAttribute((const void*)mega_fwd, hipFuncAttributeMaxDynamicSharedMemorySize, LDS_BYTES) != hipSuccess) { fprintf(stderr, "kernel_launch: hipFuncSetAttribute failed\n"); grid = -1; return; }
        if (hipOccupancyMaxActiveBlocksPerMultiprocessor(&per_cu, (const void*)mega_fwd, NWAVES * 64, LDS_BYTES) != hipSuccess || per_cu < 1)
            fprintf(stderr, "kernel_launch: note: occupancy query reports %d workgroups per CU\n", per_cu);
        (void)hipGetLastError();
        grid = cus;
    }
    if (grid < 0) return;
    if (hipMemsetAsync((char*)d_ws + WS_CTL, 0, CTL_ZERO_BYTES, stream) != hipSuccess) { fprintf(stderr, "kernel_launch: memset failed\n"); return; }
    Args a{};
    for (int i = 0; i < 31; ++i) a.in[i] = (const float*)d_in[i];
    a.out = (float*)d_out; a.ws = (unsigned char*)d_ws;
#if MK_PER_PHASE
#ifndef REPMASK
#define REPMASK 0u
#endif
    for (int p = 0; p < NPH; ++p) { a.ph_lo = p; a.ph_hi = p + 1; hipLaunchKernelGGL(mega_fwd, dim3(grid), dim3(NWAVES * 64), LDS_BYTES, stream, a);
        if ((REPMASK >> p) & 1u) hipLaunchKernelGGL(mega_fwd, dim3(grid), dim3(NWAVES * 64), LDS_BYTES, stream, a); }
#else
    a.ph_lo = 0; a.ph_hi = NPH;
    hipLaunchKernelGGL(mega_fwd, dim3(grid), dim3(NWAVES * 64), LDS_BYTES, stream, a);
#endif
    const hipError_t le = hipPeekAtLastError();
    if (le != hipSuccess) fprintf(stderr, "kernel_launch: launch failed: %s\n", hipGetErrorName(le));
}
```
